# Optimizing an MI355X kernel written in HIP

```python
import jax, jax.numpy as jnp
from jax import lax
import numpy as np

D_MODEL = 1024
BATCH = 8
SEQ = 4096
DEPTH = 1

EPS = 1e-6
ROPE_THETA = 10000.0
NEG_INF = -1e30

SWA_HEADS = 8
SWA_KV_HEADS = 2
SWA_GROUP = SWA_HEADS // SWA_KV_HEADS
SWA_HEAD_DIM = 64
SWA_WINDOW = 128
SWA_BLOCK = 128

MLA_HEADS = 8
MLA_Q_RANK = 256
MLA_KV_RANK = 128
MLA_NOPE_DIM = 64
MLA_ROPE_DIM = 32
MLA_V_DIM = 64
MLA_QK_DIM = MLA_NOPE_DIM + MLA_ROPE_DIM
MLA_Q_BLOCK = 128

SWA_WIDTH = SWA_HEADS * SWA_HEAD_DIM
MLA_WIDTH = MLA_HEADS * MLA_V_DIM
MIX_WIDTH = SWA_WIDTH + MLA_WIDTH

IN_SIZES = (SWA_HEADS * SWA_HEAD_DIM,
            SWA_KV_HEADS * SWA_HEAD_DIM,
            SWA_KV_HEADS * SWA_HEAD_DIM,
            MLA_Q_RANK,
            MLA_KV_RANK,
            MLA_ROPE_DIM)
IN_WIDTH = int(sum(IN_SIZES))
IN_SPLITS = tuple(int(v) for v in np.cumsum(IN_SIZES)[:-1])

PEER_HEADS = 8
PEER_N_KEYS = 128
PEER_EXPERTS = PEER_N_KEYS * PEER_N_KEYS
PEER_QUERY_DIM = 256
PEER_HALF_DIM = PEER_QUERY_DIM // 2
PEER_TOPK = 16
PEER_TOKEN_BLOCK = 128

N_MOD = 6

kernel_name = "hymba_swa_mla_peer_adaln_encoder"


def rmsnorm(x, gain=None):
    xf = x.astype(jnp.float32)
    y = xf * lax.rsqrt(jnp.mean(xf * xf, axis=-1, keepdims=True) + EPS)
    if gain is not None:
        y = y * gain.astype(jnp.float32)
    return y.astype(x.dtype)


def modulate(h, shift, scale):
    return h * (1.0 + scale[:, None, :]) + shift[:, None, :]


def rope_tables(seq, dim):
    inv = 1.0 / (ROPE_THETA ** (jnp.arange(0, dim, 2, dtype=jnp.float32) / dim))
    ang = jnp.arange(seq, dtype=jnp.float32)[:, None] * inv[None, :]
    return jnp.cos(ang), jnp.sin(ang)


def apply_rope(x, cos, sin):
    xf = x.astype(jnp.float32)
    half = xf.shape[-1] // 2
    x1, x2 = xf[..., :half], xf[..., half:]
    c = cos[None, :, None, :]
    s = sin[None, :, None, :]
    return jnp.concatenate([x1 * c - x2 * s, x2 * c + x1 * s], axis=-1).astype(x.dtype)


def windowed_gqa(q, k, v, sink):
    B, S = q.shape[0], q.shape[1]
    nb = S // SWA_BLOCK
    cos, sin = rope_tables(S, SWA_HEAD_DIM)
    q = apply_rope(q, cos, sin)
    k = apply_rope(k, cos, sin)
    qb = q.reshape(B, nb, SWA_BLOCK, SWA_KV_HEADS, SWA_GROUP, SWA_HEAD_DIM)
    pad = ((0, 0), (SWA_BLOCK, SWA_BLOCK), (0, 0), (0, 0))
    kp = jnp.pad(k, pad).reshape(B, nb + 2, SWA_BLOCK, SWA_KV_HEADS, SWA_HEAD_DIM)
    vp = jnp.pad(v, pad).reshape(B, nb + 2, SWA_BLOCK, SWA_KV_HEADS, SWA_HEAD_DIM)
    kb = jnp.concatenate([kp[:, :-2], kp[:, 1:-1], kp[:, 2:]], axis=2)
    vb = jnp.concatenate([vp[:, :-2], vp[:, 1:-1], vp[:, 2:]], axis=2)
    scores = jnp.einsum('bnqhgd,bnkhd->bnhgqk', qb, kb).astype(jnp.float32) * (SWA_HEAD_DIM ** -0.5)
    q_off = jnp.arange(SWA_BLOCK)[:, None]
    k_off = jnp.arange(3 * SWA_BLOCK)[None, :] - SWA_BLOCK
    band = jnp.abs(k_off - q_off) <= SWA_WINDOW
    k_pos = (jnp.arange(nb) * SWA_BLOCK)[:, None] + k_off
    valid = (k_pos >= 0) & (k_pos < S)
    mask = band[None, :, :] & valid[:, None, :]
    scores = jnp.where(mask[None, :, None, None], scores, NEG_INF)
    sink_l = jnp.broadcast_to(sink.astype(jnp.float32).reshape(1, 1, SWA_KV_HEADS, SWA_GROUP, 1, 1),
                              scores.shape[:-1] + (1,))
    probs = jax.nn.softmax(jnp.concatenate([scores, sink_l], axis=-1), axis=-1)[..., :-1]
    out = jnp.einsum('bnhgqk,bnkhd->bnqhgd', probs.astype(v.dtype), vb)
    return out.reshape(B, S, SWA_WIDTH)


def latent_attention(q_lat, kv_lat, k_rope_raw, q_norm, w_q_up, kv_norm, w_kv_up):
    B, S = q_lat.shape[0], q_lat.shape[1]
    nb = S // MLA_Q_BLOCK
    cos, sin = rope_tables(S, MLA_ROPE_DIM)
    q = (rmsnorm(q_lat, q_norm) @ w_q_up).reshape(B, S, MLA_HEADS, MLA_QK_DIM)
    q_nope = q[..., :MLA_NOPE_DIM]
    q_rope = apply_rope(q[..., MLA_NOPE_DIM:], cos, sin)
    kv = (rmsnorm(kv_lat, kv_norm) @ w_kv_up).reshape(B, S, MLA_HEADS, MLA_NOPE_DIM + MLA_V_DIM)
    k_nope = kv[..., :MLA_NOPE_DIM]
    v = kv[..., MLA_NOPE_DIM:]
    k_rope = apply_rope(k_rope_raw[:, :, None, :], cos, sin)[:, :, 0, :]
    scale = MLA_QK_DIM ** -0.5
    qn_blocks = q_nope.reshape(B, nb, MLA_Q_BLOCK, MLA_HEADS, MLA_NOPE_DIM).transpose(1, 0, 2, 3, 4)
    qr_blocks = q_rope.reshape(B, nb, MLA_Q_BLOCK, MLA_HEADS, MLA_ROPE_DIM).transpose(1, 0, 2, 3, 4)

    def attend(blk):
        qn, qr = blk
        s = (jnp.einsum('bqhd,bkhd->bhqk', qn, k_nope)
             + jnp.einsum('bqhd,bkd->bhqk', qr, k_rope)).astype(jnp.float32) * scale
        p = jax.nn.softmax(s, axis=-1).astype(v.dtype)
        return jnp.einsum('bhqk,bkhd->bqhd', p, v)

    out = lax.map(attend, (qn_blocks, qr_blocks))
    return out.transpose(1, 0, 2, 3, 4).reshape(B, S, MLA_WIDTH)


def peer(h, w_query, sub_keys, expert_u, expert_v):
    B, S, D = h.shape
    blocks = h.reshape((B * S) // PEER_TOKEN_BLOCK, PEER_TOKEN_BLOCK, D)

    def block(xb):
        q = (xb @ w_query).reshape(PEER_TOKEN_BLOCK, PEER_HEADS, 2, PEER_HALF_DIM)
        s = jnp.einsum('chpd,hpnd->chpn', q, sub_keys).astype(jnp.float32)
        top_s, top_i = lax.top_k(s, PEER_TOPK)
        cand_s = (top_s[:, :, 0, :, None] + top_s[:, :, 1, None, :]).reshape(
            PEER_TOKEN_BLOCK, PEER_HEADS, PEER_TOPK * PEER_TOPK)
        cand_i = (top_i[:, :, 0, :, None] * PEER_N_KEYS + top_i[:, :, 1, None, :]).reshape(
            PEER_TOKEN_BLOCK, PEER_HEADS, PEER_TOPK * PEER_TOPK)
        best_s, pos = lax.top_k(cand_s, PEER_TOPK)
        idx = jnp.take_along_axis(cand_i, pos, axis=-1)
        g = jax.nn.softmax(best_s, axis=-1)
        u = expert_u[idx]
        act = jax.nn.gelu(jnp.einsum('cd,chkd->chk', xb, u).astype(jnp.float32), approximate=False)
        w = (g * act).astype(xb.dtype)
        return jnp.einsum('chk,chkd->cd', w, expert_v[idx])

    return lax.map(block, blocks).reshape(B, S, D)


def setup_inputs(seed: int = 0) -> dict:
    key = jax.random.key(seed)
    ks = jax.random.split(key, 20)
    f32 = jnp.float32
    nrm = lambda k, shape, s: jax.random.normal(k, shape, f32) * s
    L, D = DEPTH, D_MODEL
    return {
        "x": nrm(ks[0], (BATCH, SEQ, D), 1.0),
        "c": nrm(ks[1], (BATCH, D), 1.0),
        "w_ada": nrm(ks[2], (L, D, N_MOD * D), D ** -0.5),
        "b_ada": nrm(ks[3], (L, N_MOD * D), 0.01),
        "w_in": nrm(ks[4], (L, D, IN_WIDTH), D ** -0.5),
        "swa_sink": nrm(ks[5], (L, SWA_HEADS), 0.5),
        "mla_q_norm": 1.0 + nrm(ks[6], (L, MLA_Q_RANK), 0.02),
        "w_mla_q_up": nrm(ks[7], (L, MLA_Q_RANK, MLA_HEADS * MLA_QK_DIM), MLA_Q_RANK ** -0.5),
        "mla_kv_norm": 1.0 + nrm(ks[8], (L, MLA_KV_RANK), 0.02),
        "w_mla_kv_up": nrm(ks[9], (L, MLA_KV_RANK, MLA_HEADS * (MLA_NOPE_DIM + MLA_V_DIM)), MLA_KV_RANK ** -0.5),
        "out_norm_swa": 1.0 + nrm(ks[10], (L, SWA_WIDTH), 0.02),
        "out_norm_mla": 1.0 + nrm(ks[11], (L, MLA_WIDTH), 0.02),
        "w_out": nrm(ks[12], (L, MIX_WIDTH, D), MIX_WIDTH ** -0.5),
        "w_peer_query": nrm(ks[13], (L, D, PEER_HEADS * PEER_QUERY_DIM), D ** -0.5),
        "peer_sub_keys": nrm(ks[14], (L, PEER_HEADS, 2, PEER_N_KEYS, PEER_HALF_DIM), PEER_HALF_DIM ** -0.5),
        "peer_expert_u": nrm(ks[15], (L, PEER_EXPERTS, D), D ** -0.5),
        "peer_expert_v": nrm(ks[16], (L, PEER_EXPERTS, D), PEER_HEADS ** -0.5),
        "final_norm": 1.0 + nrm(ks[17], (D,), 0.02),
    }


def reference(x, c, w_ada, b_ada, w_in, swa_sink, mla_q_norm, w_mla_q_up, mla_kv_norm, w_mla_kv_up,
              out_norm_swa, out_norm_mla, w_out, w_peer_query, peer_sub_keys, peer_expert_u,
              peer_expert_v, final_norm):
    B, S, D = x.shape
    c_act = jax.nn.silu(c)
    for l in range(DEPTH):
        mod = c_act @ w_ada[l] + b_ada[l]
        sh_a, sc_a, g_a, sh_f, sc_f, g_f = jnp.split(mod, N_MOD, axis=-1)

        h = modulate(rmsnorm(x), sh_a, sc_a)
        proj = h @ w_in[l]
        qa, ka, va, q_lat, kv_lat, k_rope_raw = jnp.split(proj, IN_SPLITS, axis=-1)
        o_a = windowed_gqa(qa.reshape(B, S, SWA_HEADS, SWA_HEAD_DIM),
                           ka.reshape(B, S, SWA_KV_HEADS, SWA_HEAD_DIM),
                           va.reshape(B, S, SWA_KV_HEADS, SWA_HEAD_DIM),
                           swa_sink[l])
        o_b = latent_attention(q_lat, kv_lat, k_rope_raw, mla_q_norm[l], w_mla_q_up[l],
                               mla_kv_norm[l], w_mla_kv_up[l])
        mixed = jnp.concatenate([rmsnorm(o_a, out_norm_swa[l]), rmsnorm(o_b, out_norm_mla[l])], axis=-1)
        x = x + g_a[:, None, :] * (mixed @ w_out[l])

        h = modulate(rmsnorm(x), sh_f, sc_f)
        x = x + g_f[:, None, :] * peer(h, w_peer_query[l], peer_sub_keys[l], peer_expert_u[l], peer_expert_v[l])
    return rmsnorm(x, final_norm)
```

```cpp
#include <hip/hip_runtime.h>
#include <hip/hip_cooperative_groups.h>
#include <cstdio>
#include <cstdint>
namespace cg = cooperative_groups;

constexpr int Bsz = 8, S = 4096, D = 1024, T = Bsz * S;
constexpr int INW = 1184;
constexpr int C_QA = 0, C_KA = 512, C_VA = 640, C_QL = 768, C_KVL = 1024, C_KR = 1152;
constexpr int NMOD = 6 * D;
constexpr float EPS = 1e-6f;
constexpr int NTHREADS = 512, NWAVES = 8;

constexpr size_t MiB = 1u << 20;
constexpr size_t WS_MOD = 0;
constexpr size_t WS_COSA = 1 * MiB;
constexpr size_t WS_SINA = WS_COSA + 512 * 1024;
constexpr size_t WS_COSB = 2 * MiB;
constexpr size_t WS_SINB = WS_COSB + 256 * 1024;
constexpr size_t WS_H = 4 * MiB;
constexpr size_t WS_PROJ = 132 * MiB;
constexpr size_t WS_QM = 280 * MiB;
constexpr size_t WS_KVM = 376 * MiB;
constexpr size_t WS_PQ = 132 * MiB;
constexpr size_t WS_TOPS = 388 * MiB;
constexpr size_t WS_TOPI = 420 * MiB;
constexpr size_t WS_IDX = 452 * MiB;
constexpr size_t WS_G = 468 * MiB;
constexpr size_t WS_END = 504 * MiB;

struct Params {
    const float *x, *c, *w_ada, *b_ada, *w_in, *sink, *qnorm, *w_qup, *kvnorm, *w_kvup, *onorm_a, *onorm_b, *w_out, *w_pq, *subk, *eu, *ev, *fnorm;
    float* out;
    unsigned char* ws;
};

typedef short bf16x8 __attribute__((ext_vector_type(8)));
typedef float f32x4 __attribute__((ext_vector_type(4)));
typedef unsigned u32x4 __attribute__((ext_vector_type(4)));

__device__ __forceinline__ unsigned f2bf(float f) { unsigned u = __builtin_bit_cast(unsigned, f); return (u + 0x7fffu + ((u >> 16) & 1u)) >> 16; }
__device__ __forceinline__ unsigned pk2(float lo, float hi) { return f2bf(lo) | (f2bf(hi) << 16); }
__device__ __forceinline__ float wave_sum(float v) {
#pragma unroll
    for (int o = 1; o < 64; o <<= 1) v += __shfl_xor(v, o);
    return v;
}

__device__ void stage_prologue(const Params& p, float* lds) {
    float* mod = (float*)(p.ws + WS_MOD);
    const int tid = threadIdx.x;
    for (int i = tid; i < Bsz * D; i += NTHREADS) { float v = p.c[i]; lds[i] = v / (1.f + __expf(-v)); }
    __syncthreads();
    float* red = lds + Bsz * D;
    const int col_l = tid & 63, slice = tid >> 6;
    for (int item = blockIdx.x; item < NMOD / 64; item += gridDim.x) {
        const int n = item * 64 + col_l;
        float acc[Bsz];
#pragma unroll
        for (int b = 0; b < Bsz; ++b) acc[b] = 0.f;
        for (int kk = 0; kk < 128; ++kk) {
            const int k = slice * 128 + kk;
            const float w = p.w_ada[(size_t)k * NMOD + n];
#pragma unroll
            for (int b = 0; b < Bsz; ++b) acc[b] += lds[b * D + k] * w;
        }
#pragma unroll
        for (int b = 0; b < Bsz; ++b) red[(slice * 64 + col_l) * Bsz + b] = acc[b];
        __syncthreads();
        {
            const int cc = tid >> 3, b = tid & 7;
            float s = 0.f;
#pragma unroll
            for (int sl = 0; sl < 8; ++sl) s += red[(sl * 64 + cc) * Bsz + b];
            mod[b * NMOD + item * 64 + cc] = s + p.b_ada[item * 64 + cc];
        }
        __syncthreads();
    }
    float* cosA = (float*)(p.ws + WS_COSA); float* sinA = (float*)(p.ws + WS_SINA);
    float* cosB = (float*)(p.ws + WS_COSB); float* sinB = (float*)(p.ws + WS_SINB);
    const int gtid = blockIdx.x * NTHREADS + tid, gn = gridDim.x * NTHREADS;
    for (int e = gtid; e < S * 32; e += gn) {
        const int pos = e >> 5, i = e & 31;
        const double inv = exp2(-(double)(2 * i) / 64.0 * 13.287712379549449);
        const double a = (double)pos * inv;
        cosA[e] = (float)cos(a); sinA[e] = (float)sin(a);
    }
    for (int e = gtid; e < S * 16; e += gn) {
        const int pos = e >> 4, i = e & 15;
        const double inv = exp2(-(double)(2 * i) / 32.0 * 13.287712379549449);
        const double a = (double)pos * inv;
        cosB[e] = (float)cos(a); sinB[e] = (float)sin(a);
    }
}

__device__ void stage_norm_mod(const Params& p, const float* src, float* dst, int sh_off, int sc_off) {
    const float* mod = (const float*)(p.ws + WS_MOD);
    const int lane = threadIdx.x & 63, wave = threadIdx.x >> 6;
    for (int t = blockIdx.x * NWAVES + wave; t < T; t += gridDim.x * NWAVES) {
        const int b = t >> 12;
        const f32x4* xr = (const f32x4*)(src + (size_t)t * D) + lane;
        f32x4 v[4]; float s = 0.f;
#pragma unroll
        for (int j = 0; j < 4; ++j) { v[j] = xr[64 * j]; s += v[j].x * v[j].x + v[j].y * v[j].y + v[j].z * v[j].z + v[j].w * v[j].w; }
        const float rstd = rsqrtf(wave_sum(s) * (1.f / D) + EPS);
        f32x4* o = (f32x4*)(dst + (size_t)t * D) + lane;
#pragma unroll
        for (int j = 0; j < 4; ++j) {
            const f32x4 sh = *((const f32x4*)(mod + b * NMOD + sh_off) + lane + 64 * j);
            const f32x4 sc = *((const f32x4*)(mod + b * NMOD + sc_off) + lane + 64 * j);
            f32x4 r;
            r.x = v[j].x * rstd * (1.f + sc.x) + sh.x; r.y = v[j].y * rstd * (1.f + sc.y) + sh.y;
            r.z = v[j].z * rstd * (1.f + sc.z) + sh.z; r.w = v[j].w * rstd * (1.f + sc.w) + sh.w;
            o[64 * j] = r;
        }
    }
}

constexpr int GBM = 128, GBN = 128, GBK = 32, GLD = 40;
template <int EPI>
__device__ void stage_gemm(const float* A, int lda, const float* W, int ldw, float* C, int ldc, int M, int N, int K,
                           const float* resid, const float* gate, unsigned short* lds) {
    unsigned short* sA = lds;
    unsigned short* sB = lds + GBM * GLD;
    const int tid = threadIdx.x, lane = tid & 63, wave = tid >> 6;
    const int wm = wave >> 1, wn = wave & 1, fr = lane & 15, fq = lane >> 4;
    const int nNt = (N + GBN - 1) / GBN, nMt = M / GBM, ntiles = nMt * nNt;
    const int a_row = tid >> 2, a_k = (tid & 3) * 8;
    const int b_n = tid & 127, b_k = (tid >> 7) * 8;
    for (int tile = blockIdx.x; tile < ntiles; tile += gridDim.x) {
        const int mt = tile / nNt, nt = tile % nNt, m0 = mt * GBM, n0 = nt * GBN;
        f32x4 acc[2][4];
#pragma unroll
        for (int i = 0; i < 2; ++i)
#pragma unroll
            for (int j = 0; j < 4; ++j) acc[i][j] = (f32x4){0.f, 0.f, 0.f, 0.f};
        const float* ap = A + (size_t)(m0 + a_row) * lda + a_k;
        const bool bok = (n0 + b_n) < N;
        const float* bp = W + (size_t)b_k * ldw + (n0 + b_n);
        f32x4 ra0, ra1; float rb[8];
        ra0 = *(const f32x4*)(ap); ra1 = *(const f32x4*)(ap + 4);
#pragma unroll
        for (int j = 0; j < 8; ++j) rb[j] = bok ? bp[(size_t)j * ldw] : 0.f;
        for (int k0 = 0; k0 < K; k0 += GBK) {
            __syncthreads();
            {
                u32x4 va; va.x = pk2(ra0.x, ra0.y); va.y = pk2(ra0.z, ra0.w); va.z = pk2(ra1.x, ra1.y); va.w = pk2(ra1.z, ra1.w);
                *(u32x4*)(sA + a_row * GLD + a_k) = va;
                u32x4 vb; vb.x = pk2(rb[0], rb[1]); vb.y = pk2(rb[2], rb[3]); vb.z = pk2(rb[4], rb[5]); vb.w = pk2(rb[6], rb[7]);
                *(u32x4*)(sB + b_n * GLD + b_k) = vb;
            }
            __syncthreads();
            if (k0 + GBK < K) {
                const float* ap2 = ap + (k0 + GBK);
                ra0 = *(const f32x4*)(ap2); ra1 = *(const f32x4*)(ap2 + 4);
                const float* bp2 = bp + (size_t)(k0 + GBK) * ldw;
#pragma unroll
                for (int j = 0; j < 8; ++j) rb[j] = bok ? bp2[(size_t)j * ldw] : 0.f;
            }
            bf16x8 af[2], bfr[4];
#pragma unroll
            for (int i = 0; i < 2; ++i) af[i] = *(const bf16x8*)(sA + (wm * 32 + i * 16 + fr) * GLD + fq * 8);
#pragma unroll
            for (int j = 0; j < 4; ++j) bfr[j] = *(const bf16x8*)(sB + (wn * 64 + j * 16 + fr) * GLD + fq * 8);
#pragma unroll
            for (int i = 0; i < 2; ++i)
#pragma unroll
                for (int j = 0; j < 4; ++j) acc[i][j] = __builtin_amdgcn_mfma_f32_16x16x32_bf16(af[i], bfr[j], acc[i][j], 0, 0, 0);
        }
#pragma unroll
        for (int i = 0; i < 2; ++i)
#pragma unroll
            for (int j = 0; j < 4; ++j) {
                const int col = n0 + wn * 64 + j * 16 + fr;
                if (col < N) {
#pragma unroll
                    for (int r = 0; r < 4; ++r) {
                        const int row = m0 + wm * 32 + i * 16 + fq * 4 + r;
                        float v = acc[i][j][r];
                        if (EPI == 1) v = resid[(size_t)row * ldc + col] + gate[(row >> 12) * NMOD + col] * v;
                        C[(size_t)row * ldc + col] = v;
                    }
                }
            }
    }
}

__device__ void stage_postproj(const Params& p) {
    float* proj = (float*)(p.ws + WS_PROJ);
    const float* cosA = (const float*)(p.ws + WS_COSA); const float* sinA = (const float*)(p.ws + WS_SINA);
    const float* cosB = (const float*)(p.ws + WS_COSB); const float* sinB = (const float*)(p.ws + WS_SINB);
    const int lane = threadIdx.x & 63, wave = threadIdx.x >> 6;
    for (int t = blockIdx.x * NWAVES + wave; t < T; t += gridDim.x * NWAVES) {
        const int pos = t & (S - 1);
        float* row = proj + (size_t)t * INW;
#pragma unroll
        for (int it = 0; it < 5; ++it) {
            const int e = it * 64 + lane;
            const int hh = e >> 5, i = e & 31;
            const int base = hh * 64;
            const float x1 = row[base + i], x2 = row[base + 32 + i];
            const float c = cosA[pos * 32 + i], s = sinA[pos * 32 + i];
            row[base + i] = x1 * c - x2 * s; row[base + 32 + i] = x2 * c + x1 * s;
        }
        {
            f32x4 v = *((const f32x4*)(row + C_QL) + lane);
            const float ss = wave_sum(v.x * v.x + v.y * v.y + v.z * v.z + v.w * v.w);
            const float rstd = rsqrtf(ss * (1.f / 256.f) + EPS);
            const f32x4 g = *((const f32x4*)p.qnorm + lane);
            v.x *= rstd * g.x; v.y *= rstd * g.y; v.z *= rstd * g.z; v.w *= rstd * g.w;
            *((f32x4*)(row + C_QL) + lane) = v;
        }
        {
            float a0 = row[C_KVL + lane * 2], a1 = row[C_KVL + lane * 2 + 1];
            const float ss = wave_sum(a0 * a0 + a1 * a1);
            const float rstd = rsqrtf(ss * (1.f / 128.f) + EPS);
            row[C_KVL + lane * 2] = a0 * rstd * p.kvnorm[lane * 2];
            row[C_KVL + lane * 2 + 1] = a1 * rstd * p.kvnorm[lane * 2 + 1];
        }
        if (lane < 16) {
            const float x1 = row[C_KR + lane], x2 = row[C_KR + 16 + lane];
            const float c = cosB[pos * 16 + lane], s = sinB[pos * 16 + lane];
            row[C_KR + lane] = x1 * c - x2 * s; row[C_KR + 16 + lane] = x2 * c + x1 * s;
        }
    }
}

__device__ void stage_attn_mla(const Params& p) {
    const float* proj = (const float*)(p.ws + WS_PROJ);
    const float* qm = (const float*)(p.ws + WS_QM);
    const float* kvm = (const float*)(p.ws + WS_KVM);
    const float* cosB = (const float*)(p.ws + WS_COSB); const float* sinB = (const float*)(p.ws + WS_SINB);
    float* oab = (float*)(p.ws + WS_H);
    const int lane = threadIdx.x & 63;
    const int wave = __builtin_amdgcn_readfirstlane(threadIdx.x >> 6);
    const float scale = 0.10206207261596575f;
    const int nitems = Bsz * 8 * (S / 64);
    for (int item = blockIdx.x * NWAVES + wave; item < nitems; item += gridDim.x * NWAVES) {
        const int qb = item & 63, h = (item >> 6) & 7, b = item >> 9;
        const int pos = qb * 64 + lane, tq = b * S + pos;
        float q[96], acc[64];
        const float* qr = qm + (size_t)tq * 768 + h * 96;
#pragma unroll
        for (int d = 0; d < 64; ++d) q[d] = qr[d] * scale;
#pragma unroll
        for (int i = 0; i < 16; ++i) {
            const float x1 = qr[64 + i], x2 = qr[80 + i];
            const float c = cosB[pos * 16 + i], s = sinB[pos * 16 + i];
            q[64 + i] = (x1 * c - x2 * s) * scale; q[80 + i] = (x2 * c + x1 * s) * scale;
        }
#pragma unroll
        for (int d = 0; d < 64; ++d) acc[d] = 0.f;
        float m = -1e30f, l = 0.f;
        const float* kbase = kvm + (size_t)b * S * 1024 + h * 128;
        const float* rbase = proj + (size_t)b * S * INW + C_KR;
        for (int j = 0; j < S; ++j) {
            const float* kn = kbase + (size_t)j * 1024;
            const float* kr = rbase + (size_t)j * INW;
            float s0 = 0.f, s1 = 0.f;
#pragma unroll
            for (int d = 0; d < 64; d += 2) { s0 += q[d] * kn[d]; s1 += q[d + 1] * kn[d + 1]; }
#pragma unroll
            for (int d = 0; d < 32; d += 2) { s0 += q[64 + d] * kr[d]; s1 += q[65 + d] * kr[d + 1]; }
            const float sc = s0 + s1;
            if (sc > m) {
                const float al = __expf(m - sc);
                l *= al;
#pragma unroll
                for (int d = 0; d < 64; ++d) acc[d] *= al;
                m = sc;
            }
            const float pr = __expf(sc - m);
            l += pr;
#pragma unroll
            for (int d = 0; d < 64; ++d) acc[d] += pr * kn[64 + d];
        }
        const float il = 1.f / l;
        float* o = oab + (size_t)tq * D + 512 + h * 64;
#pragma unroll
        for (int d = 0; d < 64; ++d) o[d] = acc[d] * il;
    }
}

__device__ void stage_attn_swa(const Params& p) {
    const float* proj = (const float*)(p.ws + WS_PROJ);
    float* oab = (float*)(p.ws + WS_H);
    const int lane = threadIdx.x & 63;
    const int wave = __builtin_amdgcn_readfirstlane(threadIdx.x >> 6);
    const int nitems = Bsz * 8 * (S / 64);
    for (int item = blockIdx.x * NWAVES + wave; item < nitems; item += gridDim.x * NWAVES) {
        const int qb = item & 63, h = (item >> 6) & 7, b = item >> 9;
        const int kvh = h >> 2;
        const int q0 = qb * 64, pos = q0 + lane, tq = b * S + pos;
        float q[64], acc[64];
        const float* qr = proj + (size_t)tq * INW + C_QA + h * 64;
#pragma unroll
        for (int d = 0; d < 64; ++d) { q[d] = qr[d] * 0.125f; acc[d] = 0.f; }
        float m = p.sink[h], l = 1.f;
        const int jlo = (q0 - 128 < 0) ? 0 : q0 - 128;
        const int jhi = (q0 + 63 + 128 > S - 1) ? S - 1 : q0 + 63 + 128;
        const float* kbase = proj + (size_t)b * S * INW + C_KA + kvh * 64;
        const float* vbase = proj + (size_t)b * S * INW + C_VA + kvh * 64;
        for (int j = jlo; j <= jhi; ++j) {
            const float* kn = kbase + (size_t)j * INW;
            const float* vn = vbase + (size_t)j * INW;
            float s0 = 0.f, s1 = 0.f;
#pragma unroll
            for (int d = 0; d < 64; d += 2) { s0 += q[d] * kn[d]; s1 += q[d + 1] * kn[d + 1]; }
            const float sc = s0 + s1;
            const int dd = pos - j;
            const bool ok = (dd <= 128) && (dd >= -128);
            if (ok) {
                if (sc > m) {
                    const float al = __expf(m - sc);
                    l *= al;
#pragma unroll
                    for (int d = 0; d < 64; ++d) acc[d] *= al;
                    m = sc;
                }
                const float pr = __expf(sc - m);
                l += pr;
#pragma unroll
                for (int d = 0; d < 64; ++d) acc[d] += pr * vn[d];
            }
        }
        const float il = 1.f / l;
        float* o = oab + (size_t)tq * D + h * 64;
#pragma unroll
        for (int d = 0; d < 64; ++d) o[d] = acc[d] * il;
    }
}

__device__ void stage_outnorm(const Params& p) {
    float* oab = (float*)(p.ws + WS_H);
    const int lane = threadIdx.x & 63, wave = threadIdx.x >> 6;
    for (int t = blockIdx.x * NWAVES + wave; t < T; t += gridDim.x * NWAVES) {
        f32x4* r = (f32x4*)(oab + (size_t)t * D) + lane;
#pragma unroll
        for (int half = 0; half < 2; ++half) {
            f32x4 v0 = r[half * 128], v1 = r[half * 128 + 64];
            float s = v0.x * v0.x + v0.y * v0.y + v0.z * v0.z + v0.w * v0.w + v1.x * v1.x + v1.y * v1.y + v1.z * v1.z + v1.w * v1.w;
            const float rstd = rsqrtf(wave_sum(s) * (1.f / 512.f) + EPS);
            const float* gn = half ? p.onorm_b : p.onorm_a;
            const f32x4 g0 = *((const f32x4*)gn + lane), g1 = *((const f32x4*)gn + 64 + lane);
            v0.x *= rstd * g0.x; v0.y *= rstd * g0.y; v0.z *= rstd * g0.z; v0.w *= rstd * g0.w;
            v1.x *= rstd * g1.x; v1.y *= rstd * g1.y; v1.z *= rstd * g1.z; v1.w *= rstd * g1.w;
            r[half * 128] = v0; r[half * 128 + 64] = v1;
        }
    }
}

__device__ __forceinline__ void top_insert(float (&tv)[16], int (&ti)[16], float s, int id) {
    if (s > tv[15]) {
        tv[15] = s; ti[15] = id;
#pragma unroll
        for (int i = 15; i > 0; --i) {
            const bool sw = tv[i] > tv[i - 1];
            const float a = tv[i], b = tv[i - 1]; const int ia = ti[i], ib = ti[i - 1];
            tv[i] = sw ? b : a; tv[i - 1] = sw ? a : b; ti[i] = sw ? ib : ia; ti[i - 1] = sw ? ia : ib;
        }
    }
}
__device__ void stage_peer_scores(const Params& p) {
    const float* pq = (const float*)(p.ws + WS_PQ);
    float* tops = (float*)(p.ws + WS_TOPS); int* topi = (int*)(p.ws + WS_TOPI);
    const int lane = threadIdx.x & 63;
    const int wave = __builtin_amdgcn_readfirstlane(threadIdx.x >> 6);
    const int nitems = (T / 64) * 16;
    for (int item = blockIdx.x * NWAVES + wave; item < nitems; item += gridDim.x * NWAVES) {
        const int hp = item & 15, tb = item >> 4;
        const int t = tb * 64 + lane;
        float q[128];
        const float* qr = pq + (size_t)t * 2048 + hp * 128;
#pragma unroll
        for (int d = 0; d < 128; ++d) q[d] = qr[d];
        float tv[16]; int ti[16];
#pragma unroll
        for (int i = 0; i < 16; ++i) { tv[i] = -3.0e38f; ti[i] = 0; }
        const float* kb = p.subk + (size_t)hp * 128 * 128;
        for (int n = 0; n < 128; ++n) {
            const float* kr = kb + n * 128;
            float s0 = 0.f, s1 = 0.f;
#pragma unroll
            for (int d = 0; d < 128; d += 2) { s0 += q[d] * kr[d]; s1 += q[d + 1] * kr[d + 1]; }
            top_insert(tv, ti, s0 + s1, n);
        }
        float* os = tops + ((size_t)t * 16 + hp) * 16; int* oi = topi + ((size_t)t * 16 + hp) * 16;
#pragma unroll
        for (int i = 0; i < 16; ++i) { os[i] = tv[i]; oi[i] = ti[i]; }
    }
}
__device__ void stage_peer_select(const Params& p) {
    const float* tops = (const float*)(p.ws + WS_TOPS); const int* topi = (const int*)(p.ws + WS_TOPI);
    int* idx = (int*)(p.ws + WS_IDX); float* g = (float*)(p.ws + WS_G);
    for (int e = blockIdx.x * NTHREADS + threadIdx.x; e < T * 8; e += gridDim.x * NTHREADS) {
        const float* s0 = tops + (size_t)e * 32; const float* s1 = s0 + 16;
        const int* i0 = topi + (size_t)e * 32; const int* i1 = i0 + 16;
        float a[16], b[16]; int ia[16], ib[16];
#pragma unroll
        for (int i = 0; i < 16; ++i) { a[i] = s0[i]; b[i] = s1[i]; ia[i] = i0[i]; ib[i] = i1[i]; }
        float tv[16]; int ti[16];
#pragma unroll
        for (int i = 0; i < 16; ++i) { tv[i] = -3.0e38f; ti[i] = 0; }
#pragma unroll
        for (int i = 0; i < 16; ++i)
#pragma unroll
            for (int j = 0; j < 16; ++j)
                if ((i + 1) * (j + 1) <= 16) top_insert(tv, ti, a[i] + b[j], ia[i] * 128 + ib[j]);
        float sum = 0.f, ex[16];
#pragma unroll
        for (int i = 0; i < 16; ++i) { ex[i] = __expf(tv[i] - tv[0]); sum += ex[i]; }
        const float inv = 1.f / sum;
#pragma unroll
        for (int i = 0; i < 16; ++i) { idx[(size_t)e * 16 + i] = ti[i]; g[(size_t)e * 16 + i] = ex[i] * inv; }
    }
}
__device__ void stage_peer_gather(const Params& p) {
    const float* h2 = (const float*)(p.ws + WS_H);
    const float* mod = (const float*)(p.ws + WS_MOD);
    const int* idx = (const int*)(p.ws + WS_IDX); const float* g = (const float*)(p.ws + WS_G);
    const int lane = threadIdx.x & 63, wave = threadIdx.x >> 6;
    for (int t = blockIdx.x * NWAVES + wave; t < T; t += gridDim.x * NWAVES) {
        const int b = t >> 12;
        f32x4 hv[4], acc[4];
        const f32x4* hr = (const f32x4*)(h2 + (size_t)t * D) + lane;
#pragma unroll
        for (int j = 0; j < 4; ++j) { hv[j] = hr[64 * j]; acc[j] = (f32x4){0.f, 0.f, 0.f, 0.f}; }
        const int id0 = idx[(size_t)t * 128 + lane], id1 = idx[(size_t)t * 128 + 64 + lane];
        const float g0 = g[(size_t)t * 128 + lane], g1 = g[(size_t)t * 128 + 64 + lane];
        for (int k = 0; k < 128; ++k) {
            const int id = __shfl((k < 64) ? id0 : id1, k & 63);
            const float gk = __shfl((k < 64) ? g0 : g1, k & 63);
            const f32x4* ur = (const f32x4*)(p.eu + (size_t)id * D) + lane;
            float s = 0.f;
#pragma unroll
            for (int j = 0; j < 4; ++j) { const f32x4 u = ur[64 * j]; s += u.x * hv[j].x + u.y * hv[j].y + u.z * hv[j].z + u.w * hv[j].w; }
            s = wave_sum(s);
            const float act = 0.5f * s * (1.f + erff(s * 0.70710678118654752f));
            const float w = gk * act;
            const f32x4* vr = (const f32x4*)(p.ev + (size_t)id * D) + lane;
#pragma unroll
            for (int j = 0; j < 4; ++j) { const f32x4 v = vr[64 * j]; acc[j].x += w * v.x; acc[j].y += w * v.y; acc[j].z += w * v.z; acc[j].w += w * v.w; }
        }
        f32x4* xr = (f32x4*)(p.out + (size_t)t * D) + lane;
        f32x4 x2[4]; float ss = 0.f;
#pragma unroll
        for (int j = 0; j < 4; ++j) {
            const f32x4 x1 = xr[64 * j];
            const f32x4 gf = *((const f32x4*)(mod + b * NMOD + 5 * D) + lane + 64 * j);
            x2[j].x = x1.x + gf.x * acc[j].x; x2[j].y = x1.y + gf.y * acc[j].y; x2[j].z = x1.z + gf.z * acc[j].z; x2[j].w = x1.w + gf.w * acc[j].w;
            ss += x2[j].x * x2[j].x + x2[j].y * x2[j].y + x2[j].z * x2[j].z + x2[j].w * x2[j].w;
        }
        const float rstd = rsqrtf(wave_sum(ss) * (1.f / D) + EPS);
#pragma unroll
        for (int j = 0; j < 4; ++j) {
            const f32x4 fn = *((const f32x4*)p.fnorm + lane + 64 * j);
            f32x4 r; r.x = x2[j].x * rstd * fn.x; r.y = x2[j].y * rstd * fn.y; r.z = x2[j].z * rstd * fn.z; r.w = x2[j].w * rstd * fn.w;
            xr[64 * j] = r;
        }
    }
}

__global__ void __launch_bounds__(NTHREADS) fwd_megakernel(Params p) {
    __shared__ __attribute__((aligned(16))) unsigned char lds_raw[49152];
    cg::grid_group grid = cg::this_grid();
    float* hb = (float*)(p.ws + WS_H);
    float* proj = (float*)(p.ws + WS_PROJ);
    const float* mod = (const float*)(p.ws + WS_MOD);

    stage_prologue(p, (float*)lds_raw);
    grid.sync();
    stage_norm_mod(p, p.x, hb, 0 * D, 1 * D);
    grid.sync();
    stage_gemm<0>(hb, D, p.w_in, INW, proj, INW, T, INW, D, nullptr, nullptr, (unsigned short*)lds_raw);
    grid.sync();
    stage_postproj(p);
    grid.sync();
    stage_gemm<0>(proj + C_QL, INW, p.w_qup, 768, (float*)(p.ws + WS_QM), 768, T, 768, 256, nullptr, nullptr, (unsigned short*)lds_raw);
    stage_gemm<0>(proj + C_KVL, INW, p.w_kvup, 1024, (float*)(p.ws + WS_KVM), 1024, T, 1024, 128, nullptr, nullptr, (unsigned short*)lds_raw);
    grid.sync();
    stage_attn_swa(p);
    stage_attn_mla(p);
    grid.sync();
    stage_outnorm(p);
    grid.sync();
    stage_gemm<1>(hb, D, p.w_out, D, p.out, D, T, D, D, p.x, mod + 2 * D, (unsigned short*)lds_raw);
    grid.sync();
    stage_norm_mod(p, p.out, hb, 3 * D, 4 * D);
    grid.sync();
    stage_gemm<0>(hb, D, p.w_pq, 2048, (float*)(p.ws + WS_PQ), 2048, T, 2048, D, nullptr, nullptr, (unsigned short*)lds_raw);
    grid.sync();
    stage_peer_scores(p);
    grid.sync();
    stage_peer_select(p);
    grid.sync();
    stage_peer_gather(p);
}

extern "C" void kernel_launch(void* const* d_in, const int* in_sizes, int n_in, void* d_out, int out_size, void* d_ws, size_t ws_size, hipStream_t stream) {
    static int grid_blocks = 0;
    if (grid_blocks == 0) {
        if (n_in != 18 || in_sizes[0] != T * D || out_size != T * D || ws_size < WS_END) {
            fprintf(stderr, "kernel_launch: unexpected shapes (n_in %d, in0 %d, out %d, ws %zu); nothing launched\n", n_in, n_in > 0 ? in_sizes[0] : -1, out_size, ws_size);
            grid_blocks = -1; return;
        }
        int dev = 0, cus = 0, per_cu = 0;
        hipGetDevice(&dev);
        hipDeviceGetAttribute(&cus, hipDeviceAttributeMultiprocessorCount, dev);
        hipOccupancyMaxActiveBlocksPerMultiprocessor(&per_cu, fwd_megakernel, NTHREADS, 0);
        if (per_cu < 1) { fprintf(stderr, "kernel_launch: occupancy query says %d blocks/CU\n", per_cu); grid_blocks = -1; return; }
        grid_blocks = cus;
    }
    if (grid_blocks < 0) return;
    Params p{};
    p.x = (const float*)d_in[0]; p.c = (const float*)d_in[1]; p.w_ada = (const float*)d_in[2]; p.b_ada = (const float*)d_in[3];
    p.w_in = (const float*)d_in[4]; p.sink = (const float*)d_in[5]; p.qnorm = (const float*)d_in[6]; p.w_qup = (const float*)d_in[7];
    p.kvnorm = (const float*)d_in[8]; p.w_kvup = (const float*)d_in[9]; p.onorm_a = (const float*)d_in[10]; p.onorm_b = (const float*)d_in[11];
    p.w_out = (const float*)d_in[12]; p.w_pq = (const float*)d_in[13]; p.subk = (const float*)d_in[14]; p.eu = (const float*)d_in[15];
    p.ev = (const float*)d_in[16]; p.fnorm = (const float*)d_in[17];
    p.out = (float*)d_out; p.ws = (unsigned char*)d_ws;
    void* args[] = {&p};
    hipError_t e = hipLaunchCooperativeKernel((void*)fwd_megakernel, dim3(grid_blocks), dim3(NTHREADS), args, 0, stream);
    if (e != hipSuccess) fprintf(stderr, "cooperative launch failed: %s (grid %d)\n", hipGetErrorString(e), grid_blocks);
}
```

```cpp
#include <hip/hip_runtime.h>
#include <hip/hip_cooperative_groups.h>
#include <cstdio>
#include <cstdint>
namespace cg = cooperative_groups;

constexpr int Bsz = 8, S = 4096, D = 1024, T = Bsz * S;
constexpr int INW = 1184;
constexpr int C_QA = 0, C_KA = 512, C_VA = 640, C_QL = 768, C_KVL = 1024, C_KR = 1152;
constexpr int NMOD = 6 * D;
constexpr float EPS = 1e-6f;
constexpr int NTHREADS = 512, NWAVES = 8;

constexpr size_t MiB = 1u << 20;
constexpr size_t WS_MOD = 0;
constexpr size_t WS_COSA = 1 * MiB;
constexpr size_t WS_SINA = WS_COSA + 512 * 1024;
constexpr size_t WS_COSB = 2 * MiB;
constexpr size_t WS_SINB = WS_COSB + 256 * 1024;
constexpr size_t WS_WIN = 4 * MiB;
constexpr size_t WS_WQUP = 7 * MiB;
constexpr size_t WS_WKVUP = 7 * MiB + 512 * 1024;
constexpr size_t WS_WOUT = 8 * MiB;
constexpr size_t WS_WPQ = 10 * MiB;
constexpr size_t WS_SUBK = 14 * MiB;
constexpr size_t WS_EU8 = 16 * MiB;
constexpr size_t WS_EV8 = 32 * MiB;
constexpr size_t WS_US = 48 * MiB;
constexpr size_t WS_VS = WS_US + 64 * 1024;
constexpr size_t WS_H = 52 * MiB;
constexpr size_t WS_QA = 52 * MiB;
constexpr size_t WS_KA = 84 * MiB;
constexpr size_t WS_VAT = 92 * MiB;
constexpr size_t WS_QMB = 100 * MiB;
constexpr size_t WS_VT = 148 * MiB;
constexpr size_t WS_PROJ = 180 * MiB;
constexpr size_t WS_OAB = 180 * MiB;
constexpr size_t WS_HB = 244 * MiB;
constexpr size_t WS_TOPS = 52 * MiB;
constexpr size_t WS_TOPI = 84 * MiB;
constexpr size_t WS_IDX = 92 * MiB;
constexpr size_t WS_G = 100 * MiB;
constexpr size_t WS_KVM = 328 * MiB;
constexpr size_t WS_PQ = 328 * MiB;
constexpr size_t WS_K96 = 456 * MiB;
constexpr size_t WS_END = 504 * MiB;
constexpr int LDS_BYTES = 102400;
constexpr int NEXP = 16384;

struct Params {
    const float *x, *c, *w_ada, *b_ada, *w_in, *sink, *qnorm, *w_qup, *kvnorm, *w_kvup, *onorm_a, *onorm_b, *w_out, *w_pq, *subk, *eu, *ev, *fnorm;
    float* out;
    unsigned char* ws;
};

typedef short bf16x8 __attribute__((ext_vector_type(8)));
typedef float f32x4 __attribute__((ext_vector_type(4)));
typedef unsigned u32x4 __attribute__((ext_vector_type(4)));
typedef float f32x2 __attribute__((ext_vector_type(2)));

__device__ __forceinline__ unsigned f2bf(float f) { unsigned u = __builtin_bit_cast(unsigned, f); return (u + 0x7fffu + ((u >> 16) & 1u)) >> 16; }
__device__ __forceinline__ unsigned pk2(float lo, float hi) { return f2bf(lo) | (f2bf(hi) << 16); }
__device__ __forceinline__ float bf2f(unsigned short h) { return __builtin_bit_cast(float, (unsigned)h << 16); }
__device__ __forceinline__ float bflo(unsigned w) { return __builtin_bit_cast(float, w << 16); }
__device__ __forceinline__ float bfhi(unsigned w) { return __builtin_bit_cast(float, w & 0xffff0000u); }
__device__ __forceinline__ float wave_sum(float v) {
#pragma unroll
    for (int o = 1; o < 64; o <<= 1) v += __shfl_xor(v, o);
    return v;
}

__device__ __forceinline__ float wave_max(float v) {
#pragma unroll
    for (int o = 1; o < 64; o <<= 1) v = fmaxf(v, __shfl_xor(v, o));
    return v;
}
template <int CTRL> __device__ __forceinline__ float dpp_add(float s) {
    return s + __builtin_bit_cast(float, __builtin_amdgcn_update_dpp(0, __builtin_bit_cast(int, s), CTRL, 0xF, 0xF, true));
}
__device__ __forceinline__ float group16_sum(float s) { s = dpp_add<0xB1>(s); s = dpp_add<0x4E>(s); s = dpp_add<0x141>(s); s = dpp_add<0x140>(s); return s; }

template <int MAP> __device__ __forceinline__ int map_row(int n) {
    if (MAP == 1) { const int h = n / 96, j = n % 96; return j < 64 ? h * 64 + j : 512 + h * 32 + (j - 64); }
    return n;
}
template <int MAP>
__device__ __forceinline__ void transpose_item(const float* W, int K, int N, unsigned short* WT, const float* kgain, float* scr, int item, int lane) {
    const int nblk = N / 32, kb = item / nblk, nb = item % nblk, k0 = 64 * kb, n0 = 32 * nb;
#pragma unroll 8
    for (int i = 0; i < 32; ++i) {
        const int kk = 2 * i + (lane >> 5);
        float w = W[(size_t)(k0 + kk) * N + n0 + (lane & 31)];
        if (kgain) w *= kgain[k0 + kk];
        scr[kk * 33 + (lane & 31)] = w;
    }
    asm volatile("s_waitcnt lgkmcnt(0)" ::: "memory");
    const int c = lane & 7;
#pragma unroll
    for (int j = 0; j < 4; ++j) {
        const int n = (lane >> 3) + 8 * j; const float* q = scr + (8 * c) * 33 + n;
        u32x4 o; o.x = pk2(q[0 * 33], q[1 * 33]); o.y = pk2(q[2 * 33], q[3 * 33]); o.z = pk2(q[4 * 33], q[5 * 33]); o.w = pk2(q[6 * 33], q[7 * 33]);
        *(u32x4*)(WT + (size_t)map_row<MAP>(n0 + n) * K + k0 + 8 * c) = o;
    }
    asm volatile("s_waitcnt lgkmcnt(0)" ::: "memory");
}

__device__ void stage_prologue(const Params& p, float* lds) {
    float* mod = (float*)(p.ws + WS_MOD);
    const int tid = threadIdx.x;
    for (int i = tid; i < Bsz * D; i += NTHREADS) { float v = p.c[i]; lds[i] = v / (1.f + __expf(-v)); }
    __syncthreads();
    float* red = lds + Bsz * D;
    const int col_l = tid & 63, slice = tid >> 6;
    for (int item = blockIdx.x; item < NMOD / 64; item += gridDim.x) {
        const int n = item * 64 + col_l;
        float acc[Bsz];
#pragma unroll
        for (int b = 0; b < Bsz; ++b) acc[b] = 0.f;
        for (int kk = 0; kk < 128; ++kk) {
            const int k = slice * 128 + kk;
            const float w = p.w_ada[(size_t)k * NMOD + n];
#pragma unroll
            for (int b = 0; b < Bsz; ++b) acc[b] += lds[b * D + k] * w;
        }
#pragma unroll
        for (int b = 0; b < Bsz; ++b) red[(slice * 64 + col_l) * Bsz + b] = acc[b];
        __syncthreads();
        {
            const int cc = tid >> 3, b = tid & 7;
            float s = 0.f;
#pragma unroll
            for (int sl = 0; sl < 8; ++sl) s += red[(sl * 64 + cc) * Bsz + b];
            mod[b * NMOD + item * 64 + cc] = s + p.b_ada[item * 64 + cc];
        }
        __syncthreads();
    }
    float* cosA = (float*)(p.ws + WS_COSA); float* sinA = (float*)(p.ws + WS_SINA);
    float* cosB = (float*)(p.ws + WS_COSB); float* sinB = (float*)(p.ws + WS_SINB);
    const int gtid = blockIdx.x * NTHREADS + tid, gn = gridDim.x * NTHREADS;
    for (int e = gtid; e < S * 32; e += gn) {
        const int pos = e >> 5, i = e & 31;
        const double inv = exp2(-(double)(2 * i) / 64.0 * 13.287712379549449);
        const double a = (double)pos * inv;
        cosA[e] = (float)cos(a); sinA[e] = (float)sin(a);
    }
    for (int e = gtid; e < S * 16; e += gn) {
        const int pos = e >> 4, i = e & 15;
        const double inv = exp2(-(double)(2 * i) / 32.0 * 13.287712379549449);
        const double a = (double)pos * inv;
        cosB[e] = (float)cos(a); sinB[e] = (float)sin(a);
    }
    {
        const int lane = tid & 63, wave = tid >> 6;
        float* scr = lds + wave * (64 * 33);
        const int gw = blockIdx.x * NWAVES + wave, NGW = gridDim.x * NWAVES;
        constexpr int I_IN = (D / 64) * (INW / 32), I_QU = (256 / 64) * (768 / 32), I_KV = (128 / 64) * (1024 / 32), I_OUT = (D / 64) * (D / 32), I_PQ = (D / 64) * (2048 / 32);
        constexpr int NITEMS = I_IN + I_QU + I_KV + I_OUT + I_PQ;
        __syncthreads();
        for (int it = gw; it < NITEMS; it += NGW) {
            int r = it;
            if (r < I_IN) { transpose_item<0>(p.w_in, D, INW, (unsigned short*)(p.ws + WS_WIN), nullptr, scr, r, lane); continue; } r -= I_IN;
            if (r < I_QU) { transpose_item<1>(p.w_qup, 256, 768, (unsigned short*)(p.ws + WS_WQUP), p.qnorm, scr, r, lane); continue; } r -= I_QU;
            if (r < I_KV) { transpose_item<0>(p.w_kvup, 128, 1024, (unsigned short*)(p.ws + WS_WKVUP), p.kvnorm, scr, r, lane); continue; } r -= I_KV;
            if (r < I_OUT) { transpose_item<0>(p.w_out, D, D, (unsigned short*)(p.ws + WS_WOUT), nullptr, scr, r, lane); continue; } r -= I_OUT;
            transpose_item<0>(p.w_pq, D, 2048, (unsigned short*)(p.ws + WS_WPQ), nullptr, scr, r, lane);
        }
        {
            u32x4* z = (u32x4*)(p.ws + WS_WIN + (size_t)INW * D * 2);
            const int nz = (1280 - INW) * D * 2 / 16;
            for (int e = blockIdx.x * NTHREADS + tid; e < nz; e += gridDim.x * NTHREADS) z[e] = (u32x4){0u, 0u, 0u, 0u};
        }
        {
            const f32x4* src = (const f32x4*)p.subk; unsigned long long* dst = (unsigned long long*)(p.ws + WS_SUBK);
            for (int e = blockIdx.x * NTHREADS + tid; e < 16 * 128 * 128 / 4; e += gridDim.x * NTHREADS) {
                const f32x4 v = src[e]; dst[e] = (unsigned long long)pk2(v.x, v.y) | ((unsigned long long)pk2(v.z, v.w) << 32);
            }
        }
    }
    {
        const int lane = tid & 63, wave = tid >> 6;
        for (int r = blockIdx.x * NWAVES + wave; r < 2 * NEXP; r += gridDim.x * NWAVES) {
            const int tab = r >= NEXP, row = r - tab * NEXP;
            const f32x4* src = (const f32x4*)((tab ? p.ev : p.eu) + (size_t)row * D) + lane;
            f32x4 v[4]; float am = 0.f;
#pragma unroll
            for (int j = 0; j < 4; ++j) { v[j] = src[64 * j]; am = fmaxf(am, fmaxf(fmaxf(fabsf(v[j].x), fabsf(v[j].y)), fmaxf(fabsf(v[j].z), fabsf(v[j].w)))); }
            am = wave_max(am);
            int ex = 0; (void)frexpf(am, &ex);
            const float sc = ldexpf(1.f, 8 - ex), isc = ldexpf(1.f, ex - 8);
            unsigned* dst = (unsigned*)(p.ws + (tab ? WS_EV8 : WS_EU8) + (size_t)row * D) + lane;
#pragma unroll
            for (int j = 0; j < 4; ++j) {
                int w = 0;
                w = __builtin_amdgcn_cvt_pk_fp8_f32(v[j].x * sc, v[j].y * sc, w, false);
                w = __builtin_amdgcn_cvt_pk_fp8_f32(v[j].z * sc, v[j].w * sc, w, true);
                dst[64 * j] = (unsigned)w;
            }
            if (lane == 0) ((float*)(p.ws + (tab ? WS_VS : WS_US)))[row] = isc;
        }
    }
}

template <bool BF>
__device__ void stage_norm_mod(const Params& p, const float* src, void* dstv, int sh_off, int sc_off) {
    const float* mod = (const float*)(p.ws + WS_MOD);
    const int lane = threadIdx.x & 63, wave = threadIdx.x >> 6;
    for (int t = blockIdx.x * NWAVES + wave; t < T; t += gridDim.x * NWAVES) {
        const int b = t >> 12;
        const f32x4* xr = (const f32x4*)(src + (size_t)t * D) + lane;
        f32x4 v[4]; float s = 0.f;
#pragma unroll
        for (int j = 0; j < 4; ++j) { v[j] = xr[64 * j]; s += v[j].x * v[j].x + v[j].y * v[j].y + v[j].z * v[j].z + v[j].w * v[j].w; }
        const float rstd = rsqrtf(wave_sum(s) * (1.f / D) + EPS);
#pragma unroll
        for (int j = 0; j < 4; ++j) {
            const f32x4 sh = *((const f32x4*)(mod + b * NMOD + sh_off) + lane + 64 * j);
            const f32x4 sc = *((const f32x4*)(mod + b * NMOD + sc_off) + lane + 64 * j);
            f32x4 r;
            r.x = v[j].x * rstd * (1.f + sc.x) + sh.x; r.y = v[j].y * rstd * (1.f + sc.y) + sh.y;
            r.z = v[j].z * rstd * (1.f + sc.z) + sh.z; r.w = v[j].w * rstd * (1.f + sc.w) + sh.w;
            if (BF) ((unsigned long long*)((unsigned short*)dstv + (size_t)t * D))[lane + 64 * j] = (unsigned long long)pk2(r.x, r.y) | ((unsigned long long)pk2(r.z, r.w) << 32);
            else ((f32x4*)((float*)dstv + (size_t)t * D))[lane + 64 * j] = r;
        }
    }
}

constexpr int TP = 128, TQ = 256, TBK = 64;
constexpr int XS_BYTES = TP * 128, YS_BYTES = TQ * 128, STG_BYTES = XS_BYTES + YS_BYTES;
__device__ __forceinline__ int swz(int r, int c) { return r * 128 + ((c ^ ((r >> 1) & 7)) << 4); }
template <class Epi>
__device__ void gemm_xyT(const unsigned short* X, int ldx, const unsigned short* Y, int ldy, int P, int Q, int K, unsigned char* lds, const Epi& epi) {
    const int tid = threadIdx.x, lane = tid & 63, wave = tid >> 6;
    const int wp = wave >> 2, wq = wave & 3, fr = lane & 15, fq = lane >> 4;
    const int nPt = P / TP, nQt = Q / TQ, nunits = nPt * nQt;
    const int G = gridDim.x, bx = blockIdx.x;
    const int vcu = (G % 8 == 0) ? (bx % 8) * (G / 8) + bx / 8 : bx;
    const int srow = tid >> 3, sc = tid & 7;
    const int nk = K / TBK;
    for (int u = vcu; u < nunits; u += G) {
        const int qt = u / nPt, pt = u % nPt, p0 = pt * TP, q0 = qt * TQ;
        f32x4 acc[4][4];
#pragma unroll
        for (int i = 0; i < 4; ++i)
#pragma unroll
            for (int j = 0; j < 4; ++j) acc[i][j] = (f32x4){0.f, 0.f, 0.f, 0.f};
        const unsigned short* xg = X + (size_t)(p0 + srow) * ldx + sc * 8;
        const unsigned short* yg = Y + (size_t)(q0 + srow) * ldy + sc * 8;
        u32x4 rx[2], ry[4];
#pragma unroll
        for (int i = 0; i < 2; ++i) rx[i] = *(const u32x4*)(xg + (size_t)(64 * i) * ldx);
#pragma unroll
        for (int i = 0; i < 4; ++i) ry[i] = *(const u32x4*)(yg + (size_t)(64 * i) * ldy);
        __syncthreads();
#pragma unroll
        for (int i = 0; i < 2; ++i) *(u32x4*)(lds + swz(srow + 64 * i, sc)) = rx[i];
#pragma unroll
        for (int i = 0; i < 4; ++i) *(u32x4*)(lds + XS_BYTES + swz(srow + 64 * i, sc)) = ry[i];
        __syncthreads();
        for (int kt = 0; kt < nk; ++kt) {
            unsigned char* st = lds + (kt & 1) * STG_BYTES;
            unsigned char* sn = lds + ((kt & 1) ^ 1) * STG_BYTES;
            const bool more = (kt + 1 < nk);
            if (more) {
                const int k1 = (kt + 1) * TBK;
#pragma unroll
                for (int i = 0; i < 2; ++i) rx[i] = *(const u32x4*)(xg + (size_t)(64 * i) * ldx + k1);
#pragma unroll
                for (int i = 0; i < 4; ++i) ry[i] = *(const u32x4*)(yg + (size_t)(64 * i) * ldy + k1);
            }
#pragma unroll
            for (int kk = 0; kk < 2; ++kk) {
                bf16x8 af[4], bfr[4];
#pragma unroll
                for (int i = 0; i < 4; ++i) af[i] = *(const bf16x8*)(st + swz(wp * 64 + i * 16 + fr, kk * 4 + fq));
#pragma unroll
                for (int j = 0; j < 4; ++j) bfr[j] = *(const bf16x8*)(st + XS_BYTES + swz(wq * 64 + j * 16 + fr, kk * 4 + fq));
#pragma unroll
                for (int i = 0; i < 4; ++i)
#pragma unroll
                    for (int j = 0; j < 4; ++j) acc[i][j] = __builtin_amdgcn_mfma_f32_16x16x32_bf16(af[i], bfr[j], acc[i][j], 0, 0, 0);
            }
            if (more) {
#pragma unroll
                for (int i = 0; i < 2; ++i) *(u32x4*)(sn + swz(srow + 64 * i, sc)) = rx[i];
#pragma unroll
                for (int i = 0; i < 4; ++i) *(u32x4*)(sn + XS_BYTES + swz(srow + 64 * i, sc)) = ry[i];
            }
            __syncthreads();
        }
        epi(acc, p0 + wp * 64, q0 + wq * 64, lane);
    }
}
struct EpiOutProj {
    const float* x; const float* gate; float* out;
    __device__ __forceinline__ void operator()(const f32x4 (&acc)[4][4], int pb, int qb, int lane) const {
        const int fr = lane & 15, fq = lane >> 4;
#pragma unroll
        for (int j = 0; j < 4; ++j) {
            const int t = qb + j * 16 + fr; const float* gt = gate + (t >> 12) * NMOD;
#pragma unroll
            for (int i = 0; i < 4; ++i) {
                const int n = pb + i * 16 + fq * 4;
                const f32x4 xv = *(const f32x4*)(x + (size_t)t * D + n), gv = *(const f32x4*)(gt + n);
                f32x4 r; r.x = xv.x + gv.x * acc[i][j].x; r.y = xv.y + gv.y * acc[i][j].y; r.z = xv.z + gv.z * acc[i][j].z; r.w = xv.w + gv.w * acc[i][j].w;
                *(f32x4*)(out + (size_t)t * D + n) = r;
            }
        }
    }
};
struct EpiStoreBf16 {
    unsigned short* C; int ldc;
    __device__ __forceinline__ void operator()(const f32x4 (&acc)[4][4], int pb, int qb, int lane) const {
        const int fr = lane & 15, fq = lane >> 4;
#pragma unroll
        for (int j = 0; j < 4; ++j) {
            const int t = qb + j * 16 + fr;
#pragma unroll
            for (int i = 0; i < 4; ++i) {
                const int n = pb + i * 16 + fq * 4;
                *(unsigned long long*)(C + (size_t)t * ldc + n) = (unsigned long long)pk2(acc[i][j].x, acc[i][j].y) | ((unsigned long long)pk2(acc[i][j].z, acc[i][j].w) << 32);
            }
        }
    }
};

constexpr int GBM = 128, GBN = 128, GBK = 32, GLD = 40;
template <int EPI>
__device__ void stage_gemm(const float* A, int lda, const float* W, int ldw, float* C, int ldc, int M, int N, int K,
                           const float* resid, const float* gate, unsigned short* lds) {
    unsigned short* sA = lds;
    unsigned short* sB = lds + GBM * GLD;
    const int tid = threadIdx.x, lane = tid & 63, wave = tid >> 6;
    const int wm = wave >> 1, wn = wave & 1, fr = lane & 15, fq = lane >> 4;
    const int nNt = (N + GBN - 1) / GBN, nMt = M / GBM, ntiles = nMt * nNt;
    const int a_row = tid >> 2, a_k = (tid & 3) * 8;
    const int b_n = tid & 127, b_k = (tid >> 7) * 8;
    for (int tile = blockIdx.x; tile < ntiles; tile += gridDim.x) {
        const int mt = tile / nNt, nt = tile % nNt, m0 = mt * GBM, n0 = nt * GBN;
        f32x4 acc[2][4];
#pragma unroll
        for (int i = 0; i < 2; ++i)
#pragma unroll
            for (int j = 0; j < 4; ++j) acc[i][j] = (f32x4){0.f, 0.f, 0.f, 0.f};
        const float* ap = A + (size_t)(m0 + a_row) * lda + a_k;
        const bool bok = (n0 + b_n) < N;
        const float* bp = W + (size_t)b_k * ldw + (n0 + b_n);
        f32x4 ra0, ra1; float rb[8];
        ra0 = *(const f32x4*)(ap); ra1 = *(const f32x4*)(ap + 4);
#pragma unroll
        for (int j = 0; j < 8; ++j) rb[j] = bok ? bp[(size_t)j * ldw] : 0.f;
        for (int k0 = 0; k0 < K; k0 += GBK) {
            __syncthreads();
            {
                u32x4 va; va.x = pk2(ra0.x, ra0.y); va.y = pk2(ra0.z, ra0.w); va.z = pk2(ra1.x, ra1.y); va.w = pk2(ra1.z, ra1.w);
                *(u32x4*)(sA + a_row * GLD + a_k) = va;
                u32x4 vb; vb.x = pk2(rb[0], rb[1]); vb.y = pk2(rb[2], rb[3]); vb.z = pk2(rb[4], rb[5]); vb.w = pk2(rb[6], rb[7]);
                *(u32x4*)(sB + b_n * GLD + b_k) = vb;
            }
            __syncthreads();
            if (k0 + GBK < K) {
                const float* ap2 = ap + (k0 + GBK);
                ra0 = *(const f32x4*)(ap2); ra1 = *(const f32x4*)(ap2 + 4);
                const float* bp2 = bp + (size_t)(k0 + GBK) * ldw;
#pragma unroll
                for (int j = 0; j < 8; ++j) rb[j] = bok ? bp2[(size_t)j * ldw] : 0.f;
            }
            bf16x8 af[2], bfr[4];
#pragma unroll
            for (int i = 0; i < 2; ++i) af[i] = *(const bf16x8*)(sA + (wm * 32 + i * 16 + fr) * GLD + fq * 8);
#pragma unroll
            for (int j = 0; j < 4; ++j) bfr[j] = *(const bf16x8*)(sB + (wn * 64 + j * 16 + fr) * GLD + fq * 8);
#pragma unroll
            for (int i = 0; i < 2; ++i)
#pragma unroll
                for (int j = 0; j < 4; ++j) acc[i][j] = __builtin_amdgcn_mfma_f32_16x16x32_bf16(af[i], bfr[j], acc[i][j], 0, 0, 0);
        }
#pragma unroll
        for (int i = 0; i < 2; ++i)
#pragma unroll
            for (int j = 0; j < 4; ++j) {
                const int col = n0 + wn * 64 + j * 16 + fr;
                if (col < N) {
#pragma unroll
                    for (int r = 0; r < 4; ++r) {
                        const int row = m0 + wm * 32 + i * 16 + fq * 4 + r;
                        float v = acc[i][j][r];
                        if (EPI == 1) v = resid[(size_t)row * ldc + col] + gate[(row >> 12) * NMOD + col] * v;
                        C[(size_t)row * ldc + col] = v;
                    }
                }
            }
    }
}

__device__ void stage_postproj(const Params& p) {
    float* proj = (float*)(p.ws + WS_PROJ);
    const float* cosA = (const float*)(p.ws + WS_COSA); const float* sinA = (const float*)(p.ws + WS_SINA);
    const float* cosB = (const float*)(p.ws + WS_COSB); const float* sinB = (const float*)(p.ws + WS_SINB);
    const int lane = threadIdx.x & 63, wave = threadIdx.x >> 6;
    for (int t = blockIdx.x * NWAVES + wave; t < T; t += gridDim.x * NWAVES) {
        const int pos = t & (S - 1);
        float* row = proj + (size_t)t * INW;
#pragma unroll
        for (int it = 0; it < 5; ++it) {
            const int e = it * 64 + lane;
            const int hh = e >> 5, i = e & 31;
            const int base = hh * 64;
            const float x1 = row[base + i], x2 = row[base + 32 + i];
            const float c = cosA[pos * 32 + i], s = sinA[pos * 32 + i];
            row[base + i] = x1 * c - x2 * s; row[base + 32 + i] = x2 * c + x1 * s;
        }
        {
            f32x4 v = *((const f32x4*)(row + C_QL) + lane);
            const float ss = wave_sum(v.x * v.x + v.y * v.y + v.z * v.z + v.w * v.w);
            const float rstd = rsqrtf(ss * (1.f / 256.f) + EPS);
            const f32x4 g = *((const f32x4*)p.qnorm + lane);
            v.x *= rstd * g.x; v.y *= rstd * g.y; v.z *= rstd * g.z; v.w *= rstd * g.w;
            *((f32x4*)(row + C_QL) + lane) = v;
        }
        {
            float a0 = row[C_KVL + lane * 2], a1 = row[C_KVL + lane * 2 + 1];
            const float ss = wave_sum(a0 * a0 + a1 * a1);
            const float rstd = rsqrtf(ss * (1.f / 128.f) + EPS);
            row[C_KVL + lane * 2] = a0 * rstd * p.kvnorm[lane * 2];
            row[C_KVL + lane * 2 + 1] = a1 * rstd * p.kvnorm[lane * 2 + 1];
        }
        if (lane < 16) {
            const float x1 = row[C_KR + lane], x2 = row[C_KR + 16 + lane];
            const float c = cosB[pos * 16 + lane], s = sinB[pos * 16 + lane];
            row[C_KR + lane] = x1 * c - x2 * s; row[C_KR + 16 + lane] = x2 * c + x1 * s;
        }
    }
}

constexpr float LOG2E = 1.4426950408889634f;
constexpr float QA_SCALE = 0.125f * LOG2E;
constexpr float QM_SCALE = 0.10206207261596575f * LOG2E;
__device__ void stage_attn_prep(const Params& p) {
    const float* proj = (const float*)(p.ws + WS_PROJ);
    const float* qm = p.out;
    const float* kvm = (const float*)(p.ws + WS_KVM);
    const float* cosB = (const float*)(p.ws + WS_COSB); const float* sinB = (const float*)(p.ws + WS_SINB);
    unsigned short* QA = (unsigned short*)(p.ws + WS_QA); unsigned short* KA = (unsigned short*)(p.ws + WS_KA); unsigned short* VAT = (unsigned short*)(p.ws + WS_VAT);
    unsigned short* QMB = (unsigned short*)(p.ws + WS_QMB); unsigned short* K96 = (unsigned short*)(p.ws + WS_K96); unsigned short* VT = (unsigned short*)(p.ws + WS_VT);
    const int lane = threadIdx.x & 63, wave = threadIdx.x >> 6;
    for (int t = blockIdx.x * NWAVES + wave; t < T; t += gridDim.x * NWAVES) {
        const int b = t >> 12, pos = t & (S - 1);
        const float* pr = proj + (size_t)t * INW;
        const float* qr = qm + (size_t)t * 768;
        const float* kr = kvm + (size_t)t * 1024;
#pragma unroll
        for (int h = 0; h < 8; ++h) QA[((size_t)(b * 8 + h) * S + pos) * 64 + lane] = (unsigned short)f2bf(pr[C_QA + h * 64 + lane] * QA_SCALE);
#pragma unroll
        for (int h = 0; h < 2; ++h) {
            KA[((size_t)(b * 2 + h) * S + pos) * 64 + lane] = (unsigned short)f2bf(pr[C_KA + h * 64 + lane]);
            VAT[((size_t)(b * 2 + h) * 64 + lane) * S + pos] = (unsigned short)f2bf(pr[C_VA + h * 64 + lane]);
        }
        const float krope = (lane < 32) ? pr[C_KR + lane] : 0.f;
        const int ri = lane & 15;
        const float cs = cosB[pos * 16 + ri], sn = sinB[pos * 16 + ri];
#pragma unroll
        for (int h = 0; h < 8; ++h) {
            const size_t qrow = ((size_t)(b * 8 + h) * S + pos) * 96;
            QMB[qrow + lane] = (unsigned short)f2bf(qr[h * 96 + lane] * QM_SCALE);
            if (lane < 32) {
                const float x1 = qr[h * 96 + 64 + ri], x2 = qr[h * 96 + 80 + ri];
                const float v = (lane < 16) ? (x1 * cs - x2 * sn) : (x2 * cs + x1 * sn);
                QMB[qrow + 64 + lane] = (unsigned short)f2bf(v * QM_SCALE);
                K96[qrow + 64 + lane] = (unsigned short)f2bf(krope);
            }
            K96[qrow + lane] = (unsigned short)f2bf(kr[h * 128 + lane]);
            VT[((size_t)(b * 8 + h) * 64 + lane) * S + pos] = (unsigned short)f2bf(kr[h * 128 + 64 + lane]);
        }
    }
}

typedef float f32x16 __attribute__((ext_vector_type(16)));
typedef __bf16 bf16x2_t __attribute__((ext_vector_type(2)));
__device__ __forceinline__ unsigned cvtpk(float lo, float hi) { f32x2 v = {lo, hi}; bf16x2_t b = __builtin_convertvector(v, bf16x2_t); return __builtin_bit_cast(unsigned, b); }
__device__ __forceinline__ int crow(int r, int hi) { return (r & 3) + 8 * (r >> 2) + 4 * hi; }
__device__ __forceinline__ int kperm(int rho) { return (rho & 0x13) | ((rho & 4) << 1) | ((rho & 8) >> 1); }

template <int DQK, bool SWA>
__device__ void stage_attn_flash(const Params& p, unsigned char* lds) {
    constexpr int NK = DQK / 16, KCH = DQK / 8, KSTR = (KCH + 1) * 16, VSTR = 144;
    constexpr int KT_BYTES = 64 * KSTR, VT_BYTES = 64 * VSTR, STG = KT_BYTES + VT_BYTES, NKC = 64 * KCH;
    const unsigned short* Qg = (const unsigned short*)(p.ws + (SWA ? WS_QA : WS_QMB));
    const unsigned short* Kg = (const unsigned short*)(p.ws + (SWA ? WS_KA : WS_K96));
    const unsigned short* Vg = (const unsigned short*)(p.ws + (SWA ? WS_VAT : WS_VT));
    unsigned short* O = (unsigned short*)(p.ws + WS_OAB);
    const int tid = threadIdx.x, lane = tid & 63, wave = tid >> 6, r32 = lane & 31, hi = lane >> 5;
    const int G = gridDim.x, bx = blockIdx.x;
    const int vcu = (G % 8 == 0) ? (bx % 8) * (G / 8) + bx / 8 : bx;
    const int nunits = SWA ? Bsz * 2 * 64 : Bsz * 8 * 16;
    const int kro = kperm(r32) * KSTR + hi * 16;
    const int vro = r32 * VSTR + hi * 16;
    const int kid0 = tid, kid1 = tid + 512;
    const int k0row = kid0 / KCH, k0c = kid0 % KCH, k1row = kid1 / KCH, k1c = kid1 % KCH;
    const int vrow = tid >> 3, vc = tid & 7;
    for (int u = vcu; u < nunits; u += G) {
        int b, qb, tlo, thi, sq, ocol; const unsigned short *Qp, *Kb, *Vb; float m, l;
        if (SWA) {
            qb = u & 63; const int kvh = (u >> 6) & 1; b = u >> 7;
            const int head = kvh * 4 + (wave >> 1);
            sq = qb * 64 + (wave & 1) * 32 + r32;
            Qp = Qg + ((size_t)(b * 8 + head) * S + sq) * 64;
            Kb = Kg + (size_t)(b * 2 + kvh) * S * 64; Vb = Vg + (size_t)(b * 2 + kvh) * 64 * S;
            tlo = qb - 2 < 0 ? 0 : qb - 2; thi = qb + 2 > 63 ? 63 : qb + 2;
            m = p.sink[head] * LOG2E; l = 0.5f; ocol = head * 64;
        } else {
            qb = u & 15; const int h = (u >> 4) & 7; b = u >> 7;
            sq = qb * 256 + wave * 32 + r32;
            Qp = Qg + ((size_t)(b * 8 + h) * S + sq) * 96;
            Kb = Kg + (size_t)(b * 8 + h) * S * 96; Vb = Vg + (size_t)(b * 8 + h) * 64 * S;
            tlo = 0; thi = 63; m = -1e30f; l = 0.f; ocol = 512 + h * 64;
        }
        bf16x8 qf[NK];
#pragma unroll
        for (int ks = 0; ks < NK; ++ks) qf[ks] = *(const bf16x8*)(Qp + ks * 16 + hi * 8);
        f32x16 o0, o1;
#pragma unroll
        for (int r = 0; r < 16; ++r) { o0[r] = 0.f; o1[r] = 0.f; }
        u32x4 rk0, rk1, rv;
        {
            const unsigned short* kt = Kb + (size_t)tlo * 64 * DQK;
            rk0 = *(const u32x4*)(kt + kid0 * 8);
            if (kid1 < NKC) rk1 = *(const u32x4*)(kt + kid1 * 8);
            rv = *(const u32x4*)(Vb + (size_t)vrow * S + tlo * 64 + vc * 8);
            *(u32x4*)(lds + k0row * KSTR + k0c * 16) = rk0;
            if (kid1 < NKC) *(u32x4*)(lds + k1row * KSTR + k1c * 16) = rk1;
            *(u32x4*)(lds + KT_BYTES + vrow * VSTR + vc * 16) = rv;
        }
        __syncthreads();
        for (int tt = tlo; tt <= thi; ++tt) {
            const unsigned char* Kl = lds + ((tt - tlo) & 1) * STG;
            const unsigned char* Vl = Kl + KT_BYTES;
            unsigned char* Kn = lds + (((tt - tlo) & 1) ^ 1) * STG;
            const bool more = tt < thi;
            if (more) {
                const unsigned short* kt = Kb + (size_t)(tt + 1) * 64 * DQK;
                rk0 = *(const u32x4*)(kt + kid0 * 8);
                if (kid1 < NKC) rk1 = *(const u32x4*)(kt + kid1 * 8);
                rv = *(const u32x4*)(Vb + (size_t)vrow * S + (tt + 1) * 64 + vc * 8);
            }
            f32x16 s0, s1;
#pragma unroll
            for (int r = 0; r < 16; ++r) { s0[r] = 0.f; s1[r] = 0.f; }
#pragma unroll
            for (int ks = 0; ks < NK; ++ks) {
                const bf16x8 kf0 = *(const bf16x8*)(Kl + kro + ks * 32);
                const bf16x8 kf1 = *(const bf16x8*)(Kl + 32 * KSTR + kro + ks * 32);
                s0 = __builtin_amdgcn_mfma_f32_32x32x16_bf16(kf0, qf[ks], s0, 0, 0, 0);
                s1 = __builtin_amdgcn_mfma_f32_32x32x16_bf16(kf1, qf[ks], s1, 0, 0, 0);
            }
            if (SWA) {
                const int rel = tt - qb;
                if (rel == -2 || rel == 2) {
                    const int qi = (wave & 1) * 32 + r32;
#pragma unroll
                    for (int r = 0; r < 16; ++r) {
                        const int kk = kperm(crow(r, hi));
                        const bool v0 = (rel == -2) ? (kk >= qi) : (kk <= qi);
                        const bool v1 = (rel == -2) ? (kk + 32 >= qi) : (kk + 32 <= qi);
                        s0[r] = v0 ? s0[r] : -1e30f; s1[r] = v1 ? s1[r] : -1e30f;
                    }
                }
            }
            float mx = fmaxf(s0[0], s1[0]);
#pragma unroll
            for (int r = 1; r < 16; ++r) mx = fmaxf(mx, fmaxf(s0[r], s1[r]));
            mx = fmaxf(mx, __shfl_xor(mx, 32));
            const float mn = fmaxf(m, mx);
            const float alpha = __builtin_amdgcn_exp2f(m - mn);
            m = mn;
            float rs = 0.f;
#pragma unroll
            for (int r = 0; r < 16; ++r) { s0[r] = __builtin_amdgcn_exp2f(s0[r] - mn); s1[r] = __builtin_amdgcn_exp2f(s1[r] - mn); rs += s0[r] + s1[r]; }
            l = l * alpha + rs;
#pragma unroll
            for (int r = 0; r < 16; ++r) { o0[r] *= alpha; o1[r] *= alpha; }
#pragma unroll
            for (int st = 0; st < 2; ++st) {
                u32x4 pw;
                pw.x = cvtpk(s0[8 * st + 0], s0[8 * st + 1]); pw.y = cvtpk(s0[8 * st + 2], s0[8 * st + 3]);
                pw.z = cvtpk(s0[8 * st + 4], s0[8 * st + 5]); pw.w = cvtpk(s0[8 * st + 6], s0[8 * st + 7]);
                const bf16x8 pf = __builtin_bit_cast(bf16x8, pw);
                const bf16x8 vf0 = *(const bf16x8*)(Vl + vro + st * 32);
                const bf16x8 vf1 = *(const bf16x8*)(Vl + 32 * VSTR + vro + st * 32);
                o0 = __builtin_amdgcn_mfma_f32_32x32x16_bf16(vf0, pf, o0, 0, 0, 0);
                o1 = __builtin_amdgcn_mfma_f32_32x32x16_bf16(vf1, pf, o1, 0, 0, 0);
            }
#pragma unroll
            for (int st = 0; st < 2; ++st) {
                u32x4 pw;
                pw.x = cvtpk(s1[8 * st + 0], s1[8 * st + 1]); pw.y = cvtpk(s1[8 * st + 2], s1[8 * st + 3]);
                pw.z = cvtpk(s1[8 * st + 4], s1[8 * st + 5]); pw.w = cvtpk(s1[8 * st + 6], s1[8 * st + 7]);
                const bf16x8 pf = __builtin_bit_cast(bf16x8, pw);
                const bf16x8 vf0 = *(const bf16x8*)(Vl + vro + 64 + st * 32);
                const bf16x8 vf1 = *(const bf16x8*)(Vl + 32 * VSTR + vro + 64 + st * 32);
                o0 = __builtin_amdgcn_mfma_f32_32x32x16_bf16(vf0, pf, o0, 0, 0, 0);
                o1 = __builtin_amdgcn_mfma_f32_32x32x16_bf16(vf1, pf, o1, 0, 0, 0);
            }
            if (more) {
                *(u32x4*)(Kn + k0row * KSTR + k0c * 16) = rk0;
                if (kid1 < NKC) *(u32x4*)(Kn + k1row * KSTR + k1c * 16) = rk1;
                *(u32x4*)(Kn + KT_BYTES + vrow * VSTR + vc * 16) = rv;
            }
            __syncthreads();
        }
        const float il = 1.f / (l + __shfl_xor(l, 32));
        unsigned short* orow = O + (size_t)(b * S + sq) * D + ocol + 4 * hi;
#pragma unroll
        for (int g = 0; g < 4; ++g) {
            *(unsigned long long*)(orow + 8 * g) = (unsigned long long)cvtpk(o0[4 * g] * il, o0[4 * g + 1] * il) | ((unsigned long long)cvtpk(o0[4 * g + 2] * il, o0[4 * g + 3] * il) << 32);
            *(unsigned long long*)(orow + 32 + 8 * g) = (unsigned long long)cvtpk(o1[4 * g] * il, o1[4 * g + 1] * il) | ((unsigned long long)cvtpk(o1[4 * g + 2] * il, o1[4 * g + 3] * il) << 32);
        }
    }
}

__device__ void stage_outnorm(const Params& p) {
    const unsigned short* oab = (const unsigned short*)(p.ws + WS_OAB);
    unsigned short* mixed = (unsigned short*)(p.ws + WS_HB);
    const int lane = threadIdx.x & 63, wave = threadIdx.x >> 6;
    for (int t = blockIdx.x * NWAVES + wave; t < T; t += gridDim.x * NWAVES) {
        const u32x4* r = (const u32x4*)(oab + (size_t)t * D) + lane;
        u32x4* o = (u32x4*)(mixed + (size_t)t * D) + lane;
#pragma unroll
        for (int half = 0; half < 2; ++half) {
            const u32x4 w = r[half * 64];
            float v[8] = {bflo(w.x), bfhi(w.x), bflo(w.y), bfhi(w.y), bflo(w.z), bfhi(w.z), bflo(w.w), bfhi(w.w)};
            float s = 0.f;
#pragma unroll
            for (int i = 0; i < 8; ++i) s += v[i] * v[i];
            const float rstd = rsqrtf(wave_sum(s) * (1.f / 512.f) + EPS);
            const float* gn = (half ? p.onorm_b : p.onorm_a) + lane * 8;
            const f32x4 g0 = *(const f32x4*)gn, g1 = *(const f32x4*)(gn + 4);
            u32x4 ov;
            ov.x = pk2(v[0] * rstd * g0.x, v[1] * rstd * g0.y); ov.y = pk2(v[2] * rstd * g0.z, v[3] * rstd * g0.w);
            ov.z = pk2(v[4] * rstd * g1.x, v[5] * rstd * g1.y); ov.w = pk2(v[6] * rstd * g1.z, v[7] * rstd * g1.w);
            o[half * 64] = ov;
        }
    }
}

__device__ __forceinline__ void top_insert(float (&tv)[16], int (&ti)[16], float s, int id) {
    if (s > tv[15]) {
        tv[15] = s; ti[15] = id;
#pragma unroll
        for (int i = 15; i > 0; --i) {
            const bool sw = tv[i] > tv[i - 1];
            const float a = tv[i], b = tv[i - 1]; const int ia = ti[i], ib = ti[i - 1];
            tv[i] = sw ? b : a; tv[i - 1] = sw ? a : b; ti[i] = sw ? ib : ia; ti[i - 1] = sw ? ia : ib;
        }
    }
}
__device__ void stage_peer_scores(const Params& p) {
    const unsigned short* pq = (const unsigned short*)(p.ws + WS_PQ);
    float* tops = (float*)(p.ws + WS_TOPS); unsigned char* topi = (unsigned char*)(p.ws + WS_TOPI);
    const int lane = threadIdx.x & 63;
    const int wave = __builtin_amdgcn_readfirstlane(threadIdx.x >> 6);
    const int nitems = (T / 64) * 16;
    for (int item = blockIdx.x * NWAVES + wave; item < nitems; item += gridDim.x * NWAVES) {
        const int hp = item & 15, tb = item >> 4;
        const int t = tb * 64 + lane;
        float q[128];
        const u32x4* qr = (const u32x4*)(pq + (size_t)t * 2048 + hp * 128);
#pragma unroll
        for (int d8 = 0; d8 < 16; ++d8) {
            const u32x4 w = qr[d8];
            q[d8 * 8 + 0] = bflo(w.x); q[d8 * 8 + 1] = bfhi(w.x); q[d8 * 8 + 2] = bflo(w.y); q[d8 * 8 + 3] = bfhi(w.y);
            q[d8 * 8 + 4] = bflo(w.z); q[d8 * 8 + 5] = bfhi(w.z); q[d8 * 8 + 6] = bflo(w.w); q[d8 * 8 + 7] = bfhi(w.w);
        }
        float tv[16]; int ti[16];
#pragma unroll
        for (int i = 0; i < 16; ++i) { tv[i] = -3.0e38f; ti[i] = 0; }
        const float* kb = p.subk + (size_t)hp * 128 * 128;
        for (int n = 0; n < 128; ++n) {
            const float* kr = kb + n * 128;
            float s0 = 0.f, s1 = 0.f;
#pragma unroll
            for (int d = 0; d < 128; d += 2) { s0 += q[d] * kr[d]; s1 += q[d + 1] * kr[d + 1]; }
            top_insert(tv, ti, s0 + s1, n);
        }
        float* os = tops + ((size_t)t * 16 + hp) * 16; unsigned char* oi = topi + ((size_t)t * 16 + hp) * 16;
#pragma unroll
        for (int i = 0; i < 16; ++i) { os[i] = tv[i]; oi[i] = (unsigned char)ti[i]; }
    }
}
__device__ void stage_peer_select(const Params& p) {
    const float* tops = (const float*)(p.ws + WS_TOPS); const unsigned char* topi = (const unsigned char*)(p.ws + WS_TOPI);
    unsigned short* idx = (unsigned short*)(p.ws + WS_IDX); float* g = (float*)(p.ws + WS_G);
    for (int e = blockIdx.x * NTHREADS + threadIdx.x; e < T * 8; e += gridDim.x * NTHREADS) {
        const float* s0 = tops + (size_t)e * 32; const float* s1 = s0 + 16;
        const unsigned char* i0 = topi + (size_t)e * 32; const unsigned char* i1 = i0 + 16;
        float a[16], b[16]; int ia[16], ib[16];
#pragma unroll
        for (int i = 0; i < 16; ++i) { a[i] = s0[i]; b[i] = s1[i]; ia[i] = i0[i]; ib[i] = i1[i]; }
        float tv[16]; int ti[16];
#pragma unroll
        for (int i = 0; i < 16; ++i) { tv[i] = -3.0e38f; ti[i] = 0; }
#pragma unroll
        for (int i = 0; i < 16; ++i)
#pragma unroll
            for (int j = 0; j < 16; ++j)
                if ((i + 1) * (j + 1) <= 16) top_insert(tv, ti, a[i] + b[j], ia[i] * 128 + ib[j]);
        float sum = 0.f, ex[16];
#pragma unroll
        for (int i = 0; i < 16; ++i) { ex[i] = __expf(tv[i] - tv[0]); sum += ex[i]; }
        const float inv = 1.f / sum;
#pragma unroll
        for (int i = 0; i < 16; ++i) { idx[(size_t)e * 16 + i] = (unsigned short)ti[i]; g[(size_t)e * 16 + i] = ex[i] * inv; }
    }
}
__device__ __forceinline__ void ld_row4(u32x4 (&d)[4], const unsigned char* tab, int id, int l16) {
    const u32x4* r = (const u32x4*)(tab + (size_t)id * D + l16 * 16);
#pragma unroll
    for (int j = 0; j < 4; ++j) d[j] = r[16 * j];
}
__device__ void stage_peer_gather(const Params& p) {
    const unsigned short* h2 = (const unsigned short*)(p.ws + WS_HB);
    const float* mod = (const float*)(p.ws + WS_MOD);
    const unsigned short* idx = (const unsigned short*)(p.ws + WS_IDX); const float* g = (const float*)(p.ws + WS_G);
    const unsigned char* eu8 = p.ws + WS_EU8; const unsigned char* ev8 = p.ws + WS_EV8;
    const float* us = (const float*)(p.ws + WS_US); const float* vs = (const float*)(p.ws + WS_VS);
    const int lane = threadIdx.x & 63, wave = threadIdx.x >> 6, l16 = lane & 15, grp = lane >> 4;
    for (int t = blockIdx.x * NWAVES + wave; t < T; t += gridDim.x * NWAVES) {
        const int b = t >> 12;
        float hreg[64];
#pragma unroll
        for (int j = 0; j < 4; ++j)
#pragma unroll
            for (int c = 0; c < 2; ++c) {
                const u32x4 w = *(const u32x4*)(h2 + (size_t)t * D + j * 256 + l16 * 16 + c * 8);
                hreg[j * 16 + c * 8 + 0] = bflo(w.x); hreg[j * 16 + c * 8 + 1] = bfhi(w.x); hreg[j * 16 + c * 8 + 2] = bflo(w.y); hreg[j * 16 + c * 8 + 3] = bfhi(w.y);
                hreg[j * 16 + c * 8 + 4] = bflo(w.z); hreg[j * 16 + c * 8 + 5] = bfhi(w.z); hreg[j * 16 + c * 8 + 6] = bflo(w.w); hreg[j * 16 + c * 8 + 7] = bfhi(w.w);
            }
        const int idv0 = idx[(size_t)t * 128 + lane], idv1 = idx[(size_t)t * 128 + 64 + lane];
        const float gv0 = g[(size_t)t * 128 + lane], gv1 = g[(size_t)t * 128 + 64 + lane];
        float wv0 = 0.f, wv1 = 0.f;
        {
            u32x4 cur[4], nxt[4];
            int id_c = __shfl(idv0, grp);
            ld_row4(cur, eu8, id_c, l16);
            float sc_c = us[id_c];
#pragma unroll 2
            for (int q = 0; q < 32; ++q) {
                const int qn = (q + 1 < 32) ? q + 1 : q;
                const int rn = qn * 4 + grp;
                const int id_n = __shfl((qn < 16) ? idv0 : idv1, rn & 63);
                ld_row4(nxt, eu8, id_n, l16);
                const float sc_n = us[id_n];
                float s0 = 0.f, s1 = 0.f;
#pragma unroll
                for (int j = 0; j < 4; ++j)
#pragma unroll
                    for (int c = 0; c < 4; ++c) {
                        const int w = (int)cur[j][c];
                        const f32x2 lo = __builtin_amdgcn_cvt_pk_f32_fp8(w, false), hi = __builtin_amdgcn_cvt_pk_f32_fp8(w, true);
                        s0 += lo.x * hreg[j * 16 + c * 4 + 0]; s1 += lo.y * hreg[j * 16 + c * 4 + 1];
                        s0 += hi.x * hreg[j * 16 + c * 4 + 2]; s1 += hi.y * hreg[j * 16 + c * 4 + 3];
                    }
                const float s = group16_sum(s0 + s1) * sc_c;
                const float act = 0.5f * s * (1.f + erff(s * 0.70710678118654752f));
                const int r = q * 4 + grp;
                const float gk = __shfl((q < 16) ? gv0 : gv1, r & 63);
                const float w = gk * act;
                const float wt = __shfl(w, (lane & 3) * 16);
                const bool mine = (lane >> 2) == (q & 15);
                if (q < 16) wv0 = mine ? wt : wv0; else wv1 = mine ? wt : wv1;
#pragma unroll
                for (int j = 0; j < 4; ++j) cur[j] = nxt[j];
                sc_c = sc_n;
            }
        }
        float acc[64];
#pragma unroll
        for (int i = 0; i < 64; ++i) acc[i] = 0.f;
        {
            u32x4 cur[4], nxt[4];
            int id_c = __shfl(idv0, grp);
            ld_row4(cur, ev8, id_c, l16);
            float sc_c = vs[id_c];
#pragma unroll 2
            for (int q = 0; q < 32; ++q) {
                const int qn = (q + 1 < 32) ? q + 1 : q;
                const int rn = qn * 4 + grp;
                const int id_n = __shfl((qn < 16) ? idv0 : idv1, rn & 63);
                ld_row4(nxt, ev8, id_n, l16);
                const float sc_n = vs[id_n];
                const int r = q * 4 + grp;
                const float wv = __shfl((q < 16) ? wv0 : wv1, r & 63) * sc_c;
#pragma unroll
                for (int j = 0; j < 4; ++j)
#pragma unroll
                    for (int c = 0; c < 4; ++c) {
                        const int w = (int)cur[j][c];
                        const f32x2 lo = __builtin_amdgcn_cvt_pk_f32_fp8(w, false), hi = __builtin_amdgcn_cvt_pk_f32_fp8(w, true);
                        acc[j * 16 + c * 4 + 0] += wv * lo.x; acc[j * 16 + c * 4 + 1] += wv * lo.y;
                        acc[j * 16 + c * 4 + 2] += wv * hi.x; acc[j * 16 + c * 4 + 3] += wv * hi.y;
                    }
#pragma unroll
                for (int j = 0; j < 4; ++j) cur[j] = nxt[j];
                sc_c = sc_n;
            }
        }
#pragma unroll
        for (int i = 0; i < 64; ++i) { acc[i] += __shfl_xor(acc[i], 16); acc[i] += __shfl_xor(acc[i], 32); }
        float sel[16];
#pragma unroll
        for (int bb = 0; bb < 16; ++bb) sel[bb] = (grp == 0) ? acc[bb] : (grp == 1) ? acc[16 + bb] : (grp == 2) ? acc[32 + bb] : acc[48 + bb];
        const int eoff = grp * 256 + l16 * 16;
        float* xr = p.out + (size_t)t * D + eoff;
        const float* gf = mod + b * NMOD + 5 * D + eoff;
        float ss = 0.f;
#pragma unroll
        for (int c = 0; c < 4; ++c) {
            const f32x4 x1 = *(const f32x4*)(xr + c * 4); const f32x4 gg = *(const f32x4*)(gf + c * 4);
            sel[c * 4 + 0] = x1.x + gg.x * sel[c * 4 + 0]; sel[c * 4 + 1] = x1.y + gg.y * sel[c * 4 + 1];
            sel[c * 4 + 2] = x1.z + gg.z * sel[c * 4 + 2]; sel[c * 4 + 3] = x1.w + gg.w * sel[c * 4 + 3];
            ss += sel[c * 4 + 0] * sel[c * 4 + 0] + sel[c * 4 + 1] * sel[c * 4 + 1] + sel[c * 4 + 2] * sel[c * 4 + 2] + sel[c * 4 + 3] * sel[c * 4 + 3];
        }
        const float rstd = rsqrtf(wave_sum(ss) * (1.f / D) + EPS);
#pragma unroll
        for (int c = 0; c < 4; ++c) {
            const f32x4 fn = *(const f32x4*)(p.fnorm + eoff + c * 4);
            f32x4 r; r.x = sel[c * 4 + 0] * rstd * fn.x; r.y = sel[c * 4 + 1] * rstd * fn.y; r.z = sel[c * 4 + 2] * rstd * fn.z; r.w = sel[c * 4 + 3] * rstd * fn.w;
            *(f32x4*)(xr + c * 4) = r;
        }
    }
}

__global__ void __launch_bounds__(NTHREADS) fwd_megakernel(Params p) {
    extern __shared__ __attribute__((aligned(16))) unsigned char lds_raw[];
    cg::grid_group grid = cg::this_grid();
    float* hf = (float*)(p.ws + WS_H);
    unsigned short* hb = (unsigned short*)(p.ws + WS_HB);
    float* proj = (float*)(p.ws + WS_PROJ);
    const float* mod = (const float*)(p.ws + WS_MOD);

    stage_prologue(p, (float*)lds_raw);
    grid.sync();
    stage_norm_mod<false>(p, p.x, hf, 0 * D, 1 * D);
    grid.sync();
    stage_gemm<0>(hf, D, p.w_in, INW, proj, INW, T, INW, D, nullptr, nullptr, (unsigned short*)lds_raw);
    grid.sync();
    stage_postproj(p);
    grid.sync();
    stage_gemm<0>(proj + C_QL, INW, p.w_qup, 768, p.out, 768, T, 768, 256, nullptr, nullptr, (unsigned short*)lds_raw);
    stage_gemm<0>(proj + C_KVL, INW, p.w_kvup, 1024, (float*)(p.ws + WS_KVM), 1024, T, 1024, 128, nullptr, nullptr, (unsigned short*)lds_raw);
    grid.sync();
    stage_attn_prep(p);
    grid.sync();
    stage_attn_flash<64, true>(p, lds_raw);
    stage_attn_flash<96, false>(p, lds_raw);
    grid.sync();
    stage_outnorm(p);
    grid.sync();
    gemm_xyT((const unsigned short*)(p.ws + WS_WOUT), D, hb, D, D, T, D, lds_raw, EpiOutProj{p.x, mod + 2 * D, p.out});
    grid.sync();
    stage_norm_mod<true>(p, p.out, hb, 3 * D, 4 * D);
    grid.sync();
    gemm_xyT((const unsigned short*)(p.ws + WS_WPQ), D, hb, D, 2048, T, D, lds_raw, EpiStoreBf16{(unsigned short*)(p.ws + WS_PQ), 2048});
    grid.sync();
    stage_peer_scores(p);
    grid.sync();
    stage_peer_select(p);
    grid.sync();
    stage_peer_gather(p);
}

extern "C" void kernel_launch(void* const* d_in, const int* in_sizes, int n_in, void* d_out, int out_size, void* d_ws, size_t ws_size, hipStream_t stream) {
    static int grid_blocks = 0;
    if (grid_blocks == 0) {
        if (n_in != 18 || in_sizes[0] != T * D || out_size != T * D || ws_size < WS_END) {
            fprintf(stderr, "kernel_launch: unexpected shapes (n_in %d, in0 %d, out %d, ws %zu); nothing launched\n", n_in, n_in > 0 ? in_sizes[0] : -1, out_size, ws_size);
            grid_blocks = -1; return;
        }
        int dev = 0, cus = 0, per_cu = 0;
        (void)hipGetDevice(&dev);
        (void)hipDeviceGetAttribute(&cus, hipDeviceAttributeMultiprocessorCount, dev);
        if (hipFuncSetAttribute((const void*)fwd_megakernel, hipFuncAttributeMaxDynamicSharedMemorySize, LDS_BYTES) != hipSuccess) { fprintf(stderr, "kernel_launch: hipFuncSetAttribute failed\n"); grid_blocks = -1; return; }
        (void)hipOccupancyMaxActiveBlocksPerMultiprocessor(&per_cu, fwd_megakernel, NTHREADS, LDS_BYTES);
        if (per_cu < 1) { fprintf(stderr, "kernel_launch: occupancy query says %d blocks/CU\n", per_cu); grid_blocks = -1; return; }
        grid_blocks = cus;
    }
    if (grid_blocks < 0) return;
    Params p{};
    p.x = (const float*)d_in[0]; p.c = (const float*)d_in[1]; p.w_ada = (const float*)d_in[2]; p.b_ada = (const float*)d_in[3];
    p.w_in = (const float*)d_in[4]; p.sink = (const float*)d_in[5]; p.qnorm = (const float*)d_in[6]; p.w_qup = (const float*)d_in[7];
    p.kvnorm = (const float*)d_in[8]; p.w_kvup = (const float*)d_in[9]; p.onorm_a = (const float*)d_in[10]; p.onorm_b = (const float*)d_in[11];
    p.w_out = (const float*)d_in[12]; p.w_pq = (const float*)d_in[13]; p.subk = (const float*)d_in[14]; p.eu = (const float*)d_in[15];
    p.ev = (const float*)d_in[16]; p.fnorm = (const float*)d_in[17];
    p.out = (float*)d_out; p.ws = (unsigned char*)d_ws;
    void* args[] = {&p};
    hipError_t e = hipLaunchCooperativeKernel((void*)fwd_megakernel, dim3(grid_blocks), dim3(NTHREADS), args, LDS_BYTES, stream);
    if (e != hipSuccess) fprintf(stderr, "cooperative launch failed: %s (grid %d)\n", hipGetErrorString(e), grid_blocks);
}
```

```cpp
#include <hip/hip_runtime.h>
#include <hip/hip_cooperative_groups.h>
#include <cstdio>
#include <cstdint>
namespace cg = cooperative_groups;

constexpr int Bsz = 8, S = 4096, D = 1024, T = Bsz * S;
constexpr int INW = 1184;
constexpr int C_QA = 0, C_KA = 512, C_VA = 640, C_QL = 768, C_KVL = 1024, C_KR = 1152;
constexpr int NMOD = 6 * D;
constexpr float EPS = 1e-6f;
constexpr int NTHREADS = 512, NWAVES = 8;

constexpr size_t MiB = 1u << 20;
constexpr size_t WS_MOD = 0;
constexpr size_t WS_COSA = 1 * MiB;
constexpr size_t WS_SINA = WS_COSA + 512 * 1024;
constexpr size_t WS_COSB = 2 * MiB;
constexpr size_t WS_SINB = WS_COSB + 256 * 1024;
constexpr size_t WS_WIN = 4 * MiB;
constexpr size_t WS_WQUP = 7 * MiB;
constexpr size_t WS_WKVUP = 7 * MiB + 512 * 1024;
constexpr size_t WS_WOUT = 8 * MiB;
constexpr size_t WS_WPQ = 10 * MiB;
constexpr size_t WS_SUBK = 14 * MiB;
constexpr size_t WS_EU8 = 16 * MiB;
constexpr size_t WS_EV8 = 32 * MiB;
constexpr size_t WS_US = 48 * MiB;
constexpr size_t WS_VS = WS_US + 64 * 1024;
constexpr size_t WS_HB = 52 * MiB;
constexpr size_t WS_QA = 116 * MiB;
constexpr size_t WS_KA = 148 * MiB;
constexpr size_t WS_VAT = 156 * MiB;
constexpr size_t WS_QL = 164 * MiB;
constexpr size_t WS_KVL = 180 * MiB;
constexpr size_t WS_QMB = 192 * MiB;
constexpr size_t WS_K96 = 240 * MiB;
constexpr size_t WS_VT = 288 * MiB;
constexpr size_t WS_OAB = 320 * MiB;
constexpr size_t WS_PQ = 116 * MiB;
constexpr size_t WS_TOPS = 244 * MiB;
constexpr size_t WS_TOPI = 276 * MiB;
constexpr size_t WS_IDX = 284 * MiB;
constexpr size_t WS_G = 292 * MiB;
constexpr size_t WS_END = 384 * MiB;
constexpr int LDS_BYTES = 102400;
constexpr int NEXP = 16384;

struct Params {
    const float *x, *c, *w_ada, *b_ada, *w_in, *sink, *qnorm, *w_qup, *kvnorm, *w_kvup, *onorm_a, *onorm_b, *w_out, *w_pq, *subk, *eu, *ev, *fnorm;
    float* out;
    unsigned char* ws;
};

typedef short bf16x8 __attribute__((ext_vector_type(8)));
typedef float f32x4 __attribute__((ext_vector_type(4)));
typedef unsigned u32x4 __attribute__((ext_vector_type(4)));
typedef float f32x2 __attribute__((ext_vector_type(2)));

__device__ __forceinline__ unsigned f2bf(float f) { unsigned u = __builtin_bit_cast(unsigned, f); return (u + 0x7fffu + ((u >> 16) & 1u)) >> 16; }
__device__ __forceinline__ unsigned pk2(float lo, float hi) { return f2bf(lo) | (f2bf(hi) << 16); }
__device__ __forceinline__ float bf2f(unsigned short h) { return __builtin_bit_cast(float, (unsigned)h << 16); }
__device__ __forceinline__ float bflo(unsigned w) { return __builtin_bit_cast(float, w << 16); }
__device__ __forceinline__ float bfhi(unsigned w) { return __builtin_bit_cast(float, w & 0xffff0000u); }
__device__ __forceinline__ float wave_sum(float v) {
#pragma unroll
    for (int o = 1; o < 64; o <<= 1) v += __shfl_xor(v, o);
    return v;
}

__device__ __forceinline__ float wave_max(float v) {
#pragma unroll
    for (int o = 1; o < 64; o <<= 1) v = fmaxf(v, __shfl_xor(v, o));
    return v;
}
template <int CTRL> __device__ __forceinline__ float dpp_add(float s) {
    return s + __builtin_bit_cast(float, __builtin_amdgcn_update_dpp(0, __builtin_bit_cast(int, s), CTRL, 0xF, 0xF, true));
}
__device__ __forceinline__ float group16_sum(float s) { s = dpp_add<0xB1>(s); s = dpp_add<0x4E>(s); s = dpp_add<0x141>(s); s = dpp_add<0x140>(s); return s; }

template <int MAP> __device__ __forceinline__ int map_row(int n) {
    if (MAP == 1) { const int h = n / 96, j = n % 96; return j < 64 ? h * 64 + j : 512 + h * 32 + (j - 64); }
    return n;
}
template <int MAP>
__device__ __forceinline__ void transpose_item(const float* W, int K, int N, unsigned short* WT, const float* kgain, float* scr, int item, int lane) {
    const int nblk = N / 32, kb = item / nblk, nb = item % nblk, k0 = 64 * kb, n0 = 32 * nb;
#pragma unroll 8
    for (int i = 0; i < 32; ++i) {
        const int kk = 2 * i + (lane >> 5);
        float w = W[(size_t)(k0 + kk) * N + n0 + (lane & 31)];
        if (kgain) w *= kgain[k0 + kk];
        scr[kk * 33 + (lane & 31)] = w;
    }
    asm volatile("s_waitcnt lgkmcnt(0)" ::: "memory");
    const int c = lane & 7;
#pragma unroll
    for (int j = 0; j < 4; ++j) {
        const int n = (lane >> 3) + 8 * j; const float* q = scr + (8 * c) * 33 + n;
        u32x4 o; o.x = pk2(q[0 * 33], q[1 * 33]); o.y = pk2(q[2 * 33], q[3 * 33]); o.z = pk2(q[4 * 33], q[5 * 33]); o.w = pk2(q[6 * 33], q[7 * 33]);
        *(u32x4*)(WT + (size_t)map_row<MAP>(n0 + n) * K + k0 + 8 * c) = o;
    }
    asm volatile("s_waitcnt lgkmcnt(0)" ::: "memory");
}

__device__ void stage_prologue(const Params& p, float* lds) {
    float* mod = (float*)(p.ws + WS_MOD);
    const int tid = threadIdx.x;
    for (int i = tid; i < Bsz * D; i += NTHREADS) { float v = p.c[i]; lds[i] = v / (1.f + __expf(-v)); }
    __syncthreads();
    float* red = lds + Bsz * D;
    const int col_l = tid & 63, slice = tid >> 6;
    for (int item = blockIdx.x; item < NMOD / 64; item += gridDim.x) {
        const int n = item * 64 + col_l;
        float acc[Bsz];
#pragma unroll
        for (int b = 0; b < Bsz; ++b) acc[b] = 0.f;
        for (int kk = 0; kk < 128; ++kk) {
            const int k = slice * 128 + kk;
            const float w = p.w_ada[(size_t)k * NMOD + n];
#pragma unroll
            for (int b = 0; b < Bsz; ++b) acc[b] += lds[b * D + k] * w;
        }
#pragma unroll
        for (int b = 0; b < Bsz; ++b) red[(slice * 64 + col_l) * Bsz + b] = acc[b];
        __syncthreads();
        {
            const int cc = tid >> 3, b = tid & 7;
            float s = 0.f;
#pragma unroll
            for (int sl = 0; sl < 8; ++sl) s += red[(sl * 64 + cc) * Bsz + b];
            mod[b * NMOD + item * 64 + cc] = s + p.b_ada[item * 64 + cc];
        }
        __syncthreads();
    }
    float* cosA = (float*)(p.ws + WS_COSA); float* sinA = (float*)(p.ws + WS_SINA);
    float* cosB = (float*)(p.ws + WS_COSB); float* sinB = (float*)(p.ws + WS_SINB);
    const int gtid = blockIdx.x * NTHREADS + tid, gn = gridDim.x * NTHREADS;
    for (int e = gtid; e < S * 32; e += gn) {
        const int pos = e >> 5, i = e & 31;
        const double inv = exp2(-(double)(2 * i) / 64.0 * 13.287712379549449);
        const double a = (double)pos * inv;
        cosA[e] = (float)cos(a); sinA[e] = (float)sin(a);
    }
    for (int e = gtid; e < S * 16; e += gn) {
        const int pos = e >> 4, i = e & 15;
        const double inv = exp2(-(double)(2 * i) / 32.0 * 13.287712379549449);
        const double a = (double)pos * inv;
        cosB[e] = (float)cos(a); sinB[e] = (float)sin(a);
    }
    {
        const int lane = tid & 63, wave = tid >> 6;
        float* scr = lds + wave * (64 * 33);
        const int gw = blockIdx.x * NWAVES + wave, NGW = gridDim.x * NWAVES;
        constexpr int I_IN = (D / 64) * (INW / 32), I_QU = (256 / 64) * (768 / 32), I_KV = (128 / 64) * (1024 / 32), I_OUT = (D / 64) * (D / 32), I_PQ = (D / 64) * (2048 / 32);
        constexpr int NITEMS = I_IN + I_QU + I_KV + I_OUT + I_PQ;
        __syncthreads();
        for (int it = gw; it < NITEMS; it += NGW) {
            int r = it;
            if (r < I_IN) { transpose_item<0>(p.w_in, D, INW, (unsigned short*)(p.ws + WS_WIN), nullptr, scr, r, lane); continue; } r -= I_IN;
            if (r < I_QU) { transpose_item<1>(p.w_qup, 256, 768, (unsigned short*)(p.ws + WS_WQUP), p.qnorm, scr, r, lane); continue; } r -= I_QU;
            if (r < I_KV) { transpose_item<0>(p.w_kvup, 128, 1024, (unsigned short*)(p.ws + WS_WKVUP), p.kvnorm, scr, r, lane); continue; } r -= I_KV;
            if (r < I_OUT) { transpose_item<0>(p.w_out, D, D, (unsigned short*)(p.ws + WS_WOUT), nullptr, scr, r, lane); continue; } r -= I_OUT;
            transpose_item<0>(p.w_pq, D, 2048, (unsigned short*)(p.ws + WS_WPQ), nullptr, scr, r, lane);
        }
        {
            u32x4* z = (u32x4*)(p.ws + WS_WIN + (size_t)INW * D * 2);
            const int nz = (1280 - INW) * D * 2 / 16;
            for (int e = blockIdx.x * NTHREADS + tid; e < nz; e += gridDim.x * NTHREADS) z[e] = (u32x4){0u, 0u, 0u, 0u};
        }
        {
            const f32x4* src = (const f32x4*)p.subk; unsigned long long* dst = (unsigned long long*)(p.ws + WS_SUBK);
            for (int e = blockIdx.x * NTHREADS + tid; e < 16 * 128 * 128 / 4; e += gridDim.x * NTHREADS) {
                const f32x4 v = src[e]; dst[e] = (unsigned long long)pk2(v.x, v.y) | ((unsigned long long)pk2(v.z, v.w) << 32);
            }
        }
    }
    {
        const int lane = tid & 63, wave = tid >> 6;
        for (int r = blockIdx.x * NWAVES + wave; r < 2 * NEXP; r += gridDim.x * NWAVES) {
            const int tab = r >= NEXP, row = r - tab * NEXP;
            const f32x4* src = (const f32x4*)((tab ? p.ev : p.eu) + (size_t)row * D) + lane;
            f32x4 v[4]; float am = 0.f;
#pragma unroll
            for (int j = 0; j < 4; ++j) { v[j] = src[64 * j]; am = fmaxf(am, fmaxf(fmaxf(fabsf(v[j].x), fabsf(v[j].y)), fmaxf(fabsf(v[j].z), fabsf(v[j].w)))); }
            am = wave_max(am);
            int ex = 0; (void)frexpf(am, &ex);
            const float sc = ldexpf(1.f, 8 - ex), isc = ldexpf(1.f, ex - 8);
            unsigned* dst = (unsigned*)(p.ws + (tab ? WS_EV8 : WS_EU8) + (size_t)row * D) + lane;
#pragma unroll
            for (int j = 0; j < 4; ++j) {
                int w = 0;
                w = __builtin_amdgcn_cvt_pk_fp8_f32(v[j].x * sc, v[j].y * sc, w, false);
                w = __builtin_amdgcn_cvt_pk_fp8_f32(v[j].z * sc, v[j].w * sc, w, true);
                dst[64 * j] = (unsigned)w;
            }
            if (lane == 0) ((float*)(p.ws + (tab ? WS_VS : WS_US)))[row] = isc;
        }
    }
}

template <bool BF>
__device__ void stage_norm_mod(const Params& p, const float* src, void* dstv, int sh_off, int sc_off) {
    const float* mod = (const float*)(p.ws + WS_MOD);
    const int lane = threadIdx.x & 63, wave = threadIdx.x >> 6;
    for (int t = blockIdx.x * NWAVES + wave; t < T; t += gridDim.x * NWAVES) {
        const int b = t >> 12;
        const f32x4* xr = (const f32x4*)(src + (size_t)t * D) + lane;
        f32x4 v[4]; float s = 0.f;
#pragma unroll
        for (int j = 0; j < 4; ++j) { v[j] = xr[64 * j]; s += v[j].x * v[j].x + v[j].y * v[j].y + v[j].z * v[j].z + v[j].w * v[j].w; }
        const float rstd = rsqrtf(wave_sum(s) * (1.f / D) + EPS);
#pragma unroll
        for (int j = 0; j < 4; ++j) {
            const f32x4 sh = *((const f32x4*)(mod + b * NMOD + sh_off) + lane + 64 * j);
            const f32x4 sc = *((const f32x4*)(mod + b * NMOD + sc_off) + lane + 64 * j);
            f32x4 r;
            r.x = v[j].x * rstd * (1.f + sc.x) + sh.x; r.y = v[j].y * rstd * (1.f + sc.y) + sh.y;
            r.z = v[j].z * rstd * (1.f + sc.z) + sh.z; r.w = v[j].w * rstd * (1.f + sc.w) + sh.w;
            if (BF) ((unsigned long long*)((unsigned short*)dstv + (size_t)t * D))[lane + 64 * j] = (unsigned long long)pk2(r.x, r.y) | ((unsigned long long)pk2(r.z, r.w) << 32);
            else ((f32x4*)((float*)dstv + (size_t)t * D))[lane + 64 * j] = r;
        }
    }
}

constexpr int TP = 128, TQ = 256, TBK = 64;
constexpr int XS_BYTES = TP * 128, YS_BYTES = TQ * 128, STG_BYTES = XS_BYTES + YS_BYTES;
__device__ __forceinline__ int swz(int r, int c) { return r * 128 + ((c ^ ((r >> 1) & 7)) << 4); }
constexpr int SSQ_OFF = 2 * (TP * 128 + TQ * 128);
__device__ __forceinline__ float ssq8(u32x4 w) {
    const float a0 = bflo(w.x), a1 = bfhi(w.x), a2 = bflo(w.y), a3 = bfhi(w.y), a4 = bflo(w.z), a5 = bfhi(w.z), a6 = bflo(w.w), a7 = bfhi(w.w);
    return (a0 * a0 + a1 * a1) + (a2 * a2 + a3 * a3) + (a4 * a4 + a5 * a5) + (a6 * a6 + a7 * a7);
}
template <int WPN, bool YSSQ, class Epi>
__device__ void gemm_xyT(const unsigned short* X, int ldx, const unsigned short* Y, int ldy, int P, int Q, int K, int nb, size_t xbs, size_t ybs, unsigned char* lds, const Epi& epi) {
    constexpr int WQN = 8 / WPN, FI = TP / (WPN * 16), FJ = TQ / (WQN * 16);
    const int tid = threadIdx.x, lane = tid & 63, wave = tid >> 6;
    const int wp = wave / WQN, wq = wave % WQN, fr = lane & 15, fq = lane >> 4;
    const int nPt = P / TP, nQt = Q / TQ, npb = nPt * nb, nunits = npb * nQt;
    const int G = gridDim.x, bx = blockIdx.x;
    const int vcu = (G % 8 == 0) ? (bx % 8) * (G / 8) + bx / 8 : bx;
    const int srow = tid >> 3, sc = tid & 7;
    const int nk = K / TBK;
    for (int u = vcu; u < nunits; u += G) {
        const int qt = u / npb, rem = u % npb, bi = rem / nPt, pt = rem % nPt, p0 = pt * TP, q0 = qt * TQ;
        f32x4 acc[FI][FJ];
#pragma unroll
        for (int i = 0; i < FI; ++i)
#pragma unroll
            for (int j = 0; j < FJ; ++j) acc[i][j] = (f32x4){0.f, 0.f, 0.f, 0.f};
        const unsigned short* xg = X + (size_t)bi * xbs + (size_t)(p0 + srow) * ldx + sc * 8;
        const unsigned short* yg = Y + (size_t)bi * ybs + (size_t)(q0 + srow) * ldy + sc * 8;
        u32x4 rx[2], ry[4];
        float sq[4] = {0.f, 0.f, 0.f, 0.f};
#pragma unroll
        for (int i = 0; i < 2; ++i) rx[i] = *(const u32x4*)(xg + (size_t)(64 * i) * ldx);
#pragma unroll
        for (int i = 0; i < 4; ++i) ry[i] = *(const u32x4*)(yg + (size_t)(64 * i) * ldy);
        if (YSSQ) {
#pragma unroll
            for (int i = 0; i < 4; ++i) sq[i] += ssq8(ry[i]);
        }
        __syncthreads();
#pragma unroll
        for (int i = 0; i < 2; ++i) *(u32x4*)(lds + swz(srow + 64 * i, sc)) = rx[i];
#pragma unroll
        for (int i = 0; i < 4; ++i) *(u32x4*)(lds + XS_BYTES + swz(srow + 64 * i, sc)) = ry[i];
        __syncthreads();
        for (int kt = 0; kt < nk; ++kt) {
            unsigned char* st = lds + (kt & 1) * STG_BYTES;
            unsigned char* sn = lds + ((kt & 1) ^ 1) * STG_BYTES;
            const bool more = (kt + 1 < nk);
            if (more) {
                const int k1 = (kt + 1) * TBK;
#pragma unroll
                for (int i = 0; i < 2; ++i) rx[i] = *(const u32x4*)(xg + (size_t)(64 * i) * ldx + k1);
#pragma unroll
                for (int i = 0; i < 4; ++i) ry[i] = *(const u32x4*)(yg + (size_t)(64 * i) * ldy + k1);
            }
            if (YSSQ && more) {
#pragma unroll
                for (int i = 0; i < 4; ++i) sq[i] += ssq8(ry[i]);
            }
#pragma unroll
            for (int kk = 0; kk < 2; ++kk) {
                bf16x8 af[FI], bfr[FJ];
#pragma unroll
                for (int i = 0; i < FI; ++i) af[i] = *(const bf16x8*)(st + swz(wp * (FI * 16) + i * 16 + fr, kk * 4 + fq));
#pragma unroll
                for (int j = 0; j < FJ; ++j) bfr[j] = *(const bf16x8*)(st + XS_BYTES + swz(wq * (FJ * 16) + j * 16 + fr, kk * 4 + fq));
#pragma unroll
                for (int i = 0; i < FI; ++i)
#pragma unroll
                    for (int j = 0; j < FJ; ++j) acc[i][j] = __builtin_amdgcn_mfma_f32_16x16x32_bf16(af[i], bfr[j], acc[i][j], 0, 0, 0);
            }
            if (more) {
#pragma unroll
                for (int i = 0; i < 2; ++i) *(u32x4*)(sn + swz(srow + 64 * i, sc)) = rx[i];
#pragma unroll
                for (int i = 0; i < 4; ++i) *(u32x4*)(sn + XS_BYTES + swz(srow + 64 * i, sc)) = ry[i];
            }
            __syncthreads();
        }
        if (YSSQ) {
            float* ssq = (float*)(lds + SSQ_OFF);
#pragma unroll
            for (int i = 0; i < 4; ++i) {
                float v = sq[i];
                v += __shfl_xor(v, 1); v += __shfl_xor(v, 2); v += __shfl_xor(v, 4);
                if (sc == 0) ssq[srow + 64 * i] = v;
            }
            __syncthreads();
        }
        epi(acc, p0 + wp * (FI * 16), q0 + wq * (FJ * 16), lane, (const float*)(lds + SSQ_OFF) + wq * (FJ * 16), bi);
        if (YSSQ) __syncthreads();
    }
}
struct EpiOutProj {
    const float* x; const float* gate; float* out;
    __device__ __forceinline__ void operator()(const f32x4 (&acc)[4][4], int pb, int qb, int lane, const float*, int) const {
        const int fr = lane & 15, fq = lane >> 4;
#pragma unroll
        for (int j = 0; j < 4; ++j) {
            const int t = qb + j * 16 + fr; const float* gt = gate + (t >> 12) * NMOD;
#pragma unroll
            for (int i = 0; i < 4; ++i) {
                const int n = pb + i * 16 + fq * 4;
                const f32x4 xv = *(const f32x4*)(x + (size_t)t * D + n), gv = *(const f32x4*)(gt + n);
                f32x4 r; r.x = xv.x + gv.x * acc[i][j].x; r.y = xv.y + gv.y * acc[i][j].y; r.z = xv.z + gv.z * acc[i][j].z; r.w = xv.w + gv.w * acc[i][j].w;
                *(f32x4*)(out + (size_t)t * D + n) = r;
            }
        }
    }
};
struct EpiStoreBf16 {
    unsigned short* C; int ldc;
    __device__ __forceinline__ void operator()(const f32x4 (&acc)[4][4], int pb, int qb, int lane, const float*, int) const {
        const int fr = lane & 15, fq = lane >> 4;
#pragma unroll
        for (int j = 0; j < 4; ++j) {
            const int t = qb + j * 16 + fr;
#pragma unroll
            for (int i = 0; i < 4; ++i) {
                const int n = pb + i * 16 + fq * 4;
                *(unsigned long long*)(C + (size_t)t * ldc + n) = (unsigned long long)pk2(acc[i][j].x, acc[i][j].y) | ((unsigned long long)pk2(acc[i][j].z, acc[i][j].w) << 32);
            }
        }
    }
};

constexpr float LOG2E = 1.4426950408889634f;
constexpr float QA_SCALE = 0.125f * LOG2E;
constexpr float QM_SCALE = 0.10206207261596575f * LOG2E;
__device__ __forceinline__ unsigned long long pk4(float a, float b, float c, float d) { return (unsigned long long)pk2(a, b) | ((unsigned long long)pk2(c, d) << 32); }
struct EpiProj {
    unsigned char* ws;
    __device__ __forceinline__ void operator()(const f32x4 (&acc)[4][4], int pb, int qb, int lane, const float*, int) const {
        const int fr = lane & 15, fq = lane >> 4;
        unsigned short* QA = (unsigned short*)(ws + WS_QA); unsigned short* KA = (unsigned short*)(ws + WS_KA); unsigned short* VAT = (unsigned short*)(ws + WS_VAT);
        unsigned short* QL = (unsigned short*)(ws + WS_QL); unsigned short* KVL = (unsigned short*)(ws + WS_KVL); unsigned short* K96 = (unsigned short*)(ws + WS_K96);
        const float* cosA = (const float*)(ws + WS_COSA); const float* sinA = (const float*)(ws + WS_SINA);
        const float* cosB = (const float*)(ws + WS_COSB); const float* sinB = (const float*)(ws + WS_SINB);
        if (pb >= 1216) return;
#pragma unroll
        for (int j = 0; j < 4; ++j) {
            const int t = qb + j * 16 + fr, b = t >> 12, pos = t & (S - 1);
            if (pb < C_VA) {
                const bool isq = pb < C_KA;
                const int head = isq ? (pb >> 6) : ((pb - C_KA) >> 6);
                unsigned short* dst = isq ? QA + ((size_t)(b * 8 + head) * S + pos) * 64 : KA + ((size_t)(b * 2 + head) * S + pos) * 64;
                const float sc = isq ? QA_SCALE : 1.f;
#pragma unroll
                for (int i = 0; i < 2; ++i) {
                    const int d = i * 16 + fq * 4;
                    const f32x4 c = *(const f32x4*)(cosA + pos * 32 + d), sn = *(const f32x4*)(sinA + pos * 32 + d);
                    const f32x4 x1 = acc[i][j], x2 = acc[i + 2][j];
                    *(unsigned long long*)(dst + d) = pk4((x1.x * c.x - x2.x * sn.x) * sc, (x1.y * c.y - x2.y * sn.y) * sc, (x1.z * c.z - x2.z * sn.z) * sc, (x1.w * c.w - x2.w * sn.w) * sc);
                    *(unsigned long long*)(dst + 32 + d) = pk4((x2.x * c.x + x1.x * sn.x) * sc, (x2.y * c.y + x1.y * sn.y) * sc, (x2.z * c.z + x1.z * sn.z) * sc, (x2.w * c.w + x1.w * sn.w) * sc);
                }
            } else if (pb < C_QL) {
                const int kvh = (pb - C_VA) >> 6;
                unsigned short* dst = VAT + (size_t)(b * 2 + kvh) * 64 * S + pos;
#pragma unroll
                for (int i = 0; i < 4; ++i) {
                    const int dv = i * 16 + fq * 4;
                    dst[(size_t)(dv + 0) * S] = (unsigned short)f2bf(acc[i][j].x); dst[(size_t)(dv + 1) * S] = (unsigned short)f2bf(acc[i][j].y);
                    dst[(size_t)(dv + 2) * S] = (unsigned short)f2bf(acc[i][j].z); dst[(size_t)(dv + 3) * S] = (unsigned short)f2bf(acc[i][j].w);
                }
            } else if (pb < C_KVL) {
                unsigned short* dst = QL + (size_t)t * 256 + (pb - C_QL);
#pragma unroll
                for (int i = 0; i < 4; ++i) *(unsigned long long*)(dst + i * 16 + fq * 4) = pk4(acc[i][j].x, acc[i][j].y, acc[i][j].z, acc[i][j].w);
            } else if (pb < C_KR) {
                unsigned short* dst = KVL + (size_t)t * 128 + (pb - C_KVL);
#pragma unroll
                for (int i = 0; i < 4; ++i) *(unsigned long long*)(dst + i * 16 + fq * 4) = pk4(acc[i][j].x, acc[i][j].y, acc[i][j].z, acc[i][j].w);
            } else {
                const int d = fq * 4;
                const f32x4 c = *(const f32x4*)(cosB + pos * 16 + d), sn = *(const f32x4*)(sinB + pos * 16 + d);
                const f32x4 x1 = acc[0][j], x2 = acc[1][j];
                const unsigned long long lo = pk4(x1.x * c.x - x2.x * sn.x, x1.y * c.y - x2.y * sn.y, x1.z * c.z - x2.z * sn.z, x1.w * c.w - x2.w * sn.w);
                const unsigned long long hi = pk4(x2.x * c.x + x1.x * sn.x, x2.y * c.y + x1.y * sn.y, x2.z * c.z + x1.z * sn.z, x2.w * c.w + x1.w * sn.w);
#pragma unroll
                for (int h = 0; h < 8; ++h) {
                    unsigned short* dst = K96 + ((size_t)(b * 8 + h) * S + pos) * 96 + 64 + d;
                    *(unsigned long long*)dst = lo; *(unsigned long long*)(dst + 16) = hi;
                }
            }
        }
    }
};
struct EpiQup {
    unsigned char* ws;
    __device__ __forceinline__ void operator()(const f32x4 (&acc)[4][4], int pb, int qb, int lane, const float* ssq, int) const {
        const int fr = lane & 15, fq = lane >> 4;
        unsigned short* QMB = (unsigned short*)(ws + WS_QMB);
        const float* cosB = (const float*)(ws + WS_COSB); const float* sinB = (const float*)(ws + WS_SINB);
#pragma unroll
        for (int j = 0; j < 4; ++j) {
            const int t = qb + j * 16 + fr, b = t >> 12, pos = t & (S - 1);
            const float sc = rsqrtf(ssq[j * 16 + fr] * (1.f / 256.f) + EPS) * QM_SCALE;
            if (pb < 512) {
                unsigned short* dst = QMB + ((size_t)(b * 8 + (pb >> 6)) * S + pos) * 96;
#pragma unroll
                for (int i = 0; i < 4; ++i) *(unsigned long long*)(dst + i * 16 + fq * 4) = pk4(acc[i][j].x * sc, acc[i][j].y * sc, acc[i][j].z * sc, acc[i][j].w * sc);
            } else {
                const int d = fq * 4;
                const f32x4 c = *(const f32x4*)(cosB + pos * 16 + d), sn = *(const f32x4*)(sinB + pos * 16 + d);
#pragma unroll
                for (int hh = 0; hh < 2; ++hh) {
                    const int h = ((pb - 512) >> 5) + hh;
                    unsigned short* dst = QMB + ((size_t)(b * 8 + h) * S + pos) * 96 + 64 + d;
                    const f32x4 x1 = acc[2 * hh][j], x2 = acc[2 * hh + 1][j];
                    *(unsigned long long*)dst = pk4((x1.x * c.x - x2.x * sn.x) * sc, (x1.y * c.y - x2.y * sn.y) * sc, (x1.z * c.z - x2.z * sn.z) * sc, (x1.w * c.w - x2.w * sn.w) * sc);
                    *(unsigned long long*)(dst + 16) = pk4((x2.x * c.x + x1.x * sn.x) * sc, (x2.y * c.y + x1.y * sn.y) * sc, (x2.z * c.z + x1.z * sn.z) * sc, (x2.w * c.w + x1.w * sn.w) * sc);
                }
            }
        }
    }
};
struct EpiKVup {
    unsigned char* ws;
    __device__ __forceinline__ void operator()(const f32x4 (&acc)[4][4], int pb, int qb, int lane, const float* ssq, int) const {
        const int fr = lane & 15, fq = lane >> 4;
        unsigned short* K96 = (unsigned short*)(ws + WS_K96); unsigned short* VT = (unsigned short*)(ws + WS_VT);
        const int h = pb >> 7;
#pragma unroll
        for (int j = 0; j < 4; ++j) {
            const int t = qb + j * 16 + fr, b = t >> 12, pos = t & (S - 1);
            const float sc = rsqrtf(ssq[j * 16 + fr] * (1.f / 128.f) + EPS);
            if ((pb & 64) == 0) {
                unsigned short* dst = K96 + ((size_t)(b * 8 + h) * S + pos) * 96;
#pragma unroll
                for (int i = 0; i < 4; ++i) *(unsigned long long*)(dst + i * 16 + fq * 4) = pk4(acc[i][j].x * sc, acc[i][j].y * sc, acc[i][j].z * sc, acc[i][j].w * sc);
            } else {
                unsigned short* dst = VT + (size_t)(b * 8 + h) * 64 * S + pos;
#pragma unroll
                for (int i = 0; i < 4; ++i) {
                    const int dv = i * 16 + fq * 4;
                    dst[(size_t)(dv + 0) * S] = (unsigned short)f2bf(acc[i][j].x * sc); dst[(size_t)(dv + 1) * S] = (unsigned short)f2bf(acc[i][j].y * sc);
                    dst[(size_t)(dv + 2) * S] = (unsigned short)f2bf(acc[i][j].z * sc); dst[(size_t)(dv + 3) * S] = (unsigned short)f2bf(acc[i][j].w * sc);
                }
            }
        }
    }
};

typedef float f32x16 __attribute__((ext_vector_type(16)));
typedef __bf16 bf16x2_t __attribute__((ext_vector_type(2)));
__device__ __forceinline__ unsigned cvtpk(float lo, float hi) { f32x2 v = {lo, hi}; bf16x2_t b = __builtin_convertvector(v, bf16x2_t); return __builtin_bit_cast(unsigned, b); }
__device__ __forceinline__ int crow(int r, int hi) { return (r & 3) + 8 * (r >> 2) + 4 * hi; }
__device__ __forceinline__ int kperm(int rho) { return (rho & 0x13) | ((rho & 4) << 1) | ((rho & 8) >> 1); }

template <int DQK, bool SWA>
__device__ void stage_attn_flash(const Params& p, unsigned char* lds) {
    constexpr int NK = DQK / 16, KCH = DQK / 8, KSTR = (KCH + 1) * 16, VSTR = 144;
    constexpr int KT_BYTES = 64 * KSTR, VT_BYTES = 64 * VSTR, STG = KT_BYTES + VT_BYTES, NKC = 64 * KCH;
    const unsigned short* Qg = (const unsigned short*)(p.ws + (SWA ? WS_QA : WS_QMB));
    const unsigned short* Kg = (const unsigned short*)(p.ws + (SWA ? WS_KA : WS_K96));
    const unsigned short* Vg = (const unsigned short*)(p.ws + (SWA ? WS_VAT : WS_VT));
    unsigned short* O = (unsigned short*)(p.ws + WS_OAB);
    const int tid = threadIdx.x, lane = tid & 63, wave = tid >> 6, r32 = lane & 31, hi = lane >> 5;
    const int G = gridDim.x, bx = blockIdx.x;
    const int vcu = (G % 8 == 0) ? (bx % 8) * (G / 8) + bx / 8 : bx;
    const int nunits = SWA ? Bsz * 2 * 64 : Bsz * 8 * 16;
    const int kro = kperm(r32) * KSTR + hi * 16;
    const int vro = r32 * VSTR + hi * 16;
    const int kid0 = tid, kid1 = tid + 512;
    const int k0row = kid0 / KCH, k0c = kid0 % KCH, k1row = kid1 / KCH, k1c = kid1 % KCH;
    const int vrow = tid >> 3, vc = tid & 7;
    for (int u = vcu; u < nunits; u += G) {
        int b, qb, tlo, thi, sq, ocol; const unsigned short *Qp, *Kb, *Vb; float m, l;
        if (SWA) {
            qb = u & 63; const int kvh = (u >> 6) & 1; b = u >> 7;
            const int head = kvh * 4 + (wave >> 1);
            sq = qb * 64 + (wave & 1) * 32 + r32;
            Qp = Qg + ((size_t)(b * 8 + head) * S + sq) * 64;
            Kb = Kg + (size_t)(b * 2 + kvh) * S * 64; Vb = Vg + (size_t)(b * 2 + kvh) * 64 * S;
            tlo = qb - 2 < 0 ? 0 : qb - 2; thi = qb + 2 > 63 ? 63 : qb + 2;
            m = p.sink[head] * LOG2E; l = 0.5f; ocol = head * 64;
        } else {
            qb = u & 15; const int h = (u >> 4) & 7; b = u >> 7;
            sq = qb * 256 + wave * 32 + r32;
            Qp = Qg + ((size_t)(b * 8 + h) * S + sq) * 96;
            Kb = Kg + (size_t)(b * 8 + h) * S * 96; Vb = Vg + (size_t)(b * 8 + h) * 64 * S;
            tlo = 0; thi = 63; m = -1e30f; l = 0.f; ocol = 512 + h * 64;
        }
        bf16x8 qf[NK];
#pragma unroll
        for (int ks = 0; ks < NK; ++ks) qf[ks] = *(const bf16x8*)(Qp + ks * 16 + hi * 8);
        f32x16 o0, o1;
#pragma unroll
        for (int r = 0; r < 16; ++r) { o0[r] = 0.f; o1[r] = 0.f; }
        u32x4 rk0, rk1, rv;
        {
            const unsigned short* kt = Kb + (size_t)tlo * 64 * DQK;
            rk0 = *(const u32x4*)(kt + kid0 * 8);
            if (kid1 < NKC) rk1 = *(const u32x4*)(kt + kid1 * 8);
            rv = *(const u32x4*)(Vb + (size_t)vrow * S + tlo * 64 + vc * 8);
            *(u32x4*)(lds + k0row * KSTR + k0c * 16) = rk0;
            if (kid1 < NKC) *(u32x4*)(lds + k1row * KSTR + k1c * 16) = rk1;
            *(u32x4*)(lds + KT_BYTES + vrow * VSTR + vc * 16) = rv;
        }
        __syncthreads();
        for (int tt = tlo; tt <= thi; ++tt) {
            const unsigned char* Kl = lds + ((tt - tlo) & 1) * STG;
            const unsigned char* Vl = Kl + KT_BYTES;
            unsigned char* Kn = lds + (((tt - tlo) & 1) ^ 1) * STG;
            const bool more = tt < thi;
            if (more) {
                const unsigned short* kt = Kb + (size_t)(tt + 1) * 64 * DQK;
                rk0 = *(const u32x4*)(kt + kid0 * 8);
                if (kid1 < NKC) rk1 = *(const u32x4*)(kt + kid1 * 8);
                rv = *(const u32x4*)(Vb + (size_t)vrow * S + (tt + 1) * 64 + vc * 8);
            }
            f32x16 s0, s1;
#pragma unroll
            for (int r = 0; r < 16; ++r) { s0[r] = 0.f; s1[r] = 0.f; }
#pragma unroll
            for (int ks = 0; ks < NK; ++ks) {
                const bf16x8 kf0 = *(const bf16x8*)(Kl + kro + ks * 32);
                const bf16x8 kf1 = *(const bf16x8*)(Kl + 32 * KSTR + kro + ks * 32);
                s0 = __builtin_amdgcn_mfma_f32_32x32x16_bf16(kf0, qf[ks], s0, 0, 0, 0);
                s1 = __builtin_amdgcn_mfma_f32_32x32x16_bf16(kf1, qf[ks], s1, 0, 0, 0);
            }
            if (SWA) {
                const int rel = tt - qb;
                if (rel == -2 || rel == 2) {
                    const int qi = (wave & 1) * 32 + r32;
#pragma unroll
                    for (int r = 0; r < 16; ++r) {
                        const int kk = kperm(crow(r, hi));
                        const bool v0 = (rel == -2) ? (kk >= qi) : (kk <= qi);
                        const bool v1 = (rel == -2) ? (kk + 32 >= qi) : (kk + 32 <= qi);
                        s0[r] = v0 ? s0[r] : -1e30f; s1[r] = v1 ? s1[r] : -1e30f;
                    }
                }
            }
            float mx = fmaxf(s0[0], s1[0]);
#pragma unroll
            for (int r = 1; r < 16; ++r) mx = fmaxf(mx, fmaxf(s0[r], s1[r]));
            mx = fmaxf(mx, __shfl_xor(mx, 32));
            const float mn = fmaxf(m, mx);
            const float alpha = __builtin_amdgcn_exp2f(m - mn);
            m = mn;
            float rs = 0.f;
#pragma unroll
            for (int r = 0; r < 16; ++r) { s0[r] = __builtin_amdgcn_exp2f(s0[r] - mn); s1[r] = __builtin_amdgcn_exp2f(s1[r] - mn); rs += s0[r] + s1[r]; }
            l = l * alpha + rs;
#pragma unroll
            for (int r = 0; r < 16; ++r) { o0[r] *= alpha; o1[r] *= alpha; }
#pragma unroll
            for (int st = 0; st < 2; ++st) {
                u32x4 pw;
                pw.x = cvtpk(s0[8 * st + 0], s0[8 * st + 1]); pw.y = cvtpk(s0[8 * st + 2], s0[8 * st + 3]);
                pw.z = cvtpk(s0[8 * st + 4], s0[8 * st + 5]); pw.w = cvtpk(s0[8 * st + 6], s0[8 * st + 7]);
                const bf16x8 pf = __builtin_bit_cast(bf16x8, pw);
                const bf16x8 vf0 = *(const bf16x8*)(Vl + vro + st * 32);
                const bf16x8 vf1 = *(const bf16x8*)(Vl + 32 * VSTR + vro + st * 32);
                o0 = __builtin_amdgcn_mfma_f32_32x32x16_bf16(vf0, pf, o0, 0, 0, 0);
                o1 = __builtin_amdgcn_mfma_f32_32x32x16_bf16(vf1, pf, o1, 0, 0, 0);
            }
#pragma unroll
            for (int st = 0; st < 2; ++st) {
                u32x4 pw;
                pw.x = cvtpk(s1[8 * st + 0], s1[8 * st + 1]); pw.y = cvtpk(s1[8 * st + 2], s1[8 * st + 3]);
                pw.z = cvtpk(s1[8 * st + 4], s1[8 * st + 5]); pw.w = cvtpk(s1[8 * st + 6], s1[8 * st + 7]);
                const bf16x8 pf = __builtin_bit_cast(bf16x8, pw);
                const bf16x8 vf0 = *(const bf16x8*)(Vl + vro + 64 + st * 32);
                const bf16x8 vf1 = *(const bf16x8*)(Vl + 32 * VSTR + vro + 64 + st * 32);
                o0 = __builtin_amdgcn_mfma_f32_32x32x16_bf16(vf0, pf, o0, 0, 0, 0);
                o1 = __builtin_amdgcn_mfma_f32_32x32x16_bf16(vf1, pf, o1, 0, 0, 0);
            }
            if (more) {
                *(u32x4*)(Kn + k0row * KSTR + k0c * 16) = rk0;
                if (kid1 < NKC) *(u32x4*)(Kn + k1row * KSTR + k1c * 16) = rk1;
                *(u32x4*)(Kn + KT_BYTES + vrow * VSTR + vc * 16) = rv;
            }
            __syncthreads();
        }
        const float il = 1.f / (l + __shfl_xor(l, 32));
        unsigned short* orow = O + (size_t)(b * S + sq) * D + ocol + 4 * hi;
#pragma unroll
        for (int g = 0; g < 4; ++g) {
            *(unsigned long long*)(orow + 8 * g) = (unsigned long long)cvtpk(o0[4 * g] * il, o0[4 * g + 1] * il) | ((unsigned long long)cvtpk(o0[4 * g + 2] * il, o0[4 * g + 3] * il) << 32);
            *(unsigned long long*)(orow + 32 + 8 * g) = (unsigned long long)cvtpk(o1[4 * g] * il, o1[4 * g + 1] * il) | ((unsigned long long)cvtpk(o1[4 * g + 2] * il, o1[4 * g + 3] * il) << 32);
        }
    }
}

__device__ void stage_outnorm(const Params& p) {
    const unsigned short* oab = (const unsigned short*)(p.ws + WS_OAB);
    unsigned short* mixed = (unsigned short*)(p.ws + WS_HB);
    const int lane = threadIdx.x & 63, wave = threadIdx.x >> 6;
    for (int t = blockIdx.x * NWAVES + wave; t < T; t += gridDim.x * NWAVES) {
        const u32x4* r = (const u32x4*)(oab + (size_t)t * D) + lane;
        u32x4* o = (u32x4*)(mixed + (size_t)t * D) + lane;
#pragma unroll
        for (int half = 0; half < 2; ++half) {
            const u32x4 w = r[half * 64];
            float v[8] = {bflo(w.x), bfhi(w.x), bflo(w.y), bfhi(w.y), bflo(w.z), bfhi(w.z), bflo(w.w), bfhi(w.w)};
            float s = 0.f;
#pragma unroll
            for (int i = 0; i < 8; ++i) s += v[i] * v[i];
            const float rstd = rsqrtf(wave_sum(s) * (1.f / 512.f) + EPS);
            const float* gn = (half ? p.onorm_b : p.onorm_a) + lane * 8;
            const f32x4 g0 = *(const f32x4*)gn, g1 = *(const f32x4*)(gn + 4);
            u32x4 ov;
            ov.x = pk2(v[0] * rstd * g0.x, v[1] * rstd * g0.y); ov.y = pk2(v[2] * rstd * g0.z, v[3] * rstd * g0.w);
            ov.z = pk2(v[4] * rstd * g1.x, v[5] * rstd * g1.y); ov.w = pk2(v[6] * rstd * g1.z, v[7] * rstd * g1.w);
            o[half * 64] = ov;
        }
    }
}

__device__ __forceinline__ void ce_desc(int& a, int& b) { const int hi = max(a, b), lo = min(a, b); a = hi; b = lo; }
__device__ __forceinline__ void ce_asc(int& a, int& b) { const int hi = max(a, b), lo = min(a, b); a = lo; b = hi; }
template <int N, int OFF> __device__ __forceinline__ void bitonic_sort_desc(int (&a)[32]) {
#pragma unroll
    for (int k = 2; k <= N; k <<= 1)
#pragma unroll
        for (int j = k >> 1; j > 0; j >>= 1)
#pragma unroll
            for (int i = 0; i < N; ++i) {
                const int l = i ^ j;
                if (l > i) { if ((i & k) == 0) ce_desc(a[OFF + i], a[OFF + l]); else ce_asc(a[OFF + i], a[OFF + l]); }
            }
}
__device__ __forceinline__ void bitonic_clean16_desc(int (&a)[32]) {
#pragma unroll
    for (int j = 8; j > 0; j >>= 1)
#pragma unroll
        for (int i = 0; i < 16; ++i) { const int l = i ^ j; if (l > i) ce_desc(a[i], a[l]); }
}
__device__ __forceinline__ int f2sortable(float f) { const int b = __builtin_bit_cast(int, f); return b ^ ((b >> 31) & 0x7fffffff); }
__device__ __forceinline__ float sortable2f(int s) { return __builtin_bit_cast(float, s ^ ((s >> 31) & 0x7fffffff)); }
struct EpiTopk {
    unsigned* topp;
    __device__ __forceinline__ void operator()(const f32x4 (&acc)[8][2], int pb, int qb, int lane, const float*, int hp) const {
        const int fr = lane & 15, fq = lane >> 4;
#pragma unroll
        for (int j = 0; j < 2; ++j) {
            int v[32];
#pragma unroll
            for (int i = 0; i < 8; ++i)
#pragma unroll
                for (int r = 0; r < 4; ++r) v[i * 4 + r] = (f2sortable(acc[i][j][r]) & ~127) | (i * 16 + fq * 4 + r);
            bitonic_sort_desc<16, 0>(v); bitonic_sort_desc<16, 16>(v);
#pragma unroll
            for (int i = 0; i < 16; ++i) v[i] = max(v[i], v[31 - i]);
            bitonic_clean16_desc(v);
#pragma unroll
            for (int x = 16; x <= 32; x <<= 1) {
#pragma unroll
                for (int i = 0; i < 16; ++i) v[16 + i] = __shfl_xor(v[i], x);
#pragma unroll
                for (int i = 0; i < 16; ++i) v[i] = max(v[i], v[31 - i]);
                bitonic_clean16_desc(v);
            }
            const int t = qb + j * 16 + fr;
            u32x4 o;
            o.x = (unsigned)((fq == 0) ? v[0] : (fq == 1) ? v[4] : (fq == 2) ? v[8] : v[12]);
            o.y = (unsigned)((fq == 0) ? v[1] : (fq == 1) ? v[5] : (fq == 2) ? v[9] : v[13]);
            o.z = (unsigned)((fq == 0) ? v[2] : (fq == 1) ? v[6] : (fq == 2) ? v[10] : v[14]);
            o.w = (unsigned)((fq == 0) ? v[3] : (fq == 1) ? v[7] : (fq == 2) ? v[11] : v[15]);
            *(u32x4*)(topp + ((size_t)t * 16 + hp) * 16 + fq * 4) = o;
        }
    }
};
__device__ __forceinline__ void top_insert(float (&tv)[16], int (&ti)[16], float s, int id) {
    if (s > tv[15]) {
        tv[15] = s; ti[15] = id;
#pragma unroll
        for (int i = 15; i > 0; --i) {
            const bool sw = tv[i] > tv[i - 1];
            const float a = tv[i], b = tv[i - 1]; const int ia = ti[i], ib = ti[i - 1];
            tv[i] = sw ? b : a; tv[i - 1] = sw ? a : b; ti[i] = sw ? ib : ia; ti[i - 1] = sw ? ia : ib;
        }
    }
}
__device__ void stage_peer_select(const Params& p) {
    const unsigned* topp = (const unsigned*)(p.ws + WS_TOPS);
    unsigned short* idx = (unsigned short*)(p.ws + WS_IDX); float* g = (float*)(p.ws + WS_G);
    for (int e = blockIdx.x * NTHREADS + threadIdx.x; e < T * 8; e += gridDim.x * NTHREADS) {
        const u32x4* src = (const u32x4*)(topp + (size_t)e * 32);
        float a[16], b[16]; int ia[16], ib[16];
#pragma unroll
        for (int i = 0; i < 4; ++i) {
            const u32x4 w0 = src[i], w1 = src[4 + i];
#pragma unroll
            for (int c = 0; c < 4; ++c) {
                a[i * 4 + c] = sortable2f((int)w0[c] & ~127); ia[i * 4 + c] = (int)(w0[c] & 127u);
                b[i * 4 + c] = sortable2f((int)w1[c] & ~127); ib[i * 4 + c] = (int)(w1[c] & 127u);
            }
        }
        float tv[16]; int ti[16];
#pragma unroll
        for (int i = 0; i < 16; ++i) { tv[i] = -3.0e38f; ti[i] = 0; }
#pragma unroll
        for (int i = 0; i < 16; ++i)
#pragma unroll
            for (int j = 0; j < 16; ++j)
                if ((i + 1) * (j + 1) <= 16) top_insert(tv, ti, a[i] + b[j], ia[i] * 128 + ib[j]);
        float sum = 0.f, ex[16];
#pragma unroll
        for (int i = 0; i < 16; ++i) { ex[i] = __expf(tv[i] - tv[0]); sum += ex[i]; }
        const float inv = 1.f / sum;
#pragma unroll
        for (int i = 0; i < 16; ++i) { idx[(size_t)e * 16 + i] = (unsigned short)ti[i]; g[(size_t)e * 16 + i] = ex[i] * inv; }
    }
}
__device__ __forceinline__ void ld_row4(u32x4 (&d)[4], const unsigned char* tab, int id, int l16) {
    const u32x4* r = (const u32x4*)(tab + (size_t)id * D + l16 * 16);
#pragma unroll
    for (int j = 0; j < 4; ++j) d[j] = r[16 * j];
}
__device__ void stage_peer_gather(const Params& p) {
    const unsigned short* h2 = (const unsigned short*)(p.ws + WS_HB);
    const float* mod = (const float*)(p.ws + WS_MOD);
    const unsigned short* idx = (const unsigned short*)(p.ws + WS_IDX); const float* g = (const float*)(p.ws + WS_G);
    const unsigned char* eu8 = p.ws + WS_EU8; const unsigned char* ev8 = p.ws + WS_EV8;
    const float* us = (const float*)(p.ws + WS_US); const float* vs = (const float*)(p.ws + WS_VS);
    const int lane = threadIdx.x & 63, wave = threadIdx.x >> 6, l16 = lane & 15, grp = lane >> 4;
    for (int t = blockIdx.x * NWAVES + wave; t < T; t += gridDim.x * NWAVES) {
        const int b = t >> 12;
        float hreg[64];
#pragma unroll
        for (int j = 0; j < 4; ++j)
#pragma unroll
            for (int c = 0; c < 2; ++c) {
                const u32x4 w = *(const u32x4*)(h2 + (size_t)t * D + j * 256 + l16 * 16 + c * 8);
                hreg[j * 16 + c * 8 + 0] = bflo(w.x); hreg[j * 16 + c * 8 + 1] = bfhi(w.x); hreg[j * 16 + c * 8 + 2] = bflo(w.y); hreg[j * 16 + c * 8 + 3] = bfhi(w.y);
                hreg[j * 16 + c * 8 + 4] = bflo(w.z); hreg[j * 16 + c * 8 + 5] = bfhi(w.z); hreg[j * 16 + c * 8 + 6] = bflo(w.w); hreg[j * 16 + c * 8 + 7] = bfhi(w.w);
            }
        const int idv0 = idx[(size_t)t * 128 + lane], idv1 = idx[(size_t)t * 128 + 64 + lane];
        const float gv0 = g[(size_t)t * 128 + lane], gv1 = g[(size_t)t * 128 + 64 + lane];
        float wv0 = 0.f, wv1 = 0.f;
        {
            u32x4 cur[4], nxt[4];
            int id_c = __shfl(idv0, grp);
            ld_row4(cur, eu8, id_c, l16);
            float sc_c = us[id_c];
#pragma unroll 2
            for (int q = 0; q < 32; ++q) {
                const int qn = (q + 1 < 32) ? q + 1 : q;
                const int rn = qn * 4 + grp;
                const int id_n = __shfl((qn < 16) ? idv0 : idv1, rn & 63);
                ld_row4(nxt, eu8, id_n, l16);
                const float sc_n = us[id_n];
                float s0 = 0.f, s1 = 0.f;
#pragma unroll
                for (int j = 0; j < 4; ++j)
#pragma unroll
                    for (int c = 0; c < 4; ++c) {
                        const int w = (int)cur[j][c];
                        const f32x2 lo = __builtin_amdgcn_cvt_pk_f32_fp8(w, false), hi = __builtin_amdgcn_cvt_pk_f32_fp8(w, true);
                        s0 += lo.x * hreg[j * 16 + c * 4 + 0]; s1 += lo.y * hreg[j * 16 + c * 4 + 1];
                        s0 += hi.x * hreg[j * 16 + c * 4 + 2]; s1 += hi.y * hreg[j * 16 + c * 4 + 3];
                    }
                const float s = group16_sum(s0 + s1) * sc_c;
                const float act = 0.5f * s * (1.f + erff(s * 0.70710678118654752f));
                const int r = q * 4 + grp;
                const float gk = __shfl((q < 16) ? gv0 : gv1, r & 63);
                const float w = gk * act;
                const float wt = __shfl(w, (lane & 3) * 16);
                const bool mine = (lane >> 2) == (q & 15);
                if (q < 16) wv0 = mine ? wt : wv0; else wv1 = mine ? wt : wv1;
#pragma unroll
                for (int j = 0; j < 4; ++j) cur[j] = nxt[j];
                sc_c = sc_n;
            }
        }
        float acc[64];
#pragma unroll
        for (int i = 0; i < 64; ++i) acc[i] = 0.f;
        {
            u32x4 cur[4], nxt[4];
            int id_c = __shfl(idv0, grp);
            ld_row4(cur, ev8, id_c, l16);
            float sc_c = vs[id_c];
#pragma unroll 2
            for (int q = 0; q < 32; ++q) {
                const int qn = (q + 1 < 32) ? q + 1 : q;
                const int rn = qn * 4 + grp;
                const int id_n = __shfl((qn < 16) ? idv0 : idv1, rn & 63);
                ld_row4(nxt, ev8, id_n, l16);
                const float sc_n = vs[id_n];
                const int r = q * 4 + grp;
                const float wv = __shfl((q < 16) ? wv0 : wv1, r & 63) * sc_c;
#pragma unroll
                for (int j = 0; j < 4; ++j)
#pragma unroll
                    for (int c = 0; c < 4; ++c) {
                        const int w = (int)cur[j][c];
                        const f32x2 lo = __builtin_amdgcn_cvt_pk_f32_fp8(w, false), hi = __builtin_amdgcn_cvt_pk_f32_fp8(w, true);
                        acc[j * 16 + c * 4 + 0] += wv * lo.x; acc[j * 16 + c * 4 + 1] += wv * lo.y;
                        acc[j * 16 + c * 4 + 2] += wv * hi.x; acc[j * 16 + c * 4 + 3] += wv * hi.y;
                    }
#pragma unroll
                for (int j = 0; j < 4; ++j) cur[j] = nxt[j];
                sc_c = sc_n;
            }
        }
#pragma unroll
        for (int i = 0; i < 64; ++i) { acc[i] += __shfl_xor(acc[i], 16); acc[i] += __shfl_xor(acc[i], 32); }
        float sel[16];
#pragma unroll
        for (int bb = 0; bb < 16; ++bb) sel[bb] = (grp == 0) ? acc[bb] : (grp == 1) ? acc[16 + bb] : (grp == 2) ? acc[32 + bb] : acc[48 + bb];
        const int eoff = grp * 256 + l16 * 16;
        float* xr = p.out + (size_t)t * D + eoff;
        const float* gf = mod + b * NMOD + 5 * D + eoff;
        float ss = 0.f;
#pragma unroll
        for (int c = 0; c < 4; ++c) {
            const f32x4 x1 = *(const f32x4*)(xr + c * 4); const f32x4 gg = *(const f32x4*)(gf + c * 4);
            sel[c * 4 + 0] = x1.x + gg.x * sel[c * 4 + 0]; sel[c * 4 + 1] = x1.y + gg.y * sel[c * 4 + 1];
            sel[c * 4 + 2] = x1.z + gg.z * sel[c * 4 + 2]; sel[c * 4 + 3] = x1.w + gg.w * sel[c * 4 + 3];
            ss += sel[c * 4 + 0] * sel[c * 4 + 0] + sel[c * 4 + 1] * sel[c * 4 + 1] + sel[c * 4 + 2] * sel[c * 4 + 2] + sel[c * 4 + 3] * sel[c * 4 + 3];
        }
        const float rstd = rsqrtf(wave_sum(ss) * (1.f / D) + EPS);
#pragma unroll
        for (int c = 0; c < 4; ++c) {
            const f32x4 fn = *(const f32x4*)(p.fnorm + eoff + c * 4);
            f32x4 r; r.x = sel[c * 4 + 0] * rstd * fn.x; r.y = sel[c * 4 + 1] * rstd * fn.y; r.z = sel[c * 4 + 2] * rstd * fn.z; r.w = sel[c * 4 + 3] * rstd * fn.w;
            *(f32x4*)(xr + c * 4) = r;
        }
    }
}

__global__ void __launch_bounds__(NTHREADS) fwd_megakernel(Params p) {
    extern __shared__ __attribute__((aligned(16))) unsigned char lds_raw[];
    cg::grid_group grid = cg::this_grid();
    unsigned short* hb = (unsigned short*)(p.ws + WS_HB);
    const float* mod = (const float*)(p.ws + WS_MOD);
    typedef const unsigned short* cbf;

    stage_prologue(p, (float*)lds_raw);
    grid.sync();
    stage_norm_mod<true>(p, p.x, hb, 0 * D, 1 * D);
    grid.sync();
    gemm_xyT<2, false>((cbf)(p.ws + WS_WIN), D, hb, D, 1280, T, D, 1, 0, 0, lds_raw, EpiProj{p.ws});
    grid.sync();
    gemm_xyT<2, true>((cbf)(p.ws + WS_WQUP), 256, (cbf)(p.ws + WS_QL), 256, 768, T, 256, 1, 0, 0, lds_raw, EpiQup{p.ws});
    gemm_xyT<2, true>((cbf)(p.ws + WS_WKVUP), 128, (cbf)(p.ws + WS_KVL), 128, 1024, T, 128, 1, 0, 0, lds_raw, EpiKVup{p.ws});
    grid.sync();
    stage_attn_flash<64, true>(p, lds_raw);
    stage_attn_flash<96, false>(p, lds_raw);
    grid.sync();
    stage_outnorm(p);
    grid.sync();
    gemm_xyT<2, false>((cbf)(p.ws + WS_WOUT), D, hb, D, D, T, D, 1, 0, 0, lds_raw, EpiOutProj{p.x, mod + 2 * D, p.out});
    grid.sync();
    stage_norm_mod<true>(p, p.out, hb, 3 * D, 4 * D);
    grid.sync();
    gemm_xyT<2, false>((cbf)(p.ws + WS_WPQ), D, hb, D, 2048, T, D, 1, 0, 0, lds_raw, EpiStoreBf16{(unsigned short*)(p.ws + WS_PQ), 2048});
    grid.sync();
    gemm_xyT<1, false>((cbf)(p.ws + WS_SUBK), 128, (cbf)(p.ws + WS_PQ), 2048, 128, T, 128, 16, 128 * 128, 128, lds_raw, EpiTopk{(unsigned*)(p.ws + WS_TOPS)});
    grid.sync();
    stage_peer_select(p);
    grid.sync();
    stage_peer_gather(p);
}

extern "C" void kernel_launch(void* const* d_in, const int* in_sizes, int n_in, void* d_out, int out_size, void* d_ws, size_t ws_size, hipStream_t stream) {
    static int grid_blocks = 0;
    if (grid_blocks == 0) {
        if (n_in != 18 || in_sizes[0] != T * D || out_size != T * D || ws_size < WS_END) {
            fprintf(stderr, "kernel_launch: unexpected shapes (n_in %d, in0 %d, out %d, ws %zu); nothing launched\n", n_in, n_in > 0 ? in_sizes[0] : -1, out_size, ws_size);
            grid_blocks = -1; return;
        }
        int dev = 0, cus = 0, per_cu = 0;
        (void)hipGetDevice(&dev);
        (void)hipDeviceGetAttribute(&cus, hipDeviceAttributeMultiprocessorCount, dev);
        if (hipFuncSetAttribute((const void*)fwd_megakernel, hipFuncAttributeMaxDynamicSharedMemorySize, LDS_BYTES) != hipSuccess) { fprintf(stderr, "kernel_launch: hipFuncSetAttribute failed\n"); grid_blocks = -1; return; }
        (void)hipOccupancyMaxActiveBlocksPerMultiprocessor(&per_cu, fwd_megakernel, NTHREADS, LDS_BYTES);
        if (per_cu < 1) { fprintf(stderr, "kernel_launch: occupancy query says %d blocks/CU\n", per_cu); grid_blocks = -1; return; }
        grid_blocks = cus;
    }
    if (grid_blocks < 0) return;
    Params p{};
    p.x = (const float*)d_in[0]; p.c = (const float*)d_in[1]; p.w_ada = (const float*)d_in[2]; p.b_ada = (const float*)d_in[3];
    p.w_in = (const float*)d_in[4]; p.sink = (const float*)d_in[5]; p.qnorm = (const float*)d_in[6]; p.w_qup = (const float*)d_in[7];
    p.kvnorm = (const float*)d_in[8]; p.w_kvup = (const float*)d_in[9]; p.onorm_a = (const float*)d_in[10]; p.onorm_b = (const float*)d_in[11];
    p.w_out = (const float*)d_in[12]; p.w_pq = (const float*)d_in[13]; p.subk = (const float*)d_in[14]; p.eu = (const float*)d_in[15];
    p.ev = (const float*)d_in[16]; p.fnorm = (const float*)d_in[17];
    p.out = (float*)d_out; p.ws = (unsigned char*)d_ws;
    void* args[] = {&p};
    hipError_t e = hipLaunchCooperativeKernel((void*)fwd_megakernel, dim3(grid_blocks), dim3(NTHREADS), args, LDS_BYTES, stream);
    if (e != hipSuccess) fprintf(stderr, "cooperative launch failed: %s (grid %d)\n", hipGetErrorString(e), grid_blocks);
}
```

```cpp
#include <hip/hip_runtime.h>
#include <hip/hip_cooperative_groups.h>
#include <cstdio>
#include <cstdint>
namespace cg = cooperative_groups;

constexpr int Bsz = 8, S = 4096, D = 1024, T = Bsz * S;
constexpr int INW = 1184;
constexpr int C_QA = 0, C_KA = 512, C_VA = 640, C_QL = 768, C_KVL = 1024, C_KR = 1152;
constexpr int NMOD = 6 * D;
constexpr float EPS = 1e-6f;
constexpr int NTHREADS = 512, NWAVES = 8;

constexpr size_t MiB = 1u << 20;
constexpr size_t WS_MOD = 0;
constexpr size_t WS_COSA = 1 * MiB;
constexpr size_t WS_SINA = WS_COSA + 512 * 1024;
constexpr size_t WS_COSB = 2 * MiB;
constexpr size_t WS_SINB = WS_COSB + 256 * 1024;
constexpr size_t WS_WIN = 4 * MiB;
constexpr size_t WS_WQUP = 7 * MiB;
constexpr size_t WS_WKVUP = 7 * MiB + 512 * 1024;
constexpr size_t WS_WOUT = 8 * MiB;
constexpr size_t WS_WPQ = 10 * MiB;
constexpr size_t WS_SUBK = 14 * MiB;
constexpr size_t WS_EU8 = 16 * MiB;
constexpr size_t WS_EV8 = 32 * MiB;
constexpr size_t WS_US = 48 * MiB;
constexpr size_t WS_VS = WS_US + 64 * 1024;
constexpr size_t WS_HB = 52 * MiB;
constexpr size_t WS_QA = 116 * MiB;
constexpr size_t WS_KA = 148 * MiB;
constexpr size_t WS_VAT = 156 * MiB;
constexpr size_t WS_QL = 164 * MiB;
constexpr size_t WS_KVL = 180 * MiB;
constexpr size_t WS_QMB = 192 * MiB;
constexpr size_t WS_K96 = 240 * MiB;
constexpr size_t WS_VT = 288 * MiB;
constexpr size_t WS_OAB = 320 * MiB;
constexpr size_t WS_PQ = 116 * MiB;
constexpr size_t WS_TOPS = 244 * MiB;
constexpr size_t WS_TOPI = 276 * MiB;
constexpr size_t WS_IDX = 284 * MiB;
constexpr size_t WS_G = 292 * MiB;
constexpr size_t WS_END = 512 * MiB;
constexpr int LDS_BYTES = 148480;
constexpr int NEXP = 16384;

struct Params {
    const float *x, *c, *w_ada, *b_ada, *w_in, *sink, *qnorm, *w_qup, *kvnorm, *w_kvup, *onorm_a, *onorm_b, *w_out, *w_pq, *subk, *eu, *ev, *fnorm;
    float* out;
    unsigned char* ws;
};

typedef short bf16x8 __attribute__((ext_vector_type(8)));
typedef float f32x4 __attribute__((ext_vector_type(4)));
typedef unsigned u32x4 __attribute__((ext_vector_type(4)));
typedef float f32x2 __attribute__((ext_vector_type(2)));

__device__ __forceinline__ unsigned f2bf(float f) { unsigned u = __builtin_bit_cast(unsigned, f); return (u + 0x7fffu + ((u >> 16) & 1u)) >> 16; }
__device__ __forceinline__ unsigned pk2(float lo, float hi) { return f2bf(lo) | (f2bf(hi) << 16); }
__device__ __forceinline__ float bf2f(unsigned short h) { return __builtin_bit_cast(float, (unsigned)h << 16); }
__device__ __forceinline__ float bflo(unsigned w) { return __builtin_bit_cast(float, w << 16); }
__device__ __forceinline__ float bfhi(unsigned w) { return __builtin_bit_cast(float, w & 0xffff0000u); }
__device__ __forceinline__ float wave_sum(float v) {
#pragma unroll
    for (int o = 1; o < 64; o <<= 1) v += __shfl_xor(v, o);
    return v;
}

__device__ __forceinline__ float wave_max(float v) {
#pragma unroll
    for (int o = 1; o < 64; o <<= 1) v = fmaxf(v, __shfl_xor(v, o));
    return v;
}
template <int CTRL> __device__ __forceinline__ float dpp_add(float s) {
    return s + __builtin_bit_cast(float, __builtin_amdgcn_update_dpp(0, __builtin_bit_cast(int, s), CTRL, 0xF, 0xF, true));
}
__device__ __forceinline__ float group16_sum(float s) { s = dpp_add<0xB1>(s); s = dpp_add<0x4E>(s); s = dpp_add<0x141>(s); s = dpp_add<0x140>(s); return s; }

template <int MAP> __device__ __forceinline__ int map_row(int n) {
    if (MAP == 1) { const int h = n / 96, j = n % 96; return j < 64 ? h * 64 + j : 512 + h * 32 + (j - 64); }
    return n;
}
template <int MAP>
__device__ __forceinline__ void transpose_item(const float* W, int K, int N, unsigned short* WT, const float* kgain, float* scr, int item, int lane) {
    const int nblk = N / 32, kb = item / nblk, nb = item % nblk, k0 = 64 * kb, n0 = 32 * nb;
#pragma unroll 8
    for (int i = 0; i < 32; ++i) {
        const int kk = 2 * i + (lane >> 5);
        float w = W[(size_t)(k0 + kk) * N + n0 + (lane & 31)];
        if (kgain) w *= kgain[k0 + kk];
        scr[kk * 33 + (lane & 31)] = w;
    }
    asm volatile("s_waitcnt lgkmcnt(0)" ::: "memory");
    const int c = lane & 7;
#pragma unroll
    for (int j = 0; j < 4; ++j) {
        const int n = (lane >> 3) + 8 * j; const float* q = scr + (8 * c) * 33 + n;
        u32x4 o; o.x = pk2(q[0 * 33], q[1 * 33]); o.y = pk2(q[2 * 33], q[3 * 33]); o.z = pk2(q[4 * 33], q[5 * 33]); o.w = pk2(q[6 * 33], q[7 * 33]);
        *(u32x4*)(WT + (size_t)map_row<MAP>(n0 + n) * K + k0 + 8 * c) = o;
    }
    asm volatile("s_waitcnt lgkmcnt(0)" ::: "memory");
}

__device__ void stage_prologue(const Params& p, float* lds) {
    float* mod = (float*)(p.ws + WS_MOD);
    const int tid = threadIdx.x;
    for (int i = tid; i < Bsz * D; i += NTHREADS) { float v = p.c[i]; lds[i] = v / (1.f + __expf(-v)); }
    __syncthreads();
    float* red = lds + Bsz * D;
    const int col_l = tid & 63, slice = tid >> 6;
    for (int item = blockIdx.x; item < NMOD / 64; item += gridDim.x) {
        const int n = item * 64 + col_l;
        float acc[Bsz];
#pragma unroll
        for (int b = 0; b < Bsz; ++b) acc[b] = 0.f;
        for (int kk = 0; kk < 128; ++kk) {
            const int k = slice * 128 + kk;
            const float w = p.w_ada[(size_t)k * NMOD + n];
#pragma unroll
            for (int b = 0; b < Bsz; ++b) acc[b] += lds[b * D + k] * w;
        }
#pragma unroll
        for (int b = 0; b < Bsz; ++b) red[(slice * 64 + col_l) * Bsz + b] = acc[b];
        __syncthreads();
        {
            const int cc = tid >> 3, b = tid & 7;
            float s = 0.f;
#pragma unroll
            for (int sl = 0; sl < 8; ++sl) s += red[(sl * 64 + cc) * Bsz + b];
            mod[b * NMOD + item * 64 + cc] = s + p.b_ada[item * 64 + cc];
        }
        __syncthreads();
    }
    float* cosA = (float*)(p.ws + WS_COSA); float* sinA = (float*)(p.ws + WS_SINA);
    float* cosB = (float*)(p.ws + WS_COSB); float* sinB = (float*)(p.ws + WS_SINB);
    const int gtid = blockIdx.x * NTHREADS + tid, gn = gridDim.x * NTHREADS;
    for (int e = gtid; e < S * 32; e += gn) {
        const int pos = e >> 5, i = e & 31;
        const double inv = exp2(-(double)(2 * i) / 64.0 * 13.287712379549449);
        const double a = (double)pos * inv;
        cosA[e] = (float)cos(a); sinA[e] = (float)sin(a);
    }
    for (int e = gtid; e < S * 16; e += gn) {
        const int pos = e >> 4, i = e & 15;
        const double inv = exp2(-(double)(2 * i) / 32.0 * 13.287712379549449);
        const double a = (double)pos * inv;
        cosB[e] = (float)cos(a); sinB[e] = (float)sin(a);
    }
    {
        const int lane = tid & 63, wave = tid >> 6;
        float* scr = lds + wave * (64 * 33);
        const int gw = blockIdx.x * NWAVES + wave, NGW = gridDim.x * NWAVES;
        constexpr int I_IN = (D / 64) * (INW / 32), I_QU = (256 / 64) * (768 / 32), I_KV = (128 / 64) * (1024 / 32), I_OUT = (D / 64) * (D / 32), I_PQ = (D / 64) * (2048 / 32);
        constexpr int NITEMS = I_IN + I_QU + I_KV + I_OUT + I_PQ;
        __syncthreads();
        for (int it = gw; it < NITEMS; it += NGW) {
            int r = it;
            if (r < I_IN) { transpose_item<0>(p.w_in, D, INW, (unsigned short*)(p.ws + WS_WIN), nullptr, scr, r, lane); continue; } r -= I_IN;
            if (r < I_QU) { transpose_item<1>(p.w_qup, 256, 768, (unsigned short*)(p.ws + WS_WQUP), p.qnorm, scr, r, lane); continue; } r -= I_QU;
            if (r < I_KV) { transpose_item<0>(p.w_kvup, 128, 1024, (unsigned short*)(p.ws + WS_WKVUP), p.kvnorm, scr, r, lane); continue; } r -= I_KV;
            if (r < I_OUT) { transpose_item<0>(p.w_out, D, D, (unsigned short*)(p.ws + WS_WOUT), nullptr, scr, r, lane); continue; } r -= I_OUT;
            transpose_item<0>(p.w_pq, D, 2048, (unsigned short*)(p.ws + WS_WPQ), nullptr, scr, r, lane);
        }
        {
            u32x4* z = (u32x4*)(p.ws + WS_WIN + (size_t)INW * D * 2);
            const int nz = (1280 - INW) * D * 2 / 16;
            for (int e = blockIdx.x * NTHREADS + tid; e < nz; e += gridDim.x * NTHREADS) z[e] = (u32x4){0u, 0u, 0u, 0u};
        }
        {
            const f32x4* src = (const f32x4*)p.subk; unsigned long long* dst = (unsigned long long*)(p.ws + WS_SUBK);
            for (int e = blockIdx.x * NTHREADS + tid; e < 16 * 128 * 128 / 4; e += gridDim.x * NTHREADS) {
                const f32x4 v = src[e]; dst[e] = (unsigned long long)pk2(v.x, v.y) | ((unsigned long long)pk2(v.z, v.w) << 32);
            }
        }
    }
    {
        const int lane = tid & 63, wave = tid >> 6;
        for (int r = blockIdx.x * NWAVES + wave; r < 2 * NEXP; r += gridDim.x * NWAVES) {
            const int tab = r >= NEXP, row = r - tab * NEXP;
            const f32x4* src = (const f32x4*)((tab ? p.ev : p.eu) + (size_t)row * D) + lane;
            f32x4 v[4]; float am = 0.f;
#pragma unroll
            for (int j = 0; j < 4; ++j) { v[j] = src[64 * j]; am = fmaxf(am, fmaxf(fmaxf(fabsf(v[j].x), fabsf(v[j].y)), fmaxf(fabsf(v[j].z), fabsf(v[j].w)))); }
            am = wave_max(am);
            int ex = 0; (void)frexpf(am, &ex);
            const float sc = ldexpf(1.f, 8 - ex), isc = ldexpf(1.f, ex - 8);
            unsigned* dst = (unsigned*)(p.ws + (tab ? WS_EV8 : WS_EU8) + (size_t)row * D) + lane;
#pragma unroll
            for (int j = 0; j < 4; ++j) {
                int w = 0;
                w = __builtin_amdgcn_cvt_pk_fp8_f32(v[j].x * sc, v[j].y * sc, w, false);
                w = __builtin_amdgcn_cvt_pk_fp8_f32(v[j].z * sc, v[j].w * sc, w, true);
                dst[64 * j] = (unsigned)w;
            }
            if (lane == 0) ((float*)(p.ws + (tab ? WS_VS : WS_US)))[row] = isc;
        }
    }
}

template <bool BF>
__device__ void stage_norm_mod(const Params& p, const float* src, void* dstv, int sh_off, int sc_off) {
    const float* mod = (const float*)(p.ws + WS_MOD);
    const int lane = threadIdx.x & 63, wave = threadIdx.x >> 6;
    for (int t = blockIdx.x * NWAVES + wave; t < T; t += gridDim.x * NWAVES) {
        const int b = t >> 12;
        const f32x4* xr = (const f32x4*)(src + (size_t)t * D) + lane;
        f32x4 v[4]; float s = 0.f;
#pragma unroll
        for (int j = 0; j < 4; ++j) { v[j] = xr[64 * j]; s += v[j].x * v[j].x + v[j].y * v[j].y + v[j].z * v[j].z + v[j].w * v[j].w; }
        const float rstd = rsqrtf(wave_sum(s) * (1.f / D) + EPS);
#pragma unroll
        for (int j = 0; j < 4; ++j) {
            const f32x4 sh = *((const f32x4*)(mod + b * NMOD + sh_off) + lane + 64 * j);
            const f32x4 sc = *((const f32x4*)(mod + b * NMOD + sc_off) + lane + 64 * j);
            f32x4 r;
            r.x = v[j].x * rstd * (1.f + sc.x) + sh.x; r.y = v[j].y * rstd * (1.f + sc.y) + sh.y;
            r.z = v[j].z * rstd * (1.f + sc.z) + sh.z; r.w = v[j].w * rstd * (1.f + sc.w) + sh.w;
            if (BF) ((unsigned long long*)((unsigned short*)dstv + (size_t)t * D))[lane + 64 * j] = (unsigned long long)pk2(r.x, r.y) | ((unsigned long long)pk2(r.z, r.w) << 32);
            else ((f32x4*)((float*)dstv + (size_t)t * D))[lane + 64 * j] = r;
        }
    }
}

constexpr int TP = 128, TQ = 256, TBK = 64;
constexpr int XS_BYTES = TP * 128, YS_BYTES = TQ * 128, STG_BYTES = XS_BYTES + YS_BYTES;
__device__ __forceinline__ int swz(int r, int c) { return r * 128 + ((c ^ ((r >> 1) & 7)) << 4); }
constexpr int SSQ_OFF = 2 * (TP * 128 + TQ * 128);
__device__ __forceinline__ float ssq8(u32x4 w) {
    const float a0 = bflo(w.x), a1 = bfhi(w.x), a2 = bflo(w.y), a3 = bfhi(w.y), a4 = bflo(w.z), a5 = bfhi(w.z), a6 = bflo(w.w), a7 = bfhi(w.w);
    return (a0 * a0 + a1 * a1) + (a2 * a2 + a3 * a3) + (a4 * a4 + a5 * a5) + (a6 * a6 + a7 * a7);
}
template <int WPN, bool YSSQ, class Epi>
__device__ void gemm_xyT(const unsigned short* X, int ldx, const unsigned short* Y, int ldy, int P, int Q, int K, int nb, size_t xbs, size_t ybs, unsigned char* lds, const Epi& epi) {
    constexpr int WQN = 8 / WPN, FI = TP / (WPN * 16), FJ = TQ / (WQN * 16);
    const int tid = threadIdx.x, lane = tid & 63, wave = tid >> 6;
    const int wp = wave / WQN, wq = wave % WQN, fr = lane & 15, fq = lane >> 4;
    const int nPt = P / TP, nQt = Q / TQ, npb = nPt * nb, nunits = npb * nQt;
    const int G = gridDim.x, bx = blockIdx.x;
    const int vcu = (G % 8 == 0) ? (bx % 8) * (G / 8) + bx / 8 : bx;
    const int srow = tid >> 3, sc = tid & 7;
    const int nk = K / TBK;
    for (int u = vcu; u < nunits; u += G) {
        const int qt = u / npb, rem = u % npb, bi = rem / nPt, pt = rem % nPt, p0 = pt * TP, q0 = qt * TQ;
        f32x4 acc[FI][FJ];
#pragma unroll
        for (int i = 0; i < FI; ++i)
#pragma unroll
            for (int j = 0; j < FJ; ++j) acc[i][j] = (f32x4){0.f, 0.f, 0.f, 0.f};
        const unsigned short* xg = X + (size_t)bi * xbs + (size_t)(p0 + srow) * ldx + sc * 8;
        const unsigned short* yg = Y + (size_t)bi * ybs + (size_t)(q0 + srow) * ldy + sc * 8;
        u32x4 rx[2], ry[4];
        float sq[4] = {0.f, 0.f, 0.f, 0.f};
#pragma unroll
        for (int i = 0; i < 2; ++i) rx[i] = *(const u32x4*)(xg + (size_t)(64 * i) * ldx);
#pragma unroll
        for (int i = 0; i < 4; ++i) ry[i] = *(const u32x4*)(yg + (size_t)(64 * i) * ldy);
        if (YSSQ) {
#pragma unroll
            for (int i = 0; i < 4; ++i) sq[i] += ssq8(ry[i]);
        }
        __syncthreads();
#pragma unroll
        for (int i = 0; i < 2; ++i) *(u32x4*)(lds + swz(srow + 64 * i, sc)) = rx[i];
#pragma unroll
        for (int i = 0; i < 4; ++i) *(u32x4*)(lds + XS_BYTES + swz(srow + 64 * i, sc)) = ry[i];
        __syncthreads();
        for (int kt = 0; kt < nk; ++kt) {
            unsigned char* st = lds + (kt & 1) * STG_BYTES;
            unsigned char* sn = lds + ((kt & 1) ^ 1) * STG_BYTES;
            const bool more = (kt + 1 < nk);
            if (more) {
                const int k1 = (kt + 1) * TBK;
#pragma unroll
                for (int i = 0; i < 2; ++i) rx[i] = *(const u32x4*)(xg + (size_t)(64 * i) * ldx + k1);
#pragma unroll
                for (int i = 0; i < 4; ++i) ry[i] = *(const u32x4*)(yg + (size_t)(64 * i) * ldy + k1);
            }
            if (YSSQ && more) {
#pragma unroll
                for (int i = 0; i < 4; ++i) sq[i] += ssq8(ry[i]);
            }
#pragma unroll
            for (int kk = 0; kk < 2; ++kk) {
                bf16x8 af[FI], bfr[FJ];
#pragma unroll
                for (int i = 0; i < FI; ++i) af[i] = *(const bf16x8*)(st + swz(wp * (FI * 16) + i * 16 + fr, kk * 4 + fq));
#pragma unroll
                for (int j = 0; j < FJ; ++j) bfr[j] = *(const bf16x8*)(st + XS_BYTES + swz(wq * (FJ * 16) + j * 16 + fr, kk * 4 + fq));
#pragma unroll
                for (int i = 0; i < FI; ++i)
#pragma unroll
                    for (int j = 0; j < FJ; ++j) acc[i][j] = __builtin_amdgcn_mfma_f32_16x16x32_bf16(af[i], bfr[j], acc[i][j], 0, 0, 0);
            }
            if (more) {
#pragma unroll
                for (int i = 0; i < 2; ++i) *(u32x4*)(sn + swz(srow + 64 * i, sc)) = rx[i];
#pragma unroll
                for (int i = 0; i < 4; ++i) *(u32x4*)(sn + XS_BYTES + swz(srow + 64 * i, sc)) = ry[i];
            }
            __syncthreads();
        }
        if (YSSQ) {
            float* ssq = (float*)(lds + SSQ_OFF);
#pragma unroll
            for (int i = 0; i < 4; ++i) {
                float v = sq[i];
                v += __shfl_xor(v, 1); v += __shfl_xor(v, 2); v += __shfl_xor(v, 4);
                if (sc == 0) ssq[srow + 64 * i] = v;
            }
            __syncthreads();
        }
        epi(acc, p0 + wp * (FI * 16), q0 + wq * (FJ * 16), lane, (const float*)(lds + SSQ_OFF) + wq * (FJ * 16), bi);
        if (YSSQ) __syncthreads();
    }
}
constexpr int DMA_STAGES = 3;
#define RAW_BARRIER() do { asm volatile("s_waitcnt lgkmcnt(0)" ::: "memory"); __builtin_amdgcn_s_barrier(); } while (0)
template <int WPN, int SUB, class Epi>
__device__ void gemm_dma(const unsigned short* X, int ldx, const unsigned short* Y, int ldy, int P, int Q, int K, int nb, size_t xbs, size_t ybs, unsigned char* lds, Epi epi) {
    constexpr int WQN = 8 / WPN, FI = TP / (WPN * 16), FJ = TQ / (WQN * 16);
    const int tid = threadIdx.x, lane = tid & 63, wave = __builtin_amdgcn_readfirstlane(tid >> 6);
    const int wp = wave / WQN, wq = wave % WQN, fr = lane & 15, fq = lane >> 4;
    const int nPt = P / TP, nQt = Q / TQ, npb = nPt * nb / SUB, nunits = npb * nQt;
    const int G = gridDim.x, bx = blockIdx.x;
    const int vcu = (G % 8 == 0) ? (bx % 8) * (G / 8) + bx / 8 : bx;
    const int srow = wave * 8 + (lane >> 3), pc = lane & 7;
    const int nk = K / TBK;
    const int lc = pc ^ ((srow >> 1) & 7);
    for (int u = vcu; u < nunits; u += G)
#pragma unroll
    for (int sub = 0; sub < SUB; ++sub) {
        const int qt = u / npb, rem = (u % npb) * SUB + sub, bi = rem / nPt, pt = rem % nPt, p0 = pt * TP, q0 = qt * TQ;
        f32x4 acc[FI][FJ];
#pragma unroll
        for (int i = 0; i < FI; ++i)
#pragma unroll
            for (int j = 0; j < FJ; ++j) acc[i][j] = (f32x4){0.f, 0.f, 0.f, 0.f};
        const unsigned short* xg = X + (size_t)bi * xbs + (size_t)(p0 + srow) * ldx + lc * 8;
        const unsigned short* yg = Y + (size_t)bi * ybs + (size_t)(q0 + srow) * ldy + lc * 8;
        asm volatile("s_waitcnt vmcnt(0)" ::: "memory");
        RAW_BARRIER();
#define GEMM_DMA_TILE(kt_, stg_) do { \
            unsigned char* _b = lds + (stg_) * STG_BYTES + wave * 1024; const int _k = (kt_) * TBK; \
            _Pragma("unroll") for (int _i = 0; _i < 2; ++_i) __builtin_amdgcn_global_load_lds((const unsigned*)(xg + (size_t)(64 * _i) * ldx + _k), (unsigned*)(_b + _i * 8192), 16, 0, 0); \
            _Pragma("unroll") for (int _i = 0; _i < 4; ++_i) __builtin_amdgcn_global_load_lds((const unsigned*)(yg + (size_t)(64 * _i) * ldy + _k), (unsigned*)(_b + XS_BYTES + _i * 8192), 16, 0, 0); \
        } while (0)
        GEMM_DMA_TILE(0, 0);
        GEMM_DMA_TILE(1, 1);
        int cur = 0;
        for (int kt = 0; kt < nk; ++kt) {
            if (kt + 1 < nk) asm volatile("s_waitcnt vmcnt(6)" ::: "memory"); else asm volatile("s_waitcnt vmcnt(0)" ::: "memory");
            RAW_BARRIER();
            if (kt + 2 < nk) { const int nxt = (cur == 0) ? 2 : cur - 1; GEMM_DMA_TILE(kt + 2, nxt); }
            const unsigned char* st = lds + cur * STG_BYTES;
#pragma unroll
            for (int kk = 0; kk < 2; ++kk) {
                bf16x8 af[FI], bfr[FJ];
#pragma unroll
                for (int i = 0; i < FI; ++i) af[i] = *(const bf16x8*)(st + swz(wp * (FI * 16) + i * 16 + fr, kk * 4 + fq));
#pragma unroll
                for (int j = 0; j < FJ; ++j) bfr[j] = *(const bf16x8*)(st + XS_BYTES + swz(wq * (FJ * 16) + j * 16 + fr, kk * 4 + fq));
#pragma unroll
                for (int i = 0; i < FI; ++i)
#pragma unroll
                    for (int j = 0; j < FJ; ++j) acc[i][j] = __builtin_amdgcn_mfma_f32_16x16x32_bf16(af[i], bfr[j], acc[i][j], 0, 0, 0);
            }
            cur = (cur == 2) ? 0 : cur + 1;
        }
#undef GEMM_DMA_TILE
        epi(acc, p0 + wp * (FI * 16), q0 + wq * (FJ * 16), lane, (const float*)nullptr, bi, sub);
    }
}
struct EpiOutProj {
    const float* x; const float* gate; float* out;
    __device__ __forceinline__ void operator()(const f32x4 (&acc)[4][4], int pb, int qb, int lane, const float*, int, int = 0) const {
        const int fr = lane & 15, fq = lane >> 4;
#pragma unroll
        for (int j = 0; j < 4; ++j) {
            const int t = qb + j * 16 + fr; const float* gt = gate + (t >> 12) * NMOD;
#pragma unroll
            for (int i = 0; i < 4; ++i) {
                const int n = pb + i * 16 + fq * 4;
                const f32x4 xv = *(const f32x4*)(x + (size_t)t * D + n), gv = *(const f32x4*)(gt + n);
                f32x4 r; r.x = xv.x + gv.x * acc[i][j].x; r.y = xv.y + gv.y * acc[i][j].y; r.z = xv.z + gv.z * acc[i][j].z; r.w = xv.w + gv.w * acc[i][j].w;
                *(f32x4*)(out + (size_t)t * D + n) = r;
            }
        }
    }
};
struct EpiStoreBf16 {
    unsigned short* C; int ldc;
    __device__ __forceinline__ void operator()(const f32x4 (&acc)[4][4], int pb, int qb, int lane, const float*, int, int = 0) const {
        const int fr = lane & 15, fq = lane >> 4;
#pragma unroll
        for (int j = 0; j < 4; ++j) {
            const int t = qb + j * 16 + fr;
#pragma unroll
            for (int i = 0; i < 4; ++i) {
                const int n = pb + i * 16 + fq * 4;
                *(unsigned long long*)(C + (size_t)t * ldc + n) = (unsigned long long)pk2(acc[i][j].x, acc[i][j].y) | ((unsigned long long)pk2(acc[i][j].z, acc[i][j].w) << 32);
            }
        }
    }
};

constexpr float LOG2E = 1.4426950408889634f;
constexpr float QA_SCALE = 0.125f * LOG2E;
constexpr float QM_SCALE = 0.10206207261596575f * LOG2E;
__device__ __forceinline__ unsigned long long pk4(float a, float b, float c, float d) { return (unsigned long long)pk2(a, b) | ((unsigned long long)pk2(c, d) << 32); }
struct EpiProj {
    unsigned char* ws;
    __device__ __forceinline__ void operator()(const f32x4 (&acc)[4][4], int pb, int qb, int lane, const float*, int, int = 0) const {
        const int fr = lane & 15, fq = lane >> 4;
        unsigned short* QA = (unsigned short*)(ws + WS_QA); unsigned short* KA = (unsigned short*)(ws + WS_KA); unsigned short* VAT = (unsigned short*)(ws + WS_VAT);
        unsigned short* QL = (unsigned short*)(ws + WS_QL); unsigned short* KVL = (unsigned short*)(ws + WS_KVL); unsigned short* K96 = (unsigned short*)(ws + WS_K96);
        const float* cosA = (const float*)(ws + WS_COSA); const float* sinA = (const float*)(ws + WS_SINA);
        const float* cosB = (const float*)(ws + WS_COSB); const float* sinB = (const float*)(ws + WS_SINB);
        if (pb >= 1216) return;
#pragma unroll
        for (int j = 0; j < 4; ++j) {
            const int t = qb + j * 16 + fr, b = t >> 12, pos = t & (S - 1);
            if (pb < C_VA) {
                const bool isq = pb < C_KA;
                const int head = isq ? (pb >> 6) : ((pb - C_KA) >> 6);
                unsigned short* dst = isq ? QA + ((size_t)(b * 8 + head) * S + pos) * 64 : KA + ((size_t)(b * 2 + head) * S + pos) * 64;
                const float sc = isq ? QA_SCALE : 1.f;
#pragma unroll
                for (int i = 0; i < 2; ++i) {
                    const int d = i * 16 + fq * 4;
                    const f32x4 c = *(const f32x4*)(cosA + pos * 32 + d), sn = *(const f32x4*)(sinA + pos * 32 + d);
                    const f32x4 x1 = acc[i][j], x2 = acc[i + 2][j];
                    *(unsigned long long*)(dst + d) = pk4((x1.x * c.x - x2.x * sn.x) * sc, (x1.y * c.y - x2.y * sn.y) * sc, (x1.z * c.z - x2.z * sn.z) * sc, (x1.w * c.w - x2.w * sn.w) * sc);
                    *(unsigned long long*)(dst + 32 + d) = pk4((x2.x * c.x + x1.x * sn.x) * sc, (x2.y * c.y + x1.y * sn.y) * sc, (x2.z * c.z + x1.z * sn.z) * sc, (x2.w * c.w + x1.w * sn.w) * sc);
                }
            } else if (pb < C_QL) {
                const int kvh = (pb - C_VA) >> 6;
                unsigned short* dst = VAT + (size_t)(b * 2 + kvh) * 64 * S + pos;
#pragma unroll
                for (int i = 0; i < 4; ++i) {
                    const int dv = i * 16 + fq * 4;
                    dst[(size_t)(dv + 0) * S] = (unsigned short)f2bf(acc[i][j].x); dst[(size_t)(dv + 1) * S] = (unsigned short)f2bf(acc[i][j].y);
                    dst[(size_t)(dv + 2) * S] = (unsigned short)f2bf(acc[i][j].z); dst[(size_t)(dv + 3) * S] = (unsigned short)f2bf(acc[i][j].w);
                }
            } else if (pb < C_KVL) {
                unsigned short* dst = QL + (size_t)t * 256 + (pb - C_QL);
#pragma unroll
                for (int i = 0; i < 4; ++i) *(unsigned long long*)(dst + i * 16 + fq * 4) = pk4(acc[i][j].x, acc[i][j].y, acc[i][j].z, acc[i][j].w);
            } else if (pb < C_KR) {
                unsigned short* dst = KVL + (size_t)t * 128 + (pb - C_KVL);
#pragma unroll
                for (int i = 0; i < 4; ++i) *(unsigned long long*)(dst + i * 16 + fq * 4) = pk4(acc[i][j].x, acc[i][j].y, acc[i][j].z, acc[i][j].w);
            } else {
                const int d = fq * 4;
                const f32x4 c = *(const f32x4*)(cosB + pos * 16 + d), sn = *(const f32x4*)(sinB + pos * 16 + d);
                const f32x4 x1 = acc[0][j], x2 = acc[1][j];
                const unsigned long long lo = pk4(x1.x * c.x - x2.x * sn.x, x1.y * c.y - x2.y * sn.y, x1.z * c.z - x2.z * sn.z, x1.w * c.w - x2.w * sn.w);
                const unsigned long long hi = pk4(x2.x * c.x + x1.x * sn.x, x2.y * c.y + x1.y * sn.y, x2.z * c.z + x1.z * sn.z, x2.w * c.w + x1.w * sn.w);
#pragma unroll
                for (int h = 0; h < 8; ++h) {
                    unsigned short* dst = K96 + ((size_t)(b * 8 + h) * S + pos) * 96 + 64 + d;
                    *(unsigned long long*)dst = lo; *(unsigned long long*)(dst + 16) = hi;
                }
            }
        }
    }
};
struct EpiQup {
    unsigned char* ws;
    __device__ __forceinline__ void operator()(const f32x4 (&acc)[4][4], int pb, int qb, int lane, const float* ssq, int, int = 0) const {
        const int fr = lane & 15, fq = lane >> 4;
        unsigned short* QMB = (unsigned short*)(ws + WS_QMB);
        const float* cosB = (const float*)(ws + WS_COSB); const float* sinB = (const float*)(ws + WS_SINB);
#pragma unroll
        for (int j = 0; j < 4; ++j) {
            const int t = qb + j * 16 + fr, b = t >> 12, pos = t & (S - 1);
            const float sc = rsqrtf(ssq[j * 16 + fr] * (1.f / 256.f) + EPS) * QM_SCALE;
            if (pb < 512) {
                unsigned short* dst = QMB + ((size_t)(b * 8 + (pb >> 6)) * S + pos) * 96;
#pragma unroll
                for (int i = 0; i < 4; ++i) *(unsigned long long*)(dst + i * 16 + fq * 4) = pk4(acc[i][j].x * sc, acc[i][j].y * sc, acc[i][j].z * sc, acc[i][j].w * sc);
            } else {
                const int d = fq * 4;
                const f32x4 c = *(const f32x4*)(cosB + pos * 16 + d), sn = *(const f32x4*)(sinB + pos * 16 + d);
#pragma unroll
                for (int hh = 0; hh < 2; ++hh) {
                    const int h = ((pb - 512) >> 5) + hh;
                    unsigned short* dst = QMB + ((size_t)(b * 8 + h) * S + pos) * 96 + 64 + d;
                    const f32x4 x1 = acc[2 * hh][j], x2 = acc[2 * hh + 1][j];
                    *(unsigned long long*)dst = pk4((x1.x * c.x - x2.x * sn.x) * sc, (x1.y * c.y - x2.y * sn.y) * sc, (x1.z * c.z - x2.z * sn.z) * sc, (x1.w * c.w - x2.w * sn.w) * sc);
                    *(unsigned long long*)(dst + 16) = pk4((x2.x * c.x + x1.x * sn.x) * sc, (x2.y * c.y + x1.y * sn.y) * sc, (x2.z * c.z + x1.z * sn.z) * sc, (x2.w * c.w + x1.w * sn.w) * sc);
                }
            }
        }
    }
};
struct EpiKVup {
    unsigned char* ws;
    __device__ __forceinline__ void operator()(const f32x4 (&acc)[4][4], int pb, int qb, int lane, const float* ssq, int, int = 0) const {
        const int fr = lane & 15, fq = lane >> 4;
        unsigned short* K96 = (unsigned short*)(ws + WS_K96); unsigned short* VT = (unsigned short*)(ws + WS_VT);
        const int h = pb >> 7;
#pragma unroll
        for (int j = 0; j < 4; ++j) {
            const int t = qb + j * 16 + fr, b = t >> 12, pos = t & (S - 1);
            const float sc = rsqrtf(ssq[j * 16 + fr] * (1.f / 128.f) + EPS);
            if ((pb & 64) == 0) {
                unsigned short* dst = K96 + ((size_t)(b * 8 + h) * S + pos) * 96;
#pragma unroll
                for (int i = 0; i < 4; ++i) *(unsigned long long*)(dst + i * 16 + fq * 4) = pk4(acc[i][j].x * sc, acc[i][j].y * sc, acc[i][j].z * sc, acc[i][j].w * sc);
            } else {
                unsigned short* dst = VT + (size_t)(b * 8 + h) * 64 * S + pos;
#pragma unroll
                for (int i = 0; i < 4; ++i) {
                    const int dv = i * 16 + fq * 4;
                    dst[(size_t)(dv + 0) * S] = (unsigned short)f2bf(acc[i][j].x * sc); dst[(size_t)(dv + 1) * S] = (unsigned short)f2bf(acc[i][j].y * sc);
                    dst[(size_t)(dv + 2) * S] = (unsigned short)f2bf(acc[i][j].z * sc); dst[(size_t)(dv + 3) * S] = (unsigned short)f2bf(acc[i][j].w * sc);
                }
            }
        }
    }
};

typedef float f32x16 __attribute__((ext_vector_type(16)));
typedef __bf16 bf16x2_t __attribute__((ext_vector_type(2)));
__device__ __forceinline__ unsigned cvtpk(float lo, float hi) { f32x2 v = {lo, hi}; bf16x2_t b = __builtin_convertvector(v, bf16x2_t); return __builtin_bit_cast(unsigned, b); }
__device__ __forceinline__ int crow(int r, int hi) { return (r & 3) + 8 * (r >> 2) + 4 * hi; }
__device__ __forceinline__ int kperm(int rho) { return (rho & 0x13) | ((rho & 4) << 1) | ((rho & 8) >> 1); }

template <int DQK, bool SWA>
__device__ void stage_attn_flash(const Params& p, unsigned char* lds) {
    constexpr int NK = DQK / 16, KCH = DQK / 8, KSTR = (KCH + 1) * 16, VSTR = 144;
    constexpr int KT_BYTES = 64 * KSTR, VT_BYTES = 64 * VSTR, STG = KT_BYTES + VT_BYTES, NKC = 64 * KCH;
    const unsigned short* Qg = (const unsigned short*)(p.ws + (SWA ? WS_QA : WS_QMB));
    const unsigned short* Kg = (const unsigned short*)(p.ws + (SWA ? WS_KA : WS_K96));
    const unsigned short* Vg = (const unsigned short*)(p.ws + (SWA ? WS_VAT : WS_VT));
    unsigned short* O = (unsigned short*)(p.ws + WS_OAB);
    const int tid = threadIdx.x, lane = tid & 63, wave = tid >> 6, r32 = lane & 31, hi = lane >> 5;
    const int G = gridDim.x, bx = blockIdx.x;
    const int vcu = (G % 8 == 0) ? (bx % 8) * (G / 8) + bx / 8 : bx;
    const int nunits = SWA ? Bsz * 2 * 64 : Bsz * 8 * 16;
    const int kro = kperm(r32) * KSTR + hi * 16;
    const int vro = r32 * VSTR + hi * 16;
    const int kid0 = tid, kid1 = tid + 512;
    const int k0row = kid0 / KCH, k0c = kid0 % KCH, k1row = kid1 / KCH, k1c = kid1 % KCH;
    const int vrow = tid >> 3, vc = tid & 7;
    for (int u = vcu; u < nunits; u += G) {
        int b, qb, tlo, thi, sq, ocol; const unsigned short *Qp, *Kb, *Vb; float m, l;
        if (SWA) {
            qb = u & 63; const int kvh = (u >> 6) & 1; b = u >> 7;
            const int head = kvh * 4 + (wave >> 1);
            sq = qb * 64 + (wave & 1) * 32 + r32;
            Qp = Qg + ((size_t)(b * 8 + head) * S + sq) * 64;
            Kb = Kg + (size_t)(b * 2 + kvh) * S * 64; Vb = Vg + (size_t)(b * 2 + kvh) * 64 * S;
            tlo = qb - 2 < 0 ? 0 : qb - 2; thi = qb + 2 > 63 ? 63 : qb + 2;
            m = p.sink[head] * LOG2E; l = 0.5f; ocol = head * 64;
        } else {
            qb = u & 15; const int h = (u >> 4) & 7; b = u >> 7;
            sq = qb * 256 + wave * 32 + r32;
            Qp = Qg + ((size_t)(b * 8 + h) * S + sq) * 96;
            Kb = Kg + (size_t)(b * 8 + h) * S * 96; Vb = Vg + (size_t)(b * 8 + h) * 64 * S;
            tlo = 0; thi = 63; m = -1e30f; l = 0.f; ocol = 512 + h * 64;
        }
        bf16x8 qf[NK];
#pragma unroll
        for (int ks = 0; ks < NK; ++ks) qf[ks] = *(const bf16x8*)(Qp + ks * 16 + hi * 8);
        f32x16 o0, o1;
#pragma unroll
        for (int r = 0; r < 16; ++r) { o0[r] = 0.f; o1[r] = 0.f; }
        u32x4 rk0, rk1, rv;
        {
            const unsigned short* kt = Kb + (size_t)tlo * 64 * DQK;
            rk0 = *(const u32x4*)(kt + kid0 * 8);
            if (kid1 < NKC) rk1 = *(const u32x4*)(kt + kid1 * 8);
            rv = *(const u32x4*)(Vb + (size_t)vrow * S + tlo * 64 + vc * 8);
            *(u32x4*)(lds + k0row * KSTR + k0c * 16) = rk0;
            if (kid1 < NKC) *(u32x4*)(lds + k1row * KSTR + k1c * 16) = rk1;
            *(u32x4*)(lds + KT_BYTES + vrow * VSTR + vc * 16) = rv;
        }
        __syncthreads();
        for (int tt = tlo; tt <= thi; ++tt) {
            const unsigned char* Kl = lds + ((tt - tlo) & 1) * STG;
            const unsigned char* Vl = Kl + KT_BYTES;
            unsigned char* Kn = lds + (((tt - tlo) & 1) ^ 1) * STG;
            const bool more = tt < thi;
            if (more) {
                const unsigned short* kt = Kb + (size_t)(tt + 1) * 64 * DQK;
                rk0 = *(const u32x4*)(kt + kid0 * 8);
                if (kid1 < NKC) rk1 = *(const u32x4*)(kt + kid1 * 8);
                rv = *(const u32x4*)(Vb + (size_t)vrow * S + (tt + 1) * 64 + vc * 8);
            }
            f32x16 s0, s1;
#pragma unroll
            for (int r = 0; r < 16; ++r) { s0[r] = 0.f; s1[r] = 0.f; }
#pragma unroll
            for (int ks = 0; ks < NK; ++ks) {
                const bf16x8 kf0 = *(const bf16x8*)(Kl + kro + ks * 32);
                const bf16x8 kf1 = *(const bf16x8*)(Kl + 32 * KSTR + kro + ks * 32);
                s0 = __builtin_amdgcn_mfma_f32_32x32x16_bf16(kf0, qf[ks], s0, 0, 0, 0);
                s1 = __builtin_amdgcn_mfma_f32_32x32x16_bf16(kf1, qf[ks], s1, 0, 0, 0);
            }
            if (SWA) {
                const int rel = tt - qb;
                if (rel == -2 || rel == 2) {
                    const int qi = (wave & 1) * 32 + r32;
#pragma unroll
                    for (int r = 0; r < 16; ++r) {
                        const int kk = kperm(crow(r, hi));
                        const bool v0 = (rel == -2) ? (kk >= qi) : (kk <= qi);
                        const bool v1 = (rel == -2) ? (kk + 32 >= qi) : (kk + 32 <= qi);
                        s0[r] = v0 ? s0[r] : -1e30f; s1[r] = v1 ? s1[r] : -1e30f;
                    }
                }
            }
            float mx = fmaxf(s0[0], s1[0]);
#pragma unroll
            for (int r = 1; r < 16; ++r) mx = fmaxf(mx, fmaxf(s0[r], s1[r]));
            mx = fmaxf(mx, __shfl_xor(mx, 32));
            const float mn = fmaxf(m, mx);
            const float alpha = __builtin_amdgcn_exp2f(m - mn);
            m = mn;
            float rs = 0.f;
#pragma unroll
            for (int r = 0; r < 16; ++r) { s0[r] = __builtin_amdgcn_exp2f(s0[r] - mn); s1[r] = __builtin_amdgcn_exp2f(s1[r] - mn); rs += s0[r] + s1[r]; }
            l = l * alpha + rs;
#pragma unroll
            for (int r = 0; r < 16; ++r) { o0[r] *= alpha; o1[r] *= alpha; }
#pragma unroll
            for (int st = 0; st < 2; ++st) {
                u32x4 pw;
                pw.x = cvtpk(s0[8 * st + 0], s0[8 * st + 1]); pw.y = cvtpk(s0[8 * st + 2], s0[8 * st + 3]);
                pw.z = cvtpk(s0[8 * st + 4], s0[8 * st + 5]); pw.w = cvtpk(s0[8 * st + 6], s0[8 * st + 7]);
                const bf16x8 pf = __builtin_bit_cast(bf16x8, pw);
                const bf16x8 vf0 = *(const bf16x8*)(Vl + vro + st * 32);
                const bf16x8 vf1 = *(const bf16x8*)(Vl + 32 * VSTR + vro + st * 32);
                o0 = __builtin_amdgcn_mfma_f32_32x32x16_bf16(vf0, pf, o0, 0, 0, 0);
                o1 = __builtin_amdgcn_mfma_f32_32x32x16_bf16(vf1, pf, o1, 0, 0, 0);
            }
#pragma unroll
            for (int st = 0; st < 2; ++st) {
                u32x4 pw;
                pw.x = cvtpk(s1[8 * st + 0], s1[8 * st + 1]); pw.y = cvtpk(s1[8 * st + 2], s1[8 * st + 3]);
                pw.z = cvtpk(s1[8 * st + 4], s1[8 * st + 5]); pw.w = cvtpk(s1[8 * st + 6], s1[8 * st + 7]);
                const bf16x8 pf = __builtin_bit_cast(bf16x8, pw);
                const bf16x8 vf0 = *(const bf16x8*)(Vl + vro + 64 + st * 32);
                const bf16x8 vf1 = *(const bf16x8*)(Vl + 32 * VSTR + vro + 64 + st * 32);
                o0 = __builtin_amdgcn_mfma_f32_32x32x16_bf16(vf0, pf, o0, 0, 0, 0);
                o1 = __builtin_amdgcn_mfma_f32_32x32x16_bf16(vf1, pf, o1, 0, 0, 0);
            }
            if (more) {
                *(u32x4*)(Kn + k0row * KSTR + k0c * 16) = rk0;
                if (kid1 < NKC) *(u32x4*)(Kn + k1row * KSTR + k1c * 16) = rk1;
                *(u32x4*)(Kn + KT_BYTES + vrow * VSTR + vc * 16) = rv;
            }
            __syncthreads();
        }
        const float il = 1.f / (l + __shfl_xor(l, 32));
        unsigned short* orow = O + (size_t)(b * S + sq) * D + ocol + 4 * hi;
#pragma unroll
        for (int g = 0; g < 4; ++g) {
            *(unsigned long long*)(orow + 8 * g) = (unsigned long long)cvtpk(o0[4 * g] * il, o0[4 * g + 1] * il) | ((unsigned long long)cvtpk(o0[4 * g + 2] * il, o0[4 * g + 3] * il) << 32);
            *(unsigned long long*)(orow + 32 + 8 * g) = (unsigned long long)cvtpk(o1[4 * g] * il, o1[4 * g + 1] * il) | ((unsigned long long)cvtpk(o1[4 * g + 2] * il, o1[4 * g + 3] * il) << 32);
        }
    }
}

__device__ void stage_outnorm(const Params& p) {
    const unsigned short* oab = (const unsigned short*)(p.ws + WS_OAB);
    unsigned short* mixed = (unsigned short*)(p.ws + WS_HB);
    const int lane = threadIdx.x & 63, wave = threadIdx.x >> 6;
    for (int t = blockIdx.x * NWAVES + wave; t < T; t += gridDim.x * NWAVES) {
        const u32x4* r = (const u32x4*)(oab + (size_t)t * D) + lane;
        u32x4* o = (u32x4*)(mixed + (size_t)t * D) + lane;
#pragma unroll
        for (int half = 0; half < 2; ++half) {
            const u32x4 w = r[half * 64];
            float v[8] = {bflo(w.x), bfhi(w.x), bflo(w.y), bfhi(w.y), bflo(w.z), bfhi(w.z), bflo(w.w), bfhi(w.w)};
            float s = 0.f;
#pragma unroll
            for (int i = 0; i < 8; ++i) s += v[i] * v[i];
            const float rstd = rsqrtf(wave_sum(s) * (1.f / 512.f) + EPS);
            const float* gn = (half ? p.onorm_b : p.onorm_a) + lane * 8;
            const f32x4 g0 = *(const f32x4*)gn, g1 = *(const f32x4*)(gn + 4);
            u32x4 ov;
            ov.x = pk2(v[0] * rstd * g0.x, v[1] * rstd * g0.y); ov.y = pk2(v[2] * rstd * g0.z, v[3] * rstd * g0.w);
            ov.z = pk2(v[4] * rstd * g1.x, v[5] * rstd * g1.y); ov.w = pk2(v[6] * rstd * g1.z, v[7] * rstd * g1.w);
            o[half * 64] = ov;
        }
    }
}

__device__ __forceinline__ void ce_desc(int& a, int& b) { const int hi = max(a, b), lo = min(a, b); a = hi; b = lo; }
__device__ __forceinline__ void ce_asc(int& a, int& b) { const int hi = max(a, b), lo = min(a, b); a = lo; b = hi; }
template <int N, int OFF> __device__ __forceinline__ void bitonic_sort_desc(int (&a)[32]) {
#pragma unroll
    for (int k = 2; k <= N; k <<= 1)
#pragma unroll
        for (int j = k >> 1; j > 0; j >>= 1)
#pragma unroll
            for (int i = 0; i < N; ++i) {
                const int l = i ^ j;
                if (l > i) { if ((i & k) == 0) ce_desc(a[OFF + i], a[OFF + l]); else ce_asc(a[OFF + i], a[OFF + l]); }
            }
}
__device__ __forceinline__ void bitonic_clean16_desc(int (&a)[32]) {
#pragma unroll
    for (int j = 8; j > 0; j >>= 1)
#pragma unroll
        for (int i = 0; i < 16; ++i) { const int l = i ^ j; if (l > i) ce_desc(a[i], a[l]); }
}
__device__ __forceinline__ int f2sortable(float f) { const int b = __builtin_bit_cast(int, f); return b ^ ((b >> 31) & 0x7fffffff); }
__device__ __forceinline__ float sortable2f(int s) { return __builtin_bit_cast(float, s ^ ((s >> 31) & 0x7fffffff)); }
struct CandTab { int i[52], j[52]; };
constexpr CandTab make_cands() { CandTab t{}; int n = 0; for (int i = 0; i < 16; ++i) for (int j = 0; j < 16; ++j) if ((i + 1) * (j + 1) <= 16) { t.i[n] = i; t.j[n] = j; ++n; } for (; n < 52; ++n) { t.i[n] = -1; t.j[n] = -1; } return t; }
constexpr CandTab CANDS = make_cands();
struct EpiTopkSel {
    unsigned short* idx; float* g;
    int keep[2][16];
    __device__ __forceinline__ void operator()(const f32x4 (&acc)[8][2], int pb, int qb, int lane, const float*, int hp, int half) {
        const int fr = lane & 15, fq = lane >> 4;
#pragma unroll
        for (int j = 0; j < 2; ++j) {
            int v[32];
#pragma unroll
            for (int i = 0; i < 8; ++i)
#pragma unroll
                for (int r = 0; r < 4; ++r) v[i * 4 + r] = (f2sortable(acc[i][j][r]) & ~127) | (i * 16 + fq * 4 + r);
            bitonic_sort_desc<16, 0>(v); bitonic_sort_desc<16, 16>(v);
#pragma unroll
            for (int i = 0; i < 16; ++i) v[i] = max(v[i], v[31 - i]);
            bitonic_clean16_desc(v);
#pragma unroll
            for (int x = 16; x <= 32; x <<= 1) {
#pragma unroll
                for (int i = 0; i < 16; ++i) v[16 + i] = __shfl_xor(v[i], x);
#pragma unroll
                for (int i = 0; i < 16; ++i) v[i] = max(v[i], v[31 - i]);
                bitonic_clean16_desc(v);
            }
            if (half == 0) {
#pragma unroll
                for (int i = 0; i < 16; ++i) keep[j][i] = v[i];
            } else {
                float as[16], bs[16]; int ai[16], bi[16];
#pragma unroll
                for (int i = 0; i < 16; ++i) { as[i] = sortable2f(keep[j][i] & ~127); ai[i] = (keep[j][i] & 127) << 7; bs[i] = sortable2f(v[i] & ~127); bi[i] = v[i] & 127; }
                int w[32];
#pragma unroll
                for (int sl = 0; sl < 13; ++sl) {
                    int c4[4];
#pragma unroll
                    for (int f = 0; f < 4; ++f) {
                        constexpr int dummy = 0; (void)dummy;
                        const int ci = CANDS.i[sl * 4 + f], cj = CANDS.j[sl * 4 + f];
                        c4[f] = (ci >= 0) ? ((f2sortable(as[ci >= 0 ? ci : 0] + bs[cj >= 0 ? cj : 0]) & ~0x3fff) | (ai[ci >= 0 ? ci : 0] | bi[cj >= 0 ? cj : 0])) : (int)0x80000000;
                    }
                    w[sl] = (fq == 0) ? c4[0] : (fq == 1) ? c4[1] : (fq == 2) ? c4[2] : c4[3];
                }
                w[13] = w[14] = w[15] = (int)0x80000000;
                bitonic_sort_desc<16, 0>(w);
#pragma unroll
                for (int x = 16; x <= 32; x <<= 1) {
#pragma unroll
                    for (int i = 0; i < 16; ++i) w[16 + i] = __shfl_xor(w[i], x);
#pragma unroll
                    for (int i = 0; i < 16; ++i) w[i] = max(w[i], w[31 - i]);
                    bitonic_clean16_desc(w);
                }
                int my[4];
#pragma unroll
                for (int c = 0; c < 4; ++c) my[c] = (fq == 0) ? w[c] : (fq == 1) ? w[4 + c] : (fq == 2) ? w[8 + c] : w[12 + c];
                const float top = sortable2f(w[0] & ~0x3fff);
                float e[4], part = 0.f;
#pragma unroll
                for (int c = 0; c < 4; ++c) { e[c] = __expf(sortable2f(my[c] & ~0x3fff) - top); part += e[c]; }
                part += __shfl_xor(part, 16); part += __shfl_xor(part, 32);
                const float inv = 1.f / part;
                const int t = qb + j * 16 + fr;
                const size_t o = (size_t)t * 128 + (hp >> 1) * 16 + fq * 4;
                *(unsigned long long*)(idx + o) = (unsigned long long)(unsigned)((my[0] & 0x3fff) | ((my[1] & 0x3fff) << 16)) | ((unsigned long long)(unsigned)((my[2] & 0x3fff) | ((my[3] & 0x3fff) << 16)) << 32);
                *(f32x4*)(g + o) = (f32x4){e[0] * inv, e[1] * inv, e[2] * inv, e[3] * inv};
            }
        }
    }
};
__device__ __forceinline__ void ld_row4(u32x4 (&d)[4], const unsigned char* tab, int id, int l16) {
    const u32x4* r = (const u32x4*)(tab + (size_t)id * D + l16 * 16);
#pragma unroll
    for (int j = 0; j < 4; ++j) d[j] = r[16 * j];
}
__device__ void stage_peer_u(const Params& p) {
    const unsigned short* h2 = (const unsigned short*)(p.ws + WS_HB);
    const float* mod = (const float*)(p.ws + WS_MOD);
    const unsigned short* idx = (const unsigned short*)(p.ws + WS_IDX); float* g = (float*)(p.ws + WS_G);
    const unsigned char* eu8 = p.ws + WS_EU8; const unsigned char* ev8 = p.ws + WS_EV8;
    const float* us = (const float*)(p.ws + WS_US); const float* vs = (const float*)(p.ws + WS_VS);
    const int lane = threadIdx.x & 63, wave = threadIdx.x >> 6, l16 = lane & 15, grp = lane >> 4;
    for (int t = blockIdx.x * NWAVES + wave; t < T; t += gridDim.x * NWAVES) {
        const int b = t >> 12;
        float hreg[64];
#pragma unroll
        for (int j = 0; j < 4; ++j)
#pragma unroll
            for (int c = 0; c < 2; ++c) {
                const u32x4 w = *(const u32x4*)(h2 + (size_t)t * D + j * 256 + l16 * 16 + c * 8);
                hreg[j * 16 + c * 8 + 0] = bflo(w.x); hreg[j * 16 + c * 8 + 1] = bfhi(w.x); hreg[j * 16 + c * 8 + 2] = bflo(w.y); hreg[j * 16 + c * 8 + 3] = bfhi(w.y);
                hreg[j * 16 + c * 8 + 4] = bflo(w.z); hreg[j * 16 + c * 8 + 5] = bfhi(w.z); hreg[j * 16 + c * 8 + 6] = bflo(w.w); hreg[j * 16 + c * 8 + 7] = bfhi(w.w);
            }
        const int idv0 = idx[(size_t)t * 128 + lane], idv1 = idx[(size_t)t * 128 + 64 + lane];
        const float gv0 = g[(size_t)t * 128 + lane], gv1 = g[(size_t)t * 128 + 64 + lane];
        float wv0 = 0.f, wv1 = 0.f;
        {
            u32x4 cur[4], nxt[4];
            int id_c = __shfl(idv0, grp);
            ld_row4(cur, eu8, id_c, l16);
            float sc_c = us[id_c];
#pragma unroll 2
            for (int q = 0; q < 32; ++q) {
                const int qn = (q + 1 < 32) ? q + 1 : q;
                const int rn = qn * 4 + grp;
                const int id_n = __shfl((qn < 16) ? idv0 : idv1, rn & 63);
                ld_row4(nxt, eu8, id_n, l16);
                const float sc_n = us[id_n];
                float s0 = 0.f, s1 = 0.f;
#pragma unroll
                for (int j = 0; j < 4; ++j)
#pragma unroll
                    for (int c = 0; c < 4; ++c) {
                        const int w = (int)cur[j][c];
                        const f32x2 lo = __builtin_amdgcn_cvt_pk_f32_fp8(w, false), hi = __builtin_amdgcn_cvt_pk_f32_fp8(w, true);
                        s0 += lo.x * hreg[j * 16 + c * 4 + 0]; s1 += lo.y * hreg[j * 16 + c * 4 + 1];
                        s0 += hi.x * hreg[j * 16 + c * 4 + 2]; s1 += hi.y * hreg[j * 16 + c * 4 + 3];
                    }
                const float s = group16_sum(s0 + s1) * sc_c;
                const float act = 0.5f * s * (1.f + erff(s * 0.70710678118654752f));
                const int r = q * 4 + grp;
                const float gk = __shfl((q < 16) ? gv0 : gv1, r & 63);
                const float w = gk * act;
                const float wt = __shfl(w, (lane & 3) * 16);
                const bool mine = (lane >> 2) == (q & 15);
                if (q < 16) wv0 = mine ? wt : wv0; else wv1 = mine ? wt : wv1;
#pragma unroll
                for (int j = 0; j < 4; ++j) cur[j] = nxt[j];
                sc_c = sc_n;
            }
        }
        g[(size_t)t * 128 + lane] = wv0; g[(size_t)t * 128 + 64 + lane] = wv1;
    }
}
__device__ void stage_peer_v(const Params& p, float* outp) {
    const float* mod = (const float*)(p.ws + WS_MOD);
    const unsigned short* idx = (const unsigned short*)(p.ws + WS_IDX); const float* g = (const float*)(p.ws + WS_G);
    const unsigned char* ev8 = p.ws + WS_EV8;
    const float* vs = (const float*)(p.ws + WS_VS);
    const int lane = threadIdx.x & 63, wave = threadIdx.x >> 6, l16 = lane & 15, grp = lane >> 4;
    for (int t = blockIdx.x * NWAVES + wave; t < T; t += gridDim.x * NWAVES) {
        const int b = t >> 12;
        const int idv0 = idx[(size_t)t * 128 + lane], idv1 = idx[(size_t)t * 128 + 64 + lane];
        const float wv0 = g[(size_t)t * 128 + lane], wv1 = g[(size_t)t * 128 + 64 + lane];
        float acc[64];
#pragma unroll
        for (int i = 0; i < 64; ++i) acc[i] = 0.f;
        {
            u32x4 cur[4], nxt[4];
            int id_c = __shfl(idv0, grp);
            ld_row4(cur, ev8, id_c, l16);
            float sc_c = vs[id_c];
#pragma unroll 2
            for (int q = 0; q < 32; ++q) {
                const int qn = (q + 1 < 32) ? q + 1 : q;
                const int rn = qn * 4 + grp;
                const int id_n = __shfl((qn < 16) ? idv0 : idv1, rn & 63);
                ld_row4(nxt, ev8, id_n, l16);
                const float sc_n = vs[id_n];
                const int r = q * 4 + grp;
                const float wv = __shfl((q < 16) ? wv0 : wv1, r & 63) * sc_c;
#pragma unroll
                for (int j = 0; j < 4; ++j)
#pragma unroll
                    for (int c = 0; c < 4; ++c) {
                        const int w = (int)cur[j][c];
                        const f32x2 lo = __builtin_amdgcn_cvt_pk_f32_fp8(w, false), hi = __builtin_amdgcn_cvt_pk_f32_fp8(w, true);
                        acc[j * 16 + c * 4 + 0] += wv * lo.x; acc[j * 16 + c * 4 + 1] += wv * lo.y;
                        acc[j * 16 + c * 4 + 2] += wv * hi.x; acc[j * 16 + c * 4 + 3] += wv * hi.y;
                    }
#pragma unroll
                for (int j = 0; j < 4; ++j) cur[j] = nxt[j];
                sc_c = sc_n;
            }
        }
#pragma unroll
        for (int i = 0; i < 64; ++i) { acc[i] += __shfl_xor(acc[i], 16); acc[i] += __shfl_xor(acc[i], 32); }
        float sel[16];
#pragma unroll
        for (int bb = 0; bb < 16; ++bb) sel[bb] = (grp == 0) ? acc[bb] : (grp == 1) ? acc[16 + bb] : (grp == 2) ? acc[32 + bb] : acc[48 + bb];
        const int eoff = grp * 256 + l16 * 16;
        const float* xin = p.out + (size_t)t * D + eoff;
        float* xr = outp + (size_t)t * D + eoff;
        const float* gf = mod + b * NMOD + 5 * D + eoff;
        float ss = 0.f;
#pragma unroll
        for (int c = 0; c < 4; ++c) {
            const f32x4 x1 = *(const f32x4*)(xin + c * 4); const f32x4 gg = *(const f32x4*)(gf + c * 4);
            sel[c * 4 + 0] = x1.x + gg.x * sel[c * 4 + 0]; sel[c * 4 + 1] = x1.y + gg.y * sel[c * 4 + 1];
            sel[c * 4 + 2] = x1.z + gg.z * sel[c * 4 + 2]; sel[c * 4 + 3] = x1.w + gg.w * sel[c * 4 + 3];
            ss += sel[c * 4 + 0] * sel[c * 4 + 0] + sel[c * 4 + 1] * sel[c * 4 + 1] + sel[c * 4 + 2] * sel[c * 4 + 2] + sel[c * 4 + 3] * sel[c * 4 + 3];
        }
        const float rstd = rsqrtf(wave_sum(ss) * (1.f / D) + EPS);
#pragma unroll
        for (int c = 0; c < 4; ++c) {
            const f32x4 fn = *(const f32x4*)(p.fnorm + eoff + c * 4);
            f32x4 r; r.x = sel[c * 4 + 0] * rstd * fn.x; r.y = sel[c * 4 + 1] * rstd * fn.y; r.z = sel[c * 4 + 2] * rstd * fn.z; r.w = sel[c * 4 + 3] * rstd * fn.w;
            *(f32x4*)(xr + c * 4) = r;
        }
    }
}

#define LAS __attribute__((address_space(3)))
constexpr size_t WS_BAR = 3 * MiB;
constexpr int BAR_BYTES = 16384;
constexpr int LDS_MISC_OFF = 147456;
#define XB_TMO      128
#define XB_XCNT(j)  (256  + 64 * (j))
#define XB_XSUB(j)  (1280 + 64 * (j))
#define XB_XGEN(j)  (2304 + 64 * (j))
#define XB_TOP      3328
#define XB_TOPGEN   3392
#define XB_SPIN_CAP (1u << 18)
__device__ __forceinline__ unsigned xb_ld(unsigned* p)              { return __hip_atomic_load(p, __ATOMIC_RELAXED, __HIP_MEMORY_SCOPE_AGENT); }
__device__ __forceinline__ unsigned xb_add(unsigned* p, unsigned v) { return __hip_atomic_fetch_add(p, v, __ATOMIC_RELAXED, __HIP_MEMORY_SCOPE_AGENT); }
__device__ __forceinline__ unsigned xb_xcc_id() { return (unsigned)__builtin_amdgcn_s_getreg((3 << 11) | 20) & 0xFu; }
#define XB_SPIN(cond, bar) do { unsigned _sp = 0; while (cond) { __builtin_amdgcn_s_sleep(1); \
    if ((++_sp & 255u) == 0u) { if (xb_ld(&(bar)[XB_TMO])) break; if (_sp > XB_SPIN_CAP) { atomicAdd(&(bar)[XB_TMO], 1u); break; } } } } while (0)
struct XcdBarrier { unsigned* bar; unsigned x; volatile LAS unsigned* st; };
__device__ __forceinline__ XcdBarrier xcd_barrier_post(unsigned* bar, volatile LAS unsigned* st) {
    XcdBarrier b; b.bar = bar; b.x = xb_xcc_id(); b.st = st;
    if (threadIdx.x == 0) (void)xb_add(&bar[XB_XCNT(b.x)], 1u);
    return b;
}
__device__ __forceinline__ void xcd_barrier_complete(unsigned* bar, unsigned x, unsigned& nloc, unsigned& nx) {
    const unsigned G = gridDim.x * gridDim.y * gridDim.z;
    unsigned sum, cnt, mine, sp = 0u;
    for (;;) {
        sum = 0u; cnt = 0u; mine = 0u;
#pragma unroll
        for (unsigned j = 0; j < 16; ++j) { const unsigned c = xb_ld(&bar[XB_XCNT(j)]); sum += c; cnt += (c > 0u) ? 1u : 0u; mine = (j == x) ? c : mine; }
        if (sum == G) break;
        __builtin_amdgcn_s_sleep(1);
        if ((++sp & 255u) == 0u) { if (xb_ld(&bar[XB_TMO])) break; if (sp > XB_SPIN_CAP) { atomicAdd(&bar[XB_TMO], 1u); break; } }
    }
    nloc = mine > 0u ? mine : 1u; nx = cnt > 0u ? cnt : 1u;
}
__device__ __forceinline__ void xcd_barrier(const XcdBarrier& b) {
    asm volatile("s_waitcnt vmcnt(0)" ::: "memory");
    __syncthreads();
    if (threadIdx.x == 0) {
        unsigned* bar = b.bar;
        __builtin_amdgcn_s_waitcnt(0);
        unsigned nloc = b.st[0], nx = b.st[1];
        if (nloc == 0u) { xcd_barrier_complete(bar, b.x, nloc, nx); b.st[0] = nloc; b.st[1] = nx; }
        const unsigned old = xb_add(&bar[XB_XSUB(b.x)], 1u);
        const unsigned gen = old / nloc;
        if (old + 1u == (gen + 1u) * nloc) {
            __builtin_amdgcn_fence(__ATOMIC_RELEASE, "agent");
            asm volatile("s_waitcnt vmcnt(0)" ::: "memory");
            const unsigned og = xb_add(&bar[XB_TOP], 1u);
            const unsigned tg = og / nx;
            if (og + 1u == (tg + 1u) * nx) xb_add(&bar[XB_TOPGEN], 1u);
            else XB_SPIN(xb_ld(&bar[XB_TOPGEN]) == tg, bar);
            __builtin_amdgcn_fence(__ATOMIC_ACQUIRE, "agent");
            xb_add(&bar[XB_XGEN(b.x)], 1u);
            asm volatile("s_waitcnt vmcnt(0)" ::: "memory");
        } else {
            XB_SPIN(xb_ld(&bar[XB_XGEN(b.x)]) == gen, bar);
            __builtin_amdgcn_fence(__ATOMIC_ACQUIRE, "agent");
            asm volatile("s_waitcnt vmcnt(0)" ::: "memory");
        }
    }
    __syncthreads();
}

__global__ void __launch_bounds__(NTHREADS) fwd_megakernel(Params p) {
    extern __shared__ __attribute__((aligned(16))) unsigned char lds_raw[];
    cg::grid_group grid = cg::this_grid();
    unsigned short* hb = (unsigned short*)(p.ws + WS_HB);
    const float* mod = (const float*)(p.ws + WS_MOD);
    typedef const unsigned short* cbf;

    volatile LAS unsigned* bst = (volatile LAS unsigned*)((LAS unsigned char*)lds_raw + LDS_MISC_OFF);
    if (threadIdx.x < 2) bst[threadIdx.x] = 0u;
    __syncthreads();
    const XcdBarrier xbar = xcd_barrier_post((unsigned*)(p.ws + WS_BAR), bst);
#ifdef PROBE_A
    for (int rep = 0, nrep = (p.ws != nullptr) ? 2 : 1; rep < nrep; ++rep) { if (rep) xcd_barrier(xbar);
#endif
    stage_prologue(p, (float*)lds_raw);
#ifdef PROBE_A
    }
#endif
    grid.sync();
#ifdef PROBE_A
    for (int rep = 0, nrep = (p.ws != nullptr) ? 2 : 1; rep < nrep; ++rep) { if (rep) xcd_barrier(xbar);
#endif
    stage_norm_mod<true>(p, p.x, hb, 0 * D, 1 * D);
#ifdef PROBE_A
    }
#endif
    xcd_barrier(xbar);
    gemm_dma<2, 1>((cbf)(p.ws + WS_WIN), D, hb, D, 1280, T, D, 1, 0, 0, lds_raw, EpiProj{p.ws});
    xcd_barrier(xbar);
    gemm_xyT<2, true>((cbf)(p.ws + WS_WQUP), 256, (cbf)(p.ws + WS_QL), 256, 768, T, 256, 1, 0, 0, lds_raw, EpiQup{p.ws});
    gemm_xyT<2, true>((cbf)(p.ws + WS_WKVUP), 128, (cbf)(p.ws + WS_KVL), 128, 1024, T, 128, 1, 0, 0, lds_raw, EpiKVup{p.ws});
    xcd_barrier(xbar);
#ifdef PROBE_SWA
    for (int rep = 0, nrep = (p.ws != nullptr) ? 2 : 1; rep < nrep; ++rep) { if (rep) xcd_barrier(xbar);
#endif
    stage_attn_flash<64, true>(p, lds_raw);
#ifdef PROBE_SWA
    }
#endif
#ifdef PROBE_MLA
    for (int rep = 0, nrep = (p.ws != nullptr) ? 2 : 1; rep < nrep; ++rep) { if (rep) xcd_barrier(xbar);
#endif
    stage_attn_flash<96, false>(p, lds_raw);
#ifdef PROBE_MLA
    }
#endif
    xcd_barrier(xbar);
#ifdef PROBE_B
    for (int rep = 0, nrep = (p.ws != nullptr) ? 2 : 1; rep < nrep; ++rep) { if (rep) xcd_barrier(xbar);
#endif
    stage_outnorm(p);
#ifdef PROBE_B
    }
#endif
    xcd_barrier(xbar);
    gemm_dma<2, 1>((cbf)(p.ws + WS_WOUT), D, hb, D, D, T, D, 1, 0, 0, lds_raw, EpiOutProj{p.x, mod + 2 * D, p.out});
    xcd_barrier(xbar);
#ifdef PROBE_B
    for (int rep = 0, nrep = (p.ws != nullptr) ? 2 : 1; rep < nrep; ++rep) { if (rep) xcd_barrier(xbar);
#endif
    stage_norm_mod<true>(p, p.out, hb, 3 * D, 4 * D);
#ifdef PROBE_B
    }
#endif
    xcd_barrier(xbar);
#ifdef PROBE_PQ
    for (int rep = 0, nrep = (p.ws != nullptr) ? 2 : 1; rep < nrep; ++rep) { if (rep) xcd_barrier(xbar);
#endif
    gemm_dma<2, 1>((cbf)(p.ws + WS_WPQ), D, hb, D, 2048, T, D, 1, 0, 0, lds_raw, EpiStoreBf16{(unsigned short*)(p.ws + WS_PQ), 2048});
#ifdef PROBE_PQ
    }
#endif
    xcd_barrier(xbar);
    gemm_dma<1, 2>((cbf)(p.ws + WS_SUBK), 128, (cbf)(p.ws + WS_PQ), 2048, 128, T, 128, 16, 128 * 128, 128, lds_raw, EpiTopkSel{(unsigned short*)(p.ws + WS_IDX), (float*)(p.ws + WS_G), {}});
    xcd_barrier(xbar);
    stage_peer_u(p);
    xcd_barrier(xbar);
    stage_peer_v(p, p.out);
}

extern "C" void kernel_launch(void* const* d_in, const int* in_sizes, int n_in, void* d_out, int out_size, void* d_ws, size_t ws_size, hipStream_t stream) {
    static int grid_blocks = 0;
    if (grid_blocks == 0) {
        if (n_in != 18 || in_sizes[0] != T * D || out_size != T * D || ws_size < WS_END) {
            fprintf(stderr, "kernel_launch: unexpected shapes (n_in %d, in0 %d, out %d, ws %zu); nothing launched\n", n_in, n_in > 0 ? in_sizes[0] : -1, out_size, ws_size);
            grid_blocks = -1; return;
        }
        int dev = 0, cus = 0, per_cu = 0;
        (void)hipGetDevice(&dev);
        (void)hipDeviceGetAttribute(&cus, hipDeviceAttributeMultiprocessorCount, dev);
        if (hipFuncSetAttribute((const void*)fwd_megakernel, hipFuncAttributeMaxDynamicSharedMemorySize, LDS_BYTES) != hipSuccess) { fprintf(stderr, "kernel_launch: hipFuncSetAttribute failed\n"); grid_blocks = -1; return; }
        (void)hipOccupancyMaxActiveBlocksPerMultiprocessor(&per_cu, fwd_megakernel, NTHREADS, LDS_BYTES);
        if (per_cu < 1) { fprintf(stderr, "kernel_launch: occupancy query says %d blocks/CU\n", per_cu); grid_blocks = -1; return; }
        grid_blocks = cus;
    }
    if (grid_blocks < 0) return;
    Params p{};
    p.x = (const float*)d_in[0]; p.c = (const float*)d_in[1]; p.w_ada = (const float*)d_in[2]; p.b_ada = (const float*)d_in[3];
    p.w_in = (const float*)d_in[4]; p.sink = (const float*)d_in[5]; p.qnorm = (const float*)d_in[6]; p.w_qup = (const float*)d_in[7];
    p.kvnorm = (const float*)d_in[8]; p.w_kvup = (const float*)d_in[9]; p.onorm_a = (const float*)d_in[10]; p.onorm_b = (const float*)d_in[11];
    p.w_out = (const float*)d_in[12]; p.w_pq = (const float*)d_in[13]; p.subk = (const float*)d_in[14]; p.eu = (const float*)d_in[15];
    p.ev = (const float*)d_in[16]; p.fnorm = (const float*)d_in[17];
    p.out = (float*)d_out; p.ws = (unsigned char*)d_ws;
    if (hipMemsetAsync((char*)d_ws + WS_BAR, 0, BAR_BYTES, stream) != hipSuccess) { fprintf(stderr, "kernel_launch: hipMemsetAsync failed\n"); return; }
    void* args[] = {&p};
    hipError_t e = hipLaunchCooperativeKernel((void*)fwd_megakernel, dim3(grid_blocks), dim3(NTHREADS), args, LDS_BYTES, stream);
    if (e != hipSuccess) fprintf(stderr, "cooperative launch failed: %s (grid %d)\n", hipGetErrorString(e), grid_blocks);
}
```

```cpp
#include <hip/hip_runtime.h>
#include <hip/hip_cooperative_groups.h>
#include <cstdio>
#include <cstdint>
namespace cg = cooperative_groups;

constexpr int Bsz = 8, S = 4096, D = 1024, T = Bsz * S;
constexpr int INW = 1184;
constexpr int C_QA = 0, C_KA = 512, C_VA = 640, C_QL = 768, C_KVL = 1024, C_KR = 1152;
constexpr int NMOD = 6 * D;
constexpr float EPS = 1e-6f;
constexpr float LOG2E = 1.4426950408889634f;
constexpr float QA_SCALE = 0.125f * LOG2E;
constexpr float QM_SCALE = 0.10206207261596575f * LOG2E;
constexpr int NTHREADS = 512, NWAVES = 8;

constexpr size_t MiB = 1u << 20;
constexpr size_t WS_MOD = 0;
constexpr size_t WS_COSA = 1 * MiB;
constexpr size_t WS_SINA = WS_COSA + 512 * 1024;
constexpr size_t WS_COSB = 2 * MiB;
constexpr size_t WS_SINB = WS_COSB + 256 * 1024;
constexpr size_t WS_WIN = 4 * MiB;
constexpr size_t WS_WQUP = 7 * MiB;
constexpr size_t WS_WKVUP = 7 * MiB + 512 * 1024;
constexpr size_t WS_WOUT = 8 * MiB;
constexpr size_t WS_WPQ = 10 * MiB;
constexpr size_t WS_SUBK = 14 * MiB;
constexpr size_t WS_EU8 = 16 * MiB;
constexpr size_t WS_EV8 = 32 * MiB;
constexpr size_t WS_US = 48 * MiB;
constexpr size_t WS_VS = WS_US + 64 * 1024;
constexpr size_t WS_HB = 52 * MiB;
constexpr size_t WS_QA = 116 * MiB;
constexpr size_t WS_KA = 148 * MiB;
constexpr size_t WS_VAT = 156 * MiB;
constexpr size_t WS_QL = 164 * MiB;
constexpr size_t WS_KVL = 180 * MiB;
constexpr size_t WS_QMB = 192 * MiB;
constexpr size_t WS_K96 = 240 * MiB;
constexpr size_t WS_VT = 288 * MiB;
constexpr size_t WS_OAB = 320 * MiB;
constexpr size_t WS_PQ = 116 * MiB;
constexpr size_t WS_TOPS = 244 * MiB;
constexpr size_t WS_TOPI = 276 * MiB;
constexpr size_t WS_IDX = 284 * MiB;
constexpr size_t WS_G = 292 * MiB;
constexpr size_t WS_SSQO = 49 * MiB;
constexpr size_t WS_SSQ1 = 384 * MiB;
constexpr size_t WS_BPQ = 3 * MiB + 64 * 1024;
constexpr size_t WS_KEEP = 386 * MiB;
constexpr size_t WS_END = 512 * MiB;
constexpr int LDS_BYTES = 148480;
constexpr int NEXP = 16384;

struct Params {
    const float *x, *c, *w_ada, *b_ada, *w_in, *sink, *qnorm, *w_qup, *kvnorm, *w_kvup, *onorm_a, *onorm_b, *w_out, *w_pq, *subk, *eu, *ev, *fnorm;
    float* out;
    unsigned char* ws;
};

typedef short bf16x8 __attribute__((ext_vector_type(8)));
typedef float f32x4 __attribute__((ext_vector_type(4)));
typedef unsigned u32x4 __attribute__((ext_vector_type(4)));
typedef float f32x2 __attribute__((ext_vector_type(2)));

__device__ __forceinline__ unsigned f2bf(float f) { unsigned u = __builtin_bit_cast(unsigned, f); return (u + 0x7fffu + ((u >> 16) & 1u)) >> 16; }
__device__ __forceinline__ unsigned pk2(float lo, float hi) { return f2bf(lo) | (f2bf(hi) << 16); }
__device__ __forceinline__ float bf2f(unsigned short h) { return __builtin_bit_cast(float, (unsigned)h << 16); }
__device__ __forceinline__ float bflo(unsigned w) { return __builtin_bit_cast(float, w << 16); }
__device__ __forceinline__ float bfhi(unsigned w) { return __builtin_bit_cast(float, w & 0xffff0000u); }
__device__ __forceinline__ float wave_sum(float v) {
#pragma unroll
    for (int o = 1; o < 64; o <<= 1) v += __shfl_xor(v, o);
    return v;
}

__device__ __forceinline__ float wave_max(float v) {
#pragma unroll
    for (int o = 1; o < 64; o <<= 1) v = fmaxf(v, __shfl_xor(v, o));
    return v;
}
template <int CTRL> __device__ __forceinline__ float dpp_add(float s) {
    return s + __builtin_bit_cast(float, __builtin_amdgcn_update_dpp(0, __builtin_bit_cast(int, s), CTRL, 0xF, 0xF, true));
}
__device__ __forceinline__ float group16_sum(float s) { s = dpp_add<0xB1>(s); s = dpp_add<0x4E>(s); s = dpp_add<0x141>(s); s = dpp_add<0x140>(s); return s; }

__device__ void stage_gemv8(const float* vec, int vstride, bool silu, const float* W, int N, const float* bias, float* dst, float* lds) {
    const int tid = threadIdx.x;
    __syncthreads();
    for (int i = tid; i < Bsz * D; i += NTHREADS) { const int b = i >> 10, k = i & 1023; float v = vec[b * vstride + k]; lds[i] = silu ? v / (1.f + __expf(-v)) : v; }
    __syncthreads();
    float* red = lds + Bsz * D;
    const int col_l = tid & 15, slice = tid >> 4;
    for (int item = blockIdx.x; item < N / 16; item += gridDim.x) {
        const int n = item * 16 + col_l;
        float acc[Bsz];
#pragma unroll
        for (int b = 0; b < Bsz; ++b) acc[b] = 0.f;
#pragma unroll 8
        for (int kk = 0; kk < 32; ++kk) {
            const int k = slice * 32 + kk;
            const float w = W[(size_t)k * N + n];
#pragma unroll
            for (int b = 0; b < Bsz; ++b) acc[b] += lds[b * D + k] * w;
        }
#pragma unroll
        for (int b = 0; b < Bsz; ++b) red[(slice * 16 + col_l) * Bsz + b] = acc[b];
        __syncthreads();
        if (tid < 128) {
            const int cc = tid >> 3, b = tid & 7;
            float sacc = 0.f;
#pragma unroll
            for (int sl = 0; sl < 32; ++sl) sacc += red[(sl * 16 + cc) * Bsz + b];
            dst[b * N + item * 16 + cc] = sacc + (bias ? bias[item * 16 + cc] : 0.f);
        }
        __syncthreads();
    }
}

template <int MAP> __device__ __forceinline__ int map_row(int n) {
    if (MAP == 1) { const int h = n / 96, j = n % 96; return j < 64 ? h * 64 + j : 512 + h * 32 + (j - 64); }
    return n;
}
template <int MAP>
__device__ __forceinline__ void transpose_item(const float* W, int K, int N, unsigned short* WT, const float* kgain, float* scr, int item, int lane, const float* kgain2 = nullptr) {
    const int nblk = N / 32, kb = item / nblk, nb = item % nblk, k0 = 64 * kb, n0 = 32 * nb;
#pragma unroll 8
    for (int i = 0; i < 32; ++i) {
        const int kk = 2 * i + (lane >> 5);
        float w = W[(size_t)(k0 + kk) * N + n0 + (lane & 31)];
        if (kgain) w *= (kgain2 && k0 + kk >= 512) ? kgain2[k0 + kk - 512] : kgain[k0 + kk];
        scr[kk * 33 + (lane & 31)] = w;
    }
    asm volatile("s_waitcnt lgkmcnt(0)" ::: "memory");
    const int c = lane & 7;
#pragma unroll
    for (int j = 0; j < 4; ++j) {
        const int n = (lane >> 3) + 8 * j; const float* q = scr + (8 * c) * 33 + n;
        u32x4 o; o.x = pk2(q[0 * 33], q[1 * 33]); o.y = pk2(q[2 * 33], q[3 * 33]); o.z = pk2(q[4 * 33], q[5 * 33]); o.w = pk2(q[6 * 33], q[7 * 33]);
        *(u32x4*)(WT + (size_t)map_row<MAP>(n0 + n) * K + k0 + 8 * c) = o;
    }
    asm volatile("s_waitcnt lgkmcnt(0)" ::: "memory");
}

__device__ void stage_prologue(const Params& p, float* lds) {
    const int tid = threadIdx.x;
    stage_gemv8(p.c, D, true, p.w_ada, NMOD, p.b_ada, (float*)(p.ws + WS_MOD), lds);
    float* cosA = (float*)(p.ws + WS_COSA); float* sinA = (float*)(p.ws + WS_SINA);
    float* cosB = (float*)(p.ws + WS_COSB); float* sinB = (float*)(p.ws + WS_SINB);
    const int gtid = blockIdx.x * NTHREADS + tid, gn = gridDim.x * NTHREADS;
    for (int e = gtid; e < S * 32; e += gn) {
        const int pos = e >> 5, i = e & 31;
        const double inv = exp2(-(double)(2 * i) / 64.0 * 13.287712379549449);
        const double a = (double)pos * inv;
        cosA[e] = (float)cos(a); sinA[e] = (float)sin(a);
    }
    for (int e = gtid; e < S * 16; e += gn) {
        const int pos = e >> 4, i = e & 15;
        const double inv = exp2(-(double)(2 * i) / 32.0 * 13.287712379549449);
        const double a = (double)pos * inv;
        cosB[e] = (float)cos(a); sinB[e] = (float)sin(a);
    }
    {
        const int lane = tid & 63, wave = tid >> 6;
        float* scr = lds + wave * (64 * 33);
        const int gw = blockIdx.x * NWAVES + wave, NGW = gridDim.x * NWAVES;
        constexpr int I_IN = (D / 64) * (INW / 32), I_QU = (256 / 64) * (768 / 32), I_KV = (128 / 64) * (1024 / 32), I_OUT = (D / 64) * (D / 32), I_PQ = (D / 64) * (2048 / 32);
        constexpr int NITEMS = I_IN + I_QU + I_KV + I_OUT + I_PQ;
        __syncthreads();
        for (int it = gw; it < NITEMS; it += NGW) {
            int r = it;
            if (r < I_IN) { transpose_item<0>(p.w_in, D, INW, (unsigned short*)(p.ws + WS_WIN), nullptr, scr, r, lane); continue; } r -= I_IN;
            if (r < I_QU) { transpose_item<1>(p.w_qup, 256, 768, (unsigned short*)(p.ws + WS_WQUP), p.qnorm, scr, r, lane); continue; } r -= I_QU;
            if (r < I_KV) { transpose_item<0>(p.w_kvup, 128, 1024, (unsigned short*)(p.ws + WS_WKVUP), p.kvnorm, scr, r, lane); continue; } r -= I_KV;
            if (r < I_OUT) { transpose_item<0>(p.w_out, D, D, (unsigned short*)(p.ws + WS_WOUT), p.onorm_a, scr, r, lane, p.onorm_b); continue; } r -= I_OUT;
            transpose_item<0>(p.w_pq, D, 2048, (unsigned short*)(p.ws + WS_WPQ), nullptr, scr, r, lane);
        }
        {
            u32x4* z = (u32x4*)(p.ws + WS_WIN + (size_t)INW * D * 2);
            const int nz = (1280 - INW) * D * 2 / 16;
            for (int e = blockIdx.x * NTHREADS + tid; e < nz; e += gridDim.x * NTHREADS) z[e] = (u32x4){0u, 0u, 0u, 0u};
        }
        {
            const f32x4* src = (const f32x4*)p.subk; unsigned long long* dst = (unsigned long long*)(p.ws + WS_SUBK);
            for (int e = blockIdx.x * NTHREADS + tid; e < 16 * 128 * 128 / 4; e += gridDim.x * NTHREADS) {
                const f32x4 v = src[e]; dst[e] = (unsigned long long)pk2(v.x, v.y) | ((unsigned long long)pk2(v.z, v.w) << 32);
            }
        }
    }
    {
        const int lane = tid & 63, wave = tid >> 6;
        for (int r = blockIdx.x * NWAVES + wave; r < 2 * NEXP; r += gridDim.x * NWAVES) {
            const int tab = r >= NEXP, row = r - tab * NEXP;
            const f32x4* src = (const f32x4*)((tab ? p.ev : p.eu) + (size_t)row * D) + lane;
            f32x4 v[4]; float am = 0.f;
#pragma unroll
            for (int j = 0; j < 4; ++j) { v[j] = src[64 * j]; am = fmaxf(am, fmaxf(fmaxf(fabsf(v[j].x), fabsf(v[j].y)), fmaxf(fabsf(v[j].z), fabsf(v[j].w)))); }
            am = wave_max(am);
            int ex = 0; (void)frexpf(am, &ex);
            const float sc = ldexpf(1.f, 8 - ex), isc = ldexpf(1.f, ex - 8);
            unsigned* dst = (unsigned*)(p.ws + (tab ? WS_EV8 : WS_EU8) + (size_t)row * D) + lane;
#pragma unroll
            for (int j = 0; j < 4; ++j) {
                int w = 0;
                w = __builtin_amdgcn_cvt_pk_fp8_f32(v[j].x * sc, v[j].y * sc, w, false);
                w = __builtin_amdgcn_cvt_pk_fp8_f32(v[j].z * sc, v[j].w * sc, w, true);
                dst[64 * j] = (unsigned)w;
            }
            if (lane == 0) ((float*)(p.ws + (tab ? WS_VS : WS_US)))[row] = isc;
        }
    }
}

template <bool BF>
__device__ void stage_norm_mod(const Params& p, const float* src, void* dstv, int sh_off, int sc_off) {
    const float* mod = (const float*)(p.ws + WS_MOD);
    const int lane = threadIdx.x & 63, wave = threadIdx.x >> 6;
    for (int t = blockIdx.x * NWAVES + wave; t < T; t += gridDim.x * NWAVES) {
        const int b = t >> 12;
        const f32x4* xr = (const f32x4*)(src + (size_t)t * D) + lane;
        f32x4 v[4]; float s = 0.f;
#pragma unroll
        for (int j = 0; j < 4; ++j) { v[j] = xr[64 * j]; s += v[j].x * v[j].x + v[j].y * v[j].y + v[j].z * v[j].z + v[j].w * v[j].w; }
        const float rstd = rsqrtf(wave_sum(s) * (1.f / D) + EPS);
#pragma unroll
        for (int j = 0; j < 4; ++j) {
            const f32x4 sh = *((const f32x4*)(mod + b * NMOD + sh_off) + lane + 64 * j);
            const f32x4 sc = *((const f32x4*)(mod + b * NMOD + sc_off) + lane + 64 * j);
            f32x4 r;
            r.x = v[j].x * rstd * (1.f + sc.x) + sh.x; r.y = v[j].y * rstd * (1.f + sc.y) + sh.y;
            r.z = v[j].z * rstd * (1.f + sc.z) + sh.z; r.w = v[j].w * rstd * (1.f + sc.w) + sh.w;
            if (BF) ((unsigned long long*)((unsigned short*)dstv + (size_t)t * D))[lane + 64 * j] = (unsigned long long)pk2(r.x, r.y) | ((unsigned long long)pk2(r.z, r.w) << 32);
            else ((f32x4*)((float*)dstv + (size_t)t * D))[lane + 64 * j] = r;
        }
    }
}

constexpr int TP = 128, TQ = 256, TBK = 64;
constexpr int XS_BYTES = TP * 128, YS_BYTES = TQ * 128, STG_BYTES = XS_BYTES + YS_BYTES;
__device__ __forceinline__ int swz(int r, int c) { return r * 128 + ((c ^ ((r >> 1) & 7)) << 4); }
constexpr int SSQ_OFF = 2 * (TP * 128 + TQ * 128);
__device__ __forceinline__ float ssq8(u32x4 w) {
    const float a0 = bflo(w.x), a1 = bfhi(w.x), a2 = bflo(w.y), a3 = bfhi(w.y), a4 = bflo(w.z), a5 = bfhi(w.z), a6 = bflo(w.w), a7 = bfhi(w.w);
    return (a0 * a0 + a1 * a1) + (a2 * a2 + a3 * a3) + (a4 * a4 + a5 * a5) + (a6 * a6 + a7 * a7);
}
template <int WPN, bool YSSQ, class Epi>
__device__ void gemm_xyT(const unsigned short* X, int ldx, const unsigned short* Y, int ldy, int P, int Q, int K, int nb, size_t xbs, size_t ybs, unsigned char* lds, const Epi& epi) {
    constexpr int WQN = 8 / WPN, FI = TP / (WPN * 16), FJ = TQ / (WQN * 16);
    const int tid = threadIdx.x, lane = tid & 63, wave = tid >> 6;
    const int wp = wave / WQN, wq = wave % WQN, fr = lane & 15, fq = lane >> 4;
    const int nPt = P / TP, nQt = Q / TQ, npb = nPt * nb, nunits = npb * nQt;
    const int G = gridDim.x, bx = blockIdx.x;
    const int vcu = (G % 8 == 0) ? (bx % 8) * (G / 8) + bx / 8 : bx;
    const int srow = tid >> 3, sc = tid & 7;
    const int nk = K / TBK;
    for (int u = vcu; u < nunits; u += G) {
        const int qt = u / npb, rem = u % npb, bi = rem / nPt, pt = rem % nPt, p0 = pt * TP, q0 = qt * TQ;
        f32x4 acc[FI][FJ];
#pragma unroll
        for (int i = 0; i < FI; ++i)
#pragma unroll
            for (int j = 0; j < FJ; ++j) acc[i][j] = (f32x4){0.f, 0.f, 0.f, 0.f};
        const unsigned short* xg = X + (size_t)bi * xbs + (size_t)(p0 + srow) * ldx + sc * 8;
        const unsigned short* yg = Y + (size_t)bi * ybs + (size_t)(q0 + srow) * ldy + sc * 8;
        u32x4 rx[2], ry[4];
        float sq[4] = {0.f, 0.f, 0.f, 0.f};
#pragma unroll
        for (int i = 0; i < 2; ++i) rx[i] = *(const u32x4*)(xg + (size_t)(64 * i) * ldx);
#pragma unroll
        for (int i = 0; i < 4; ++i) ry[i] = *(const u32x4*)(yg + (size_t)(64 * i) * ldy);
        if (YSSQ) {
#pragma unroll
            for (int i = 0; i < 4; ++i) sq[i] += ssq8(ry[i]);
        }
        __syncthreads();
#pragma unroll
        for (int i = 0; i < 2; ++i) *(u32x4*)(lds + swz(srow + 64 * i, sc)) = rx[i];
#pragma unroll
        for (int i = 0; i < 4; ++i) *(u32x4*)(lds + XS_BYTES + swz(srow + 64 * i, sc)) = ry[i];
        __syncthreads();
        for (int kt = 0; kt < nk; ++kt) {
            unsigned char* st = lds + (kt & 1) * STG_BYTES;
            unsigned char* sn = lds + ((kt & 1) ^ 1) * STG_BYTES;
            const bool more = (kt + 1 < nk);
            if (more) {
                const int k1 = (kt + 1) * TBK;
#pragma unroll
                for (int i = 0; i < 2; ++i) rx[i] = *(const u32x4*)(xg + (size_t)(64 * i) * ldx + k1);
#pragma unroll
                for (int i = 0; i < 4; ++i) ry[i] = *(const u32x4*)(yg + (size_t)(64 * i) * ldy + k1);
            }
            if (YSSQ && more) {
#pragma unroll
                for (int i = 0; i < 4; ++i) sq[i] += ssq8(ry[i]);
            }
#pragma unroll
            for (int kk = 0; kk < 2; ++kk) {
                bf16x8 af[FI], bfr[FJ];
#pragma unroll
                for (int i = 0; i < FI; ++i) af[i] = *(const bf16x8*)(st + swz(wp * (FI * 16) + i * 16 + fr, kk * 4 + fq));
#pragma unroll
                for (int j = 0; j < FJ; ++j) bfr[j] = *(const bf16x8*)(st + XS_BYTES + swz(wq * (FJ * 16) + j * 16 + fr, kk * 4 + fq));
#pragma unroll
                for (int i = 0; i < FI; ++i)
#pragma unroll
                    for (int j = 0; j < FJ; ++j) acc[i][j] = __builtin_amdgcn_mfma_f32_16x16x32_bf16(af[i], bfr[j], acc[i][j], 0, 0, 0);
            }
            if (more) {
#pragma unroll
                for (int i = 0; i < 2; ++i) *(u32x4*)(sn + swz(srow + 64 * i, sc)) = rx[i];
#pragma unroll
                for (int i = 0; i < 4; ++i) *(u32x4*)(sn + XS_BYTES + swz(srow + 64 * i, sc)) = ry[i];
            }
            __syncthreads();
        }
        if (YSSQ) {
            float* ssq = (float*)(lds + SSQ_OFF);
#pragma unroll
            for (int i = 0; i < 4; ++i) {
                float v = sq[i];
                v += __shfl_xor(v, 1); v += __shfl_xor(v, 2); v += __shfl_xor(v, 4);
                if (sc == 0) ssq[srow + 64 * i] = v;
            }
            __syncthreads();
        }
        epi(acc, p0 + wp * (FI * 16), q0 + wq * (FJ * 16), lane, (const float*)(lds + SSQ_OFF) + wq * (FJ * 16), bi);
        if (YSSQ) __syncthreads();
    }
}
constexpr int DMA_STAGES = 3;
#define RAW_BARRIER() do { asm volatile("s_waitcnt lgkmcnt(0)" ::: "memory"); __builtin_amdgcn_s_barrier(); } while (0)
template <int WPN, int SUB, class Epi>
__device__ void gemm_dma(const unsigned short* X, int ldx, const unsigned short* Y, int ldy, int P, int Q, int K, int nb, size_t xbs, size_t ybs, unsigned char* lds, Epi epi) {
    constexpr int WQN = 8 / WPN, FI = TP / (WPN * 16), FJ = TQ / (WQN * 16);
    const int tid = threadIdx.x, lane = tid & 63, wave = __builtin_amdgcn_readfirstlane(tid >> 6);
    const int wp = wave / WQN, wq = wave % WQN, fr = lane & 15, fq = lane >> 4;
    const int nPt = P / TP, nQt = Q / TQ, npb = nPt * nb / SUB, nunits = npb * nQt;
    const int G = gridDim.x, bx = blockIdx.x;
    const int vcu = (G % 8 == 0) ? (bx % 8) * (G / 8) + bx / 8 : bx;
    const int srow = wave * 8 + (lane >> 3), pc = lane & 7;
    const int nk = K / TBK;
    const int lc = pc ^ ((srow >> 1) & 7);
    for (int u = vcu; u < nunits; u += G)
#pragma unroll
    for (int sub = 0; sub < SUB; ++sub) {
        const int qt = u / npb, rem = (u % npb) * SUB + sub, bi = rem / nPt, pt = rem % nPt, p0 = pt * TP, q0 = qt * TQ;
        f32x4 acc[FI][FJ];
#pragma unroll
        for (int i = 0; i < FI; ++i)
#pragma unroll
            for (int j = 0; j < FJ; ++j) acc[i][j] = (f32x4){0.f, 0.f, 0.f, 0.f};
        const unsigned short* xg = X + (size_t)bi * xbs + (size_t)(p0 + srow) * ldx + lc * 8;
        const unsigned short* yg = Y + (size_t)bi * ybs + (size_t)(q0 + srow) * ldy + lc * 8;
        epi.pre(q0 + wq * (FJ * 16), lane);
        asm volatile("s_waitcnt vmcnt(0)" ::: "memory");
        RAW_BARRIER();
#define GEMM_DMA_TILE(kt_, stg_) do { \
            unsigned char* _b = lds + (stg_) * STG_BYTES + wave * 1024; const int _k = (kt_) * TBK; \
            _Pragma("unroll") for (int _i = 0; _i < 2; ++_i) __builtin_amdgcn_global_load_lds((const unsigned*)(xg + (size_t)(64 * _i) * ldx + _k), (unsigned*)(_b + _i * 8192), 16, 0, 0); \
            _Pragma("unroll") for (int _i = 0; _i < 4; ++_i) __builtin_amdgcn_global_load_lds((const unsigned*)(yg + (size_t)(64 * _i) * ldy + _k), (unsigned*)(_b + XS_BYTES + _i * 8192), 16, 0, 0); \
        } while (0)
        GEMM_DMA_TILE(0, 0);
        GEMM_DMA_TILE(1, 1);
        int cur = 0;
        for (int kt = 0; kt < nk; ++kt) {
            if (kt + 1 < nk) asm volatile("s_waitcnt vmcnt(6)" ::: "memory"); else asm volatile("s_waitcnt vmcnt(0)" ::: "memory");
            RAW_BARRIER();
            if (kt + 2 < nk) { const int nxt = (cur == 0) ? 2 : cur - 1; GEMM_DMA_TILE(kt + 2, nxt); }
            const unsigned char* st = lds + cur * STG_BYTES;
#pragma unroll
            for (int kk = 0; kk < 2; ++kk) {
                bf16x8 af[FI], bfr[FJ];
#pragma unroll
                for (int i = 0; i < FI; ++i) af[i] = *(const bf16x8*)(st + swz(wp * (FI * 16) + i * 16 + fr, kk * 4 + fq));
#pragma unroll
                for (int j = 0; j < FJ; ++j) bfr[j] = *(const bf16x8*)(st + XS_BYTES + swz(wq * (FJ * 16) + j * 16 + fr, kk * 4 + fq));
#pragma unroll
                for (int i = 0; i < FI; ++i)
#pragma unroll
                    for (int j = 0; j < FJ; ++j) acc[i][j] = __builtin_amdgcn_mfma_f32_16x16x32_bf16(af[i], bfr[j], acc[i][j], 0, 0, 0);
            }
            cur = (cur == 2) ? 0 : cur + 1;
            if (Epi::HAS_MID && kt + 1 == (nk >> 1)) epi.mid(acc);
        }
#undef GEMM_DMA_TILE
        epi(acc, p0 + wp * (FI * 16), q0 + wq * (FJ * 16), lane, (const float*)nullptr, bi, sub);
    }
}
__device__ __forceinline__ unsigned long long pk4(float a, float b, float c, float d) { return (unsigned long long)pk2(a, b) | ((unsigned long long)pk2(c, d) << 32); }
struct EpiOutProj {
    static constexpr bool HAS_MID = true;
    const float* x; const float* mod; float* out; unsigned short* y1; const float* ssqo; float* ssq1;
    float ratio[4], rb[4];
    __device__ __forceinline__ void pre(int qb, int lane) {
#pragma unroll
        for (int j = 0; j < 4; ++j) {
            const f32x4* s4 = (const f32x4*)(ssqo + (size_t)(qb + j * 16 + (lane & 15)) * 16);
            const f32x4 a0 = s4[0], a1 = s4[1], b0 = s4[2], b1 = s4[3];
            const float sa = (a0.x + a0.y + a0.z + a0.w) + (a1.x + a1.y + a1.z + a1.w), sb = (b0.x + b0.y + b0.z + b0.w) + (b1.x + b1.y + b1.z + b1.w);
            const float ra = rsqrtf(sa * (1.f / 512.f) + EPS); rb[j] = rsqrtf(sb * (1.f / 512.f) + EPS); ratio[j] = ra / rb[j];
        }
    }
    __device__ __forceinline__ void mid(f32x4 (&acc)[4][4]) {
#pragma unroll
        for (int i = 0; i < 4; ++i)
#pragma unroll
            for (int j = 0; j < 4; ++j) { acc[i][j].x *= ratio[j]; acc[i][j].y *= ratio[j]; acc[i][j].z *= ratio[j]; acc[i][j].w *= ratio[j]; }
    }
    __device__ __forceinline__ void operator()(const f32x4 (&acc)[4][4], int pb, int qb, int lane, const float*, int, int = 0) {
        const int fr = lane & 15, fq = lane >> 4;
        const float* __restrict__ xr = x; float* __restrict__ outr = out; unsigned short* __restrict__ yr = y1; float* __restrict__ sr = ssq1;
        const float* mt = mod + (qb >> 12) * NMOD + pb + fq * 4;
        f32x4 gv[4], scv[4], xv[4][4];
#pragma unroll
        for (int j = 0; j < 4; ++j)
#pragma unroll
            for (int i = 0; i < 4; ++i) xv[j][i] = *(const f32x4*)(xr + (size_t)(qb + j * 16 + fr) * D + pb + i * 16 + fq * 4);
#pragma unroll
        for (int i = 0; i < 4; ++i) { gv[i] = *(const f32x4*)(mt + 2 * D + i * 16); scv[i] = *(const f32x4*)(mt + 4 * D + i * 16); }
#pragma unroll
        for (int j = 0; j < 4; ++j) {
            const int t = qb + j * 16 + fr;
            float ss = 0.f;
#pragma unroll
            for (int i = 0; i < 4; ++i) {
                const int n = pb + i * 16 + fq * 4;
                const f32x4 xx = xv[j][i];
                f32x4 r; r.x = xx.x + gv[i].x * (acc[i][j].x * rb[j]); r.y = xx.y + gv[i].y * (acc[i][j].y * rb[j]); r.z = xx.z + gv[i].z * (acc[i][j].z * rb[j]); r.w = xx.w + gv[i].w * (acc[i][j].w * rb[j]);
                *(f32x4*)(outr + (size_t)t * D + n) = r;
                ss += (r.x * r.x + r.y * r.y) + (r.z * r.z + r.w * r.w);
                *(unsigned long long*)(yr + (size_t)t * D + n) = pk4(r.x * (1.f + scv[i].x), r.y * (1.f + scv[i].y), r.z * (1.f + scv[i].z), r.w * (1.f + scv[i].w));
            }
            ss += __shfl_xor(ss, 16); ss += __shfl_xor(ss, 32);
            if (fq == 0) sr[(size_t)t * 16 + (pb >> 6)] = ss;
        }
    }
};
struct EpiPQ {
    static constexpr bool HAS_MID = false;
    unsigned short* C; const float* ssq1; const float* bias;
    float r1[4];
    __device__ __forceinline__ void pre(int qb, int lane) {
#pragma unroll
        for (int j = 0; j < 4; ++j) {
            const f32x4* s4 = (const f32x4*)(ssq1 + (size_t)(qb + j * 16 + (lane & 15)) * 16);
            const f32x4 a0 = s4[0], a1 = s4[1], a2 = s4[2], a3 = s4[3];
            const float sa = ((a0.x + a0.y + a0.z + a0.w) + (a1.x + a1.y + a1.z + a1.w)) + ((a2.x + a2.y + a2.z + a2.w) + (a3.x + a3.y + a3.z + a3.w));
            r1[j] = rsqrtf(sa * (1.f / D) + EPS);
        }
    }
    template <class A> __device__ __forceinline__ void mid(A&) {}
    __device__ __forceinline__ void operator()(const f32x4 (&acc)[4][4], int pb, int qb, int lane, const float*, int, int = 0) {
        const int fr = lane & 15, fq = lane >> 4;
        unsigned short* __restrict__ Cr = C;
        const float* bt = bias + (qb >> 12) * 2048 + pb + fq * 4;
        f32x4 bv[4];
#pragma unroll
        for (int i = 0; i < 4; ++i) bv[i] = *(const f32x4*)(bt + i * 16);
#pragma unroll
        for (int j = 0; j < 4; ++j) {
            const int t = qb + j * 16 + fr;
#pragma unroll
            for (int i = 0; i < 4; ++i) {
                const int n = pb + i * 16 + fq * 4;
                *(unsigned long long*)(Cr + (size_t)t * 2048 + n) = pk4(acc[i][j].x * r1[j] + bv[i].x, acc[i][j].y * r1[j] + bv[i].y, acc[i][j].z * r1[j] + bv[i].z, acc[i][j].w * r1[j] + bv[i].w);
            }
        }
    }
};

struct EpiProj {
    static constexpr bool HAS_MID = false;
    __device__ __forceinline__ void pre(int, int) {}
    template <class A> __device__ __forceinline__ void mid(A&) {}
    unsigned char* ws;
    __device__ __forceinline__ void operator()(const f32x4 (&acc)[4][4], int pb, int qb, int lane, const float*, int, int = 0) const {
        const int fr = lane & 15, fq = lane >> 4;
        if (pb >= 1216) return;
        const int t0 = qb + fr, b = t0 >> 12, pos0 = t0 & (S - 1);
        if (pb < C_VA) {
            const float* __restrict__ cosA = (const float*)(ws + WS_COSA); const float* __restrict__ sinA = (const float*)(ws + WS_SINA);
            const bool isq = pb < C_KA;
            const int head = isq ? (pb >> 6) : ((pb - C_KA) >> 6);
            unsigned short* __restrict__ dst0 = isq ? (unsigned short*)(ws + WS_QA) + ((size_t)(b * 8 + head) * S + pos0) * 64 : (unsigned short*)(ws + WS_KA) + ((size_t)(b * 2 + head) * S + pos0) * 64;
            const float sc = isq ? QA_SCALE : 1.f;
#pragma unroll
            for (int jh = 0; jh < 4; jh += 2) {
                f32x4 c[2][2], sn[2][2];
#pragma unroll
                for (int jj = 0; jj < 2; ++jj)
#pragma unroll
                    for (int i = 0; i < 2; ++i) { c[jj][i] = *(const f32x4*)(cosA + (pos0 + 16 * (jh + jj)) * 32 + i * 16 + fq * 4); sn[jj][i] = *(const f32x4*)(sinA + (pos0 + 16 * (jh + jj)) * 32 + i * 16 + fq * 4); }
#pragma unroll
                for (int jj = 0; jj < 2; ++jj)
#pragma unroll
                    for (int i = 0; i < 2; ++i) {
                        const int j = jh + jj, d = i * 16 + fq * 4;
                        const f32x4 x1 = acc[i][j], x2 = acc[i + 2][j], cc = c[jj][i], ss = sn[jj][i];
                        unsigned short* dst = dst0 + (size_t)(16 * j) * 64;
                        *(unsigned long long*)(dst + d) = pk4((x1.x * cc.x - x2.x * ss.x) * sc, (x1.y * cc.y - x2.y * ss.y) * sc, (x1.z * cc.z - x2.z * ss.z) * sc, (x1.w * cc.w - x2.w * ss.w) * sc);
                        *(unsigned long long*)(dst + 32 + d) = pk4((x2.x * cc.x + x1.x * ss.x) * sc, (x2.y * cc.y + x1.y * ss.y) * sc, (x2.z * cc.z + x1.z * ss.z) * sc, (x2.w * cc.w + x1.w * ss.w) * sc);
                    }
            }
        } else if (pb < C_QL) {
            const int kvh = (pb - C_VA) >> 6;
            unsigned short* __restrict__ dst0 = (unsigned short*)(ws + WS_VAT) + (size_t)(b * 2 + kvh) * 64 * S + pos0;
#pragma unroll
            for (int j = 0; j < 4; ++j)
#pragma unroll
                for (int i = 0; i < 4; ++i) {
                    const int dv = i * 16 + fq * 4; unsigned short* dst = dst0 + 16 * j;
                    dst[(size_t)(dv + 0) * S] = (unsigned short)f2bf(acc[i][j].x); dst[(size_t)(dv + 1) * S] = (unsigned short)f2bf(acc[i][j].y);
                    dst[(size_t)(dv + 2) * S] = (unsigned short)f2bf(acc[i][j].z); dst[(size_t)(dv + 3) * S] = (unsigned short)f2bf(acc[i][j].w);
                }
        } else if (pb < C_KR) {
            const bool isq = pb < C_KVL;
            unsigned short* __restrict__ dst0 = isq ? (unsigned short*)(ws + WS_QL) + (size_t)t0 * 256 + (pb - C_QL) : (unsigned short*)(ws + WS_KVL) + (size_t)t0 * 128 + (pb - C_KVL);
            const int ld = isq ? 256 : 128;
#pragma unroll
            for (int j = 0; j < 4; ++j)
#pragma unroll
                for (int i = 0; i < 4; ++i) *(unsigned long long*)(dst0 + (size_t)(16 * j) * ld + i * 16 + fq * 4) = pk4(acc[i][j].x, acc[i][j].y, acc[i][j].z, acc[i][j].w);
        } else {
            const float* __restrict__ cosB = (const float*)(ws + WS_COSB); const float* __restrict__ sinB = (const float*)(ws + WS_SINB);
            unsigned short* __restrict__ K96 = (unsigned short*)(ws + WS_K96);
            const int d = fq * 4;
            f32x4 c[4], sn[4];
#pragma unroll
            for (int j = 0; j < 4; ++j) { c[j] = *(const f32x4*)(cosB + (pos0 + 16 * j) * 16 + d); sn[j] = *(const f32x4*)(sinB + (pos0 + 16 * j) * 16 + d); }
#pragma unroll
            for (int j = 0; j < 4; ++j) {
                const f32x4 x1 = acc[0][j], x2 = acc[1][j], cc = c[j], ss = sn[j];
                const unsigned long long lo = pk4(x1.x * cc.x - x2.x * ss.x, x1.y * cc.y - x2.y * ss.y, x1.z * cc.z - x2.z * ss.z, x1.w * cc.w - x2.w * ss.w);
                const unsigned long long hi = pk4(x2.x * cc.x + x1.x * ss.x, x2.y * cc.y + x1.y * ss.y, x2.z * cc.z + x1.z * ss.z, x2.w * cc.w + x1.w * ss.w);
#pragma unroll
                for (int h = 0; h < 8; ++h) {
                    unsigned short* dst = K96 + ((size_t)(b * 8 + h) * S + pos0 + 16 * j) * 96 + 64 + d;
                    *(unsigned long long*)dst = lo; *(unsigned long long*)(dst + 16) = hi;
                }
            }
        }
    }
};
struct EpiQup {
    unsigned char* ws;
    __device__ __forceinline__ void operator()(const f32x4 (&acc)[4][4], int pb, int qb, int lane, const float* ssq, int, int = 0) const {
        const int fr = lane & 15, fq = lane >> 4;
        unsigned short* __restrict__ QMB = (unsigned short*)(ws + WS_QMB);
        const float* __restrict__ cosB = (const float*)(ws + WS_COSB); const float* __restrict__ sinB = (const float*)(ws + WS_SINB);
        const int t0 = qb + fr, b = t0 >> 12, pos0 = t0 & (S - 1);
        float sc[4];
#pragma unroll
        for (int j = 0; j < 4; ++j) sc[j] = rsqrtf(ssq[j * 16 + fr] * (1.f / 256.f) + EPS) * QM_SCALE;
        if (pb < 512) {
            unsigned short* dst0 = QMB + ((size_t)(b * 8 + (pb >> 6)) * S + pos0) * 96;
#pragma unroll
            for (int j = 0; j < 4; ++j)
#pragma unroll
                for (int i = 0; i < 4; ++i) *(unsigned long long*)(dst0 + (size_t)(16 * j) * 96 + i * 16 + fq * 4) = pk4(acc[i][j].x * sc[j], acc[i][j].y * sc[j], acc[i][j].z * sc[j], acc[i][j].w * sc[j]);
        } else {
            const int d = fq * 4;
            f32x4 c[4], sn[4];
#pragma unroll
            for (int j = 0; j < 4; ++j) { c[j] = *(const f32x4*)(cosB + (pos0 + 16 * j) * 16 + d); sn[j] = *(const f32x4*)(sinB + (pos0 + 16 * j) * 16 + d); }
#pragma unroll
            for (int j = 0; j < 4; ++j)
#pragma unroll
                for (int hh = 0; hh < 2; ++hh) {
                    const int h = ((pb - 512) >> 5) + hh;
                    unsigned short* dst = QMB + ((size_t)(b * 8 + h) * S + pos0 + 16 * j) * 96 + 64 + d;
                    const f32x4 x1 = acc[2 * hh][j], x2 = acc[2 * hh + 1][j], cc = c[j], ss = sn[j]; const float s_ = sc[j];
                    *(unsigned long long*)dst = pk4((x1.x * cc.x - x2.x * ss.x) * s_, (x1.y * cc.y - x2.y * ss.y) * s_, (x1.z * cc.z - x2.z * ss.z) * s_, (x1.w * cc.w - x2.w * ss.w) * s_);
                    *(unsigned long long*)(dst + 16) = pk4((x2.x * cc.x + x1.x * ss.x) * s_, (x2.y * cc.y + x1.y * ss.y) * s_, (x2.z * cc.z + x1.z * ss.z) * s_, (x2.w * cc.w + x1.w * ss.w) * s_);
                }
        }
    }
};
struct EpiKVup {
    unsigned char* ws;
    __device__ __forceinline__ void operator()(const f32x4 (&acc)[4][4], int pb, int qb, int lane, const float* ssq, int, int = 0) const {
        const int fr = lane & 15, fq = lane >> 4;
        unsigned short* K96 = (unsigned short*)(ws + WS_K96); unsigned short* VT = (unsigned short*)(ws + WS_VT);
        const int h = pb >> 7;
#pragma unroll
        for (int j = 0; j < 4; ++j) {
            const int t = qb + j * 16 + fr, b = t >> 12, pos = t & (S - 1);
            const float sc = rsqrtf(ssq[j * 16 + fr] * (1.f / 128.f) + EPS);
            if ((pb & 64) == 0) {
                unsigned short* dst = K96 + ((size_t)(b * 8 + h) * S + pos) * 96;
#pragma unroll
                for (int i = 0; i < 4; ++i) *(unsigned long long*)(dst + i * 16 + fq * 4) = pk4(acc[i][j].x * sc, acc[i][j].y * sc, acc[i][j].z * sc, acc[i][j].w * sc);
            } else {
                unsigned short* dst = VT + (size_t)(b * 8 + h) * 64 * S + pos;
#pragma unroll
                for (int i = 0; i < 4; ++i) {
                    const int dv = i * 16 + fq * 4;
                    dst[(size_t)(dv + 0) * S] = (unsigned short)f2bf(acc[i][j].x * sc); dst[(size_t)(dv + 1) * S] = (unsigned short)f2bf(acc[i][j].y * sc);
                    dst[(size_t)(dv + 2) * S] = (unsigned short)f2bf(acc[i][j].z * sc); dst[(size_t)(dv + 3) * S] = (unsigned short)f2bf(acc[i][j].w * sc);
                }
            }
        }
    }
};

typedef float f32x16 __attribute__((ext_vector_type(16)));
typedef __bf16 bf16x2_t __attribute__((ext_vector_type(2)));
__device__ __forceinline__ unsigned cvtpk(float lo, float hi) { f32x2 v = {lo, hi}; bf16x2_t b = __builtin_convertvector(v, bf16x2_t); return __builtin_bit_cast(unsigned, b); }
__device__ __forceinline__ int crow(int r, int hi) { return (r & 3) + 8 * (r >> 2) + 4 * hi; }
__device__ __forceinline__ int kperm(int rho) { return (rho & 0x13) | ((rho & 4) << 1) | ((rho & 8) >> 1); }

template <int DQK, bool SWA>
__device__ void stage_attn_flash(const Params& p, unsigned char* lds) {
    constexpr int NK = DQK / 16, KCH = DQK / 8, KSTR = (KCH + 1) * 16, VSTR = 144;
    constexpr int KT_BYTES = 64 * KSTR, VT_BYTES = 64 * VSTR, STG = KT_BYTES + VT_BYTES, NKC = 64 * KCH;
    const unsigned short* Qg = (const unsigned short*)(p.ws + (SWA ? WS_QA : WS_QMB));
    const unsigned short* Kg = (const unsigned short*)(p.ws + (SWA ? WS_KA : WS_K96));
    const unsigned short* Vg = (const unsigned short*)(p.ws + (SWA ? WS_VAT : WS_VT));
    unsigned short* O = (unsigned short*)(p.ws + WS_OAB);
    const int tid = threadIdx.x, lane = tid & 63, wave = tid >> 6, r32 = lane & 31, hi = lane >> 5;
    const int G = gridDim.x, bx = blockIdx.x;
    const int vcu = (G % 8 == 0) ? (bx % 8) * (G / 8) + bx / 8 : bx;
    const int nunits = SWA ? Bsz * 2 * 64 : Bsz * 8 * 16;
    const int kro = kperm(r32) * KSTR + hi * 16;
    const int vro = r32 * VSTR + hi * 16;
    const int kid0 = tid, kid1 = tid + 512;
    const int k0row = kid0 / KCH, k0c = kid0 % KCH, k1row = kid1 / KCH, k1c = kid1 % KCH;
    const int vrow = tid >> 3, vc = tid & 7;
    for (int u = vcu; u < nunits; u += G) {
        int b, qb, tlo, thi, sq, ocol; const unsigned short *Qp, *Kb, *Vb; float m, l;
        if (SWA) {
            qb = u & 63; const int kvh = (u >> 6) & 1; b = u >> 7;
            const int head = kvh * 4 + (wave >> 1);
            sq = qb * 64 + (wave & 1) * 32 + r32;
            Qp = Qg + ((size_t)(b * 8 + head) * S + sq) * 64;
            Kb = Kg + (size_t)(b * 2 + kvh) * S * 64; Vb = Vg + (size_t)(b * 2 + kvh) * 64 * S;
            tlo = qb - 2 < 0 ? 0 : qb - 2; thi = qb + 2 > 63 ? 63 : qb + 2;
            m = p.sink[head] * LOG2E; l = 0.5f; ocol = head * 64;
        } else {
            qb = u & 15; const int h = (u >> 4) & 7; b = u >> 7;
            sq = qb * 256 + wave * 32 + r32;
            Qp = Qg + ((size_t)(b * 8 + h) * S + sq) * 96;
            Kb = Kg + (size_t)(b * 8 + h) * S * 96; Vb = Vg + (size_t)(b * 8 + h) * 64 * S;
            tlo = 0; thi = 63; m = -1e30f; l = 0.f; ocol = 512 + h * 64;
        }
        bf16x8 qf[NK];
#pragma unroll
        for (int ks = 0; ks < NK; ++ks) qf[ks] = *(const bf16x8*)(Qp + ks * 16 + hi * 8);
        f32x16 o0, o1;
#pragma unroll
        for (int r = 0; r < 16; ++r) { o0[r] = 0.f; o1[r] = 0.f; }
        u32x4 rk0, rk1, rv;
        {
            const unsigned short* kt = Kb + (size_t)tlo * 64 * DQK;
            rk0 = *(const u32x4*)(kt + kid0 * 8);
            if (kid1 < NKC) rk1 = *(const u32x4*)(kt + kid1 * 8);
            rv = *(const u32x4*)(Vb + (size_t)vrow * S + tlo * 64 + vc * 8);
            *(u32x4*)(lds + k0row * KSTR + k0c * 16) = rk0;
            if (kid1 < NKC) *(u32x4*)(lds + k1row * KSTR + k1c * 16) = rk1;
            *(u32x4*)(lds + KT_BYTES + vrow * VSTR + vc * 16) = rv;
        }
        __syncthreads();
        for (int tt = tlo; tt <= thi; ++tt) {
            const unsigned char* Kl = lds + ((tt - tlo) & 1) * STG;
            const unsigned char* Vl = Kl + KT_BYTES;
            unsigned char* Kn = lds + (((tt - tlo) & 1) ^ 1) * STG;
            const bool more = tt < thi;
            if (more) {
                const unsigned short* kt = Kb + (size_t)(tt + 1) * 64 * DQK;
                rk0 = *(const u32x4*)(kt + kid0 * 8);
                if (kid1 < NKC) rk1 = *(const u32x4*)(kt + kid1 * 8);
                rv = *(const u32x4*)(Vb + (size_t)vrow * S + (tt + 1) * 64 + vc * 8);
            }
            f32x16 s0, s1;
#pragma unroll
            for (int r = 0; r < 16; ++r) { s0[r] = 0.f; s1[r] = 0.f; }
#pragma unroll
            for (int ks = 0; ks < NK; ++ks) {
                const bf16x8 kf0 = *(const bf16x8*)(Kl + kro + ks * 32);
                const bf16x8 kf1 = *(const bf16x8*)(Kl + 32 * KSTR + kro + ks * 32);
                s0 = __builtin_amdgcn_mfma_f32_32x32x16_bf16(kf0, qf[ks], s0, 0, 0, 0);
                s1 = __builtin_amdgcn_mfma_f32_32x32x16_bf16(kf1, qf[ks], s1, 0, 0, 0);
            }
            if (SWA) {
                const int rel = tt - qb;
                if (rel == -2 || rel == 2) {
                    const int qi = (wave & 1) * 32 + r32;
#pragma unroll
                    for (int r = 0; r < 16; ++r) {
                        const int kk = kperm(crow(r, hi));
                        const bool v0 = (rel == -2) ? (kk >= qi) : (kk <= qi);
                        const bool v1 = (rel == -2) ? (kk + 32 >= qi) : (kk + 32 <= qi);
                        s0[r] = v0 ? s0[r] : -1e30f; s1[r] = v1 ? s1[r] : -1e30f;
                    }
                }
            }
            float mx = fmaxf(s0[0], s1[0]);
#pragma unroll
            for (int r = 1; r < 16; ++r) mx = fmaxf(mx, fmaxf(s0[r], s1[r]));
            mx = fmaxf(mx, __shfl_xor(mx, 32));
            const float mn = fmaxf(m, mx);
            const float alpha = __builtin_amdgcn_exp2f(m - mn);
            m = mn;
            float rs = 0.f;
#pragma unroll
            for (int r = 0; r < 16; ++r) { s0[r] = __builtin_amdgcn_exp2f(s0[r] - mn); s1[r] = __builtin_amdgcn_exp2f(s1[r] - mn); rs += s0[r] + s1[r]; }
            l = l * alpha + rs;
#pragma unroll
            for (int r = 0; r < 16; ++r) { o0[r] *= alpha; o1[r] *= alpha; }
#pragma unroll
            for (int st = 0; st < 2; ++st) {
                u32x4 pw;
                pw.x = cvtpk(s0[8 * st + 0], s0[8 * st + 1]); pw.y = cvtpk(s0[8 * st + 2], s0[8 * st + 3]);
                pw.z = cvtpk(s0[8 * st + 4], s0[8 * st + 5]); pw.w = cvtpk(s0[8 * st + 6], s0[8 * st + 7]);
                const bf16x8 pf = __builtin_bit_cast(bf16x8, pw);
                const bf16x8 vf0 = *(const bf16x8*)(Vl + vro + st * 32);
                const bf16x8 vf1 = *(const bf16x8*)(Vl + 32 * VSTR + vro + st * 32);
                o0 = __builtin_amdgcn_mfma_f32_32x32x16_bf16(vf0, pf, o0, 0, 0, 0);
                o1 = __builtin_amdgcn_mfma_f32_32x32x16_bf16(vf1, pf, o1, 0, 0, 0);
            }
#pragma unroll
            for (int st = 0; st < 2; ++st) {
                u32x4 pw;
                pw.x = cvtpk(s1[8 * st + 0], s1[8 * st + 1]); pw.y = cvtpk(s1[8 * st + 2], s1[8 * st + 3]);
                pw.z = cvtpk(s1[8 * st + 4], s1[8 * st + 5]); pw.w = cvtpk(s1[8 * st + 6], s1[8 * st + 7]);
                const bf16x8 pf = __builtin_bit_cast(bf16x8, pw);
                const bf16x8 vf0 = *(const bf16x8*)(Vl + vro + 64 + st * 32);
                const bf16x8 vf1 = *(const bf16x8*)(Vl + 32 * VSTR + vro + 64 + st * 32);
                o0 = __builtin_amdgcn_mfma_f32_32x32x16_bf16(vf0, pf, o0, 0, 0, 0);
                o1 = __builtin_amdgcn_mfma_f32_32x32x16_bf16(vf1, pf, o1, 0, 0, 0);
            }
            if (more) {
                *(u32x4*)(Kn + k0row * KSTR + k0c * 16) = rk0;
                if (kid1 < NKC) *(u32x4*)(Kn + k1row * KSTR + k1c * 16) = rk1;
                *(u32x4*)(Kn + KT_BYTES + vrow * VSTR + vc * 16) = rv;
            }
            __syncthreads();
        }
        const float il = 1.f / (l + __shfl_xor(l, 32));
        {
            float ss = 0.f;
#pragma unroll
            for (int r = 0; r < 16; ++r) { const float a0 = o0[r] * il, a1 = o1[r] * il; ss += a0 * a0 + a1 * a1; }
            ss += __shfl_xor(ss, 32);
            if (hi == 0) ((float*)(p.ws + WS_SSQO))[(size_t)(b * S + sq) * 16 + (ocol >> 6)] = ss;
        }
        unsigned short* orow = O + (size_t)(b * S + sq) * D + ocol + 4 * hi;
#pragma unroll
        for (int g = 0; g < 4; ++g) {
            *(unsigned long long*)(orow + 8 * g) = (unsigned long long)cvtpk(o0[4 * g] * il, o0[4 * g + 1] * il) | ((unsigned long long)cvtpk(o0[4 * g + 2] * il, o0[4 * g + 3] * il) << 32);
            *(unsigned long long*)(orow + 32 + 8 * g) = (unsigned long long)cvtpk(o1[4 * g] * il, o1[4 * g + 1] * il) | ((unsigned long long)cvtpk(o1[4 * g + 2] * il, o1[4 * g + 3] * il) << 32);
        }
    }
}

__device__ __forceinline__ void ce_desc(int& a, int& b) { const int hi = max(a, b), lo = min(a, b); a = hi; b = lo; }
__device__ __forceinline__ void ce_asc(int& a, int& b) { const int hi = max(a, b), lo = min(a, b); a = lo; b = hi; }
template <int N, int OFF> __device__ __forceinline__ void bitonic_sort_desc(int (&a)[32]) {
#pragma unroll
    for (int k = 2; k <= N; k <<= 1)
#pragma unroll
        for (int j = k >> 1; j > 0; j >>= 1)
#pragma unroll
            for (int i = 0; i < N; ++i) {
                const int l = i ^ j;
                if (l > i) { if ((i & k) == 0) ce_desc(a[OFF + i], a[OFF + l]); else ce_asc(a[OFF + i], a[OFF + l]); }
            }
}
__device__ __forceinline__ void bitonic_clean16_desc(int (&a)[32]) {
#pragma unroll
    for (int j = 8; j > 0; j >>= 1)
#pragma unroll
        for (int i = 0; i < 16; ++i) { const int l = i ^ j; if (l > i) ce_desc(a[i], a[l]); }
}
__device__ __forceinline__ int f2sortable(float f) { const int b = __builtin_bit_cast(int, f); return b ^ ((b >> 31) & 0x7fffffff); }
__device__ __forceinline__ float sortable2f(int s) { return __builtin_bit_cast(float, s ^ ((s >> 31) & 0x7fffffff)); }
struct CandTab { int i[52], j[52]; };
constexpr CandTab make_cands() { CandTab t{}; int n = 0; for (int i = 0; i < 16; ++i) for (int j = 0; j < 16; ++j) if ((i + 1) * (j + 1) <= 16) { t.i[n] = i; t.j[n] = j; ++n; } for (; n < 52; ++n) { t.i[n] = -1; t.j[n] = -1; } return t; }
constexpr CandTab CANDS = make_cands();
struct EpiTopkSel {
    static constexpr bool HAS_MID = false;
    __device__ __forceinline__ void pre(int, int) {}
    template <class A> __device__ __forceinline__ void mid(A&) {}
    unsigned short* idx; float* g;
    int* keepg;
    __device__ __forceinline__ void operator()(const f32x4 (&acc)[8][2], int pb, int qb, int lane, const float*, int hp, int half) {
        const int fr = lane & 15, fq = lane >> 4;
#pragma unroll
        for (int j = 0; j < 2; ++j) {
            int v[32];
#pragma unroll
            for (int i = 0; i < 8; ++i)
#pragma unroll
                for (int r = 0; r < 4; ++r) v[i * 4 + r] = (f2sortable(acc[i][j][r]) & ~127) | (i * 16 + fq * 4 + r);
            bitonic_sort_desc<16, 0>(v); bitonic_sort_desc<16, 16>(v);
#pragma unroll
            for (int i = 0; i < 16; ++i) v[i] = max(v[i], v[31 - i]);
            bitonic_clean16_desc(v);
#pragma unroll
            for (int x = 16; x <= 32; x <<= 1) {
#pragma unroll
                for (int i = 0; i < 16; ++i) v[16 + i] = __shfl_xor(v[i], x);
#pragma unroll
                for (int i = 0; i < 16; ++i) v[i] = max(v[i], v[31 - i]);
                bitonic_clean16_desc(v);
            }
            u32x4* kp = (u32x4*)(keepg + ((qb & 255) + j * 16 + fr) * 16);
            if (half == 0) {
                if (fq == 0) {
#pragma unroll
                    for (int i = 0; i < 4; ++i) kp[i] = (u32x4){(unsigned)v[4 * i], (unsigned)v[4 * i + 1], (unsigned)v[4 * i + 2], (unsigned)v[4 * i + 3]};
                }
            } else {
                float as[16], bs[16]; int ai[16], bi[16];
#pragma unroll
                for (int i = 0; i < 4; ++i) {
                    const u32x4 kv = kp[i];
#pragma unroll
                    for (int c = 0; c < 4; ++c) { as[4 * i + c] = sortable2f((int)kv[c] & ~127); ai[4 * i + c] = ((int)kv[c] & 127) << 7; }
                }
#pragma unroll
                for (int i = 0; i < 16; ++i) { bs[i] = sortable2f(v[i] & ~127); bi[i] = v[i] & 127; }
                int w[32];
#pragma unroll
                for (int sl = 0; sl < 13; ++sl) {
                    int c4[4];
#pragma unroll
                    for (int f = 0; f < 4; ++f) {
                        constexpr int dummy = 0; (void)dummy;
                        const int ci = CANDS.i[sl * 4 + f], cj = CANDS.j[sl * 4 + f];
                        c4[f] = (ci >= 0) ? ((f2sortable(as[ci >= 0 ? ci : 0] + bs[cj >= 0 ? cj : 0]) & ~0x3fff) | (ai[ci >= 0 ? ci : 0] | bi[cj >= 0 ? cj : 0])) : (int)0x80000000;
                    }
                    w[sl] = (fq == 0) ? c4[0] : (fq == 1) ? c4[1] : (fq == 2) ? c4[2] : c4[3];
                }
                w[13] = w[14] = w[15] = (int)0x80000000;
                bitonic_sort_desc<16, 0>(w);
#pragma unroll
                for (int x = 16; x <= 32; x <<= 1) {
#pragma unroll
                    for (int i = 0; i < 16; ++i) w[16 + i] = __shfl_xor(w[i], x);
#pragma unroll
                    for (int i = 0; i < 16; ++i) w[i] = max(w[i], w[31 - i]);
                    bitonic_clean16_desc(w);
                }
                int my[4];
#pragma unroll
                for (int c = 0; c < 4; ++c) my[c] = (fq == 0) ? w[c] : (fq == 1) ? w[4 + c] : (fq == 2) ? w[8 + c] : w[12 + c];
                const float top = sortable2f(w[0] & ~0x3fff);
                float e[4], part = 0.f;
#pragma unroll
                for (int c = 0; c < 4; ++c) { e[c] = __expf(sortable2f(my[c] & ~0x3fff) - top); part += e[c]; }
                part += __shfl_xor(part, 16); part += __shfl_xor(part, 32);
                const float inv = 1.f / part;
                const int t = qb + j * 16 + fr;
                const size_t o = (size_t)t * 128 + (hp >> 1) * 16 + fq * 4;
                *(unsigned long long*)(idx + o) = (unsigned long long)(unsigned)((my[0] & 0x3fff) | ((my[1] & 0x3fff) << 16)) | ((unsigned long long)(unsigned)((my[2] & 0x3fff) | ((my[3] & 0x3fff) << 16)) << 32);
                *(f32x4*)(g + o) = (f32x4){e[0] * inv, e[1] * inv, e[2] * inv, e[3] * inv};
            }
        }
    }
};
__device__ void gemm_pq_fused(const Params& p, unsigned char* lds) {
    const unsigned short* X = (const unsigned short*)(p.ws + WS_WPQ);
    const unsigned short* Y = (const unsigned short*)(p.ws + WS_HB);
    const unsigned short* SK = (const unsigned short*)(p.ws + WS_SUBK);
    const float* ssq1 = (const float*)(p.ws + WS_SSQ1); const float* bias = (const float*)(p.ws + WS_BPQ);
    EpiTopkSel tsel{(unsigned short*)(p.ws + WS_IDX), (float*)(p.ws + WS_G), (int*)(p.ws + WS_KEEP) + (size_t)blockIdx.x * 4096};
    const int tid = threadIdx.x, lane = tid & 63, wave = __builtin_amdgcn_readfirstlane(tid >> 6);
    const int wp = wave >> 2, wq = wave & 3, fr = lane & 15, fq = lane >> 4;
    const int G = gridDim.x, bx = blockIdx.x;
    const int vcu = (G % 8 == 0) ? (bx % 8) * (G / 8) + bx / 8 : bx;
    const int srow = wave * 8 + (lane >> 3), pc = lane & 7, lc = pc ^ ((srow >> 1) & 7);
    constexpr int nk = D / TBK, nunits = 8 * (T / TQ);
    for (int u = vcu; u < nunits; u += G) {
        const int qt = u >> 3, h = u & 7, q0 = qt * TQ;
#pragma unroll
        for (int sub = 0; sub < 2; ++sub) {
            const int hp = h * 2 + sub, p0 = hp * TP;
            f32x4 acc[4][4];
#pragma unroll
            for (int i = 0; i < 4; ++i)
#pragma unroll
                for (int j = 0; j < 4; ++j) acc[i][j] = (f32x4){0.f, 0.f, 0.f, 0.f};
            const unsigned short* xg = X + (size_t)(p0 + srow) * D + lc * 8;
            const unsigned short* yg = Y + (size_t)(q0 + srow) * D + lc * 8;
            asm volatile("s_waitcnt vmcnt(0)" ::: "memory");
            RAW_BARRIER();
#define PQ_DMA_TILE(kt_, stg_) do { \
                unsigned char* _b = lds + (stg_) * STG_BYTES + wave * 1024; const int _k = (kt_) * TBK; \
                _Pragma("unroll") for (int _i = 0; _i < 2; ++_i) __builtin_amdgcn_global_load_lds((const unsigned*)(xg + (size_t)(64 * _i) * D + _k), (unsigned*)(_b + _i * 8192), 16, 0, 0); \
                _Pragma("unroll") for (int _i = 0; _i < 4; ++_i) __builtin_amdgcn_global_load_lds((const unsigned*)(yg + (size_t)(64 * _i) * D + _k), (unsigned*)(_b + XS_BYTES + _i * 8192), 16, 0, 0); \
            } while (0)
            PQ_DMA_TILE(0, 0);
            PQ_DMA_TILE(1, 1);
            int cur = 0;
            for (int kt = 0; kt < nk; ++kt) {
                if (kt + 1 < nk) asm volatile("s_waitcnt vmcnt(6)" ::: "memory"); else asm volatile("s_waitcnt vmcnt(0)" ::: "memory");
                RAW_BARRIER();
                if (kt + 2 < nk) { const int nxt = (cur == 0) ? 2 : cur - 1; PQ_DMA_TILE(kt + 2, nxt); }
                const unsigned char* st = lds + cur * STG_BYTES;
#pragma unroll
                for (int kk = 0; kk < 2; ++kk) {
                    bf16x8 af[4], bfr[4];
#pragma unroll
                    for (int i = 0; i < 4; ++i) af[i] = *(const bf16x8*)(st + swz(wp * 64 + i * 16 + fr, kk * 4 + fq));
#pragma unroll
                    for (int j = 0; j < 4; ++j) bfr[j] = *(const bf16x8*)(st + XS_BYTES + swz(wq * 64 + j * 16 + fr, kk * 4 + fq));
#pragma unroll
                    for (int i = 0; i < 4; ++i)
#pragma unroll
                        for (int j = 0; j < 4; ++j) acc[i][j] = __builtin_amdgcn_mfma_f32_16x16x32_bf16(af[i], bfr[j], acc[i][j], 0, 0, 0);
                }
                cur = (cur == 2) ? 0 : cur + 1;
            }
#undef PQ_DMA_TILE
            RAW_BARRIER();
            {
                float r1[4]; f32x4 bv[4];
#pragma unroll
                for (int j = 0; j < 4; ++j) {
                    const f32x4* s4 = (const f32x4*)(ssq1 + (size_t)(q0 + wq * 64 + j * 16 + fr) * 16);
                    const f32x4 a0 = s4[0], a1 = s4[1], a2 = s4[2], a3 = s4[3];
                    r1[j] = rsqrtf((((a0.x + a0.y + a0.z + a0.w) + (a1.x + a1.y + a1.z + a1.w)) + ((a2.x + a2.y + a2.z + a2.w) + (a3.x + a3.y + a3.z + a3.w))) * (1.f / D) + EPS);
                }
                {
                    const float* bt = bias + (q0 >> 12) * 2048 + p0 + wp * 64 + fq * 4;
#pragma unroll
                    for (int i = 0; i < 4; ++i) bv[i] = *(const f32x4*)(bt + i * 16);
                }
                const unsigned short* kg = SK + (size_t)hp * 128 * 128 + (size_t)srow * 128 + lc * 8;
#pragma unroll
                for (int s2 = 0; s2 < 2; ++s2)
#pragma unroll
                    for (int i = 0; i < 2; ++i) __builtin_amdgcn_global_load_lds((const unsigned*)(kg + (size_t)(64 * i) * 128 + s2 * 64), (unsigned*)(lds + s2 * STG_BYTES + wave * 1024 + i * 8192), 16, 0, 0);
                unsigned char* yb = lds + wp * STG_BYTES + XS_BYTES + (fq & 1) * 8;
#pragma unroll
                for (int j = 0; j < 4; ++j)
#pragma unroll
                    for (int i = 0; i < 4; ++i)
                        *(unsigned long long*)(yb + swz(wq * 64 + j * 16 + fr, 2 * i + (fq >> 1))) =
                            pk4(acc[i][j].x * r1[j] + bv[i].x, acc[i][j].y * r1[j] + bv[i].y, acc[i][j].z * r1[j] + bv[i].z, acc[i][j].w * r1[j] + bv[i].w);
            }
            asm volatile("s_waitcnt vmcnt(0)" ::: "memory");
            RAW_BARRIER();
            f32x4 sc2[8][2];
#pragma unroll
            for (int i = 0; i < 8; ++i)
#pragma unroll
                for (int j = 0; j < 2; ++j) sc2[i][j] = (f32x4){0.f, 0.f, 0.f, 0.f};
#pragma unroll
            for (int s2 = 0; s2 < 2; ++s2) {
                const unsigned char* st = lds + s2 * STG_BYTES;
#pragma unroll
                for (int kk = 0; kk < 2; ++kk) {
                    bf16x8 af[8], bfr[2];
#pragma unroll
                    for (int i = 0; i < 8; ++i) af[i] = *(const bf16x8*)(st + swz(i * 16 + fr, kk * 4 + fq));
#pragma unroll
                    for (int j = 0; j < 2; ++j) bfr[j] = *(const bf16x8*)(st + XS_BYTES + swz(wave * 32 + j * 16 + fr, kk * 4 + fq));
#pragma unroll
                    for (int i = 0; i < 8; ++i)
#pragma unroll
                        for (int j = 0; j < 2; ++j) sc2[i][j] = __builtin_amdgcn_mfma_f32_16x16x32_bf16(af[i], bfr[j], sc2[i][j], 0, 0, 0);
                }
            }
            tsel(sc2, 0, q0 + wave * 32, lane, (const float*)nullptr, hp, sub);
        }
    }
}

__device__ __forceinline__ void ld_row4(u32x4 (&d)[4], const unsigned char* tab, int id, int l16) {
    const u32x4* r = (const u32x4*)(tab + (size_t)id * D + l16 * 16);
#pragma unroll
    for (int j = 0; j < 4; ++j) d[j] = r[16 * j];
}
__device__ void stage_peer_u(const Params& p) {
    const unsigned short* h2 = (const unsigned short*)(p.ws + WS_HB);
    const float* mod = (const float*)(p.ws + WS_MOD);
    const unsigned short* idx = (const unsigned short*)(p.ws + WS_IDX); float* g = (float*)(p.ws + WS_G);
    const unsigned char* eu8 = p.ws + WS_EU8; const unsigned char* ev8 = p.ws + WS_EV8;
    const float* us = (const float*)(p.ws + WS_US); const float* vs = (const float*)(p.ws + WS_VS);
    const int lane = threadIdx.x & 63, wave = threadIdx.x >> 6, l16 = lane & 15, grp = lane >> 4;
    for (int t = blockIdx.x * NWAVES + wave; t < T; t += gridDim.x * NWAVES) {
        const int b = t >> 12;
        float hreg[64];
        const float rstd1 = rsqrtf(group16_sum(((const float*)(p.ws + WS_SSQ1))[(size_t)t * 16 + l16]) * (1.f / D) + EPS);
        const float* shf = mod + b * NMOD + 3 * D;
#pragma unroll
        for (int j = 0; j < 4; ++j)
#pragma unroll
            for (int c = 0; c < 2; ++c) {
                const u32x4 w = *(const u32x4*)(h2 + (size_t)t * D + j * 256 + l16 * 16 + c * 8);
                const f32x4 s0 = *(const f32x4*)(shf + j * 256 + l16 * 16 + c * 8), s1 = *(const f32x4*)(shf + j * 256 + l16 * 16 + c * 8 + 4);
                hreg[j * 16 + c * 8 + 0] = bflo(w.x) * rstd1 + s0.x; hreg[j * 16 + c * 8 + 1] = bfhi(w.x) * rstd1 + s0.y; hreg[j * 16 + c * 8 + 2] = bflo(w.y) * rstd1 + s0.z; hreg[j * 16 + c * 8 + 3] = bfhi(w.y) * rstd1 + s0.w;
                hreg[j * 16 + c * 8 + 4] = bflo(w.z) * rstd1 + s1.x; hreg[j * 16 + c * 8 + 5] = bfhi(w.z) * rstd1 + s1.y; hreg[j * 16 + c * 8 + 6] = bflo(w.w) * rstd1 + s1.z; hreg[j * 16 + c * 8 + 7] = bfhi(w.w) * rstd1 + s1.w;
            }
        const int idv0 = idx[(size_t)t * 128 + lane], idv1 = idx[(size_t)t * 128 + 64 + lane];
        const float gv0 = g[(size_t)t * 128 + lane], gv1 = g[(size_t)t * 128 + 64 + lane];
        float wv0 = 0.f, wv1 = 0.f;
        {
            u32x4 cur[4], nxt[4];
            int id_c = __shfl(idv0, grp);
            ld_row4(cur, eu8, id_c, l16);
            float sc_c = us[id_c];
#pragma unroll 2
            for (int q = 0; q < 32; ++q) {
                const int qn = (q + 1 < 32) ? q + 1 : q;
                const int rn = qn * 4 + grp;
                const int id_n = __shfl((qn < 16) ? idv0 : idv1, rn & 63);
                ld_row4(nxt, eu8, id_n, l16);
                const float sc_n = us[id_n];
                float s0 = 0.f, s1 = 0.f;
#pragma unroll
                for (int j = 0; j < 4; ++j)
#pragma unroll
                    for (int c = 0; c < 4; ++c) {
                        const int w = (int)cur[j][c];
                        const f32x2 lo = __builtin_amdgcn_cvt_pk_f32_fp8(w, false), hi = __builtin_amdgcn_cvt_pk_f32_fp8(w, true);
                        s0 += lo.x * hreg[j * 16 + c * 4 + 0]; s1 += lo.y * hreg[j * 16 + c * 4 + 1];
                        s0 += hi.x * hreg[j * 16 + c * 4 + 2]; s1 += hi.y * hreg[j * 16 + c * 4 + 3];
                    }
                const float s = group16_sum(s0 + s1) * sc_c;
                const float act = 0.5f * s * (1.f + erff(s * 0.70710678118654752f));
                const int r = q * 4 + grp;
                const float gk = __shfl((q < 16) ? gv0 : gv1, r & 63);
                const float w = gk * act;
                const float wt = __shfl(w, (lane & 3) * 16);
                const bool mine = (lane >> 2) == (q & 15);
                if (q < 16) wv0 = mine ? wt : wv0; else wv1 = mine ? wt : wv1;
#pragma unroll
                for (int j = 0; j < 4; ++j) cur[j] = nxt[j];
                sc_c = sc_n;
            }
        }
        g[(size_t)t * 128 + lane] = wv0; g[(size_t)t * 128 + 64 + lane] = wv1;
    }
}
__device__ void stage_peer_v(const Params& p, float* outp) {
    const float* mod = (const float*)(p.ws + WS_MOD);
    const unsigned short* idx = (const unsigned short*)(p.ws + WS_IDX); const float* g = (const float*)(p.ws + WS_G);
    const unsigned char* ev8 = p.ws + WS_EV8;
    const float* vs = (const float*)(p.ws + WS_VS);
    const int lane = threadIdx.x & 63, wave = threadIdx.x >> 6, l16 = lane & 15, grp = lane >> 4;
    for (int t = blockIdx.x * NWAVES + wave; t < T; t += gridDim.x * NWAVES) {
        const int b = t >> 12;
        const int idv0 = idx[(size_t)t * 128 + lane], idv1 = idx[(size_t)t * 128 + 64 + lane];
        const float wv0 = g[(size_t)t * 128 + lane], wv1 = g[(size_t)t * 128 + 64 + lane];
        float acc[64];
#pragma unroll
        for (int i = 0; i < 64; ++i) acc[i] = 0.f;
        {
            u32x4 cur[4], nxt[4];
            int id_c = __shfl(idv0, grp);
            ld_row4(cur, ev8, id_c, l16);
            float sc_c = vs[id_c];
#pragma unroll 2
            for (int q = 0; q < 32; ++q) {
                const int qn = (q + 1 < 32) ? q + 1 : q;
                const int rn = qn * 4 + grp;
                const int id_n = __shfl((qn < 16) ? idv0 : idv1, rn & 63);
                ld_row4(nxt, ev8, id_n, l16);
                const float sc_n = vs[id_n];
                const int r = q * 4 + grp;
                const float wv = __shfl((q < 16) ? wv0 : wv1, r & 63) * sc_c;
#pragma unroll
                for (int j = 0; j < 4; ++j)
#pragma unroll
                    for (int c = 0; c < 4; ++c) {
                        const int w = (int)cur[j][c];
                        const f32x2 lo = __builtin_amdgcn_cvt_pk_f32_fp8(w, false), hi = __builtin_amdgcn_cvt_pk_f32_fp8(w, true);
                        acc[j * 16 + c * 4 + 0] += wv * lo.x; acc[j * 16 + c * 4 + 1] += wv * lo.y;
                        acc[j * 16 + c * 4 + 2] += wv * hi.x; acc[j * 16 + c * 4 + 3] += wv * hi.y;
                    }
#pragma unroll
                for (int j = 0; j < 4; ++j) cur[j] = nxt[j];
                sc_c = sc_n;
            }
        }
#pragma unroll
        for (int i = 0; i < 64; ++i) { acc[i] += __shfl_xor(acc[i], 16); acc[i] += __shfl_xor(acc[i], 32); }
        float sel[16];
#pragma unroll
        for (int bb = 0; bb < 16; ++bb) sel[bb] = (grp == 0) ? acc[bb] : (grp == 1) ? acc[16 + bb] : (grp == 2) ? acc[32 + bb] : acc[48 + bb];
        const int eoff = grp * 256 + l16 * 16;
        const float* xin = p.out + (size_t)t * D + eoff;
        float* xr = outp + (size_t)t * D + eoff;
        const float* gf = mod + b * NMOD + 5 * D + eoff;
        float ss = 0.f;
#pragma unroll
        for (int c = 0; c < 4; ++c) {
            const f32x4 x1 = *(const f32x4*)(xin + c * 4); const f32x4 gg = *(const f32x4*)(gf + c * 4);
            sel[c * 4 + 0] = x1.x + gg.x * sel[c * 4 + 0]; sel[c * 4 + 1] = x1.y + gg.y * sel[c * 4 + 1];
            sel[c * 4 + 2] = x1.z + gg.z * sel[c * 4 + 2]; sel[c * 4 + 3] = x1.w + gg.w * sel[c * 4 + 3];
            ss += sel[c * 4 + 0] * sel[c * 4 + 0] + sel[c * 4 + 1] * sel[c * 4 + 1] + sel[c * 4 + 2] * sel[c * 4 + 2] + sel[c * 4 + 3] * sel[c * 4 + 3];
        }
        const float rstd = rsqrtf(wave_sum(ss) * (1.f / D) + EPS);
#pragma unroll
        for (int c = 0; c < 4; ++c) {
            const f32x4 fn = *(const f32x4*)(p.fnorm + eoff + c * 4);
            f32x4 r; r.x = sel[c * 4 + 0] * rstd * fn.x; r.y = sel[c * 4 + 1] * rstd * fn.y; r.z = sel[c * 4 + 2] * rstd * fn.z; r.w = sel[c * 4 + 3] * rstd * fn.w;
            *(f32x4*)(xr + c * 4) = r;
        }
    }
}

#define LAS __attribute__((address_space(3)))
constexpr size_t WS_BAR = 3 * MiB;
constexpr int BAR_BYTES = 16384;
constexpr int LDS_MISC_OFF = 147456;
#define XB_TMO      128
#define XB_XCNT(j)  (256  + 64 * (j))
#define XB_XSUB(j)  (1280 + 64 * (j))
#define XB_XGEN(j)  (2304 + 64 * (j))
#define XB_TOP      3328
#define XB_TOPGEN   3392
#define XB_SPIN_CAP (1u << 18)
__device__ __forceinline__ unsigned xb_ld(unsigned* p)              { return __hip_atomic_load(p, __ATOMIC_RELAXED, __HIP_MEMORY_SCOPE_AGENT); }
__device__ __forceinline__ unsigned xb_add(unsigned* p, unsigned v) { return __hip_atomic_fetch_add(p, v, __ATOMIC_RELAXED, __HIP_MEMORY_SCOPE_AGENT); }
__device__ __forceinline__ unsigned xb_xcc_id() { return (unsigned)__builtin_amdgcn_s_getreg((3 << 11) | 20) & 0xFu; }
#define XB_SPIN(cond, bar) do { unsigned _sp = 0; while (cond) { __builtin_amdgcn_s_sleep(1); \
    if ((++_sp & 255u) == 0u) { if (xb_ld(&(bar)[XB_TMO])) break; if (_sp > XB_SPIN_CAP) { atomicAdd(&(bar)[XB_TMO], 1u); break; } } } } while (0)
struct XcdBarrier { unsigned* bar; unsigned x; volatile LAS unsigned* st; };
__device__ __forceinline__ XcdBarrier xcd_barrier_post(unsigned* bar, volatile LAS unsigned* st) {
    XcdBarrier b; b.bar = bar; b.x = xb_xcc_id(); b.st = st;
    if (threadIdx.x == 0) (void)xb_add(&bar[XB_XCNT(b.x)], 1u);
    return b;
}
__device__ __forceinline__ void xcd_barrier_complete(unsigned* bar, unsigned x, unsigned& nloc, unsigned& nx) {
    const unsigned G = gridDim.x * gridDim.y * gridDim.z;
    unsigned sum, cnt, mine, sp = 0u;
    for (;;) {
        sum = 0u; cnt = 0u; mine = 0u;
#pragma unroll
        for (unsigned j = 0; j < 16; ++j) { const unsigned c = xb_ld(&bar[XB_XCNT(j)]); sum += c; cnt += (c > 0u) ? 1u : 0u; mine = (j == x) ? c : mine; }
        if (sum == G) break;
        __builtin_amdgcn_s_sleep(1);
        if ((++sp & 255u) == 0u) { if (xb_ld(&bar[XB_TMO])) break; if (sp > XB_SPIN_CAP) { atomicAdd(&bar[XB_TMO], 1u); break; } }
    }
    nloc = mine > 0u ? mine : 1u; nx = cnt > 0u ? cnt : 1u;
}
__device__ __forceinline__ void xcd_barrier(const XcdBarrier& b) {
    asm volatile("s_waitcnt vmcnt(0)" ::: "memory");
    __syncthreads();
    if (threadIdx.x == 0) {
        unsigned* bar = b.bar;
        __builtin_amdgcn_s_waitcnt(0);
        unsigned nloc = b.st[0], nx = b.st[1];
        if (nloc == 0u) { xcd_barrier_complete(bar, b.x, nloc, nx); b.st[0] = nloc; b.st[1] = nx; }
        const unsigned old = xb_add(&bar[XB_XSUB(b.x)], 1u);
        const unsigned gen = old / nloc;
        if (old + 1u == (gen + 1u) * nloc) {
            __builtin_amdgcn_fence(__ATOMIC_RELEASE, "agent");
            asm volatile("s_waitcnt vmcnt(0)" ::: "memory");
            const unsigned og = xb_add(&bar[XB_TOP], 1u);
            const unsigned tg = og / nx;
            if (og + 1u == (tg + 1u) * nx) xb_add(&bar[XB_TOPGEN], 1u);
            else XB_SPIN(xb_ld(&bar[XB_TOPGEN]) == tg, bar);
            __builtin_amdgcn_fence(__ATOMIC_ACQUIRE, "agent");
            xb_add(&bar[XB_XGEN(b.x)], 1u);
            asm volatile("s_waitcnt vmcnt(0)" ::: "memory");
        } else {
            XB_SPIN(xb_ld(&bar[XB_XGEN(b.x)]) == gen, bar);
            __builtin_amdgcn_fence(__ATOMIC_ACQUIRE, "agent");
            asm volatile("s_waitcnt vmcnt(0)" ::: "memory");
        }
    }
    __syncthreads();
}

__global__ void __launch_bounds__(NTHREADS) fwd_megakernel(Params p) {
    extern __shared__ __attribute__((aligned(16))) unsigned char lds_raw[];
    cg::grid_group grid = cg::this_grid();
    unsigned short* hb = (unsigned short*)(p.ws + WS_HB);
    const float* mod = (const float*)(p.ws + WS_MOD);
    typedef const unsigned short* cbf;

    volatile LAS unsigned* bst = (volatile LAS unsigned*)((LAS unsigned char*)lds_raw + LDS_MISC_OFF);
    if (threadIdx.x < 2) bst[threadIdx.x] = 0u;
    __syncthreads();
    const XcdBarrier xbar = xcd_barrier_post((unsigned*)(p.ws + WS_BAR), bst);
#ifdef PROBE_A
    for (int rep = 0, nrep = (p.ws != nullptr) ? 2 : 1; rep < nrep; ++rep) { if (rep) xcd_barrier(xbar);
#endif
    stage_prologue(p, (float*)lds_raw);
    grid.sync();
#ifdef PROBE_P1
    for (int rep = 0, nrep = (p.ws != nullptr) ? 2 : 1; rep < nrep; ++rep) { if (rep) xcd_barrier(xbar);
#endif
    stage_norm_mod<true>(p, p.x, hb, 0 * D, 1 * D);
    stage_gemv8(mod + 3 * D, NMOD, false, p.w_pq, 2048, nullptr, (float*)(p.ws + WS_BPQ), (float*)lds_raw);
#ifdef PROBE_P1
    }
#endif
    xcd_barrier(xbar);
    gemm_dma<2, 1>((cbf)(p.ws + WS_WIN), D, hb, D, 1280, T, D, 1, 0, 0, lds_raw, EpiProj{p.ws});
    xcd_barrier(xbar);
    gemm_xyT<2, true>((cbf)(p.ws + WS_WQUP), 256, (cbf)(p.ws + WS_QL), 256, 768, T, 256, 1, 0, 0, lds_raw, EpiQup{p.ws});
    gemm_xyT<2, true>((cbf)(p.ws + WS_WKVUP), 128, (cbf)(p.ws + WS_KVL), 128, 1024, T, 128, 1, 0, 0, lds_raw, EpiKVup{p.ws});
    xcd_barrier(xbar);
    stage_attn_flash<64, true>(p, lds_raw);
    stage_attn_flash<96, false>(p, lds_raw);
    xcd_barrier(xbar);
#ifdef PROBE_OUT
    for (int rep = 0, nrep = (p.ws != nullptr) ? 2 : 1; rep < nrep; ++rep) { if (rep) xcd_barrier(xbar);
#endif
    gemm_dma<2, 1>((cbf)(p.ws + WS_WOUT), D, (cbf)(p.ws + WS_OAB), D, D, T, D, 1, 0, 0, lds_raw,
                   EpiOutProj{p.x, mod, p.out, hb, (const float*)(p.ws + WS_SSQO), (float*)(p.ws + WS_SSQ1), {}, {}});
#ifdef PROBE_OUT
    }
#endif
    xcd_barrier(xbar);
    gemm_pq_fused(p, lds_raw);
    xcd_barrier(xbar);
    stage_peer_u(p);
    xcd_barrier(xbar);
    stage_peer_v(p, p.out);
}

extern "C" void kernel_launch(void* const* d_in, const int* in_sizes, int n_in, void* d_out, int out_size, void* d_ws, size_t ws_size, hipStream_t stream) {
    static int grid_blocks = 0;
    if (grid_blocks == 0) {
        if (n_in != 18 || in_sizes[0] != T * D || out_size != T * D || ws_size < WS_END) {
            fprintf(stderr, "kernel_launch: unexpected shapes (n_in %d, in0 %d, out %d, ws %zu); nothing launched\n", n_in, n_in > 0 ? in_sizes[0] : -1, out_size, ws_size);
            grid_blocks = -1; return;
        }
        int dev = 0, cus = 0, per_cu = 0;
        (void)hipGetDevice(&dev);
        (void)hipDeviceGetAttribute(&cus, hipDeviceAttributeMultiprocessorCount, dev);
        if (hipFuncSetAttribute((const void*)fwd_megakernel, hipFuncAttributeMaxDynamicSharedMemorySize, LDS_BYTES) != hipSuccess) { fprintf(stderr, "kernel_launch: hipFuncSetAttribute failed\n"); grid_blocks = -1; return; }
        (void)hipOccupancyMaxActiveBlocksPerMultiprocessor(&per_cu, fwd_megakernel, NTHREADS, LDS_BYTES);
        if (per_cu < 1) { fprintf(stderr, "kernel_launch: occupancy query says %d blocks/CU\n", per_cu); grid_blocks = -1; return; }
        grid_blocks = cus;
    }
    if (grid_blocks < 0) return;
    Params p{};
    p.x = (const float*)d_in[0]; p.c = (const float*)d_in[1]; p.w_ada = (const float*)d_in[2]; p.b_ada = (const float*)d_in[3];
    p.w_in = (const float*)d_in[4]; p.sink = (const float*)d_in[5]; p.qnorm = (const float*)d_in[6]; p.w_qup = (const float*)d_in[7];
    p.kvnorm = (const float*)d_in[8]; p.w_kvup = (const float*)d_in[9]; p.onorm_a = (const float*)d_in[10]; p.onorm_b = (const float*)d_in[11];
    p.w_out = (const float*)d_in[12]; p.w_pq = (const float*)d_in[13]; p.subk = (const float*)d_in[14]; p.eu = (const float*)d_in[15];
    p.ev = (const float*)d_in[16]; p.fnorm = (const float*)d_in[17];
    p.out = (float*)d_out; p.ws = (unsigned char*)d_ws;
    if (hipMemsetAsync((char*)d_ws + WS_BAR, 0, BAR_BYTES, stream) != hipSuccess) { fprintf(stderr, "kernel_launch: hipMemsetAsync failed\n"); return; }
    void* args[] = {&p};
    hipError_t e = hipLaunchCooperativeKernel((void*)fwd_megakernel, dim3(grid_blocks), dim3(NTHREADS), args, LDS_BYTES, stream);
    if (e != hipSuccess) fprintf(stderr, "cooperative launch failed: %s (grid %d)\n", hipGetErrorString(e), grid_blocks);
}
```

```cpp
#include <hip/hip_runtime.h>
#include <hip/hip_cooperative_groups.h>
#include <cstdio>
#include <cstdint>
namespace cg = cooperative_groups;

constexpr int Bsz = 8, S = 4096, D = 1024, T = Bsz * S;
constexpr int INW = 1184;
constexpr int C_QA = 0, C_KA = 512, C_VA = 640, C_QL = 768, C_KVL = 1024, C_KR = 1152;
constexpr int NMOD = 6 * D;
constexpr float EPS = 1e-6f;
constexpr float LOG2E = 1.4426950408889634f;
constexpr float QA_SCALE = 0.125f * LOG2E;
constexpr float QM_SCALE = 0.10206207261596575f * LOG2E;
constexpr int NTHREADS = 512, NWAVES = 8;

constexpr size_t MiB = 1u << 20;
constexpr size_t WS_MOD = 0;
constexpr size_t WS_COSA = 1 * MiB;
constexpr size_t WS_SINA = WS_COSA + 512 * 1024;
constexpr size_t WS_COSB = 2 * MiB;
constexpr size_t WS_SINB = WS_COSB + 256 * 1024;
constexpr size_t WS_WIN = 4 * MiB;
constexpr size_t WS_WQUP = 7 * MiB;
constexpr size_t WS_WKVUP = 7 * MiB + 512 * 1024;
constexpr size_t WS_WOUT = 8 * MiB;
constexpr size_t WS_WPQ = 10 * MiB;
constexpr size_t WS_SUBK = 14 * MiB;
constexpr size_t WS_EU8 = 16 * MiB;
constexpr size_t WS_EV8 = 32 * MiB;
constexpr size_t WS_US = 48 * MiB;
constexpr size_t WS_VS = WS_US + 64 * 1024;
constexpr size_t WS_HB = 52 * MiB;
constexpr size_t WS_QA = 116 * MiB;
constexpr size_t WS_KA = 148 * MiB;
constexpr size_t WS_VAT = 156 * MiB;
constexpr size_t WS_QL = 164 * MiB;
constexpr size_t WS_KVL = 180 * MiB;
constexpr size_t WS_QMB = 192 * MiB;
constexpr size_t WS_K96 = 240 * MiB;
constexpr size_t WS_VT = 288 * MiB;
constexpr size_t WS_OAB = 320 * MiB;
constexpr size_t WS_PQ = 116 * MiB;
constexpr size_t WS_TOPS = 244 * MiB;
constexpr size_t WS_TOPI = 276 * MiB;
constexpr size_t WS_IDX = 284 * MiB;
constexpr size_t WS_G = 292 * MiB;
constexpr size_t WS_SSQO = 49 * MiB;
constexpr size_t WS_SSQ1 = 384 * MiB;
constexpr size_t WS_BPQ = 3 * MiB + 64 * 1024;
constexpr size_t WS_KEEP = 386 * MiB;
constexpr size_t WS_END = 512 * MiB;
constexpr int LDS_BYTES = 148480;
constexpr int NEXP = 16384;

struct Params {
    const float *x, *c, *w_ada, *b_ada, *w_in, *sink, *qnorm, *w_qup, *kvnorm, *w_kvup, *onorm_a, *onorm_b, *w_out, *w_pq, *subk, *eu, *ev, *fnorm;
    float* out;
    unsigned char* ws;
};

typedef short bf16x8 __attribute__((ext_vector_type(8)));
typedef float f32x4 __attribute__((ext_vector_type(4)));
typedef unsigned u32x4 __attribute__((ext_vector_type(4)));
typedef float f32x2 __attribute__((ext_vector_type(2)));

__device__ __forceinline__ unsigned f2bf(float f) { unsigned u = __builtin_bit_cast(unsigned, f); return (u + 0x7fffu + ((u >> 16) & 1u)) >> 16; }
__device__ __forceinline__ unsigned pk2(float lo, float hi) { return f2bf(lo) | (f2bf(hi) << 16); }
__device__ __forceinline__ float bf2f(unsigned short h) { return __builtin_bit_cast(float, (unsigned)h << 16); }
__device__ __forceinline__ float bflo(unsigned w) { return __builtin_bit_cast(float, w << 16); }
__device__ __forceinline__ float bfhi(unsigned w) { return __builtin_bit_cast(float, w & 0xffff0000u); }
__device__ __forceinline__ float wave_sum(float v) {
#pragma unroll
    for (int o = 1; o < 64; o <<= 1) v += __shfl_xor(v, o);
    return v;
}

__device__ __forceinline__ float wave_max(float v) {
#pragma unroll
    for (int o = 1; o < 64; o <<= 1) v = fmaxf(v, __shfl_xor(v, o));
    return v;
}
template <int CTRL> __device__ __forceinline__ float dpp_add(float s) {
    return s + __builtin_bit_cast(float, __builtin_amdgcn_update_dpp(0, __builtin_bit_cast(int, s), CTRL, 0xF, 0xF, true));
}
__device__ __forceinline__ float group16_sum(float s) { s = dpp_add<0xB1>(s); s = dpp_add<0x4E>(s); s = dpp_add<0x141>(s); s = dpp_add<0x140>(s); return s; }

__device__ void stage_gemv8(const float* vec, int vstride, bool silu, const float* W, int N, const float* bias, float* dst, float* lds) {
    const int tid = threadIdx.x;
    __syncthreads();
    for (int i = tid; i < Bsz * D; i += NTHREADS) { const int b = i >> 10, k = i & 1023; float v = vec[b * vstride + k]; lds[i] = silu ? v / (1.f + __expf(-v)) : v; }
    __syncthreads();
    float* red = lds + Bsz * D;
    const int col_l = tid & 15, slice = tid >> 4;
    for (int item = blockIdx.x; item < N / 16; item += gridDim.x) {
        const int n = item * 16 + col_l;
        float acc[Bsz];
#pragma unroll
        for (int b = 0; b < Bsz; ++b) acc[b] = 0.f;
#pragma unroll 8
        for (int kk = 0; kk < 32; ++kk) {
            const int k = slice * 32 + kk;
            const float w = W[(size_t)k * N + n];
#pragma unroll
            for (int b = 0; b < Bsz; ++b) acc[b] += lds[b * D + k] * w;
        }
#pragma unroll
        for (int b = 0; b < Bsz; ++b) red[(slice * 16 + col_l) * Bsz + b] = acc[b];
        __syncthreads();
        if (tid < 128) {
            const int cc = tid >> 3, b = tid & 7;
            float sacc = 0.f;
#pragma unroll
            for (int sl = 0; sl < 32; ++sl) sacc += red[(sl * 16 + cc) * Bsz + b];
            dst[b * N + item * 16 + cc] = sacc + (bias ? bias[item * 16 + cc] : 0.f);
        }
        __syncthreads();
    }
}

template <int MAP> __device__ __forceinline__ int map_row(int n) {
    if (MAP == 1) { const int h = n / 96, j = n % 96; return j < 64 ? h * 64 + j : 512 + h * 32 + (j - 64); }
    return n;
}
template <int MAP>
__device__ __forceinline__ void transpose_item(const float* W, int K, int N, unsigned short* WT, const float* kgain, float* scr, int item, int lane, const float* kgain2 = nullptr) {
    const int nblk = N / 32, kb = item / nblk, nb = item % nblk, k0 = 64 * kb, n0 = 32 * nb;
#pragma unroll 8
    for (int i = 0; i < 32; ++i) {
        const int kk = 2 * i + (lane >> 5);
        float w = W[(size_t)(k0 + kk) * N + n0 + (lane & 31)];
        if (kgain) w *= (kgain2 && k0 + kk >= 512) ? kgain2[k0 + kk - 512] : kgain[k0 + kk];
        scr[kk * 33 + (lane & 31)] = w;
    }
    asm volatile("s_waitcnt lgkmcnt(0)" ::: "memory");
    const int c = lane & 7;
#pragma unroll
    for (int j = 0; j < 4; ++j) {
        const int n = (lane >> 3) + 8 * j; const float* q = scr + (8 * c) * 33 + n;
        u32x4 o; o.x = pk2(q[0 * 33], q[1 * 33]); o.y = pk2(q[2 * 33], q[3 * 33]); o.z = pk2(q[4 * 33], q[5 * 33]); o.w = pk2(q[6 * 33], q[7 * 33]);
        *(u32x4*)(WT + (size_t)map_row<MAP>(n0 + n) * K + k0 + 8 * c) = o;
    }
    asm volatile("s_waitcnt lgkmcnt(0)" ::: "memory");
}

__device__ void stage_prologue(const Params& p, float* lds) {
    const int tid = threadIdx.x;
    stage_gemv8(p.c, D, true, p.w_ada, NMOD, p.b_ada, (float*)(p.ws + WS_MOD), lds);
    float* cosA = (float*)(p.ws + WS_COSA); float* sinA = (float*)(p.ws + WS_SINA);
    float* cosB = (float*)(p.ws + WS_COSB); float* sinB = (float*)(p.ws + WS_SINB);
    const int gtid = blockIdx.x * NTHREADS + tid, gn = gridDim.x * NTHREADS;
    for (int e = gtid; e < S * 32; e += gn) {
        const int pos = e >> 5, i = e & 31;
        const double inv = exp2(-(double)(2 * i) / 64.0 * 13.287712379549449);
        const double a = (double)pos * inv;
        cosA[e] = (float)cos(a); sinA[e] = (float)sin(a);
    }
    for (int e = gtid; e < S * 16; e += gn) {
        const int pos = e >> 4, i = e & 15;
        const double inv = exp2(-(double)(2 * i) / 32.0 * 13.287712379549449);
        const double a = (double)pos * inv;
        cosB[e] = (float)cos(a); sinB[e] = (float)sin(a);
    }
    {
        const int lane = tid & 63, wave = tid >> 6;
        float* scr = lds + wave * (64 * 33);
        const int gw = blockIdx.x * NWAVES + wave, NGW = gridDim.x * NWAVES;
        constexpr int I_IN = (D / 64) * (INW / 32), I_QU = (256 / 64) * (768 / 32), I_KV = (128 / 64) * (1024 / 32), I_OUT = (D / 64) * (D / 32), I_PQ = (D / 64) * (2048 / 32);
        constexpr int NITEMS = I_IN + I_QU + I_KV + I_OUT + I_PQ;
        __syncthreads();
        for (int it = gw; it < NITEMS; it += NGW) {
            int r = it;
            if (r < I_IN) { transpose_item<0>(p.w_in, D, INW, (unsigned short*)(p.ws + WS_WIN), nullptr, scr, r, lane); continue; } r -= I_IN;
            if (r < I_QU) { transpose_item<1>(p.w_qup, 256, 768, (unsigned short*)(p.ws + WS_WQUP), p.qnorm, scr, r, lane); continue; } r -= I_QU;
            if (r < I_KV) { transpose_item<0>(p.w_kvup, 128, 1024, (unsigned short*)(p.ws + WS_WKVUP), p.kvnorm, scr, r, lane); continue; } r -= I_KV;
            if (r < I_OUT) { transpose_item<0>(p.w_out, D, D, (unsigned short*)(p.ws + WS_WOUT), p.onorm_a, scr, r, lane, p.onorm_b); continue; } r -= I_OUT;
            transpose_item<0>(p.w_pq, D, 2048, (unsigned short*)(p.ws + WS_WPQ), nullptr, scr, r, lane);
        }
        {
            u32x4* z = (u32x4*)(p.ws + WS_WIN + (size_t)INW * D * 2);
            const int nz = (1280 - INW) * D * 2 / 16;
            for (int e = blockIdx.x * NTHREADS + tid; e < nz; e += gridDim.x * NTHREADS) z[e] = (u32x4){0u, 0u, 0u, 0u};
        }
        {
            const f32x4* src = (const f32x4*)p.subk; unsigned long long* dst = (unsigned long long*)(p.ws + WS_SUBK);
            for (int e = blockIdx.x * NTHREADS + tid; e < 16 * 128 * 128 / 4; e += gridDim.x * NTHREADS) {
                const f32x4 v = src[e]; dst[e] = (unsigned long long)pk2(v.x, v.y) | ((unsigned long long)pk2(v.z, v.w) << 32);
            }
        }
    }
    {
        const int lane = tid & 63, wave = tid >> 6;
        for (int r = blockIdx.x * NWAVES + wave; r < 2 * NEXP; r += gridDim.x * NWAVES) {
            const int tab = r >= NEXP, row = r - tab * NEXP;
            const f32x4* src = (const f32x4*)((tab ? p.ev : p.eu) + (size_t)row * D) + lane;
            f32x4 v[4]; float am = 0.f;
#pragma unroll
            for (int j = 0; j < 4; ++j) { v[j] = src[64 * j]; am = fmaxf(am, fmaxf(fmaxf(fabsf(v[j].x), fabsf(v[j].y)), fmaxf(fabsf(v[j].z), fabsf(v[j].w)))); }
            am = wave_max(am);
            int ex = 0; (void)frexpf(am, &ex);
            const float sc = ldexpf(1.f, 8 - ex), isc = ldexpf(1.f, ex - 8);
            unsigned* dst = (unsigned*)(p.ws + (tab ? WS_EV8 : WS_EU8) + (size_t)row * D) + lane;
#pragma unroll
            for (int j = 0; j < 4; ++j) {
                int w = 0;
                w = __builtin_amdgcn_cvt_pk_fp8_f32(v[j].x * sc, v[j].y * sc, w, false);
                w = __builtin_amdgcn_cvt_pk_fp8_f32(v[j].z * sc, v[j].w * sc, w, true);
                dst[64 * j] = (unsigned)w;
            }
            if (lane == 0) ((float*)(p.ws + (tab ? WS_VS : WS_US)))[row] = isc;
        }
    }
}

template <bool BF>
__device__ void stage_norm_mod(const Params& p, const float* src, void* dstv, int sh_off, int sc_off) {
    const float* mod = (const float*)(p.ws + WS_MOD);
    const int lane = threadIdx.x & 63, wave = threadIdx.x >> 6;
    for (int t = blockIdx.x * NWAVES + wave; t < T; t += gridDim.x * NWAVES) {
        const int b = t >> 12;
        const f32x4* xr = (const f32x4*)(src + (size_t)t * D) + lane;
        f32x4 v[4]; float s = 0.f;
#pragma unroll
        for (int j = 0; j < 4; ++j) { v[j] = xr[64 * j]; s += v[j].x * v[j].x + v[j].y * v[j].y + v[j].z * v[j].z + v[j].w * v[j].w; }
        const float rstd = rsqrtf(wave_sum(s) * (1.f / D) + EPS);
#pragma unroll
        for (int j = 0; j < 4; ++j) {
            const f32x4 sh = *((const f32x4*)(mod + b * NMOD + sh_off) + lane + 64 * j);
            const f32x4 sc = *((const f32x4*)(mod + b * NMOD + sc_off) + lane + 64 * j);
            f32x4 r;
            r.x = v[j].x * rstd * (1.f + sc.x) + sh.x; r.y = v[j].y * rstd * (1.f + sc.y) + sh.y;
            r.z = v[j].z * rstd * (1.f + sc.z) + sh.z; r.w = v[j].w * rstd * (1.f + sc.w) + sh.w;
            if (BF) ((unsigned long long*)((unsigned short*)dstv + (size_t)t * D))[lane + 64 * j] = (unsigned long long)pk2(r.x, r.y) | ((unsigned long long)pk2(r.z, r.w) << 32);
            else ((f32x4*)((float*)dstv + (size_t)t * D))[lane + 64 * j] = r;
        }
    }
}

constexpr int TP = 128, TQ = 256, TBK = 64;
constexpr int XS_BYTES = TP * 128, YS_BYTES = TQ * 128, STG_BYTES = XS_BYTES + YS_BYTES;
__device__ __forceinline__ int swz(int r, int c) { return r * 128 + ((c ^ ((r >> 1) & 7)) << 4); }
constexpr int SSQ_OFF = 2 * (TP * 128 + TQ * 128);
__device__ __forceinline__ float ssq8(u32x4 w) {
    const float a0 = bflo(w.x), a1 = bfhi(w.x), a2 = bflo(w.y), a3 = bfhi(w.y), a4 = bflo(w.z), a5 = bfhi(w.z), a6 = bflo(w.w), a7 = bfhi(w.w);
    return (a0 * a0 + a1 * a1) + (a2 * a2 + a3 * a3) + (a4 * a4 + a5 * a5) + (a6 * a6 + a7 * a7);
}
template <int WPN, bool YSSQ, class Epi>
__device__ void gemm_xyT(const unsigned short* X, int ldx, const unsigned short* Y, int ldy, int P, int Q, int K, int nb, size_t xbs, size_t ybs, unsigned char* lds, const Epi& epi) {
    constexpr int WQN = 8 / WPN, FI = TP / (WPN * 16), FJ = TQ / (WQN * 16);
    const int tid = threadIdx.x, lane = tid & 63, wave = tid >> 6;
    const int wp = wave / WQN, wq = wave % WQN, fr = lane & 15, fq = lane >> 4;
    const int nPt = P / TP, nQt = Q / TQ, npb = nPt * nb, nunits = npb * nQt;
    const int G = gridDim.x, bx = blockIdx.x;
    const int vcu = (G % 8 == 0) ? (bx % 8) * (G / 8) + bx / 8 : bx;
    const int srow = tid >> 3, sc = tid & 7;
    const int nk = K / TBK;
    for (int u = vcu; u < nunits; u += G) {
        const int qt = u / npb, rem = u % npb, bi = rem / nPt, pt = rem % nPt, p0 = pt * TP, q0 = qt * TQ;
        f32x4 acc[FI][FJ];
#pragma unroll
        for (int i = 0; i < FI; ++i)
#pragma unroll
            for (int j = 0; j < FJ; ++j) acc[i][j] = (f32x4){0.f, 0.f, 0.f, 0.f};
        const unsigned short* xg = X + (size_t)bi * xbs + (size_t)(p0 + srow) * ldx + sc * 8;
        const unsigned short* yg = Y + (size_t)bi * ybs + (size_t)(q0 + srow) * ldy + sc * 8;
        u32x4 rx[2], ry[4];
        float sq[4] = {0.f, 0.f, 0.f, 0.f};
#pragma unroll
        for (int i = 0; i < 2; ++i) rx[i] = *(const u32x4*)(xg + (size_t)(64 * i) * ldx);
#pragma unroll
        for (int i = 0; i < 4; ++i) ry[i] = *(const u32x4*)(yg + (size_t)(64 * i) * ldy);
        if (YSSQ) {
#pragma unroll
            for (int i = 0; i < 4; ++i) sq[i] += ssq8(ry[i]);
        }
        __syncthreads();
#pragma unroll
        for (int i = 0; i < 2; ++i) *(u32x4*)(lds + swz(srow + 64 * i, sc)) = rx[i];
#pragma unroll
        for (int i = 0; i < 4; ++i) *(u32x4*)(lds + XS_BYTES + swz(srow + 64 * i, sc)) = ry[i];
        __syncthreads();
        for (int kt = 0; kt < nk; ++kt) {
            unsigned char* st = lds + (kt & 1) * STG_BYTES;
            unsigned char* sn = lds + ((kt & 1) ^ 1) * STG_BYTES;
            const bool more = (kt + 1 < nk);
            if (more) {
                const int k1 = (kt + 1) * TBK;
#pragma unroll
                for (int i = 0; i < 2; ++i) rx[i] = *(const u32x4*)(xg + (size_t)(64 * i) * ldx + k1);
#pragma unroll
                for (int i = 0; i < 4; ++i) ry[i] = *(const u32x4*)(yg + (size_t)(64 * i) * ldy + k1);
            }
            if (YSSQ && more) {
#pragma unroll
                for (int i = 0; i < 4; ++i) sq[i] += ssq8(ry[i]);
            }
#pragma unroll
            for (int kk = 0; kk < 2; ++kk) {
                bf16x8 af[FI], bfr[FJ];
#pragma unroll
                for (int i = 0; i < FI; ++i) af[i] = *(const bf16x8*)(st + swz(wp * (FI * 16) + i * 16 + fr, kk * 4 + fq));
#pragma unroll
                for (int j = 0; j < FJ; ++j) bfr[j] = *(const bf16x8*)(st + XS_BYTES + swz(wq * (FJ * 16) + j * 16 + fr, kk * 4 + fq));
#pragma unroll
                for (int i = 0; i < FI; ++i)
#pragma unroll
                    for (int j = 0; j < FJ; ++j) acc[i][j] = __builtin_amdgcn_mfma_f32_16x16x32_bf16(af[i], bfr[j], acc[i][j], 0, 0, 0);
            }
            if (more) {
#pragma unroll
                for (int i = 0; i < 2; ++i) *(u32x4*)(sn + swz(srow + 64 * i, sc)) = rx[i];
#pragma unroll
                for (int i = 0; i < 4; ++i) *(u32x4*)(sn + XS_BYTES + swz(srow + 64 * i, sc)) = ry[i];
            }
            __syncthreads();
        }
        if (YSSQ) {
            float* ssq = (float*)(lds + SSQ_OFF);
#pragma unroll
            for (int i = 0; i < 4; ++i) {
                float v = sq[i];
                v += __shfl_xor(v, 1); v += __shfl_xor(v, 2); v += __shfl_xor(v, 4);
                if (sc == 0) ssq[srow + 64 * i] = v;
            }
            __syncthreads();
        }
        epi(acc, p0 + wp * (FI * 16), q0 + wq * (FJ * 16), lane, (const float*)(lds + SSQ_OFF) + wq * (FJ * 16), bi);
        if (YSSQ) __syncthreads();
    }
}
constexpr int DMA_STAGES = 3;
#define RAW_BARRIER() do { asm volatile("s_waitcnt lgkmcnt(0)" ::: "memory"); __builtin_amdgcn_s_barrier(); } while (0)
template <int WPN, int SUB, class Epi>
__device__ void gemm_dma(const unsigned short* X, int ldx, const unsigned short* Y, int ldy, int P, int Q, int K, int nb, size_t xbs, size_t ybs, unsigned char* lds, Epi epi) {
    constexpr int WQN = 8 / WPN, FI = TP / (WPN * 16), FJ = TQ / (WQN * 16);
    const int tid = threadIdx.x, lane = tid & 63, wave = __builtin_amdgcn_readfirstlane(tid >> 6);
    const int wp = wave / WQN, wq = wave % WQN, fr = lane & 15, fq = lane >> 4;
    const int nPt = P / TP, nQt = Q / TQ, npb = nPt * nb / SUB, nunits = npb * nQt;
    const int G = gridDim.x, bx = blockIdx.x;
    const int vcu = (G % 8 == 0) ? (bx % 8) * (G / 8) + bx / 8 : bx;
    const int srow = wave * 8 + (lane >> 3), pc = lane & 7;
    const int nk = K / TBK;
    const int lc = pc ^ ((srow >> 1) & 7);
    for (int u = vcu; u < nunits; u += G)
#pragma unroll
    for (int sub = 0; sub < SUB; ++sub) {
        const int qt = u / npb, rem = (u % npb) * SUB + sub, bi = rem / nPt, pt = rem % nPt, p0 = pt * TP, q0 = qt * TQ;
        f32x4 acc[FI][FJ];
#pragma unroll
        for (int i = 0; i < FI; ++i)
#pragma unroll
            for (int j = 0; j < FJ; ++j) acc[i][j] = (f32x4){0.f, 0.f, 0.f, 0.f};
        const unsigned short* xg = X + (size_t)bi * xbs + (size_t)(p0 + srow) * ldx + lc * 8;
        const unsigned short* yg = Y + (size_t)bi * ybs + (size_t)(q0 + srow) * ldy + lc * 8;
        epi.pre(q0 + wq * (FJ * 16), lane);
        asm volatile("s_waitcnt vmcnt(0)" ::: "memory");
        RAW_BARRIER();
#define GEMM_DMA_TILE(kt_, stg_) do { \
            unsigned char* _b = lds + (stg_) * STG_BYTES + wave * 1024; const int _k = (kt_) * TBK; \
            _Pragma("unroll") for (int _i = 0; _i < 2; ++_i) __builtin_amdgcn_global_load_lds((const unsigned*)(xg + (size_t)(64 * _i) * ldx + _k), (unsigned*)(_b + _i * 8192), 16, 0, 0); \
            _Pragma("unroll") for (int _i = 0; _i < 4; ++_i) __builtin_amdgcn_global_load_lds((const unsigned*)(yg + (size_t)(64 * _i) * ldy + _k), (unsigned*)(_b + XS_BYTES + _i * 8192), 16, 0, 0); \
        } while (0)
        GEMM_DMA_TILE(0, 0);
        GEMM_DMA_TILE(1, 1);
        int cur = 0;
        for (int kt = 0; kt < nk; ++kt) {
            if (kt + 1 < nk) asm volatile("s_waitcnt vmcnt(6)" ::: "memory"); else asm volatile("s_waitcnt vmcnt(0)" ::: "memory");
            RAW_BARRIER();
            if (kt + 2 < nk) { const int nxt = (cur == 0) ? 2 : cur - 1; GEMM_DMA_TILE(kt + 2, nxt); }
            const unsigned char* st = lds + cur * STG_BYTES;
#pragma unroll
            for (int kk = 0; kk < 2; ++kk) {
                bf16x8 af[FI], bfr[FJ];
#pragma unroll
                for (int i = 0; i < FI; ++i) af[i] = *(const bf16x8*)(st + swz(wp * (FI * 16) + i * 16 + fr, kk * 4 + fq));
#pragma unroll
                for (int j = 0; j < FJ; ++j) bfr[j] = *(const bf16x8*)(st + XS_BYTES + swz(wq * (FJ * 16) + j * 16 + fr, kk * 4 + fq));
#pragma unroll
                for (int i = 0; i < FI; ++i)
#pragma unroll
                    for (int j = 0; j < FJ; ++j) acc[i][j] = __builtin_amdgcn_mfma_f32_16x16x32_bf16(af[i], bfr[j], acc[i][j], 0, 0, 0);
            }
            cur = (cur == 2) ? 0 : cur + 1;
            if (Epi::HAS_MID && kt + 1 == (nk >> 1)) epi.mid(acc);
        }
#undef GEMM_DMA_TILE
        epi(acc, p0 + wp * (FI * 16), q0 + wq * (FJ * 16), lane, (const float*)nullptr, bi, sub);
    }
}
__device__ __forceinline__ unsigned long long pk4(float a, float b, float c, float d) { return (unsigned long long)pk2(a, b) | ((unsigned long long)pk2(c, d) << 32); }
struct EpiOutProj {
    static constexpr bool HAS_MID = true;
    const float* x; const float* mod; float* out; unsigned short* y1; const float* ssqo; float* ssq1;
    float ratio[4], rb[4];
    __device__ __forceinline__ void pre(int qb, int lane) {
#pragma unroll
        for (int j = 0; j < 4; ++j) {
            const f32x4* s4 = (const f32x4*)(ssqo + (size_t)(qb + j * 16 + (lane & 15)) * 16);
            const f32x4 a0 = s4[0], a1 = s4[1], b0 = s4[2], b1 = s4[3];
            const float sa = (a0.x + a0.y + a0.z + a0.w) + (a1.x + a1.y + a1.z + a1.w), sb = (b0.x + b0.y + b0.z + b0.w) + (b1.x + b1.y + b1.z + b1.w);
            const float ra = rsqrtf(sa * (1.f / 512.f) + EPS); rb[j] = rsqrtf(sb * (1.f / 512.f) + EPS); ratio[j] = ra / rb[j];
        }
    }
    __device__ __forceinline__ void mid(f32x4 (&acc)[4][4]) {
#pragma unroll
        for (int i = 0; i < 4; ++i)
#pragma unroll
            for (int j = 0; j < 4; ++j) { acc[i][j].x *= ratio[j]; acc[i][j].y *= ratio[j]; acc[i][j].z *= ratio[j]; acc[i][j].w *= ratio[j]; }
    }
    __device__ __forceinline__ void operator()(const f32x4 (&acc)[4][4], int pb, int qb, int lane, const float*, int, int = 0) {
        const int fr = lane & 15, fq = lane >> 4;
        const float* __restrict__ xr = x; float* __restrict__ outr = out; unsigned short* __restrict__ yr = y1; float* __restrict__ sr = ssq1;
        const float* mt = mod + (qb >> 12) * NMOD + pb + fq * 4;
        f32x4 gv[4], scv[4], xv[4][4];
#pragma unroll
        for (int j = 0; j < 4; ++j)
#pragma unroll
            for (int i = 0; i < 4; ++i) xv[j][i] = *(const f32x4*)(xr + (size_t)(qb + j * 16 + fr) * D + pb + i * 16 + fq * 4);
#pragma unroll
        for (int i = 0; i < 4; ++i) { gv[i] = *(const f32x4*)(mt + 2 * D + i * 16); scv[i] = *(const f32x4*)(mt + 4 * D + i * 16); }
#pragma unroll
        for (int j = 0; j < 4; ++j) {
            const int t = qb + j * 16 + fr;
            float ss = 0.f;
#pragma unroll
            for (int i = 0; i < 4; ++i) {
                const int n = pb + i * 16 + fq * 4;
                const f32x4 xx = xv[j][i];
                f32x4 r; r.x = xx.x + gv[i].x * (acc[i][j].x * rb[j]); r.y = xx.y + gv[i].y * (acc[i][j].y * rb[j]); r.z = xx.z + gv[i].z * (acc[i][j].z * rb[j]); r.w = xx.w + gv[i].w * (acc[i][j].w * rb[j]);
                *(f32x4*)(outr + (size_t)t * D + n) = r;
                ss += (r.x * r.x + r.y * r.y) + (r.z * r.z + r.w * r.w);
                *(unsigned long long*)(yr + (size_t)t * D + n) = pk4(r.x * (1.f + scv[i].x), r.y * (1.f + scv[i].y), r.z * (1.f + scv[i].z), r.w * (1.f + scv[i].w));
            }
            ss += __shfl_xor(ss, 16); ss += __shfl_xor(ss, 32);
            if (fq == 0) sr[(size_t)t * 16 + (pb >> 6)] = ss;
        }
    }
};
struct EpiPQ {
    static constexpr bool HAS_MID = false;
    unsigned short* C; const float* ssq1; const float* bias;
    float r1[4];
    __device__ __forceinline__ void pre(int qb, int lane) {
#pragma unroll
        for (int j = 0; j < 4; ++j) {
            const f32x4* s4 = (const f32x4*)(ssq1 + (size_t)(qb + j * 16 + (lane & 15)) * 16);
            const f32x4 a0 = s4[0], a1 = s4[1], a2 = s4[2], a3 = s4[3];
            const float sa = ((a0.x + a0.y + a0.z + a0.w) + (a1.x + a1.y + a1.z + a1.w)) + ((a2.x + a2.y + a2.z + a2.w) + (a3.x + a3.y + a3.z + a3.w));
            r1[j] = rsqrtf(sa * (1.f / D) + EPS);
        }
    }
    template <class A> __device__ __forceinline__ void mid(A&) {}
    __device__ __forceinline__ void operator()(const f32x4 (&acc)[4][4], int pb, int qb, int lane, const float*, int, int = 0) {
        const int fr = lane & 15, fq = lane >> 4;
        unsigned short* __restrict__ Cr = C;
        const float* bt = bias + (qb >> 12) * 2048 + pb + fq * 4;
        f32x4 bv[4];
#pragma unroll
        for (int i = 0; i < 4; ++i) bv[i] = *(const f32x4*)(bt + i * 16);
#pragma unroll
        for (int j = 0; j < 4; ++j) {
            const int t = qb + j * 16 + fr;
#pragma unroll
            for (int i = 0; i < 4; ++i) {
                const int n = pb + i * 16 + fq * 4;
                *(unsigned long long*)(Cr + (size_t)t * 2048 + n) = pk4(acc[i][j].x * r1[j] + bv[i].x, acc[i][j].y * r1[j] + bv[i].y, acc[i][j].z * r1[j] + bv[i].z, acc[i][j].w * r1[j] + bv[i].w);
            }
        }
    }
};

struct EpiProj {
    static constexpr bool HAS_MID = false;
    __device__ __forceinline__ void pre(int, int) {}
    template <class A> __device__ __forceinline__ void mid(A&) {}
    unsigned char* ws;
    __device__ __forceinline__ void operator()(const f32x4 (&acc)[4][4], int pb, int qb, int lane, const float*, int, int = 0) const {
        const int fr = lane & 15, fq = lane >> 4;
        if (pb >= 1216) return;
        const int t0 = qb + fr, b = t0 >> 12, pos0 = t0 & (S - 1);
        if (pb < C_VA) {
            const float* __restrict__ cosA = (const float*)(ws + WS_COSA); const float* __restrict__ sinA = (const float*)(ws + WS_SINA);
            const bool isq = pb < C_KA;
            const int head = isq ? (pb >> 6) : ((pb - C_KA) >> 6);
            unsigned short* __restrict__ dst0 = isq ? (unsigned short*)(ws + WS_QA) + ((size_t)(b * 8 + head) * S + pos0) * 64 : (unsigned short*)(ws + WS_KA) + ((size_t)(b * 2 + head) * S + pos0) * 64;
            const float sc = isq ? QA_SCALE : 1.f;
#pragma unroll
            for (int jh = 0; jh < 4; jh += 2) {
                f32x4 c[2][2], sn[2][2];
#pragma unroll
                for (int jj = 0; jj < 2; ++jj)
#pragma unroll
                    for (int i = 0; i < 2; ++i) { c[jj][i] = *(const f32x4*)(cosA + (pos0 + 16 * (jh + jj)) * 32 + i * 16 + fq * 4); sn[jj][i] = *(const f32x4*)(sinA + (pos0 + 16 * (jh + jj)) * 32 + i * 16 + fq * 4); }
#pragma unroll
                for (int jj = 0; jj < 2; ++jj)
#pragma unroll
                    for (int i = 0; i < 2; ++i) {
                        const int j = jh + jj, d = i * 16 + fq * 4;
                        const f32x4 x1 = acc[i][j], x2 = acc[i + 2][j], cc = c[jj][i], ss = sn[jj][i];
                        unsigned short* dst = dst0 + (size_t)(16 * j) * 64;
                        *(unsigned long long*)(dst + d) = pk4((x1.x * cc.x - x2.x * ss.x) * sc, (x1.y * cc.y - x2.y * ss.y) * sc, (x1.z * cc.z - x2.z * ss.z) * sc, (x1.w * cc.w - x2.w * ss.w) * sc);
                        *(unsigned long long*)(dst + 32 + d) = pk4((x2.x * cc.x + x1.x * ss.x) * sc, (x2.y * cc.y + x1.y * ss.y) * sc, (x2.z * cc.z + x1.z * ss.z) * sc, (x2.w * cc.w + x1.w * ss.w) * sc);
                    }
            }
        } else if (pb < C_QL) {
            const int kvh = (pb - C_VA) >> 6;
            unsigned short* __restrict__ dst0 = (unsigned short*)(ws + WS_VAT) + (size_t)(b * 2 + kvh) * 64 * S + pos0;
#pragma unroll
            for (int j = 0; j < 4; ++j)
#pragma unroll
                for (int i = 0; i < 4; ++i) {
                    const int dv = i * 16 + fq * 4; unsigned short* dst = dst0 + 16 * j;
                    dst[(size_t)(dv + 0) * S] = (unsigned short)f2bf(acc[i][j].x); dst[(size_t)(dv + 1) * S] = (unsigned short)f2bf(acc[i][j].y);
                    dst[(size_t)(dv + 2) * S] = (unsigned short)f2bf(acc[i][j].z); dst[(size_t)(dv + 3) * S] = (unsigned short)f2bf(acc[i][j].w);
                }
        } else if (pb < C_KR) {
            const bool isq = pb < C_KVL;
            unsigned short* __restrict__ dst0 = isq ? (unsigned short*)(ws + WS_QL) + (size_t)t0 * 256 + (pb - C_QL) : (unsigned short*)(ws + WS_KVL) + (size_t)t0 * 128 + (pb - C_KVL);
            const int ld = isq ? 256 : 128;
#pragma unroll
            for (int j = 0; j < 4; ++j)
#pragma unroll
                for (int i = 0; i < 4; ++i) *(unsigned long long*)(dst0 + (size_t)(16 * j) * ld + i * 16 + fq * 4) = pk4(acc[i][j].x, acc[i][j].y, acc[i][j].z, acc[i][j].w);
        } else {
            const float* __restrict__ cosB = (const float*)(ws + WS_COSB); const float* __restrict__ sinB = (const float*)(ws + WS_SINB);
            unsigned short* __restrict__ K96 = (unsigned short*)(ws + WS_K96);
            const int d = fq * 4;
            f32x4 c[4], sn[4];
#pragma unroll
            for (int j = 0; j < 4; ++j) { c[j] = *(const f32x4*)(cosB + (pos0 + 16 * j) * 16 + d); sn[j] = *(const f32x4*)(sinB + (pos0 + 16 * j) * 16 + d); }
#pragma unroll
            for (int j = 0; j < 4; ++j) {
                const f32x4 x1 = acc[0][j], x2 = acc[1][j], cc = c[j], ss = sn[j];
                const unsigned long long lo = pk4(x1.x * cc.x - x2.x * ss.x, x1.y * cc.y - x2.y * ss.y, x1.z * cc.z - x2.z * ss.z, x1.w * cc.w - x2.w * ss.w);
                const unsigned long long hi = pk4(x2.x * cc.x + x1.x * ss.x, x2.y * cc.y + x1.y * ss.y, x2.z * cc.z + x1.z * ss.z, x2.w * cc.w + x1.w * ss.w);
#pragma unroll
                for (int h = 0; h < 8; ++h) {
                    unsigned short* dst = K96 + ((size_t)(b * 8 + h) * S + pos0 + 16 * j) * 96 + 64 + d;
                    *(unsigned long long*)dst = lo; *(unsigned long long*)(dst + 16) = hi;
                }
            }
        }
    }
};
struct EpiQup {
    unsigned char* ws;
    __device__ __forceinline__ void operator()(const f32x4 (&acc)[4][4], int pb, int qb, int lane, const float* ssq, int, int = 0) const {
        const int fr = lane & 15, fq = lane >> 4;
        unsigned short* __restrict__ QMB = (unsigned short*)(ws + WS_QMB);
        const float* __restrict__ cosB = (const float*)(ws + WS_COSB); const float* __restrict__ sinB = (const float*)(ws + WS_SINB);
        const int t0 = qb + fr, b = t0 >> 12, pos0 = t0 & (S - 1);
        float sc[4];
#pragma unroll
        for (int j = 0; j < 4; ++j) sc[j] = rsqrtf(ssq[j * 16 + fr] * (1.f / 256.f) + EPS) * QM_SCALE;
        if (pb < 512) {
            unsigned short* dst0 = QMB + ((size_t)(b * 8 + (pb >> 6)) * S + pos0) * 96;
#pragma unroll
            for (int j = 0; j < 4; ++j)
#pragma unroll
                for (int i = 0; i < 4; ++i) *(unsigned long long*)(dst0 + (size_t)(16 * j) * 96 + i * 16 + fq * 4) = pk4(acc[i][j].x * sc[j], acc[i][j].y * sc[j], acc[i][j].z * sc[j], acc[i][j].w * sc[j]);
        } else {
            const int d = fq * 4;
            f32x4 c[4], sn[4];
#pragma unroll
            for (int j = 0; j < 4; ++j) { c[j] = *(const f32x4*)(cosB + (pos0 + 16 * j) * 16 + d); sn[j] = *(const f32x4*)(sinB + (pos0 + 16 * j) * 16 + d); }
#pragma unroll
            for (int j = 0; j < 4; ++j)
#pragma unroll
                for (int hh = 0; hh < 2; ++hh) {
                    const int h = ((pb - 512) >> 5) + hh;
                    unsigned short* dst = QMB + ((size_t)(b * 8 + h) * S + pos0 + 16 * j) * 96 + 64 + d;
                    const f32x4 x1 = acc[2 * hh][j], x2 = acc[2 * hh + 1][j], cc = c[j], ss = sn[j]; const float s_ = sc[j];
                    *(unsigned long long*)dst = pk4((x1.x * cc.x - x2.x * ss.x) * s_, (x1.y * cc.y - x2.y * ss.y) * s_, (x1.z * cc.z - x2.z * ss.z) * s_, (x1.w * cc.w - x2.w * ss.w) * s_);
                    *(unsigned long long*)(dst + 16) = pk4((x2.x * cc.x + x1.x * ss.x) * s_, (x2.y * cc.y + x1.y * ss.y) * s_, (x2.z * cc.z + x1.z * ss.z) * s_, (x2.w * cc.w + x1.w * ss.w) * s_);
                }
        }
    }
};
struct EpiKVup {
    unsigned char* ws;
    __device__ __forceinline__ void operator()(const f32x4 (&acc)[4][4], int pb, int qb, int lane, const float* ssq, int, int = 0) const {
        const int fr = lane & 15, fq = lane >> 4;
        unsigned short* K96 = (unsigned short*)(ws + WS_K96); unsigned short* VT = (unsigned short*)(ws + WS_VT);
        const int h = pb >> 7;
#pragma unroll
        for (int j = 0; j < 4; ++j) {
            const int t = qb + j * 16 + fr, b = t >> 12, pos = t & (S - 1);
            const float sc = rsqrtf(ssq[j * 16 + fr] * (1.f / 128.f) + EPS);
            if ((pb & 64) == 0) {
                unsigned short* dst = K96 + ((size_t)(b * 8 + h) * S + pos) * 96;
#pragma unroll
                for (int i = 0; i < 4; ++i) *(unsigned long long*)(dst + i * 16 + fq * 4) = pk4(acc[i][j].x * sc, acc[i][j].y * sc, acc[i][j].z * sc, acc[i][j].w * sc);
            } else {
                unsigned short* dst = VT + (size_t)(b * 8 + h) * 64 * S + pos;
#pragma unroll
                for (int i = 0; i < 4; ++i) {
                    const int dv = i * 16 + fq * 4;
                    dst[(size_t)(dv + 0) * S] = (unsigned short)f2bf(acc[i][j].x * sc); dst[(size_t)(dv + 1) * S] = (unsigned short)f2bf(acc[i][j].y * sc);
                    dst[(size_t)(dv + 2) * S] = (unsigned short)f2bf(acc[i][j].z * sc); dst[(size_t)(dv + 3) * S] = (unsigned short)f2bf(acc[i][j].w * sc);
                }
            }
        }
    }
};

typedef float f32x16 __attribute__((ext_vector_type(16)));
typedef __bf16 bf16x2_t __attribute__((ext_vector_type(2)));
__device__ __forceinline__ unsigned cvtpk(float lo, float hi) { f32x2 v = {lo, hi}; bf16x2_t b = __builtin_convertvector(v, bf16x2_t); return __builtin_bit_cast(unsigned, b); }
__device__ __forceinline__ int crow(int r, int hi) { return (r & 3) + 8 * (r >> 2) + 4 * hi; }
__device__ __forceinline__ int kperm(int rho) { return (rho & 0x13) | ((rho & 4) << 1) | ((rho & 8) >> 1); }

template <int DQK, bool SWA>
__device__ void stage_attn_flash(const Params& p, unsigned char* lds) {
    constexpr int NK = DQK / 16, KCH = DQK / 8, KSTR = (KCH + 1) * 16, VSTR = 144;
    constexpr int KT_BYTES = 64 * KSTR, VT_BYTES = 64 * VSTR, STG = KT_BYTES + VT_BYTES, NKC = 64 * KCH;
    const unsigned short* Qg = (const unsigned short*)(p.ws + (SWA ? WS_QA : WS_QMB));
    const unsigned short* Kg = (const unsigned short*)(p.ws + (SWA ? WS_KA : WS_K96));
    const unsigned short* Vg = (const unsigned short*)(p.ws + (SWA ? WS_VAT : WS_VT));
    unsigned short* O = (unsigned short*)(p.ws + WS_OAB);
    const int tid = threadIdx.x, lane = tid & 63, wave = tid >> 6, r32 = lane & 31, hi = lane >> 5;
    const int G = gridDim.x, bx = blockIdx.x;
    const int vcu = (G % 8 == 0) ? (bx % 8) * (G / 8) + bx / 8 : bx;
    const int nunits = SWA ? Bsz * 2 * 64 : Bsz * 8 * 16;
    const int kro = kperm(r32) * KSTR + hi * 16;
    const int vro = r32 * VSTR + hi * 16;
    const int kid0 = tid, kid1 = tid + 512;
    const int k0row = kid0 / KCH, k0c = kid0 % KCH, k1row = kid1 / KCH, k1c = kid1 % KCH;
    const int vrow = tid >> 3, vc = tid & 7;
    for (int u = vcu; u < nunits; u += G) {
        int b, qb, tlo, thi, sq, ocol; const unsigned short *Qp, *Kb, *Vb; float m, l;
        if (SWA) {
            qb = u & 63; const int kvh = (u >> 6) & 1; b = u >> 7;
            const int head = kvh * 4 + (wave >> 1);
            sq = qb * 64 + (wave & 1) * 32 + r32;
            Qp = Qg + ((size_t)(b * 8 + head) * S + sq) * 64;
            Kb = Kg + (size_t)(b * 2 + kvh) * S * 64; Vb = Vg + (size_t)(b * 2 + kvh) * 64 * S;
            tlo = qb - 2 < 0 ? 0 : qb - 2; thi = qb + 2 > 63 ? 63 : qb + 2;
            m = p.sink[head] * LOG2E; l = 0.5f; ocol = head * 64;
        } else {
            qb = u & 15; const int h = (u >> 4) & 7; b = u >> 7;
            sq = qb * 256 + wave * 32 + r32;
            Qp = Qg + ((size_t)(b * 8 + h) * S + sq) * 96;
            Kb = Kg + (size_t)(b * 8 + h) * S * 96; Vb = Vg + (size_t)(b * 8 + h) * 64 * S;
            tlo = 0; thi = 63; m = 0.f; l = 0.f; ocol = 512 + h * 64;
        }
        bf16x8 qf[NK];
#pragma unroll
        for (int ks = 0; ks < NK; ++ks) qf[ks] = *(const bf16x8*)(Qp + ks * 16 + hi * 8);
        f32x16 o0, o1;
#pragma unroll
        for (int r = 0; r < 16; ++r) { o0[r] = 0.f; o1[r] = 0.f; }
        u32x4 rk0, rk1, rv;
        {
            const unsigned short* kt = Kb + (size_t)tlo * 64 * DQK;
            rk0 = *(const u32x4*)(kt + kid0 * 8);
            if (kid1 < NKC) rk1 = *(const u32x4*)(kt + kid1 * 8);
            rv = *(const u32x4*)(Vb + (size_t)vrow * S + tlo * 64 + vc * 8);
            *(u32x4*)(lds + k0row * KSTR + k0c * 16) = rk0;
            if (kid1 < NKC) *(u32x4*)(lds + k1row * KSTR + k1c * 16) = rk1;
            *(u32x4*)(lds + KT_BYTES + vrow * VSTR + vc * 16) = rv;
        }
        __syncthreads();
        for (int tt = tlo; tt <= thi; ++tt) {
            const unsigned char* Kl = lds + ((tt - tlo) & 1) * STG;
            const unsigned char* Vl = Kl + KT_BYTES;
            unsigned char* Kn = lds + (((tt - tlo) & 1) ^ 1) * STG;
            const bool more = tt < thi;
            if (more) {
                const unsigned short* kt = Kb + (size_t)(tt + 1) * 64 * DQK;
                rk0 = *(const u32x4*)(kt + kid0 * 8);
                if (kid1 < NKC) rk1 = *(const u32x4*)(kt + kid1 * 8);
                rv = *(const u32x4*)(Vb + (size_t)vrow * S + (tt + 1) * 64 + vc * 8);
            }
            f32x16 s0, s1;
            {
                const float nm = -m;
#pragma unroll
                for (int r = 0; r < 16; ++r) { s0[r] = nm; s1[r] = nm; }
            }
#pragma unroll
            for (int ks = 0; ks < NK; ++ks) {
                const bf16x8 kf0 = *(const bf16x8*)(Kl + kro + ks * 32);
                const bf16x8 kf1 = *(const bf16x8*)(Kl + 32 * KSTR + kro + ks * 32);
                s0 = __builtin_amdgcn_mfma_f32_32x32x16_bf16(kf0, qf[ks], s0, 0, 0, 0);
                s1 = __builtin_amdgcn_mfma_f32_32x32x16_bf16(kf1, qf[ks], s1, 0, 0, 0);
            }
            if (SWA) {
                const int rel = tt - qb;
                if (rel == -2 || rel == 2) {
                    const int qi = (wave & 1) * 32 + r32;
#pragma unroll
                    for (int r = 0; r < 16; ++r) {
                        const int kk = kperm(crow(r, hi));
                        const bool v0 = (rel == -2) ? (kk >= qi) : (kk <= qi);
                        const bool v1 = (rel == -2) ? (kk + 32 >= qi) : (kk + 32 <= qi);
                        s0[r] = v0 ? s0[r] : -1e30f; s1[r] = v1 ? s1[r] : -1e30f;
                    }
                }
            }
            if ((!SWA) && (tt == tlo)) {
                float mx = fmaxf(s0[0], s1[0]);
#pragma unroll
                for (int r = 1; r < 16; ++r) mx = fmaxf(mx, fmaxf(s0[r], s1[r]));
                mx = fmaxf(mx, __shfl_xor(mx, 32));
                m = mx;
#pragma unroll
                for (int r = 0; r < 16; ++r) { s0[r] -= mx; s1[r] -= mx; }
            }
            float rs = 0.f;
#pragma unroll
            for (int r = 0; r < 16; ++r) { s0[r] = __builtin_amdgcn_exp2f(s0[r]); s1[r] = __builtin_amdgcn_exp2f(s1[r]); rs += s0[r] + s1[r]; }
            if (!__all(rs <= 1024.f)) {
                float mp = fmaxf(s0[0], s1[0]);
#pragma unroll
                for (int r = 1; r < 16; ++r) mp = fmaxf(mp, fmaxf(s0[r], s1[r]));
                mp = fmaxf(fmaxf(mp, __shfl_xor(mp, 32)), 1.f);
                const float alpha = 1.f / mp;
                m += __builtin_amdgcn_logf(mp);
                l *= alpha; rs *= alpha;
#pragma unroll
                for (int r = 0; r < 16; ++r) { o0[r] *= alpha; o1[r] *= alpha; s0[r] *= alpha; s1[r] *= alpha; }
            }
            l += rs;
#pragma unroll
            for (int st = 0; st < 2; ++st) {
                u32x4 pw;
                pw.x = cvtpk(s0[8 * st + 0], s0[8 * st + 1]); pw.y = cvtpk(s0[8 * st + 2], s0[8 * st + 3]);
                pw.z = cvtpk(s0[8 * st + 4], s0[8 * st + 5]); pw.w = cvtpk(s0[8 * st + 6], s0[8 * st + 7]);
                const bf16x8 pf = __builtin_bit_cast(bf16x8, pw);
                const bf16x8 vf0 = *(const bf16x8*)(Vl + vro + st * 32);
                const bf16x8 vf1 = *(const bf16x8*)(Vl + 32 * VSTR + vro + st * 32);
                o0 = __builtin_amdgcn_mfma_f32_32x32x16_bf16(vf0, pf, o0, 0, 0, 0);
                o1 = __builtin_amdgcn_mfma_f32_32x32x16_bf16(vf1, pf, o1, 0, 0, 0);
            }
#pragma unroll
            for (int st = 0; st < 2; ++st) {
                u32x4 pw;
                pw.x = cvtpk(s1[8 * st + 0], s1[8 * st + 1]); pw.y = cvtpk(s1[8 * st + 2], s1[8 * st + 3]);
                pw.z = cvtpk(s1[8 * st + 4], s1[8 * st + 5]); pw.w = cvtpk(s1[8 * st + 6], s1[8 * st + 7]);
                const bf16x8 pf = __builtin_bit_cast(bf16x8, pw);
                const bf16x8 vf0 = *(const bf16x8*)(Vl + vro + 64 + st * 32);
                const bf16x8 vf1 = *(const bf16x8*)(Vl + 32 * VSTR + vro + 64 + st * 32);
                o0 = __builtin_amdgcn_mfma_f32_32x32x16_bf16(vf0, pf, o0, 0, 0, 0);
                o1 = __builtin_amdgcn_mfma_f32_32x32x16_bf16(vf1, pf, o1, 0, 0, 0);
            }
            if (more) {
                *(u32x4*)(Kn + k0row * KSTR + k0c * 16) = rk0;
                if (kid1 < NKC) *(u32x4*)(Kn + k1row * KSTR + k1c * 16) = rk1;
                *(u32x4*)(Kn + KT_BYTES + vrow * VSTR + vc * 16) = rv;
            }
            __syncthreads();
        }
        const float il = 1.f / (l + __shfl_xor(l, 32));
        {
            float ss = 0.f;
#pragma unroll
            for (int r = 0; r < 16; ++r) { const float a0 = o0[r] * il, a1 = o1[r] * il; ss += a0 * a0 + a1 * a1; }
            ss += __shfl_xor(ss, 32);
            if (hi == 0) ((float*)(p.ws + WS_SSQO))[(size_t)(b * S + sq) * 16 + (ocol >> 6)] = ss;
        }
        unsigned short* orow = O + (size_t)(b * S + sq) * D + ocol + 4 * hi;
#pragma unroll
        for (int g = 0; g < 4; ++g) {
            *(unsigned long long*)(orow + 8 * g) = (unsigned long long)cvtpk(o0[4 * g] * il, o0[4 * g + 1] * il) | ((unsigned long long)cvtpk(o0[4 * g + 2] * il, o0[4 * g + 3] * il) << 32);
            *(unsigned long long*)(orow + 32 + 8 * g) = (unsigned long long)cvtpk(o1[4 * g] * il, o1[4 * g + 1] * il) | ((unsigned long long)cvtpk(o1[4 * g + 2] * il, o1[4 * g + 3] * il) << 32);
        }
    }
}

__device__ __forceinline__ void ce_desc(int& a, int& b) { const int hi = max(a, b), lo = min(a, b); a = hi; b = lo; }
__device__ __forceinline__ void ce_asc(int& a, int& b) { const int hi = max(a, b), lo = min(a, b); a = lo; b = hi; }
template <int N, int OFF> __device__ __forceinline__ void bitonic_sort_desc(int (&a)[32]) {
#pragma unroll
    for (int k = 2; k <= N; k <<= 1)
#pragma unroll
        for (int j = k >> 1; j > 0; j >>= 1)
#pragma unroll
            for (int i = 0; i < N; ++i) {
                const int l = i ^ j;
                if (l > i) { if ((i & k) == 0) ce_desc(a[OFF + i], a[OFF + l]); else ce_asc(a[OFF + i], a[OFF + l]); }
            }
}
__device__ __forceinline__ void bitonic_clean16_desc(int (&a)[32]) {
#pragma unroll
    for (int j = 8; j > 0; j >>= 1)
#pragma unroll
        for (int i = 0; i < 16; ++i) { const int l = i ^ j; if (l > i) ce_desc(a[i], a[l]); }
}
__device__ __forceinline__ int f2sortable(float f) { const int b = __builtin_bit_cast(int, f); return b ^ ((b >> 31) & 0x7fffffff); }
__device__ __forceinline__ float sortable2f(int s) { return __builtin_bit_cast(float, s ^ ((s >> 31) & 0x7fffffff)); }
struct CandTab { int i[52], j[52]; };
constexpr CandTab make_cands() { CandTab t{}; int n = 0; for (int i = 0; i < 16; ++i) for (int j = 0; j < 16; ++j) if ((i + 1) * (j + 1) <= 16) { t.i[n] = i; t.j[n] = j; ++n; } for (; n < 52; ++n) { t.i[n] = -1; t.j[n] = -1; } return t; }
constexpr CandTab CANDS = make_cands();
struct EpiTopkSel {
    static constexpr bool HAS_MID = false;
    __device__ __forceinline__ void pre(int, int) {}
    template <class A> __device__ __forceinline__ void mid(A&) {}
    unsigned short* idx; float* g;
    int* keepg;
    __device__ __forceinline__ void operator()(const f32x4 (&acc)[8][2], int pb, int qb, int lane, const float*, int hp, int half) {
        const int fr = lane & 15, fq = lane >> 4;
#pragma unroll
        for (int j = 0; j < 2; ++j) {
            int v[32];
#pragma unroll
            for (int i = 0; i < 8; ++i)
#pragma unroll
                for (int r = 0; r < 4; ++r) v[i * 4 + r] = (f2sortable(acc[i][j][r]) & ~127) | (i * 16 + fq * 4 + r);
            bitonic_sort_desc<16, 0>(v); bitonic_sort_desc<16, 16>(v);
#pragma unroll
            for (int i = 0; i < 16; ++i) v[i] = max(v[i], v[31 - i]);
            bitonic_clean16_desc(v);
#pragma unroll
            for (int x = 16; x <= 32; x <<= 1) {
#pragma unroll
                for (int i = 0; i < 16; ++i) v[16 + i] = __shfl_xor(v[i], x);
#pragma unroll
                for (int i = 0; i < 16; ++i) v[i] = max(v[i], v[31 - i]);
                bitonic_clean16_desc(v);
            }
            u32x4* kp = (u32x4*)(keepg + ((qb & 255) + j * 16 + fr) * 16);
            if (half == 0) {
                if (fq == 0) {
#pragma unroll
                    for (int i = 0; i < 4; ++i) kp[i] = (u32x4){(unsigned)v[4 * i], (unsigned)v[4 * i + 1], (unsigned)v[4 * i + 2], (unsigned)v[4 * i + 3]};
                }
            } else {
                float as[16], bs[16]; int ai[16], bi[16];
#pragma unroll
                for (int i = 0; i < 4; ++i) {
                    const u32x4 kv = kp[i];
#pragma unroll
                    for (int c = 0; c < 4; ++c) { as[4 * i + c] = sortable2f((int)kv[c] & ~127); ai[4 * i + c] = ((int)kv[c] & 127) << 7; }
                }
#pragma unroll
                for (int i = 0; i < 16; ++i) { bs[i] = sortable2f(v[i] & ~127); bi[i] = v[i] & 127; }
                int w[32];
#pragma unroll
                for (int sl = 0; sl < 13; ++sl) {
                    int c4[4];
#pragma unroll
                    for (int f = 0; f < 4; ++f) {
                        constexpr int dummy = 0; (void)dummy;
                        const int ci = CANDS.i[sl * 4 + f], cj = CANDS.j[sl * 4 + f];
                        c4[f] = (ci >= 0) ? ((f2sortable(as[ci >= 0 ? ci : 0] + bs[cj >= 0 ? cj : 0]) & ~0x3fff) | (ai[ci >= 0 ? ci : 0] | bi[cj >= 0 ? cj : 0])) : (int)0x80000000;
                    }
                    w[sl] = (fq == 0) ? c4[0] : (fq == 1) ? c4[1] : (fq == 2) ? c4[2] : c4[3];
                }
                w[13] = w[14] = w[15] = (int)0x80000000;
                bitonic_sort_desc<16, 0>(w);
#pragma unroll
                for (int x = 16; x <= 32; x <<= 1) {
#pragma unroll
                    for (int i = 0; i < 16; ++i) w[16 + i] = __shfl_xor(w[i], x);
#pragma unroll
                    for (int i = 0; i < 16; ++i) w[i] = max(w[i], w[31 - i]);
                    bitonic_clean16_desc(w);
                }
                int my[4];
#pragma unroll
                for (int c = 0; c < 4; ++c) my[c] = (fq == 0) ? w[c] : (fq == 1) ? w[4 + c] : (fq == 2) ? w[8 + c] : w[12 + c];
                const float top = sortable2f(w[0] & ~0x3fff);
                float e[4], part = 0.f;
#pragma unroll
                for (int c = 0; c < 4; ++c) { e[c] = __expf(sortable2f(my[c] & ~0x3fff) - top); part += e[c]; }
                part += __shfl_xor(part, 16); part += __shfl_xor(part, 32);
                const float inv = 1.f / part;
                const int t = qb + j * 16 + fr;
                const size_t o = (size_t)t * 128 + (hp >> 1) * 16 + fq * 4;
                *(unsigned long long*)(idx + o) = (unsigned long long)(unsigned)((my[0] & 0x3fff) | ((my[1] & 0x3fff) << 16)) | ((unsigned long long)(unsigned)((my[2] & 0x3fff) | ((my[3] & 0x3fff) << 16)) << 32);
                *(f32x4*)(g + o) = (f32x4){e[0] * inv, e[1] * inv, e[2] * inv, e[3] * inv};
            }
        }
    }
};
__device__ void gemm_pq_fused(const Params& p, unsigned char* lds) {
    const unsigned short* X = (const unsigned short*)(p.ws + WS_WPQ);
    const unsigned short* Y = (const unsigned short*)(p.ws + WS_HB);
    const unsigned short* SK = (const unsigned short*)(p.ws + WS_SUBK);
    const float* ssq1 = (const float*)(p.ws + WS_SSQ1); const float* bias = (const float*)(p.ws + WS_BPQ);
    EpiTopkSel tsel{(unsigned short*)(p.ws + WS_IDX), (float*)(p.ws + WS_G), (int*)(p.ws + WS_KEEP) + (size_t)blockIdx.x * 4096};
    const int tid = threadIdx.x, lane = tid & 63, wave = __builtin_amdgcn_readfirstlane(tid >> 6);
    const int wp = wave >> 2, wq = wave & 3, fr = lane & 15, fq = lane >> 4;
    const int G = gridDim.x, bx = blockIdx.x;
    const int vcu = (G % 8 == 0) ? (bx % 8) * (G / 8) + bx / 8 : bx;
    const int srow = wave * 8 + (lane >> 3), pc = lane & 7, lc = pc ^ ((srow >> 1) & 7);
    constexpr int nk = D / TBK, nunits = 8 * (T / TQ);
    for (int u = vcu; u < nunits; u += G) {
        const int qt = u >> 3, h = u & 7, q0 = qt * TQ;
#pragma unroll
        for (int sub = 0; sub < 2; ++sub) {
            const int hp = h * 2 + sub, p0 = hp * TP;
            f32x4 acc[4][4];
#pragma unroll
            for (int i = 0; i < 4; ++i)
#pragma unroll
                for (int j = 0; j < 4; ++j) acc[i][j] = (f32x4){0.f, 0.f, 0.f, 0.f};
            const unsigned short* xg = X + (size_t)(p0 + srow) * D + lc * 8;
            const unsigned short* yg = Y + (size_t)(q0 + srow) * D + lc * 8;
            asm volatile("s_waitcnt vmcnt(0)" ::: "memory");
            RAW_BARRIER();
#define PQ_DMA_TILE(kt_, stg_) do { \
                unsigned char* _b = lds + (stg_) * STG_BYTES + wave * 1024; const int _k = (kt_) * TBK; \
                _Pragma("unroll") for (int _i = 0; _i < 2; ++_i) __builtin_amdgcn_global_load_lds((const unsigned*)(xg + (size_t)(64 * _i) * D + _k), (unsigned*)(_b + _i * 8192), 16, 0, 0); \
                _Pragma("unroll") for (int _i = 0; _i < 4; ++_i) __builtin_amdgcn_global_load_lds((const unsigned*)(yg + (size_t)(64 * _i) * D + _k), (unsigned*)(_b + XS_BYTES + _i * 8192), 16, 0, 0); \
            } while (0)
            PQ_DMA_TILE(0, 0);
            PQ_DMA_TILE(1, 1);
            int cur = 0;
            for (int kt = 0; kt < nk; ++kt) {
                if (kt + 1 < nk) asm volatile("s_waitcnt vmcnt(6)" ::: "memory"); else asm volatile("s_waitcnt vmcnt(0)" ::: "memory");
                RAW_BARRIER();
                if (kt + 2 < nk) { const int nxt = (cur == 0) ? 2 : cur - 1; PQ_DMA_TILE(kt + 2, nxt); }
                const unsigned char* st = lds + cur * STG_BYTES;
#pragma unroll
                for (int kk = 0; kk < 2; ++kk) {
                    bf16x8 af[4], bfr[4];
#pragma unroll
                    for (int i = 0; i < 4; ++i) af[i] = *(const bf16x8*)(st + swz(wp * 64 + i * 16 + fr, kk * 4 + fq));
#pragma unroll
                    for (int j = 0; j < 4; ++j) bfr[j] = *(const bf16x8*)(st + XS_BYTES + swz(wq * 64 + j * 16 + fr, kk * 4 + fq));
#pragma unroll
                    for (int i = 0; i < 4; ++i)
#pragma unroll
                        for (int j = 0; j < 4; ++j) acc[i][j] = __builtin_amdgcn_mfma_f32_16x16x32_bf16(af[i], bfr[j], acc[i][j], 0, 0, 0);
                }
                cur = (cur == 2) ? 0 : cur + 1;
            }
#undef PQ_DMA_TILE
            RAW_BARRIER();
            {
                float r1[4]; f32x4 bv[4];
#pragma unroll
                for (int j = 0; j < 4; ++j) {
                    const f32x4* s4 = (const f32x4*)(ssq1 + (size_t)(q0 + wq * 64 + j * 16 + fr) * 16);
                    const f32x4 a0 = s4[0], a1 = s4[1], a2 = s4[2], a3 = s4[3];
                    r1[j] = rsqrtf((((a0.x + a0.y + a0.z + a0.w) + (a1.x + a1.y + a1.z + a1.w)) + ((a2.x + a2.y + a2.z + a2.w) + (a3.x + a3.y + a3.z + a3.w))) * (1.f / D) + EPS);
                }
                {
                    const float* bt = bias + (q0 >> 12) * 2048 + p0 + wp * 64 + fq * 4;
#pragma unroll
                    for (int i = 0; i < 4; ++i) bv[i] = *(const f32x4*)(bt + i * 16);
                }
                const unsigned short* kg = SK + (size_t)hp * 128 * 128 + (size_t)srow * 128 + lc * 8;
#pragma unroll
                for (int s2 = 0; s2 < 2; ++s2)
#pragma unroll
                    for (int i = 0; i < 2; ++i) __builtin_amdgcn_global_load_lds((const unsigned*)(kg + (size_t)(64 * i) * 128 + s2 * 64), (unsigned*)(lds + s2 * STG_BYTES + wave * 1024 + i * 8192), 16, 0, 0);
                unsigned char* yb = lds + wp * STG_BYTES + XS_BYTES + (fq & 1) * 8;
#pragma unroll
                for (int j = 0; j < 4; ++j)
#pragma unroll
                    for (int i = 0; i < 4; ++i)
                        *(unsigned long long*)(yb + swz(wq * 64 + j * 16 + fr, 2 * i + (fq >> 1))) =
                            pk4(acc[i][j].x * r1[j] + bv[i].x, acc[i][j].y * r1[j] + bv[i].y, acc[i][j].z * r1[j] + bv[i].z, acc[i][j].w * r1[j] + bv[i].w);
            }
            asm volatile("s_waitcnt vmcnt(0)" ::: "memory");
            RAW_BARRIER();
            f32x4 sc2[8][2];
#pragma unroll
            for (int i = 0; i < 8; ++i)
#pragma unroll
                for (int j = 0; j < 2; ++j) sc2[i][j] = (f32x4){0.f, 0.f, 0.f, 0.f};
#pragma unroll
            for (int s2 = 0; s2 < 2; ++s2) {
                const unsigned char* st = lds + s2 * STG_BYTES;
#pragma unroll
                for (int kk = 0; kk < 2; ++kk) {
                    bf16x8 af[8], bfr[2];
#pragma unroll
                    for (int i = 0; i < 8; ++i) af[i] = *(const bf16x8*)(st + swz(i * 16 + fr, kk * 4 + fq));
#pragma unroll
                    for (int j = 0; j < 2; ++j) bfr[j] = *(const bf16x8*)(st + XS_BYTES + swz(wave * 32 + j * 16 + fr, kk * 4 + fq));
#pragma unroll
                    for (int i = 0; i < 8; ++i)
#pragma unroll
                        for (int j = 0; j < 2; ++j) sc2[i][j] = __builtin_amdgcn_mfma_f32_16x16x32_bf16(af[i], bfr[j], sc2[i][j], 0, 0, 0);
                }
            }
            tsel(sc2, 0, q0 + wave * 32, lane, (const float*)nullptr, hp, sub);
        }
    }
}

__device__ __forceinline__ void ld_row4(u32x4 (&d)[4], const unsigned char* tab, int id, int l16) {
    const u32x4* r = (const u32x4*)(tab + (size_t)id * D + l16 * 16);
#pragma unroll
    for (int j = 0; j < 4; ++j) d[j] = r[16 * j];
}
__device__ void stage_peer_u(const Params& p) {
    const unsigned short* h2 = (const unsigned short*)(p.ws + WS_HB);
    const float* mod = (const float*)(p.ws + WS_MOD);
    const unsigned short* idx = (const unsigned short*)(p.ws + WS_IDX); float* g = (float*)(p.ws + WS_G);
    const unsigned char* eu8 = p.ws + WS_EU8; const unsigned char* ev8 = p.ws + WS_EV8;
    const float* us = (const float*)(p.ws + WS_US); const float* vs = (const float*)(p.ws + WS_VS);
    const int lane = threadIdx.x & 63, wave = threadIdx.x >> 6, l16 = lane & 15, grp = lane >> 4;
    for (int t = blockIdx.x * NWAVES + wave; t < T; t += gridDim.x * NWAVES) {
        const int b = t >> 12;
        float hreg[64];
        const float rstd1 = rsqrtf(group16_sum(((const float*)(p.ws + WS_SSQ1))[(size_t)t * 16 + l16]) * (1.f / D) + EPS);
        const float* shf = mod + b * NMOD + 3 * D;
#pragma unroll
        for (int j = 0; j < 4; ++j)
#pragma unroll
            for (int c = 0; c < 2; ++c) {
                const u32x4 w = *(const u32x4*)(h2 + (size_t)t * D + j * 256 + l16 * 16 + c * 8);
                const f32x4 s0 = *(const f32x4*)(shf + j * 256 + l16 * 16 + c * 8), s1 = *(const f32x4*)(shf + j * 256 + l16 * 16 + c * 8 + 4);
                hreg[j * 16 + c * 8 + 0] = bflo(w.x) * rstd1 + s0.x; hreg[j * 16 + c * 8 + 1] = bfhi(w.x) * rstd1 + s0.y; hreg[j * 16 + c * 8 + 2] = bflo(w.y) * rstd1 + s0.z; hreg[j * 16 + c * 8 + 3] = bfhi(w.y) * rstd1 + s0.w;
                hreg[j * 16 + c * 8 + 4] = bflo(w.z) * rstd1 + s1.x; hreg[j * 16 + c * 8 + 5] = bfhi(w.z) * rstd1 + s1.y; hreg[j * 16 + c * 8 + 6] = bflo(w.w) * rstd1 + s1.z; hreg[j * 16 + c * 8 + 7] = bfhi(w.w) * rstd1 + s1.w;
            }
        const int idv0 = idx[(size_t)t * 128 + lane], idv1 = idx[(size_t)t * 128 + 64 + lane];
        const float gv0 = g[(size_t)t * 128 + lane], gv1 = g[(size_t)t * 128 + 64 + lane];
        float wv0 = 0.f, wv1 = 0.f;
        {
            u32x4 cur[4], nxt[4];
            int id_c = __shfl(idv0, grp);
            ld_row4(cur, eu8, id_c, l16);
            float sc_c = us[id_c];
#pragma unroll 2
            for (int q = 0; q < 32; ++q) {
                const int qn = (q + 1 < 32) ? q + 1 : q;
                const int rn = qn * 4 + grp;
                const int id_n = __shfl((qn < 16) ? idv0 : idv1, rn & 63);
                ld_row4(nxt, eu8, id_n, l16);
                const float sc_n = us[id_n];
                float s0 = 0.f, s1 = 0.f;
#pragma unroll
                for (int j = 0; j < 4; ++j)
#pragma unroll
                    for (int c = 0; c < 4; ++c) {
                        const int w = (int)cur[j][c];
                        const f32x2 lo = __builtin_amdgcn_cvt_pk_f32_fp8(w, false), hi = __builtin_amdgcn_cvt_pk_f32_fp8(w, true);
                        s0 += lo.x * hreg[j * 16 + c * 4 + 0]; s1 += lo.y * hreg[j * 16 + c * 4 + 1];
                        s0 += hi.x * hreg[j * 16 + c * 4 + 2]; s1 += hi.y * hreg[j * 16 + c * 4 + 3];
                    }
                const float s = group16_sum(s0 + s1) * sc_c;
                const float act = 0.5f * s * (1.f + erff(s * 0.70710678118654752f));
                const int r = q * 4 + grp;
                const float gk = __shfl((q < 16) ? gv0 : gv1, r & 63);
                const float w = gk * act;
                const float wt = __shfl(w, (lane & 3) * 16);
                const bool mine = (lane >> 2) == (q & 15);
                if (q < 16) wv0 = mine ? wt : wv0; else wv1 = mine ? wt : wv1;
#pragma unroll
                for (int j = 0; j < 4; ++j) cur[j] = nxt[j];
                sc_c = sc_n;
            }
        }
        g[(size_t)t * 128 + lane] = wv0; g[(size_t)t * 128 + 64 + lane] = wv1;
    }
}
__device__ void stage_peer_v(const Params& p, float* outp) {
    const float* mod = (const float*)(p.ws + WS_MOD);
    const unsigned short* idx = (const unsigned short*)(p.ws + WS_IDX); const float* g = (const float*)(p.ws + WS_G);
    const unsigned char* ev8 = p.ws + WS_EV8;
    const float* vs = (const float*)(p.ws + WS_VS);
    const int lane = threadIdx.x & 63, wave = threadIdx.x >> 6, l16 = lane & 15, grp = lane >> 4;
    for (int t = blockIdx.x * NWAVES + wave; t < T; t += gridDim.x * NWAVES) {
        const int b = t >> 12;
        const int idv0 = idx[(size_t)t * 128 + lane], idv1 = idx[(size_t)t * 128 + 64 + lane];
        const float wv0 = g[(size_t)t * 128 + lane], wv1 = g[(size_t)t * 128 + 64 + lane];
        float acc[64];
#pragma unroll
        for (int i = 0; i < 64; ++i) acc[i] = 0.f;
        {
            u32x4 cur[4], nxt[4];
            int id_c = __shfl(idv0, grp);
            ld_row4(cur, ev8, id_c, l16);
            float sc_c = vs[id_c];
#pragma unroll 2
            for (int q = 0; q < 32; ++q) {
                const int qn = (q + 1 < 32) ? q + 1 : q;
                const int rn = qn * 4 + grp;
                const int id_n = __shfl((qn < 16) ? idv0 : idv1, rn & 63);
                ld_row4(nxt, ev8, id_n, l16);
                const float sc_n = vs[id_n];
                const int r = q * 4 + grp;
                const float wv = __shfl((q < 16) ? wv0 : wv1, r & 63) * sc_c;
#pragma unroll
                for (int j = 0; j < 4; ++j)
#pragma unroll
                    for (int c = 0; c < 4; ++c) {
                        const int w = (int)cur[j][c];
                        const f32x2 lo = __builtin_amdgcn_cvt_pk_f32_fp8(w, false), hi = __builtin_amdgcn_cvt_pk_f32_fp8(w, true);
                        acc[j * 16 + c * 4 + 0] += wv * lo.x; acc[j * 16 + c * 4 + 1] += wv * lo.y;
                        acc[j * 16 + c * 4 + 2] += wv * hi.x; acc[j * 16 + c * 4 + 3] += wv * hi.y;
                    }
#pragma unroll
                for (int j = 0; j < 4; ++j) cur[j] = nxt[j];
                sc_c = sc_n;
            }
        }
#pragma unroll
        for (int i = 0; i < 64; ++i) { acc[i] += __shfl_xor(acc[i], 16); acc[i] += __shfl_xor(acc[i], 32); }
        float sel[16];
#pragma unroll
        for (int bb = 0; bb < 16; ++bb) sel[bb] = (grp == 0) ? acc[bb] : (grp == 1) ? acc[16 + bb] : (grp == 2) ? acc[32 + bb] : acc[48 + bb];
        const int eoff = grp * 256 + l16 * 16;
        const float* xin = p.out + (size_t)t * D + eoff;
        float* xr = outp + (size_t)t * D + eoff;
        const float* gf = mod + b * NMOD + 5 * D + eoff;
        float ss = 0.f;
#pragma unroll
        for (int c = 0; c < 4; ++c) {
            const f32x4 x1 = *(const f32x4*)(xin + c * 4); const f32x4 gg = *(const f32x4*)(gf + c * 4);
            sel[c * 4 + 0] = x1.x + gg.x * sel[c * 4 + 0]; sel[c * 4 + 1] = x1.y + gg.y * sel[c * 4 + 1];
            sel[c * 4 + 2] = x1.z + gg.z * sel[c * 4 + 2]; sel[c * 4 + 3] = x1.w + gg.w * sel[c * 4 + 3];
            ss += sel[c * 4 + 0] * sel[c * 4 + 0] + sel[c * 4 + 1] * sel[c * 4 + 1] + sel[c * 4 + 2] * sel[c * 4 + 2] + sel[c * 4 + 3] * sel[c * 4 + 3];
        }
        const float rstd = rsqrtf(wave_sum(ss) * (1.f / D) + EPS);
#pragma unroll
        for (int c = 0; c < 4; ++c) {
            const f32x4 fn = *(const f32x4*)(p.fnorm + eoff + c * 4);
            f32x4 r; r.x = sel[c * 4 + 0] * rstd * fn.x; r.y = sel[c * 4 + 1] * rstd * fn.y; r.z = sel[c * 4 + 2] * rstd * fn.z; r.w = sel[c * 4 + 3] * rstd * fn.w;
            *(f32x4*)(xr + c * 4) = r;
        }
    }
}

#define LAS __attribute__((address_space(3)))
constexpr size_t WS_BAR = 3 * MiB;
constexpr int BAR_BYTES = 16384;
constexpr int LDS_MISC_OFF = 147456;
#define XB_TMO      128
#define XB_XCNT(j)  (256  + 64 * (j))
#define XB_XSUB(j)  (1280 + 64 * (j))
#define XB_XGEN(j)  (2304 + 64 * (j))
#define XB_TOP      3328
#define XB_TOPGEN   3392
#define XB_SPIN_CAP (1u << 18)
__device__ __forceinline__ unsigned xb_ld(unsigned* p)              { return __hip_atomic_load(p, __ATOMIC_RELAXED, __HIP_MEMORY_SCOPE_AGENT); }
__device__ __forceinline__ unsigned xb_add(unsigned* p, unsigned v) { return __hip_atomic_fetch_add(p, v, __ATOMIC_RELAXED, __HIP_MEMORY_SCOPE_AGENT); }
__device__ __forceinline__ unsigned xb_xcc_id() { return (unsigned)__builtin_amdgcn_s_getreg((3 << 11) | 20) & 0xFu; }
#define XB_SPIN(cond, bar) do { unsigned _sp = 0; while (cond) { __builtin_amdgcn_s_sleep(1); \
    if ((++_sp & 255u) == 0u) { if (xb_ld(&(bar)[XB_TMO])) break; if (_sp > XB_SPIN_CAP) { atomicAdd(&(bar)[XB_TMO], 1u); break; } } } } while (0)
struct XcdBarrier { unsigned* bar; unsigned x; volatile LAS unsigned* st; };
__device__ __forceinline__ XcdBarrier xcd_barrier_post(unsigned* bar, volatile LAS unsigned* st) {
    XcdBarrier b; b.bar = bar; b.x = xb_xcc_id(); b.st = st;
    if (threadIdx.x == 0) (void)xb_add(&bar[XB_XCNT(b.x)], 1u);
    return b;
}
__device__ __forceinline__ void xcd_barrier_complete(unsigned* bar, unsigned x, unsigned& nloc, unsigned& nx) {
    const unsigned G = gridDim.x * gridDim.y * gridDim.z;
    unsigned sum, cnt, mine, sp = 0u;
    for (;;) {
        sum = 0u; cnt = 0u; mine = 0u;
#pragma unroll
        for (unsigned j = 0; j < 16; ++j) { const unsigned c = xb_ld(&bar[XB_XCNT(j)]); sum += c; cnt += (c > 0u) ? 1u : 0u; mine = (j == x) ? c : mine; }
        if (sum == G) break;
        __builtin_amdgcn_s_sleep(1);
        if ((++sp & 255u) == 0u) { if (xb_ld(&bar[XB_TMO])) break; if (sp > XB_SPIN_CAP) { atomicAdd(&bar[XB_TMO], 1u); break; } }
    }
    nloc = mine > 0u ? mine : 1u; nx = cnt > 0u ? cnt : 1u;
}
__device__ __forceinline__ void xcd_barrier(const XcdBarrier& b) {
    asm volatile("s_waitcnt vmcnt(0)" ::: "memory");
    __syncthreads();
    if (threadIdx.x == 0) {
        unsigned* bar = b.bar;
        __builtin_amdgcn_s_waitcnt(0);
        unsigned nloc = b.st[0], nx = b.st[1];
        if (nloc == 0u) { xcd_barrier_complete(bar, b.x, nloc, nx); b.st[0] = nloc; b.st[1] = nx; }
        const unsigned old = xb_add(&bar[XB_XSUB(b.x)], 1u);
        const unsigned gen = old / nloc;
        if (old + 1u == (gen + 1u) * nloc) {
            __builtin_amdgcn_fence(__ATOMIC_RELEASE, "agent");
            asm volatile("s_waitcnt vmcnt(0)" ::: "memory");
            const unsigned og = xb_add(&bar[XB_TOP], 1u);
            const unsigned tg = og / nx;
            if (og + 1u == (tg + 1u) * nx) xb_add(&bar[XB_TOPGEN], 1u);
            else XB_SPIN(xb_ld(&bar[XB_TOPGEN]) == tg, bar);
            __builtin_amdgcn_fence(__ATOMIC_ACQUIRE, "agent");
            xb_add(&bar[XB_XGEN(b.x)], 1u);
            asm volatile("s_waitcnt vmcnt(0)" ::: "memory");
        } else {
            XB_SPIN(xb_ld(&bar[XB_XGEN(b.x)]) == gen, bar);
            __builtin_amdgcn_fence(__ATOMIC_ACQUIRE, "agent");
            asm volatile("s_waitcnt vmcnt(0)" ::: "memory");
        }
    }
    __syncthreads();
}

__global__ void __launch_bounds__(NTHREADS) fwd_megakernel(Params p) {
    extern __shared__ __attribute__((aligned(16))) unsigned char lds_raw[];
    cg::grid_group grid = cg::this_grid();
    unsigned short* hb = (unsigned short*)(p.ws + WS_HB);
    const float* mod = (const float*)(p.ws + WS_MOD);
    typedef const unsigned short* cbf;

    volatile LAS unsigned* bst = (volatile LAS unsigned*)((LAS unsigned char*)lds_raw + LDS_MISC_OFF);
    if (threadIdx.x < 2) bst[threadIdx.x] = 0u;
    __syncthreads();
    const XcdBarrier xbar = xcd_barrier_post((unsigned*)(p.ws + WS_BAR), bst);
#ifdef PROBE_A
    for (int rep = 0, nrep = (p.ws != nullptr) ? 2 : 1; rep < nrep; ++rep) { if (rep) xcd_barrier(xbar);
#endif
    stage_prologue(p, (float*)lds_raw);
    grid.sync();
#ifdef PROBE_P1
    for (int rep = 0, nrep = (p.ws != nullptr) ? 2 : 1; rep < nrep; ++rep) { if (rep) xcd_barrier(xbar);
#endif
    stage_norm_mod<true>(p, p.x, hb, 0 * D, 1 * D);
    stage_gemv8(mod + 3 * D, NMOD, false, p.w_pq, 2048, nullptr, (float*)(p.ws + WS_BPQ), (float*)lds_raw);
#ifdef PROBE_P1
    }
#endif
    xcd_barrier(xbar);
    gemm_dma<2, 1>((cbf)(p.ws + WS_WIN), D, hb, D, 1280, T, D, 1, 0, 0, lds_raw, EpiProj{p.ws});
    xcd_barrier(xbar);
    gemm_xyT<2, true>((cbf)(p.ws + WS_WQUP), 256, (cbf)(p.ws + WS_QL), 256, 768, T, 256, 1, 0, 0, lds_raw, EpiQup{p.ws});
    gemm_xyT<2, true>((cbf)(p.ws + WS_WKVUP), 128, (cbf)(p.ws + WS_KVL), 128, 1024, T, 128, 1, 0, 0, lds_raw, EpiKVup{p.ws});
    xcd_barrier(xbar);
    stage_attn_flash<64, true>(p, lds_raw);
    stage_attn_flash<96, false>(p, lds_raw);
    xcd_barrier(xbar);
#ifdef PROBE_OUT
    for (int rep = 0, nrep = (p.ws != nullptr) ? 2 : 1; rep < nrep; ++rep) { if (rep) xcd_barrier(xbar);
#endif
    gemm_dma<2, 1>((cbf)(p.ws + WS_WOUT), D, (cbf)(p.ws + WS_OAB), D, D, T, D, 1, 0, 0, lds_raw,
                   EpiOutProj{p.x, mod, p.out, hb, (const float*)(p.ws + WS_SSQO), (float*)(p.ws + WS_SSQ1), {}, {}});
#ifdef PROBE_OUT
    }
#endif
    xcd_barrier(xbar);
    gemm_pq_fused(p, lds_raw);
    xcd_barrier(xbar);
    stage_peer_u(p);
    xcd_barrier(xbar);
    stage_peer_v(p, p.out);
}

extern "C" void kernel_launch(void* const* d_in, const int* in_sizes, int n_in, void* d_out, int out_size, void* d_ws, size_t ws_size, hipStream_t stream) {
    static int grid_blocks = 0;
    if (grid_blocks == 0) {
        if (n_in != 18 || in_sizes[0] != T * D || out_size != T * D || ws_size < WS_END) {
            fprintf(stderr, "kernel_launch: unexpected shapes (n_in %d, in0 %d, out %d, ws %zu); nothing launched\n", n_in, n_in > 0 ? in_sizes[0] : -1, out_size, ws_size);
            grid_blocks = -1; return;
        }
        int dev = 0, cus = 0, per_cu = 0;
        (void)hipGetDevice(&dev);
        (void)hipDeviceGetAttribute(&cus, hipDeviceAttributeMultiprocessorCount, dev);
        if (hipFuncSetAttribute((const void*)fwd_megakernel, hipFuncAttributeMaxDynamicSharedMemorySize, LDS_BYTES) != hipSuccess) { fprintf(stderr, "kernel_launch: hipFuncSetAttribute failed\n"); grid_blocks = -1; return; }
        (void)hipOccupancyMaxActiveBlocksPerMultiprocessor(&per_cu, fwd_megakernel, NTHREADS, LDS_BYTES);
        if (per_cu < 1) { fprintf(stderr, "kernel_launch: occupancy query says %d blocks/CU\n", per_cu); grid_blocks = -1; return; }
        grid_blocks = cus;
    }
    if (grid_blocks < 0) return;
    Params p{};
    p.x = (const float*)d_in[0]; p.c = (const float*)d_in[1]; p.w_ada = (const float*)d_in[2]; p.b_ada = (const float*)d_in[3];
    p.w_in = (const float*)d_in[4]; p.sink = (const float*)d_in[5]; p.qnorm = (const float*)d_in[6]; p.w_qup = (const float*)d_in[7];
    p.kvnorm = (const float*)d_in[8]; p.w_kvup = (const float*)d_in[9]; p.onorm_a = (const float*)d_in[10]; p.onorm_b = (const float*)d_in[11];
    p.w_out = (const float*)d_in[12]; p.w_pq = (const float*)d_in[13]; p.subk = (const float*)d_in[14]; p.eu = (const float*)d_in[15];
    p.ev = (const float*)d_in[16]; p.fnorm = (const float*)d_in[17];
    p.out = (float*)d_out; p.ws = (unsigned char*)d_ws;
    if (hipMemsetAsync((char*)d_ws + WS_BAR, 0, BAR_BYTES, stream) != hipSuccess) { fprintf(stderr, "kernel_launch: hipMemsetAsync failed\n"); return; }
    void* args[] = {&p};
    hipError_t e = hipLaunchCooperativeKernel((void*)fwd_megakernel, dim3(grid_blocks), dim3(NTHREADS), args, LDS_BYTES, stream);
    if (e != hipSuccess) fprintf(stderr, "cooperative launch failed: %s (grid %d)\n", hipGetErrorString(e), grid_blocks);
}
```

```cpp
#include <hip/hip_runtime.h>
#include <hip/hip_cooperative_groups.h>
#include <cstdio>
#include <cstdint>
namespace cg = cooperative_groups;

constexpr int Bsz = 8, S = 4096, D = 1024, T = Bsz * S;
constexpr int INW = 1184;
constexpr int C_QA = 0, C_KA = 512, C_VA = 640, C_QL = 768, C_KVL = 1024, C_KR = 1152;
constexpr int NMOD = 6 * D;
constexpr float EPS = 1e-6f;
constexpr float LOG2E = 1.4426950408889634f;
constexpr float QA_SCALE = 0.125f * LOG2E;
constexpr float QM_SCALE = 0.10206207261596575f * LOG2E;
constexpr int NTHREADS = 512, NWAVES = 8;

constexpr size_t MiB = 1u << 20;
constexpr size_t WS_MOD = 0;
constexpr size_t WS_COSA = 1 * MiB;
constexpr size_t WS_SINA = WS_COSA + 512 * 1024;
constexpr size_t WS_COSB = 2 * MiB;
constexpr size_t WS_SINB = WS_COSB + 256 * 1024;
constexpr size_t WS_WIN = 4 * MiB;
constexpr size_t WS_WQUP = 7 * MiB;
constexpr size_t WS_WKVUP = 7 * MiB + 512 * 1024;
constexpr size_t WS_WOUT = 8 * MiB;
constexpr size_t WS_WPQ = 10 * MiB;
constexpr size_t WS_SUBK = 14 * MiB;
constexpr size_t WS_EU8 = 16 * MiB;
constexpr size_t WS_EV8 = 32 * MiB;
constexpr size_t WS_US = 48 * MiB;
constexpr size_t WS_VS = WS_US + 64 * 1024;
constexpr size_t WS_HB = 52 * MiB;
constexpr size_t WS_QA = 116 * MiB;
constexpr size_t WS_KA = 148 * MiB;
constexpr size_t WS_VAT = 156 * MiB;
constexpr size_t WS_QL = 164 * MiB;
constexpr size_t WS_KVL = 180 * MiB;
constexpr size_t WS_QMB = 192 * MiB;
constexpr size_t WS_K96 = 240 * MiB;
constexpr size_t WS_VT = 288 * MiB;
constexpr size_t WS_OAB = 320 * MiB;
constexpr size_t WS_PQ = 116 * MiB;
constexpr size_t WS_TOPS = 244 * MiB;
constexpr size_t WS_TOPI = 276 * MiB;
constexpr size_t WS_IDX = 284 * MiB;
constexpr size_t WS_G = 292 * MiB;
constexpr size_t WS_SSQO = 49 * MiB;
constexpr size_t WS_SSQ1 = 384 * MiB;
constexpr size_t WS_BPQ = 3 * MiB + 64 * 1024;
constexpr size_t WS_KEEP = 386 * MiB;
constexpr size_t WS_END = 512 * MiB;
constexpr int LDS_BYTES = 148480;
constexpr int NEXP = 16384;

struct Params {
    const float *x, *c, *w_ada, *b_ada, *w_in, *sink, *qnorm, *w_qup, *kvnorm, *w_kvup, *onorm_a, *onorm_b, *w_out, *w_pq, *subk, *eu, *ev, *fnorm;
    float* out;
    unsigned char* ws;
};

typedef short bf16x8 __attribute__((ext_vector_type(8)));
typedef float f32x4 __attribute__((ext_vector_type(4)));
typedef unsigned u32x4 __attribute__((ext_vector_type(4)));
typedef float f32x2 __attribute__((ext_vector_type(2)));

__device__ __forceinline__ int tid_opaque() { int t = threadIdx.x; asm volatile("" : "+v"(t)); return t; }
__device__ __forceinline__ unsigned f2bf(float f) { unsigned u = __builtin_bit_cast(unsigned, f); return (u + 0x7fffu + ((u >> 16) & 1u)) >> 16; }
__device__ __forceinline__ unsigned pk2(float lo, float hi) { return f2bf(lo) | (f2bf(hi) << 16); }
__device__ __forceinline__ float bf2f(unsigned short h) { return __builtin_bit_cast(float, (unsigned)h << 16); }
__device__ __forceinline__ float bflo(unsigned w) { return __builtin_bit_cast(float, w << 16); }
__device__ __forceinline__ float bfhi(unsigned w) { return __builtin_bit_cast(float, w & 0xffff0000u); }
__device__ __forceinline__ float wave_sum(float v) {
#pragma unroll
    for (int o = 1; o < 64; o <<= 1) v += __shfl_xor(v, o);
    return v;
}

__device__ __forceinline__ float wave_max(float v) {
#pragma unroll
    for (int o = 1; o < 64; o <<= 1) v = fmaxf(v, __shfl_xor(v, o));
    return v;
}
template <int CTRL> __device__ __forceinline__ float dpp_add(float s) {
    return s + __builtin_bit_cast(float, __builtin_amdgcn_update_dpp(0, __builtin_bit_cast(int, s), CTRL, 0xF, 0xF, true));
}
__device__ __forceinline__ float group16_sum(float s) { s = dpp_add<0xB1>(s); s = dpp_add<0x4E>(s); s = dpp_add<0x141>(s); s = dpp_add<0x140>(s); return s; }

__device__ void stage_gemv8(const float* vec, int vstride, bool silu, const float* W, int N, const float* bias, float* dst, float* lds) {
    const int tid = threadIdx.x;
    __syncthreads();
    for (int i = tid; i < Bsz * D; i += NTHREADS) { const int b = i >> 10, k = i & 1023; float v = vec[b * vstride + k]; lds[i] = silu ? v / (1.f + __expf(-v)) : v; }
    __syncthreads();
    float* red = lds + Bsz * D;
    const int col_l = tid & 15, slice = tid >> 4;
    for (int item = blockIdx.x; item < N / 16; item += gridDim.x) {
        const int n = item * 16 + col_l;
        float acc[Bsz];
#pragma unroll
        for (int b = 0; b < Bsz; ++b) acc[b] = 0.f;
#pragma unroll 8
        for (int kk = 0; kk < 32; ++kk) {
            const int k = slice * 32 + kk;
            const float w = W[(size_t)k * N + n];
#pragma unroll
            for (int b = 0; b < Bsz; ++b) acc[b] += lds[b * D + k] * w;
        }
#pragma unroll
        for (int b = 0; b < Bsz; ++b) red[(slice * 16 + col_l) * Bsz + b] = acc[b];
        __syncthreads();
        if (tid < 128) {
            const int cc = tid >> 3, b = tid & 7;
            float sacc = 0.f;
#pragma unroll
            for (int sl = 0; sl < 32; ++sl) sacc += red[(sl * 16 + cc) * Bsz + b];
            dst[b * N + item * 16 + cc] = sacc + (bias ? bias[item * 16 + cc] : 0.f);
        }
        __syncthreads();
    }
}

template <int MAP> __device__ __forceinline__ int map_row(int n) {
    if (MAP == 1) { const int h = n / 96, j = n % 96; return j < 64 ? h * 64 + j : 512 + h * 32 + (j - 64); }
    return n;
}
template <int MAP>
__device__ __forceinline__ void transpose_item(const float* W, int K, int N, unsigned short* WT, const float* kgain, float* scr, int item, int lane, const float* kgain2 = nullptr) {
    const int nblk = N / 32, kb = item / nblk, nb = item % nblk, k0 = 64 * kb, n0 = 32 * nb;
#pragma unroll 8
    for (int i = 0; i < 32; ++i) {
        const int kk = 2 * i + (lane >> 5);
        float w = W[(size_t)(k0 + kk) * N + n0 + (lane & 31)];
        if (kgain) w *= (kgain2 && k0 + kk >= 512) ? kgain2[k0 + kk - 512] : kgain[k0 + kk];
        scr[kk * 33 + (lane & 31)] = w;
    }
    asm volatile("s_waitcnt lgkmcnt(0)" ::: "memory");
    const int c = lane & 7;
#pragma unroll
    for (int j = 0; j < 4; ++j) {
        const int n = (lane >> 3) + 8 * j; const float* q = scr + (8 * c) * 33 + n;
        u32x4 o; o.x = pk2(q[0 * 33], q[1 * 33]); o.y = pk2(q[2 * 33], q[3 * 33]); o.z = pk2(q[4 * 33], q[5 * 33]); o.w = pk2(q[6 * 33], q[7 * 33]);
        *(u32x4*)(WT + (size_t)map_row<MAP>(n0 + n) * K + k0 + 8 * c) = o;
    }
    asm volatile("s_waitcnt lgkmcnt(0)" ::: "memory");
}

__device__ void stage_prologue(const Params& p, float* lds) {
    const int tid = threadIdx.x;
    stage_gemv8(p.c, D, true, p.w_ada, NMOD, p.b_ada, (float*)(p.ws + WS_MOD), lds);
    float* cosA = (float*)(p.ws + WS_COSA); float* sinA = (float*)(p.ws + WS_SINA);
    float* cosB = (float*)(p.ws + WS_COSB); float* sinB = (float*)(p.ws + WS_SINB);
    const int gtid = blockIdx.x * NTHREADS + tid, gn = gridDim.x * NTHREADS;
    for (int e = gtid; e < S * 32; e += gn) {
        const int pos = e >> 5, i = e & 31;
        const double inv = exp2(-(double)(2 * i) / 64.0 * 13.287712379549449);
        const double a = (double)pos * inv;
        cosA[e] = (float)cos(a); sinA[e] = (float)sin(a);
    }
    for (int e = gtid; e < S * 16; e += gn) {
        const int pos = e >> 4, i = e & 15;
        const double inv = exp2(-(double)(2 * i) / 32.0 * 13.287712379549449);
        const double a = (double)pos * inv;
        cosB[e] = (float)cos(a); sinB[e] = (float)sin(a);
    }
    {
        const int lane = tid & 63, wave = tid >> 6;
        float* scr = lds + wave * (64 * 33);
        const int gw = blockIdx.x * NWAVES + wave, NGW = gridDim.x * NWAVES;
        constexpr int I_IN = (D / 64) * (INW / 32), I_QU = (256 / 64) * (768 / 32), I_KV = (128 / 64) * (1024 / 32), I_OUT = (D / 64) * (D / 32), I_PQ = (D / 64) * (2048 / 32);
        constexpr int NITEMS = I_IN + I_QU + I_KV + I_OUT + I_PQ;
        __syncthreads();
        for (int it = gw; it < NITEMS; it += NGW) {
            int r = it;
            if (r < I_IN) { transpose_item<0>(p.w_in, D, INW, (unsigned short*)(p.ws + WS_WIN), nullptr, scr, r, lane); continue; } r -= I_IN;
            if (r < I_QU) { transpose_item<1>(p.w_qup, 256, 768, (unsigned short*)(p.ws + WS_WQUP), p.qnorm, scr, r, lane); continue; } r -= I_QU;
            if (r < I_KV) { transpose_item<0>(p.w_kvup, 128, 1024, (unsigned short*)(p.ws + WS_WKVUP), p.kvnorm, scr, r, lane); continue; } r -= I_KV;
            if (r < I_OUT) { transpose_item<0>(p.w_out, D, D, (unsigned short*)(p.ws + WS_WOUT), p.onorm_a, scr, r, lane, p.onorm_b); continue; } r -= I_OUT;
            transpose_item<0>(p.w_pq, D, 2048, (unsigned short*)(p.ws + WS_WPQ), nullptr, scr, r, lane);
        }
        {
            u32x4* z = (u32x4*)(p.ws + WS_WIN + (size_t)INW * D * 2);
            const int nz = (1280 - INW) * D * 2 / 16;
            for (int e = blockIdx.x * NTHREADS + tid; e < nz; e += gridDim.x * NTHREADS) z[e] = (u32x4){0u, 0u, 0u, 0u};
        }
        {
            const f32x4* src = (const f32x4*)p.subk; unsigned long long* dst = (unsigned long long*)(p.ws + WS_SUBK);
            for (int e = blockIdx.x * NTHREADS + tid; e < 16 * 128 * 128 / 4; e += gridDim.x * NTHREADS) {
                const f32x4 v = src[e]; dst[e] = (unsigned long long)pk2(v.x, v.y) | ((unsigned long long)pk2(v.z, v.w) << 32);
            }
        }
    }
    {
        const int lane = tid & 63, wave = tid >> 6;
        for (int r = blockIdx.x * NWAVES + wave; r < 2 * NEXP; r += gridDim.x * NWAVES) {
            const int tab = r >= NEXP, row = r - tab * NEXP;
            const f32x4* src = (const f32x4*)((tab ? p.ev : p.eu) + (size_t)row * D) + lane;
            f32x4 v[4]; float am = 0.f;
#pragma unroll
            for (int j = 0; j < 4; ++j) { v[j] = src[64 * j]; am = fmaxf(am, fmaxf(fmaxf(fabsf(v[j].x), fabsf(v[j].y)), fmaxf(fabsf(v[j].z), fabsf(v[j].w)))); }
            am = wave_max(am);
            int ex = 0; (void)frexpf(am, &ex);
            const float sc = ldexpf(1.f, 8 - ex), isc = ldexpf(1.f, ex - 8);
            unsigned* dst = (unsigned*)(p.ws + (tab ? WS_EV8 : WS_EU8) + (size_t)row * D) + lane;
#pragma unroll
            for (int j = 0; j < 4; ++j) {
                int w = 0;
                w = __builtin_amdgcn_cvt_pk_fp8_f32(v[j].x * sc, v[j].y * sc, w, false);
                w = __builtin_amdgcn_cvt_pk_fp8_f32(v[j].z * sc, v[j].w * sc, w, true);
                dst[64 * j] = (unsigned)w;
            }
            if (lane == 0) ((float*)(p.ws + (tab ? WS_VS : WS_US)))[row] = isc;
        }
    }
}

template <bool BF>
__device__ void stage_norm_mod(const Params& p, const float* src, void* dstv, int sh_off, int sc_off) {
    const float* mod = (const float*)(p.ws + WS_MOD);
    const int lane = threadIdx.x & 63, wave = threadIdx.x >> 6;
    for (int t = blockIdx.x * NWAVES + wave; t < T; t += gridDim.x * NWAVES) {
        const int b = t >> 12;
        const f32x4* xr = (const f32x4*)(src + (size_t)t * D) + lane;
        f32x4 v[4]; float s = 0.f;
#pragma unroll
        for (int j = 0; j < 4; ++j) { v[j] = xr[64 * j]; s += v[j].x * v[j].x + v[j].y * v[j].y + v[j].z * v[j].z + v[j].w * v[j].w; }
        const float rstd = rsqrtf(wave_sum(s) * (1.f / D) + EPS);
#pragma unroll
        for (int j = 0; j < 4; ++j) {
            const f32x4 sh = *((const f32x4*)(mod + b * NMOD + sh_off) + lane + 64 * j);
            const f32x4 sc = *((const f32x4*)(mod + b * NMOD + sc_off) + lane + 64 * j);
            f32x4 r;
            r.x = v[j].x * rstd * (1.f + sc.x) + sh.x; r.y = v[j].y * rstd * (1.f + sc.y) + sh.y;
            r.z = v[j].z * rstd * (1.f + sc.z) + sh.z; r.w = v[j].w * rstd * (1.f + sc.w) + sh.w;
            if (BF) ((unsigned long long*)((unsigned short*)dstv + (size_t)t * D))[lane + 64 * j] = (unsigned long long)pk2(r.x, r.y) | ((unsigned long long)pk2(r.z, r.w) << 32);
            else ((f32x4*)((float*)dstv + (size_t)t * D))[lane + 64 * j] = r;
        }
    }
}

constexpr int TP = 128, TQ = 256, TBK = 64;
constexpr int XS_BYTES = TP * 128, YS_BYTES = TQ * 128, STG_BYTES = XS_BYTES + YS_BYTES;
__device__ __forceinline__ int swz(int r, int c) { return r * 128 + ((c ^ ((r >> 1) & 7)) << 4); }
constexpr int SSQ_OFF = 2 * (TP * 128 + TQ * 128);
__device__ __forceinline__ float ssq8(u32x4 w) {
    const float a0 = bflo(w.x), a1 = bfhi(w.x), a2 = bflo(w.y), a3 = bfhi(w.y), a4 = bflo(w.z), a5 = bfhi(w.z), a6 = bflo(w.w), a7 = bfhi(w.w);
    return (a0 * a0 + a1 * a1) + (a2 * a2 + a3 * a3) + (a4 * a4 + a5 * a5) + (a6 * a6 + a7 * a7);
}
template <int WPN, bool YSSQ, class Epi>
__device__ void gemm_xyT(const unsigned short* X, int ldx, const unsigned short* Y, int ldy, int P, int Q, int K, int nb, size_t xbs, size_t ybs, unsigned char* lds, const Epi& epi) {
    constexpr int WQN = 8 / WPN, FI = TP / (WPN * 16), FJ = TQ / (WQN * 16);
    const int tid = threadIdx.x, lane = tid & 63, wave = tid >> 6;
    const int wp = wave / WQN, wq = wave % WQN, fr = lane & 15, fq = lane >> 4;
    const int nPt = P / TP, nQt = Q / TQ, npb = nPt * nb, nunits = npb * nQt;
    const int G = gridDim.x, bx = blockIdx.x;
    const int vcu = (G % 8 == 0) ? (bx % 8) * (G / 8) + bx / 8 : bx;
    const int srow = tid >> 3, sc = tid & 7;
    const int nk = K / TBK;
    for (int u = vcu; u < nunits; u += G) {
        const int qt = u / npb, rem = u % npb, bi = rem / nPt, pt = rem % nPt, p0 = pt * TP, q0 = qt * TQ;
        f32x4 acc[FI][FJ];
#pragma unroll
        for (int i = 0; i < FI; ++i)
#pragma unroll
            for (int j = 0; j < FJ; ++j) acc[i][j] = (f32x4){0.f, 0.f, 0.f, 0.f};
        const unsigned short* xg = X + (size_t)bi * xbs + (size_t)(p0 + srow) * ldx + sc * 8;
        const unsigned short* yg = Y + (size_t)bi * ybs + (size_t)(q0 + srow) * ldy + sc * 8;
        u32x4 rx[2], ry[4];
        float sq[4] = {0.f, 0.f, 0.f, 0.f};
#pragma unroll
        for (int i = 0; i < 2; ++i) rx[i] = *(const u32x4*)(xg + (size_t)(64 * i) * ldx);
#pragma unroll
        for (int i = 0; i < 4; ++i) ry[i] = *(const u32x4*)(yg + (size_t)(64 * i) * ldy);
        if (YSSQ) {
#pragma unroll
            for (int i = 0; i < 4; ++i) sq[i] += ssq8(ry[i]);
        }
        __syncthreads();
#pragma unroll
        for (int i = 0; i < 2; ++i) *(u32x4*)(lds + swz(srow + 64 * i, sc)) = rx[i];
#pragma unroll
        for (int i = 0; i < 4; ++i) *(u32x4*)(lds + XS_BYTES + swz(srow + 64 * i, sc)) = ry[i];
        __syncthreads();
        for (int kt = 0; kt < nk; ++kt) {
            unsigned char* st = lds + (kt & 1) * STG_BYTES;
            unsigned char* sn = lds + ((kt & 1) ^ 1) * STG_BYTES;
            const bool more = (kt + 1 < nk);
            if (more) {
                const int k1 = (kt + 1) * TBK;
#pragma unroll
                for (int i = 0; i < 2; ++i) rx[i] = *(const u32x4*)(xg + (size_t)(64 * i) * ldx + k1);
#pragma unroll
                for (int i = 0; i < 4; ++i) ry[i] = *(const u32x4*)(yg + (size_t)(64 * i) * ldy + k1);
            }
            if (YSSQ && more) {
#pragma unroll
                for (int i = 0; i < 4; ++i) sq[i] += ssq8(ry[i]);
            }
#pragma unroll
            for (int kk = 0; kk < 2; ++kk) {
                bf16x8 af[FI], bfr[FJ];
#pragma unroll
                for (int i = 0; i < FI; ++i) af[i] = *(const bf16x8*)(st + swz(wp * (FI * 16) + i * 16 + fr, kk * 4 + fq));
#pragma unroll
                for (int j = 0; j < FJ; ++j) bfr[j] = *(const bf16x8*)(st + XS_BYTES + swz(wq * (FJ * 16) + j * 16 + fr, kk * 4 + fq));
#pragma unroll
                for (int i = 0; i < FI; ++i)
#pragma unroll
                    for (int j = 0; j < FJ; ++j) acc[i][j] = __builtin_amdgcn_mfma_f32_16x16x32_bf16(af[i], bfr[j], acc[i][j], 0, 0, 0);
            }
            if (more) {
#pragma unroll
                for (int i = 0; i < 2; ++i) *(u32x4*)(sn + swz(srow + 64 * i, sc)) = rx[i];
#pragma unroll
                for (int i = 0; i < 4; ++i) *(u32x4*)(sn + XS_BYTES + swz(srow + 64 * i, sc)) = ry[i];
            }
            __syncthreads();
        }
        if (YSSQ) {
            float* ssq = (float*)(lds + SSQ_OFF);
#pragma unroll
            for (int i = 0; i < 4; ++i) {
                float v = sq[i];
                v += __shfl_xor(v, 1); v += __shfl_xor(v, 2); v += __shfl_xor(v, 4);
                if (sc == 0) ssq[srow + 64 * i] = v;
            }
            __syncthreads();
        }
        epi(acc, p0 + wp * (FI * 16), q0 + wq * (FJ * 16), lane, (const float*)(lds + SSQ_OFF) + wq * (FJ * 16), bi);
        if (YSSQ) __syncthreads();
    }
}
constexpr int DMA_STAGES = 3;
#define RAW_BARRIER() do { asm volatile("s_waitcnt lgkmcnt(0)" ::: "memory"); __builtin_amdgcn_s_barrier(); } while (0)
template <int WPN, int SUB, class Epi>
__device__ void gemm_dma(const unsigned short* X, int ldx, const unsigned short* Y, int ldy, int P, int Q, int K, int nb, size_t xbs, size_t ybs, unsigned char* lds, Epi epi) {
    constexpr int WQN = 8 / WPN, FI = TP / (WPN * 16), FJ = TQ / (WQN * 16);
    const int tid = threadIdx.x, lane = tid & 63, wave = __builtin_amdgcn_readfirstlane(tid >> 6);
    const int wp = wave / WQN, wq = wave % WQN, fr = lane & 15, fq = lane >> 4;
    const int nPt = P / TP, nQt = Q / TQ, npb = nPt * nb / SUB, nunits = npb * nQt;
    const int G = gridDim.x, bx = blockIdx.x;
    const int vcu = (G % 8 == 0) ? (bx % 8) * (G / 8) + bx / 8 : bx;
    const int srow = wave * 8 + (lane >> 3), pc = lane & 7;
    const int nk = K / TBK;
    const int lc = pc ^ ((srow >> 1) & 7);
    for (int u = vcu; u < nunits; u += G)
#pragma unroll
    for (int sub = 0; sub < SUB; ++sub) {
        const int qt = u / npb, rem = (u % npb) * SUB + sub, bi = rem / nPt, pt = rem % nPt, p0 = pt * TP, q0 = qt * TQ;
        f32x4 acc[FI][FJ];
#pragma unroll
        for (int i = 0; i < FI; ++i)
#pragma unroll
            for (int j = 0; j < FJ; ++j) acc[i][j] = (f32x4){0.f, 0.f, 0.f, 0.f};
        const unsigned short* xg = X + (size_t)bi * xbs + (size_t)(p0 + srow) * ldx + lc * 8;
        const unsigned short* yg = Y + (size_t)bi * ybs + (size_t)(q0 + srow) * ldy + lc * 8;
        epi.pre(q0 + wq * (FJ * 16), lane);
        asm volatile("s_waitcnt vmcnt(0)" ::: "memory");
        RAW_BARRIER();
#define GEMM_DMA_TILE(kt_, stg_) do { \
            unsigned char* _b = lds + (stg_) * STG_BYTES + wave * 1024; const int _k = (kt_) * TBK; \
            _Pragma("unroll") for (int _i = 0; _i < 2; ++_i) __builtin_amdgcn_global_load_lds((const unsigned*)(xg + (size_t)(64 * _i) * ldx + _k), (unsigned*)(_b + _i * 8192), 16, 0, 0); \
            _Pragma("unroll") for (int _i = 0; _i < 4; ++_i) __builtin_amdgcn_global_load_lds((const unsigned*)(yg + (size_t)(64 * _i) * ldy + _k), (unsigned*)(_b + XS_BYTES + _i * 8192), 16, 0, 0); \
        } while (0)
        GEMM_DMA_TILE(0, 0);
        GEMM_DMA_TILE(1, 1);
        int cur = 0;
        for (int kt = 0; kt < nk; ++kt) {
            if (kt + 1 < nk) asm volatile("s_waitcnt vmcnt(6)" ::: "memory"); else asm volatile("s_waitcnt vmcnt(0)" ::: "memory");
            RAW_BARRIER();
            if (kt + 2 < nk) { const int nxt = (cur == 0) ? 2 : cur - 1; GEMM_DMA_TILE(kt + 2, nxt); }
            const unsigned char* st = lds + cur * STG_BYTES;
#pragma unroll
            for (int kk = 0; kk < 2; ++kk) {
                bf16x8 af[FI], bfr[FJ];
#pragma unroll
                for (int i = 0; i < FI; ++i) af[i] = *(const bf16x8*)(st + swz(wp * (FI * 16) + i * 16 + fr, kk * 4 + fq));
#pragma unroll
                for (int j = 0; j < FJ; ++j) bfr[j] = *(const bf16x8*)(st + XS_BYTES + swz(wq * (FJ * 16) + j * 16 + fr, kk * 4 + fq));
#pragma unroll
                for (int i = 0; i < FI; ++i)
#pragma unroll
                    for (int j = 0; j < FJ; ++j) acc[i][j] = __builtin_amdgcn_mfma_f32_16x16x32_bf16(af[i], bfr[j], acc[i][j], 0, 0, 0);
            }
            cur = (cur == 2) ? 0 : cur + 1;
            if (Epi::HAS_MID && kt + 1 == (nk >> 1)) epi.mid(acc);
        }
#undef GEMM_DMA_TILE
        epi(acc, p0 + wp * (FI * 16), q0 + wq * (FJ * 16), lane, (const float*)nullptr, bi, sub);
    }
}
__device__ __forceinline__ unsigned long long pk4(float a, float b, float c, float d) { return (unsigned long long)pk2(a, b) | ((unsigned long long)pk2(c, d) << 32); }
struct EpiOutProj {
    static constexpr bool HAS_MID = true;
    const float* x; const float* mod; float* out; unsigned short* y1; const float* ssqo; float* ssq1;
    float ratio[4], rb[4];
    __device__ __forceinline__ void pre(int qb, int lane) {
#pragma unroll
        for (int j = 0; j < 4; ++j) {
            const f32x4* s4 = (const f32x4*)(ssqo + (size_t)(qb + j * 16 + (lane & 15)) * 16);
            const f32x4 a0 = s4[0], a1 = s4[1], b0 = s4[2], b1 = s4[3];
            const float sa = (a0.x + a0.y + a0.z + a0.w) + (a1.x + a1.y + a1.z + a1.w), sb = (b0.x + b0.y + b0.z + b0.w) + (b1.x + b1.y + b1.z + b1.w);
            const float ra = rsqrtf(sa * (1.f / 512.f) + EPS); rb[j] = rsqrtf(sb * (1.f / 512.f) + EPS); ratio[j] = ra / rb[j];
        }
    }
    __device__ __forceinline__ void mid(f32x4 (&acc)[4][4]) {
#pragma unroll
        for (int i = 0; i < 4; ++i)
#pragma unroll
            for (int j = 0; j < 4; ++j) { acc[i][j].x *= ratio[j]; acc[i][j].y *= ratio[j]; acc[i][j].z *= ratio[j]; acc[i][j].w *= ratio[j]; }
    }
    __device__ __forceinline__ void operator()(const f32x4 (&acc)[4][4], int pb, int qb, int lane, const float*, int, int = 0) {
        const int fr = lane & 15, fq = lane >> 4;
        const float* __restrict__ xr = x; float* __restrict__ outr = out; unsigned short* __restrict__ yr = y1; float* __restrict__ sr = ssq1;
        const float* mt = mod + (qb >> 12) * NMOD + pb + fq * 4;
        f32x4 gv[4], scv[4], xv[4][4];
#pragma unroll
        for (int j = 0; j < 4; ++j)
#pragma unroll
            for (int i = 0; i < 4; ++i) xv[j][i] = *(const f32x4*)(xr + (size_t)(qb + j * 16 + fr) * D + pb + i * 16 + fq * 4);
#pragma unroll
        for (int i = 0; i < 4; ++i) { gv[i] = *(const f32x4*)(mt + 2 * D + i * 16); scv[i] = *(const f32x4*)(mt + 4 * D + i * 16); }
#pragma unroll
        for (int j = 0; j < 4; ++j) {
            const int t = qb + j * 16 + fr;
            float ss = 0.f;
#pragma unroll
            for (int i = 0; i < 4; ++i) {
                const int n = pb + i * 16 + fq * 4;
                const f32x4 xx = xv[j][i];
                f32x4 r; r.x = xx.x + gv[i].x * (acc[i][j].x * rb[j]); r.y = xx.y + gv[i].y * (acc[i][j].y * rb[j]); r.z = xx.z + gv[i].z * (acc[i][j].z * rb[j]); r.w = xx.w + gv[i].w * (acc[i][j].w * rb[j]);
                *(f32x4*)(outr + (size_t)t * D + n) = r;
                ss += (r.x * r.x + r.y * r.y) + (r.z * r.z + r.w * r.w);
                *(unsigned long long*)(yr + (size_t)t * D + n) = pk4(r.x * (1.f + scv[i].x), r.y * (1.f + scv[i].y), r.z * (1.f + scv[i].z), r.w * (1.f + scv[i].w));
            }
            ss += __shfl_xor(ss, 16); ss += __shfl_xor(ss, 32);
            if (fq == 0) sr[(size_t)t * 16 + (pb >> 6)] = ss;
        }
    }
};
struct EpiPQ {
    static constexpr bool HAS_MID = false;
    unsigned short* C; const float* ssq1; const float* bias;
    float r1[4];
    __device__ __forceinline__ void pre(int qb, int lane) {
#pragma unroll
        for (int j = 0; j < 4; ++j) {
            const f32x4* s4 = (const f32x4*)(ssq1 + (size_t)(qb + j * 16 + (lane & 15)) * 16);
            const f32x4 a0 = s4[0], a1 = s4[1], a2 = s4[2], a3 = s4[3];
            const float sa = ((a0.x + a0.y + a0.z + a0.w) + (a1.x + a1.y + a1.z + a1.w)) + ((a2.x + a2.y + a2.z + a2.w) + (a3.x + a3.y + a3.z + a3.w));
            r1[j] = rsqrtf(sa * (1.f / D) + EPS);
        }
    }
    template <class A> __device__ __forceinline__ void mid(A&) {}
    __device__ __forceinline__ void operator()(const f32x4 (&acc)[4][4], int pb, int qb, int lane, const float*, int, int = 0) {
        const int fr = lane & 15, fq = lane >> 4;
        unsigned short* __restrict__ Cr = C;
        const float* bt = bias + (qb >> 12) * 2048 + pb + fq * 4;
        f32x4 bv[4];
#pragma unroll
        for (int i = 0; i < 4; ++i) bv[i] = *(const f32x4*)(bt + i * 16);
#pragma unroll
        for (int j = 0; j < 4; ++j) {
            const int t = qb + j * 16 + fr;
#pragma unroll
            for (int i = 0; i < 4; ++i) {
                const int n = pb + i * 16 + fq * 4;
                *(unsigned long long*)(Cr + (size_t)t * 2048 + n) = pk4(acc[i][j].x * r1[j] + bv[i].x, acc[i][j].y * r1[j] + bv[i].y, acc[i][j].z * r1[j] + bv[i].z, acc[i][j].w * r1[j] + bv[i].w);
            }
        }
    }
};

struct EpiProj {
    static constexpr bool HAS_MID = false;
    __device__ __forceinline__ void pre(int, int) {}
    template <class A> __device__ __forceinline__ void mid(A&) {}
    unsigned char* ws;
    __device__ __forceinline__ void operator()(const f32x4 (&acc)[4][4], int pb, int qb, int lane, const float*, int, int = 0) const {
        const int fr = lane & 15, fq = lane >> 4;
        if (pb >= 1216) return;
        const int t0 = qb + fr, b = t0 >> 12, pos0 = t0 & (S - 1);
        if (pb < C_VA) {
            const float* __restrict__ cosA = (const float*)(ws + WS_COSA); const float* __restrict__ sinA = (const float*)(ws + WS_SINA);
            const bool isq = pb < C_KA;
            const int head = isq ? (pb >> 6) : ((pb - C_KA) >> 6);
            unsigned short* __restrict__ dst0 = isq ? (unsigned short*)(ws + WS_QA) + ((size_t)(b * 8 + head) * S + pos0) * 64 : (unsigned short*)(ws + WS_KA) + ((size_t)(b * 2 + head) * S + pos0) * 64;
            const float sc = isq ? QA_SCALE : 1.f;
#pragma unroll
            for (int jh = 0; jh < 4; jh += 2) {
                f32x4 c[2][2], sn[2][2];
#pragma unroll
                for (int jj = 0; jj < 2; ++jj)
#pragma unroll
                    for (int i = 0; i < 2; ++i) { c[jj][i] = *(const f32x4*)(cosA + (pos0 + 16 * (jh + jj)) * 32 + i * 16 + fq * 4); sn[jj][i] = *(const f32x4*)(sinA + (pos0 + 16 * (jh + jj)) * 32 + i * 16 + fq * 4); }
#pragma unroll
                for (int jj = 0; jj < 2; ++jj)
#pragma unroll
                    for (int i = 0; i < 2; ++i) {
                        const int j = jh + jj, d = i * 16 + fq * 4;
                        const f32x4 x1 = acc[i][j], x2 = acc[i + 2][j], cc = c[jj][i], ss = sn[jj][i];
                        unsigned short* dst = dst0 + (size_t)(16 * j) * 64;
                        *(unsigned long long*)(dst + d) = pk4((x1.x * cc.x - x2.x * ss.x) * sc, (x1.y * cc.y - x2.y * ss.y) * sc, (x1.z * cc.z - x2.z * ss.z) * sc, (x1.w * cc.w - x2.w * ss.w) * sc);
                        *(unsigned long long*)(dst + 32 + d) = pk4((x2.x * cc.x + x1.x * ss.x) * sc, (x2.y * cc.y + x1.y * ss.y) * sc, (x2.z * cc.z + x1.z * ss.z) * sc, (x2.w * cc.w + x1.w * ss.w) * sc);
                    }
            }
        } else if (pb < C_QL) {
            const int kvh = (pb - C_VA) >> 6;
            unsigned short* __restrict__ dst0 = (unsigned short*)(ws + WS_VAT) + (size_t)(b * 2 + kvh) * 64 * S + pos0;
#pragma unroll
            for (int j = 0; j < 4; ++j)
#pragma unroll
                for (int i = 0; i < 4; ++i) {
                    const int dv = i * 16 + fq * 4; unsigned short* dst = dst0 + 16 * j;
                    dst[(size_t)(dv + 0) * S] = (unsigned short)f2bf(acc[i][j].x); dst[(size_t)(dv + 1) * S] = (unsigned short)f2bf(acc[i][j].y);
                    dst[(size_t)(dv + 2) * S] = (unsigned short)f2bf(acc[i][j].z); dst[(size_t)(dv + 3) * S] = (unsigned short)f2bf(acc[i][j].w);
                }
        } else if (pb < C_KR) {
            const bool isq = pb < C_KVL;
            unsigned short* __restrict__ dst0 = isq ? (unsigned short*)(ws + WS_QL) + (size_t)t0 * 256 + (pb - C_QL) : (unsigned short*)(ws + WS_KVL) + (size_t)t0 * 128 + (pb - C_KVL);
            const int ld = isq ? 256 : 128;
#pragma unroll
            for (int j = 0; j < 4; ++j)
#pragma unroll
                for (int i = 0; i < 4; ++i) *(unsigned long long*)(dst0 + (size_t)(16 * j) * ld + i * 16 + fq * 4) = pk4(acc[i][j].x, acc[i][j].y, acc[i][j].z, acc[i][j].w);
        } else {
            const float* __restrict__ cosB = (const float*)(ws + WS_COSB); const float* __restrict__ sinB = (const float*)(ws + WS_SINB);
            unsigned short* __restrict__ K96 = (unsigned short*)(ws + WS_K96);
            const int d = fq * 4;
            f32x4 c[4], sn[4];
#pragma unroll
            for (int j = 0; j < 4; ++j) { c[j] = *(const f32x4*)(cosB + (pos0 + 16 * j) * 16 + d); sn[j] = *(const f32x4*)(sinB + (pos0 + 16 * j) * 16 + d); }
#pragma unroll
            for (int j = 0; j < 4; ++j) {
                const f32x4 x1 = acc[0][j], x2 = acc[1][j], cc = c[j], ss = sn[j];
                const unsigned long long lo = pk4(x1.x * cc.x - x2.x * ss.x, x1.y * cc.y - x2.y * ss.y, x1.z * cc.z - x2.z * ss.z, x1.w * cc.w - x2.w * ss.w);
                const unsigned long long hi = pk4(x2.x * cc.x + x1.x * ss.x, x2.y * cc.y + x1.y * ss.y, x2.z * cc.z + x1.z * ss.z, x2.w * cc.w + x1.w * ss.w);
#pragma unroll
                for (int h = 0; h < 8; ++h) {
                    unsigned short* dst = K96 + ((size_t)(b * 8 + h) * S + pos0 + 16 * j) * 96 + 64 + d;
                    *(unsigned long long*)dst = lo; *(unsigned long long*)(dst + 16) = hi;
                }
            }
        }
    }
};
struct EpiQup {
    unsigned char* ws;
    __device__ __forceinline__ void operator()(const f32x4 (&acc)[4][4], int pb, int qb, int lane, const float* ssq, int, int = 0) const {
        const int fr = lane & 15, fq = lane >> 4;
        unsigned short* __restrict__ QMB = (unsigned short*)(ws + WS_QMB);
        const float* __restrict__ cosB = (const float*)(ws + WS_COSB); const float* __restrict__ sinB = (const float*)(ws + WS_SINB);
        const int t0 = qb + fr, b = t0 >> 12, pos0 = t0 & (S - 1);
        float sc[4];
#pragma unroll
        for (int j = 0; j < 4; ++j) sc[j] = rsqrtf(ssq[j * 16 + fr] * (1.f / 256.f) + EPS) * QM_SCALE;
        if (pb < 512) {
            unsigned short* dst0 = QMB + ((size_t)(b * 8 + (pb >> 6)) * S + pos0) * 96;
#pragma unroll
            for (int j = 0; j < 4; ++j)
#pragma unroll
                for (int i = 0; i < 4; ++i) *(unsigned long long*)(dst0 + (size_t)(16 * j) * 96 + i * 16 + fq * 4) = pk4(acc[i][j].x * sc[j], acc[i][j].y * sc[j], acc[i][j].z * sc[j], acc[i][j].w * sc[j]);
        } else {
            const int d = fq * 4;
            f32x4 c[4], sn[4];
#pragma unroll
            for (int j = 0; j < 4; ++j) { c[j] = *(const f32x4*)(cosB + (pos0 + 16 * j) * 16 + d); sn[j] = *(const f32x4*)(sinB + (pos0 + 16 * j) * 16 + d); }
#pragma unroll
            for (int j = 0; j < 4; ++j)
#pragma unroll
                for (int hh = 0; hh < 2; ++hh) {
                    const int h = ((pb - 512) >> 5) + hh;
                    unsigned short* dst = QMB + ((size_t)(b * 8 + h) * S + pos0 + 16 * j) * 96 + 64 + d;
                    const f32x4 x1 = acc[2 * hh][j], x2 = acc[2 * hh + 1][j], cc = c[j], ss = sn[j]; const float s_ = sc[j];
                    *(unsigned long long*)dst = pk4((x1.x * cc.x - x2.x * ss.x) * s_, (x1.y * cc.y - x2.y * ss.y) * s_, (x1.z * cc.z - x2.z * ss.z) * s_, (x1.w * cc.w - x2.w * ss.w) * s_);
                    *(unsigned long long*)(dst + 16) = pk4((x2.x * cc.x + x1.x * ss.x) * s_, (x2.y * cc.y + x1.y * ss.y) * s_, (x2.z * cc.z + x1.z * ss.z) * s_, (x2.w * cc.w + x1.w * ss.w) * s_);
                }
        }
    }
};
struct EpiKVup {
    unsigned char* ws;
    __device__ __forceinline__ void operator()(const f32x4 (&acc)[4][4], int pb, int qb, int lane, const float* ssq, int, int = 0) const {
        const int fr = lane & 15, fq = lane >> 4;
        unsigned short* K96 = (unsigned short*)(ws + WS_K96); unsigned short* VT = (unsigned short*)(ws + WS_VT);
        const int h = pb >> 7;
#pragma unroll
        for (int j = 0; j < 4; ++j) {
            const int t = qb + j * 16 + fr, b = t >> 12, pos = t & (S - 1);
            const float sc = rsqrtf(ssq[j * 16 + fr] * (1.f / 128.f) + EPS);
            if ((pb & 64) == 0) {
                unsigned short* dst = K96 + ((size_t)(b * 8 + h) * S + pos) * 96;
#pragma unroll
                for (int i = 0; i < 4; ++i) *(unsigned long long*)(dst + i * 16 + fq * 4) = pk4(acc[i][j].x * sc, acc[i][j].y * sc, acc[i][j].z * sc, acc[i][j].w * sc);
            } else {
                unsigned short* dst = VT + (size_t)(b * 8 + h) * 64 * S + pos;
#pragma unroll
                for (int i = 0; i < 4; ++i) {
                    const int dv = i * 16 + fq * 4;
                    dst[(size_t)(dv + 0) * S] = (unsigned short)f2bf(acc[i][j].x * sc); dst[(size_t)(dv + 1) * S] = (unsigned short)f2bf(acc[i][j].y * sc);
                    dst[(size_t)(dv + 2) * S] = (unsigned short)f2bf(acc[i][j].z * sc); dst[(size_t)(dv + 3) * S] = (unsigned short)f2bf(acc[i][j].w * sc);
                }
            }
        }
    }
};

typedef float f32x16 __attribute__((ext_vector_type(16)));
typedef __bf16 bf16x2_t __attribute__((ext_vector_type(2)));
__device__ __forceinline__ unsigned cvtpk(float lo, float hi) { f32x2 v = {lo, hi}; bf16x2_t b = __builtin_convertvector(v, bf16x2_t); return __builtin_bit_cast(unsigned, b); }
__device__ __forceinline__ int crow(int r, int hi) { return (r & 3) + 8 * (r >> 2) + 4 * hi; }
__device__ __forceinline__ int kperm(int rho) { return (rho & 0x13) | ((rho & 4) << 1) | ((rho & 8) >> 1); }

template <int DQK, bool SWA>
__device__ void stage_attn_flash(const Params& p, unsigned char* lds) {
    constexpr int NK = DQK / 16, KCH = DQK / 8, KSTR = (KCH + 1) * 16, VSTR = 144;
    constexpr int KT_BYTES = 64 * KSTR, VT_BYTES = 64 * VSTR, STG = KT_BYTES + VT_BYTES, NKC = 64 * KCH;
    const unsigned short* Qg = (const unsigned short*)(p.ws + (SWA ? WS_QA : WS_QMB));
    const unsigned short* Kg = (const unsigned short*)(p.ws + (SWA ? WS_KA : WS_K96));
    const unsigned short* Vg = (const unsigned short*)(p.ws + (SWA ? WS_VAT : WS_VT));
    unsigned short* O = (unsigned short*)(p.ws + WS_OAB);
    const int tid = threadIdx.x, lane = tid & 63, wave = tid >> 6, r32 = lane & 31, hi = lane >> 5;
    const int G = gridDim.x, bx = blockIdx.x;
    const int vcu = (G % 8 == 0) ? (bx % 8) * (G / 8) + bx / 8 : bx;
    const int nunits = SWA ? Bsz * 2 * 64 : Bsz * 8 * 16;
    const int kro = kperm(r32) * KSTR + hi * 16;
    const int vro = r32 * VSTR + hi * 16;
    const int kid0 = tid, kid1 = tid + 512;
    const int k0row = kid0 / KCH, k0c = kid0 % KCH, k1row = kid1 / KCH, k1c = kid1 % KCH;
    const int vrow = tid >> 3, vc = tid & 7;
    for (int u = vcu; u < nunits; u += G) {
        int b, qb, tlo, thi, sq, ocol; const unsigned short *Qp, *Kb, *Vb; float m, l;
        if (SWA) {
            qb = u & 63; const int kvh = (u >> 6) & 1; b = u >> 7;
            const int head = kvh * 4 + (wave >> 1);
            sq = qb * 64 + (wave & 1) * 32 + r32;
            Qp = Qg + ((size_t)(b * 8 + head) * S + sq) * 64;
            Kb = Kg + (size_t)(b * 2 + kvh) * S * 64; Vb = Vg + (size_t)(b * 2 + kvh) * 64 * S;
            tlo = qb - 2 < 0 ? 0 : qb - 2; thi = qb + 2 > 63 ? 63 : qb + 2;
            m = p.sink[head] * LOG2E; l = 0.5f; ocol = head * 64;
        } else {
            qb = u & 15; const int h = (u >> 4) & 7; b = u >> 7;
            sq = qb * 256 + wave * 32 + r32;
            Qp = Qg + ((size_t)(b * 8 + h) * S + sq) * 96;
            Kb = Kg + (size_t)(b * 8 + h) * S * 96; Vb = Vg + (size_t)(b * 8 + h) * 64 * S;
            tlo = 0; thi = 63; m = 0.f; l = 0.f; ocol = 512 + h * 64;
        }
        bf16x8 qf[NK];
#pragma unroll
        for (int ks = 0; ks < NK; ++ks) qf[ks] = *(const bf16x8*)(Qp + ks * 16 + hi * 8);
        f32x16 o0, o1;
#pragma unroll
        for (int r = 0; r < 16; ++r) { o0[r] = 0.f; o1[r] = 0.f; }
        u32x4 rk0, rk1, rv;
        {
            const unsigned short* kt = Kb + (size_t)tlo * 64 * DQK;
            rk0 = *(const u32x4*)(kt + kid0 * 8);
            if (kid1 < NKC) rk1 = *(const u32x4*)(kt + kid1 * 8);
            rv = *(const u32x4*)(Vb + (size_t)vrow * S + tlo * 64 + vc * 8);
            *(u32x4*)(lds + k0row * KSTR + k0c * 16) = rk0;
            if (kid1 < NKC) *(u32x4*)(lds + k1row * KSTR + k1c * 16) = rk1;
            *(u32x4*)(lds + KT_BYTES + vrow * VSTR + vc * 16) = rv;
        }
        __syncthreads();
        for (int tt = tlo; tt <= thi; ++tt) {
            const unsigned char* Kl = lds + ((tt - tlo) & 1) * STG;
            const unsigned char* Vl = Kl + KT_BYTES;
            unsigned char* Kn = lds + (((tt - tlo) & 1) ^ 1) * STG;
            const bool more = tt < thi;
            if (more) {
                const unsigned short* kt = Kb + (size_t)(tt + 1) * 64 * DQK;
                rk0 = *(const u32x4*)(kt + kid0 * 8);
                if (kid1 < NKC) rk1 = *(const u32x4*)(kt + kid1 * 8);
                rv = *(const u32x4*)(Vb + (size_t)vrow * S + (tt + 1) * 64 + vc * 8);
            }
            f32x16 s0, s1;
            {
                const float nm = -m;
#pragma unroll
                for (int r = 0; r < 16; ++r) { s0[r] = nm; s1[r] = nm; }
            }
#pragma unroll
            for (int ks = 0; ks < NK; ++ks) {
                const bf16x8 kf0 = *(const bf16x8*)(Kl + kro + ks * 32);
                const bf16x8 kf1 = *(const bf16x8*)(Kl + 32 * KSTR + kro + ks * 32);
                s0 = __builtin_amdgcn_mfma_f32_32x32x16_bf16(kf0, qf[ks], s0, 0, 0, 0);
                s1 = __builtin_amdgcn_mfma_f32_32x32x16_bf16(kf1, qf[ks], s1, 0, 0, 0);
            }
            if (SWA) {
                const int rel = tt - qb;
                if (rel == -2 || rel == 2) {
                    const int qi = (wave & 1) * 32 + r32;
#pragma unroll
                    for (int r = 0; r < 16; ++r) {
                        const int kk = kperm(crow(r, hi));
                        const bool v0 = (rel == -2) ? (kk >= qi) : (kk <= qi);
                        const bool v1 = (rel == -2) ? (kk + 32 >= qi) : (kk + 32 <= qi);
                        s0[r] = v0 ? s0[r] : -1e30f; s1[r] = v1 ? s1[r] : -1e30f;
                    }
                }
            }
            if ((!SWA) && (tt == tlo)) {
                float mx = fmaxf(s0[0], s1[0]);
#pragma unroll
                for (int r = 1; r < 16; ++r) mx = fmaxf(mx, fmaxf(s0[r], s1[r]));
                mx = fmaxf(mx, __shfl_xor(mx, 32));
                m = mx;
#pragma unroll
                for (int r = 0; r < 16; ++r) { s0[r] -= mx; s1[r] -= mx; }
            }
            float rs = 0.f;
#pragma unroll
            for (int r = 0; r < 16; ++r) { s0[r] = __builtin_amdgcn_exp2f(s0[r]); s1[r] = __builtin_amdgcn_exp2f(s1[r]); rs += s0[r] + s1[r]; }
            if (!__all(rs <= 1024.f)) {
                float mp = fmaxf(s0[0], s1[0]);
#pragma unroll
                for (int r = 1; r < 16; ++r) mp = fmaxf(mp, fmaxf(s0[r], s1[r]));
                mp = fmaxf(fmaxf(mp, __shfl_xor(mp, 32)), 1.f);
                const float alpha = 1.f / mp;
                m += __builtin_amdgcn_logf(mp);
                l *= alpha; rs *= alpha;
#pragma unroll
                for (int r = 0; r < 16; ++r) { o0[r] *= alpha; o1[r] *= alpha; s0[r] *= alpha; s1[r] *= alpha; }
            }
            l += rs;
#pragma unroll
            for (int st = 0; st < 2; ++st) {
                u32x4 pw;
                pw.x = cvtpk(s0[8 * st + 0], s0[8 * st + 1]); pw.y = cvtpk(s0[8 * st + 2], s0[8 * st + 3]);
                pw.z = cvtpk(s0[8 * st + 4], s0[8 * st + 5]); pw.w = cvtpk(s0[8 * st + 6], s0[8 * st + 7]);
                const bf16x8 pf = __builtin_bit_cast(bf16x8, pw);
                const bf16x8 vf0 = *(const bf16x8*)(Vl + vro + st * 32);
                const bf16x8 vf1 = *(const bf16x8*)(Vl + 32 * VSTR + vro + st * 32);
                o0 = __builtin_amdgcn_mfma_f32_32x32x16_bf16(vf0, pf, o0, 0, 0, 0);
                o1 = __builtin_amdgcn_mfma_f32_32x32x16_bf16(vf1, pf, o1, 0, 0, 0);
            }
#pragma unroll
            for (int st = 0; st < 2; ++st) {
                u32x4 pw;
                pw.x = cvtpk(s1[8 * st + 0], s1[8 * st + 1]); pw.y = cvtpk(s1[8 * st + 2], s1[8 * st + 3]);
                pw.z = cvtpk(s1[8 * st + 4], s1[8 * st + 5]); pw.w = cvtpk(s1[8 * st + 6], s1[8 * st + 7]);
                const bf16x8 pf = __builtin_bit_cast(bf16x8, pw);
                const bf16x8 vf0 = *(const bf16x8*)(Vl + vro + 64 + st * 32);
                const bf16x8 vf1 = *(const bf16x8*)(Vl + 32 * VSTR + vro + 64 + st * 32);
                o0 = __builtin_amdgcn_mfma_f32_32x32x16_bf16(vf0, pf, o0, 0, 0, 0);
                o1 = __builtin_amdgcn_mfma_f32_32x32x16_bf16(vf1, pf, o1, 0, 0, 0);
            }
            if (more) {
                *(u32x4*)(Kn + k0row * KSTR + k0c * 16) = rk0;
                if (kid1 < NKC) *(u32x4*)(Kn + k1row * KSTR + k1c * 16) = rk1;
                *(u32x4*)(Kn + KT_BYTES + vrow * VSTR + vc * 16) = rv;
            }
            __syncthreads();
        }
        const float il = 1.f / (l + __shfl_xor(l, 32));
        {
            float ss = 0.f;
#pragma unroll
            for (int r = 0; r < 16; ++r) { const float a0 = o0[r] * il, a1 = o1[r] * il; ss += a0 * a0 + a1 * a1; }
            ss += __shfl_xor(ss, 32);
            if (hi == 0) ((float*)(p.ws + WS_SSQO))[(size_t)(b * S + sq) * 16 + (ocol >> 6)] = ss;
        }
        unsigned short* orow = O + (size_t)(b * S + sq) * D + ocol + 4 * hi;
#pragma unroll
        for (int g = 0; g < 4; ++g) {
            *(unsigned long long*)(orow + 8 * g) = (unsigned long long)cvtpk(o0[4 * g] * il, o0[4 * g + 1] * il) | ((unsigned long long)cvtpk(o0[4 * g + 2] * il, o0[4 * g + 3] * il) << 32);
            *(unsigned long long*)(orow + 32 + 8 * g) = (unsigned long long)cvtpk(o1[4 * g] * il, o1[4 * g + 1] * il) | ((unsigned long long)cvtpk(o1[4 * g + 2] * il, o1[4 * g + 3] * il) << 32);
        }
    }
}

__device__ __forceinline__ void ce_desc(int& a, int& b) { const int hi = max(a, b), lo = min(a, b); a = hi; b = lo; }
__device__ __forceinline__ void ce_asc(int& a, int& b) { const int hi = max(a, b), lo = min(a, b); a = lo; b = hi; }
template <int N, int OFF> __device__ __forceinline__ void bitonic_sort_desc(int (&a)[32]) {
#pragma unroll
    for (int k = 2; k <= N; k <<= 1)
#pragma unroll
        for (int j = k >> 1; j > 0; j >>= 1)
#pragma unroll
            for (int i = 0; i < N; ++i) {
                const int l = i ^ j;
                if (l > i) { if ((i & k) == 0) ce_desc(a[OFF + i], a[OFF + l]); else ce_asc(a[OFF + i], a[OFF + l]); }
            }
}
__device__ __forceinline__ void bitonic_clean16_desc(int (&a)[32]) {
#pragma unroll
    for (int j = 8; j > 0; j >>= 1)
#pragma unroll
        for (int i = 0; i < 16; ++i) { const int l = i ^ j; if (l > i) ce_desc(a[i], a[l]); }
}
__device__ __forceinline__ int f2sortable(float f) { const int b = __builtin_bit_cast(int, f); return b ^ ((b >> 31) & 0x7fffffff); }
__device__ __forceinline__ float sortable2f(int s) { return __builtin_bit_cast(float, s ^ ((s >> 31) & 0x7fffffff)); }
struct CandTab { int i[52], j[52]; };
constexpr CandTab make_cands() { CandTab t{}; int n = 0; for (int i = 0; i < 16; ++i) for (int j = 0; j < 16; ++j) if ((i + 1) * (j + 1) <= 16) { t.i[n] = i; t.j[n] = j; ++n; } for (; n < 52; ++n) { t.i[n] = -1; t.j[n] = -1; } return t; }
constexpr CandTab CANDS = make_cands();
struct EpiTopkSel {
    static constexpr bool HAS_MID = false;
    __device__ __forceinline__ void pre(int, int) {}
    template <class A> __device__ __forceinline__ void mid(A&) {}
    unsigned short* idx; float* g;
    int* keepg;
    __device__ __forceinline__ void operator()(const f32x4 (&acc)[8][2], int pb, int qb, int lane, const float*, int hp, int half) {
        const int fr = lane & 15, fq = lane >> 4;
#pragma unroll
        for (int j = 0; j < 2; ++j) {
            int v[32];
#pragma unroll
            for (int i = 0; i < 8; ++i)
#pragma unroll
                for (int r = 0; r < 4; ++r) v[i * 4 + r] = (f2sortable(acc[i][j][r]) & ~127) | (i * 16 + fq * 4 + r);
            bitonic_sort_desc<16, 0>(v); bitonic_sort_desc<16, 16>(v);
#pragma unroll
            for (int i = 0; i < 16; ++i) v[i] = max(v[i], v[31 - i]);
            bitonic_clean16_desc(v);
#pragma unroll
            for (int x = 16; x <= 32; x <<= 1) {
#pragma unroll
                for (int i = 0; i < 16; ++i) v[16 + i] = __shfl_xor(v[i], x);
#pragma unroll
                for (int i = 0; i < 16; ++i) v[i] = max(v[i], v[31 - i]);
                bitonic_clean16_desc(v);
            }
            u32x4* kp = (u32x4*)(keepg + ((qb & 255) + j * 16 + fr) * 16);
            if (half == 0) {
                if (fq == 0) {
#pragma unroll
                    for (int i = 0; i < 4; ++i) kp[i] = (u32x4){(unsigned)v[4 * i], (unsigned)v[4 * i + 1], (unsigned)v[4 * i + 2], (unsigned)v[4 * i + 3]};
                }
            } else {
                float as[16], bs[16]; int ai[16], bi[16];
#pragma unroll
                for (int i = 0; i < 4; ++i) {
                    const u32x4 kv = kp[i];
#pragma unroll
                    for (int c = 0; c < 4; ++c) { as[4 * i + c] = sortable2f((int)kv[c] & ~127); ai[4 * i + c] = ((int)kv[c] & 127) << 7; }
                }
#pragma unroll
                for (int i = 0; i < 16; ++i) { bs[i] = sortable2f(v[i] & ~127); bi[i] = v[i] & 127; }
                int w[32];
#pragma unroll
                for (int sl = 0; sl < 13; ++sl) {
                    int c4[4];
#pragma unroll
                    for (int f = 0; f < 4; ++f) {
                        constexpr int dummy = 0; (void)dummy;
                        const int ci = CANDS.i[sl * 4 + f], cj = CANDS.j[sl * 4 + f];
                        c4[f] = (ci >= 0) ? ((f2sortable(as[ci >= 0 ? ci : 0] + bs[cj >= 0 ? cj : 0]) & ~0x3fff) | (ai[ci >= 0 ? ci : 0] | bi[cj >= 0 ? cj : 0])) : (int)0x80000000;
                    }
                    w[sl] = (fq == 0) ? c4[0] : (fq == 1) ? c4[1] : (fq == 2) ? c4[2] : c4[3];
                }
                w[13] = w[14] = w[15] = (int)0x80000000;
                bitonic_sort_desc<16, 0>(w);
#pragma unroll
                for (int x = 16; x <= 32; x <<= 1) {
#pragma unroll
                    for (int i = 0; i < 16; ++i) w[16 + i] = __shfl_xor(w[i], x);
#pragma unroll
                    for (int i = 0; i < 16; ++i) w[i] = max(w[i], w[31 - i]);
                    bitonic_clean16_desc(w);
                }
                int my[4];
#pragma unroll
                for (int c = 0; c < 4; ++c) my[c] = (fq == 0) ? w[c] : (fq == 1) ? w[4 + c] : (fq == 2) ? w[8 + c] : w[12 + c];
                const float top = sortable2f(w[0] & ~0x3fff);
                float e[4], part = 0.f;
#pragma unroll
                for (int c = 0; c < 4; ++c) { e[c] = __expf(sortable2f(my[c] & ~0x3fff) - top); part += e[c]; }
                part += __shfl_xor(part, 16); part += __shfl_xor(part, 32);
                const float inv = 1.f / part;
                const int t = qb + j * 16 + fr;
                const size_t o = (size_t)t * 128 + (hp >> 1) * 16 + fq * 4;
                *(unsigned long long*)(idx + o) = (unsigned long long)(unsigned)((my[0] & 0x3fff) | ((my[1] & 0x3fff) << 16)) | ((unsigned long long)(unsigned)((my[2] & 0x3fff) | ((my[3] & 0x3fff) << 16)) << 32);
                *(f32x4*)(g + o) = (f32x4){e[0] * inv, e[1] * inv, e[2] * inv, e[3] * inv};
            }
        }
    }
};
__device__ void gemm_pq_fused(const Params& p, unsigned char* lds) {
    const unsigned short* X = (const unsigned short*)(p.ws + WS_WPQ);
    const unsigned short* Y = (const unsigned short*)(p.ws + WS_HB);
    const unsigned short* SK = (const unsigned short*)(p.ws + WS_SUBK);
    const float* ssq1 = (const float*)(p.ws + WS_SSQ1); const float* bias = (const float*)(p.ws + WS_BPQ);
    EpiTopkSel tsel{(unsigned short*)(p.ws + WS_IDX), (float*)(p.ws + WS_G), (int*)(p.ws + WS_KEEP) + (size_t)blockIdx.x * 4096};
    const int tid = threadIdx.x, lane = tid & 63, wave = __builtin_amdgcn_readfirstlane(tid >> 6);
    const int wp = wave >> 2, wq = wave & 3, fr = lane & 15, fq = lane >> 4;
    const int G = gridDim.x, bx = blockIdx.x;
    const int vcu = (G % 8 == 0) ? (bx % 8) * (G / 8) + bx / 8 : bx;
    const int srow = wave * 8 + (lane >> 3), pc = lane & 7, lc = pc ^ ((srow >> 1) & 7);
    constexpr int nk = D / TBK, nunits = 8 * (T / TQ);
    for (int u = vcu; u < nunits; u += G) {
        const int qt = u >> 3, h = u & 7, q0 = qt * TQ;
#pragma unroll
        for (int sub = 0; sub < 2; ++sub) {
            const int hp = h * 2 + sub, p0 = hp * TP;
            f32x4 acc[4][4];
#pragma unroll
            for (int i = 0; i < 4; ++i)
#pragma unroll
                for (int j = 0; j < 4; ++j) acc[i][j] = (f32x4){0.f, 0.f, 0.f, 0.f};
            const unsigned short* xg = X + (size_t)(p0 + srow) * D + lc * 8;
            const unsigned short* yg = Y + (size_t)(q0 + srow) * D + lc * 8;
            asm volatile("s_waitcnt vmcnt(0)" ::: "memory");
            RAW_BARRIER();
#define PQ_DMA_TILE(kt_, stg_) do { \
                unsigned char* _b = lds + (stg_) * STG_BYTES + wave * 1024; const int _k = (kt_) * TBK; \
                _Pragma("unroll") for (int _i = 0; _i < 2; ++_i) __builtin_amdgcn_global_load_lds((const unsigned*)(xg + (size_t)(64 * _i) * D + _k), (unsigned*)(_b + _i * 8192), 16, 0, 0); \
                _Pragma("unroll") for (int _i = 0; _i < 4; ++_i) __builtin_amdgcn_global_load_lds((const unsigned*)(yg + (size_t)(64 * _i) * D + _k), (unsigned*)(_b + XS_BYTES + _i * 8192), 16, 0, 0); \
            } while (0)
            PQ_DMA_TILE(0, 0);
            PQ_DMA_TILE(1, 1);
            int cur = 0;
            for (int kt = 0; kt < nk; ++kt) {
                if (kt + 1 < nk) asm volatile("s_waitcnt vmcnt(6)" ::: "memory"); else asm volatile("s_waitcnt vmcnt(0)" ::: "memory");
                RAW_BARRIER();
                if (kt + 2 < nk) { const int nxt = (cur == 0) ? 2 : cur - 1; PQ_DMA_TILE(kt + 2, nxt); }
                const unsigned char* st = lds + cur * STG_BYTES;
#pragma unroll
                for (int kk = 0; kk < 2; ++kk) {
                    bf16x8 af[4], bfr[4];
#pragma unroll
                    for (int i = 0; i < 4; ++i) af[i] = *(const bf16x8*)(st + swz(wp * 64 + i * 16 + fr, kk * 4 + fq));
#pragma unroll
                    for (int j = 0; j < 4; ++j) bfr[j] = *(const bf16x8*)(st + XS_BYTES + swz(wq * 64 + j * 16 + fr, kk * 4 + fq));
#pragma unroll
                    for (int i = 0; i < 4; ++i)
#pragma unroll
                        for (int j = 0; j < 4; ++j) acc[i][j] = __builtin_amdgcn_mfma_f32_16x16x32_bf16(af[i], bfr[j], acc[i][j], 0, 0, 0);
                }
                cur = (cur == 2) ? 0 : cur + 1;
            }
#undef PQ_DMA_TILE
            RAW_BARRIER();
            {
                float r1[4]; f32x4 bv[4];
#pragma unroll
                for (int j = 0; j < 4; ++j) {
                    const f32x4* s4 = (const f32x4*)(ssq1 + (size_t)(q0 + wq * 64 + j * 16 + fr) * 16);
                    const f32x4 a0 = s4[0], a1 = s4[1], a2 = s4[2], a3 = s4[3];
                    r1[j] = rsqrtf((((a0.x + a0.y + a0.z + a0.w) + (a1.x + a1.y + a1.z + a1.w)) + ((a2.x + a2.y + a2.z + a2.w) + (a3.x + a3.y + a3.z + a3.w))) * (1.f / D) + EPS);
                }
                {
                    const float* bt = bias + (q0 >> 12) * 2048 + p0 + wp * 64 + fq * 4;
#pragma unroll
                    for (int i = 0; i < 4; ++i) bv[i] = *(const f32x4*)(bt + i * 16);
                }
                const unsigned short* kg = SK + (size_t)hp * 128 * 128 + (size_t)srow * 128 + lc * 8;
#pragma unroll
                for (int s2 = 0; s2 < 2; ++s2)
#pragma unroll
                    for (int i = 0; i < 2; ++i) __builtin_amdgcn_global_load_lds((const unsigned*)(kg + (size_t)(64 * i) * 128 + s2 * 64), (unsigned*)(lds + s2 * STG_BYTES + wave * 1024 + i * 8192), 16, 0, 0);
                unsigned char* yb = lds + wp * STG_BYTES + XS_BYTES + (fq & 1) * 8;
#pragma unroll
                for (int j = 0; j < 4; ++j)
#pragma unroll
                    for (int i = 0; i < 4; ++i)
                        *(unsigned long long*)(yb + swz(wq * 64 + j * 16 + fr, 2 * i + (fq >> 1))) =
                            pk4(acc[i][j].x * r1[j] + bv[i].x, acc[i][j].y * r1[j] + bv[i].y, acc[i][j].z * r1[j] + bv[i].z, acc[i][j].w * r1[j] + bv[i].w);
            }
            asm volatile("s_waitcnt vmcnt(0)" ::: "memory");
            RAW_BARRIER();
            f32x4 sc2[8][2];
#pragma unroll
            for (int i = 0; i < 8; ++i)
#pragma unroll
                for (int j = 0; j < 2; ++j) sc2[i][j] = (f32x4){0.f, 0.f, 0.f, 0.f};
#pragma unroll
            for (int s2 = 0; s2 < 2; ++s2) {
                const unsigned char* st = lds + s2 * STG_BYTES;
#pragma unroll
                for (int kk = 0; kk < 2; ++kk) {
                    bf16x8 af[8], bfr[2];
#pragma unroll
                    for (int i = 0; i < 8; ++i) af[i] = *(const bf16x8*)(st + swz(i * 16 + fr, kk * 4 + fq));
#pragma unroll
                    for (int j = 0; j < 2; ++j) bfr[j] = *(const bf16x8*)(st + XS_BYTES + swz(wave * 32 + j * 16 + fr, kk * 4 + fq));
#pragma unroll
                    for (int i = 0; i < 8; ++i)
#pragma unroll
                        for (int j = 0; j < 2; ++j) sc2[i][j] = __builtin_amdgcn_mfma_f32_16x16x32_bf16(af[i], bfr[j], sc2[i][j], 0, 0, 0);
                }
            }
            tsel(sc2, 0, q0 + wave * 32, lane, (const float*)nullptr, hp, sub);
        }
    }
}

__device__ __forceinline__ int rd_lane_i(int v, int l) { return __builtin_amdgcn_readlane(v, l); }
__device__ __forceinline__ float rd_lane_f(float v, int l) { return __builtin_bit_cast(float, __builtin_amdgcn_readlane(__builtin_bit_cast(int, v), l)); }
__device__ void stage_peer_u(const Params& p) {
    const unsigned short* h2 = (const unsigned short*)(p.ws + WS_HB);
    const float* mod = (const float*)(p.ws + WS_MOD);
    const unsigned short* idx = (const unsigned short*)(p.ws + WS_IDX); float* g = (float*)(p.ws + WS_G);
    const unsigned char* eu8 = p.ws + WS_EU8;
    const float* us = (const float*)(p.ws + WS_US);
    const int tid_ = tid_opaque(); const int lane = tid_ & 63, wave = tid_ >> 6;
    for (int t = blockIdx.x * NWAVES + wave; t < T; t += gridDim.x * NWAVES) {
        const int b = t >> 12;
        f32x2 hq[8];
        {
            const float rstd1 = rsqrtf(group16_sum(((const float*)(p.ws + WS_SSQ1))[(size_t)t * 16 + (lane & 15)]) * (1.f / D) + EPS);
            const float* shf = mod + b * NMOD + 3 * D + lane * 16;
            const u32x4 w0 = *(const u32x4*)(h2 + (size_t)t * D + lane * 16), w1 = *(const u32x4*)(h2 + (size_t)t * D + lane * 16 + 8);
            const f32x4 s0 = *(const f32x4*)(shf), s1 = *(const f32x4*)(shf + 4), s2 = *(const f32x4*)(shf + 8), s3 = *(const f32x4*)(shf + 12);
            hq[0] = (f32x2){bflo(w0.x) * rstd1 + s0.x, bfhi(w0.x) * rstd1 + s0.y}; hq[1] = (f32x2){bflo(w0.y) * rstd1 + s0.z, bfhi(w0.y) * rstd1 + s0.w};
            hq[2] = (f32x2){bflo(w0.z) * rstd1 + s1.x, bfhi(w0.z) * rstd1 + s1.y}; hq[3] = (f32x2){bflo(w0.w) * rstd1 + s1.z, bfhi(w0.w) * rstd1 + s1.w};
            hq[4] = (f32x2){bflo(w1.x) * rstd1 + s2.x, bfhi(w1.x) * rstd1 + s2.y}; hq[5] = (f32x2){bflo(w1.y) * rstd1 + s2.z, bfhi(w1.y) * rstd1 + s2.w};
            hq[6] = (f32x2){bflo(w1.z) * rstd1 + s3.x, bfhi(w1.z) * rstd1 + s3.y}; hq[7] = (f32x2){bflo(w1.w) * rstd1 + s3.z, bfhi(w1.w) * rstd1 + s3.w};
        }
        const int idv0 = idx[(size_t)t * 128 + lane], idv1 = idx[(size_t)t * 128 + 64 + lane];
        float wv0 = 0.f, wv1 = 0.f;
        u32x4 cur[8], nxt[8];
#pragma unroll
        for (int i = 0; i < 8; ++i) cur[i] = *(const u32x4*)(eu8 + (size_t)rd_lane_i(idv0, i) * D + lane * 16);
#pragma unroll 2
        for (int b8 = 0; b8 < 16; ++b8) {
            const int bn = (b8 + 1 < 16) ? b8 + 1 : b8;
#pragma unroll
            for (int i = 0; i < 8; ++i) { const int r = bn * 8 + i; nxt[i] = *(const u32x4*)(eu8 + (size_t)rd_lane_i((bn < 8) ? idv0 : idv1, r & 63) * D + lane * 16); }
            float pr[8];
#pragma unroll
            for (int i = 0; i < 8; ++i) {
                f32x2 a = {0.f, 0.f}, c2 = {0.f, 0.f};
#pragma unroll
                for (int c = 0; c < 4; ++c) {
                    const f32x2 lo = __builtin_amdgcn_cvt_pk_f32_fp8((int)cur[i][c], false), hi = __builtin_amdgcn_cvt_pk_f32_fp8((int)cur[i][c], true);
                    a += lo * hq[2 * c]; c2 += hi * hq[2 * c + 1];
                }
                a += c2; pr[i] = a.x + a.y;
            }
            float x4[4], x2[2], x1;
            const bool b5 = (lane & 32) != 0, b4 = (lane & 16) != 0, b3 = (lane & 8) != 0;
#pragma unroll
            for (int i = 0; i < 4; ++i) { const float keep = b5 ? pr[i + 4] : pr[i], give = b5 ? pr[i] : pr[i + 4]; x4[i] = keep + __shfl_xor(give, 32); }
#pragma unroll
            for (int i = 0; i < 2; ++i) { const float keep = b4 ? x4[i + 2] : x4[i], give = b4 ? x4[i] : x4[i + 2]; x2[i] = keep + __shfl_xor(give, 16); }
            { const float keep = b3 ? x2[1] : x2[0], give = b3 ? x2[0] : x2[1]; x1 = keep + __shfl_xor(give, 8); }
            x1 += __shfl_xor(x1, 4); x1 += __shfl_xor(x1, 2); x1 += __shfl_xor(x1, 1);
            const float st = __shfl(x1, (lane & 7) * 8);
            const bool mine = (lane >> 3) == (b8 & 7);
            if (b8 < 8) wv0 = mine ? st : wv0; else wv1 = mine ? st : wv1;
#pragma unroll
            for (int i = 0; i < 8; ++i) cur[i] = nxt[i];
        }
        {
            const float s0 = wv0 * us[idv0], s1 = wv1 * us[idv1];
            const float gv0 = g[(size_t)t * 128 + lane], gv1 = g[(size_t)t * 128 + 64 + lane];
            wv0 = gv0 * (0.5f * s0 * (1.f + erff(s0 * 0.70710678118654752f)));
            wv1 = gv1 * (0.5f * s1 * (1.f + erff(s1 * 0.70710678118654752f)));
        }
        g[(size_t)t * 128 + lane] = wv0; g[(size_t)t * 128 + 64 + lane] = wv1;
    }
}
__device__ void stage_peer_v(const Params& p, float* outp) {
    const float* mod = (const float*)(p.ws + WS_MOD);
    const unsigned short* idx = (const unsigned short*)(p.ws + WS_IDX); const float* g = (const float*)(p.ws + WS_G);
    const unsigned char* ev8 = p.ws + WS_EV8;
    const float* vs = (const float*)(p.ws + WS_VS);
    const int tid_ = tid_opaque(); const int lane = tid_ & 63, wave = tid_ >> 6;
    for (int t = blockIdx.x * NWAVES + wave; t < T; t += gridDim.x * NWAVES) {
        const int b = t >> 12;
        const int idv0 = idx[(size_t)t * 128 + lane], idv1 = idx[(size_t)t * 128 + 64 + lane];
        const float wv0 = g[(size_t)t * 128 + lane] * vs[idv0], wv1 = g[(size_t)t * 128 + 64 + lane] * vs[idv1];
        f32x2 acc[8];
#pragma unroll
        for (int i = 0; i < 8; ++i) acc[i] = (f32x2){0.f, 0.f};
        u32x4 cur[8], nxt[8];
#pragma unroll
        for (int i = 0; i < 8; ++i) cur[i] = *(const u32x4*)(ev8 + (size_t)rd_lane_i(idv0, i) * D + lane * 16);
#pragma unroll 2
        for (int b8 = 0; b8 < 16; ++b8) {
            const int bn = (b8 + 1 < 16) ? b8 + 1 : b8;
#pragma unroll
            for (int i = 0; i < 8; ++i) { const int r = bn * 8 + i; nxt[i] = *(const u32x4*)(ev8 + (size_t)rd_lane_i((bn < 8) ? idv0 : idv1, r & 63) * D + lane * 16); }
#pragma unroll
            for (int i = 0; i < 8; ++i) {
                const int r = b8 * 8 + i;
                const float wr = rd_lane_f((b8 < 8) ? wv0 : wv1, r & 63);
                const f32x2 w2 = {wr, wr};
#pragma unroll
                for (int c = 0; c < 4; ++c) {
                    const f32x2 lo = __builtin_amdgcn_cvt_pk_f32_fp8((int)cur[i][c], false), hi = __builtin_amdgcn_cvt_pk_f32_fp8((int)cur[i][c], true);
                    acc[2 * c] += w2 * lo; acc[2 * c + 1] += w2 * hi;
                }
            }
#pragma unroll
            for (int i = 0; i < 8; ++i) cur[i] = nxt[i];
        }
        const int eoff = lane * 16;
        const float* xin = p.out + (size_t)t * D + eoff;
        float* xr = outp + (size_t)t * D + eoff;
        const float* gf = mod + b * NMOD + 5 * D + eoff;
        float sel[16];
        float ss = 0.f;
#pragma unroll
        for (int c = 0; c < 4; ++c) {
            const f32x4 x1 = *(const f32x4*)(xin + c * 4); const f32x4 gg = *(const f32x4*)(gf + c * 4);
            sel[c * 4 + 0] = x1.x + gg.x * acc[2 * c].x; sel[c * 4 + 1] = x1.y + gg.y * acc[2 * c].y;
            sel[c * 4 + 2] = x1.z + gg.z * acc[2 * c + 1].x; sel[c * 4 + 3] = x1.w + gg.w * acc[2 * c + 1].y;
            ss += sel[c * 4 + 0] * sel[c * 4 + 0] + sel[c * 4 + 1] * sel[c * 4 + 1] + sel[c * 4 + 2] * sel[c * 4 + 2] + sel[c * 4 + 3] * sel[c * 4 + 3];
        }
        const float rstd = rsqrtf(wave_sum(ss) * (1.f / D) + EPS);
#pragma unroll
        for (int c = 0; c < 4; ++c) {
            const f32x4 fn = *(const f32x4*)(p.fnorm + eoff + c * 4);
            f32x4 r; r.x = sel[c * 4 + 0] * rstd * fn.x; r.y = sel[c * 4 + 1] * rstd * fn.y; r.z = sel[c * 4 + 2] * rstd * fn.z; r.w = sel[c * 4 + 3] * rstd * fn.w;
            *(f32x4*)(xr + c * 4) = r;
        }
    }
}

#define LAS __attribute__((address_space(3)))
constexpr size_t WS_BAR = 3 * MiB;
constexpr int BAR_BYTES = 16384;
constexpr int LDS_MISC_OFF = 147456;
#define XB_TMO      128
#define XB_XCNT(j)  (256  + 64 * (j))
#define XB_XSUB(j)  (1280 + 64 * (j))
#define XB_XGEN(j)  (2304 + 64 * (j))
#define XB_TOP      3328
#define XB_TOPGEN   3392
#define XB_SPIN_CAP (1u << 18)
__device__ __forceinline__ unsigned xb_ld(unsigned* p)              { return __hip_atomic_load(p, __ATOMIC_RELAXED, __HIP_MEMORY_SCOPE_AGENT); }
__device__ __forceinline__ unsigned xb_add(unsigned* p, unsigned v) { return __hip_atomic_fetch_add(p, v, __ATOMIC_RELAXED, __HIP_MEMORY_SCOPE_AGENT); }
__device__ __forceinline__ unsigned xb_xcc_id() { return (unsigned)__builtin_amdgcn_s_getreg((3 << 11) | 20) & 0xFu; }
#define XB_SPIN(cond, bar) do { unsigned _sp = 0; while (cond) { __builtin_amdgcn_s_sleep(1); \
    if ((++_sp & 255u) == 0u) { if (xb_ld(&(bar)[XB_TMO])) break; if (_sp > XB_SPIN_CAP) { atomicAdd(&(bar)[XB_TMO], 1u); break; } } } } while (0)
struct XcdBarrier { unsigned* bar; unsigned x; volatile LAS unsigned* st; };
__device__ __forceinline__ XcdBarrier xcd_barrier_post(unsigned* bar, volatile LAS unsigned* st) {
    XcdBarrier b; b.bar = bar; b.x = xb_xcc_id(); b.st = st;
    if (threadIdx.x == 0) (void)xb_add(&bar[XB_XCNT(b.x)], 1u);
    return b;
}
__device__ __forceinline__ void xcd_barrier_complete(unsigned* bar, unsigned x, unsigned& nloc, unsigned& nx) {
    const unsigned G = gridDim.x * gridDim.y * gridDim.z;
    unsigned sum, cnt, mine, sp = 0u;
    for (;;) {
        sum = 0u; cnt = 0u; mine = 0u;
#pragma unroll
        for (unsigned j = 0; j < 16; ++j) { const unsigned c = xb_ld(&bar[XB_XCNT(j)]); sum += c; cnt += (c > 0u) ? 1u : 0u; mine = (j == x) ? c : mine; }
        if (sum == G) break;
        __builtin_amdgcn_s_sleep(1);
        if ((++sp & 255u) == 0u) { if (xb_ld(&bar[XB_TMO])) break; if (sp > XB_SPIN_CAP) { atomicAdd(&bar[XB_TMO], 1u); break; } }
    }
    nloc = mine > 0u ? mine : 1u; nx = cnt > 0u ? cnt : 1u;
}
__device__ __forceinline__ void xcd_barrier(const XcdBarrier& b) {
    asm volatile("s_waitcnt vmcnt(0)" ::: "memory");
    __syncthreads();
    if (threadIdx.x == 0) {
        unsigned* bar = b.bar;
        __builtin_amdgcn_s_waitcnt(0);
        unsigned nloc = b.st[0], nx = b.st[1];
        if (nloc == 0u) { xcd_barrier_complete(bar, b.x, nloc, nx); b.st[0] = nloc; b.st[1] = nx; }
        const unsigned old = xb_add(&bar[XB_XSUB(b.x)], 1u);
        const unsigned gen = old / nloc;
        if (old + 1u == (gen + 1u) * nloc) {
            __builtin_amdgcn_fence(__ATOMIC_RELEASE, "agent");
            asm volatile("s_waitcnt vmcnt(0)" ::: "memory");
            const unsigned og = xb_add(&bar[XB_TOP], 1u);
            const unsigned tg = og / nx;
            if (og + 1u == (tg + 1u) * nx) xb_add(&bar[XB_TOPGEN], 1u);
            else XB_SPIN(xb_ld(&bar[XB_TOPGEN]) == tg, bar);
            __builtin_amdgcn_fence(__ATOMIC_ACQUIRE, "agent");
            xb_add(&bar[XB_XGEN(b.x)], 1u);
            asm volatile("s_waitcnt vmcnt(0)" ::: "memory");
        } else {
            XB_SPIN(xb_ld(&bar[XB_XGEN(b.x)]) == gen, bar);
            __builtin_amdgcn_fence(__ATOMIC_ACQUIRE, "agent");
            asm volatile("s_waitcnt vmcnt(0)" ::: "memory");
        }
    }
    __syncthreads();
}

__global__ void __launch_bounds__(NTHREADS) fwd_megakernel(Params p) {
    extern __shared__ __attribute__((aligned(16))) unsigned char lds_raw[];
    cg::grid_group grid = cg::this_grid();
    unsigned short* hb = (unsigned short*)(p.ws + WS_HB);
    const float* mod = (const float*)(p.ws + WS_MOD);
    typedef const unsigned short* cbf;

    volatile LAS unsigned* bst = (volatile LAS unsigned*)((LAS unsigned char*)lds_raw + LDS_MISC_OFF);
    if (threadIdx.x < 2) bst[threadIdx.x] = 0u;
    __syncthreads();
    const XcdBarrier xbar = xcd_barrier_post((unsigned*)(p.ws + WS_BAR), bst);
#ifdef PROBE_A
    for (int rep = 0, nrep = (p.ws != nullptr) ? 2 : 1; rep < nrep; ++rep) { if (rep) xcd_barrier(xbar);
#endif
    stage_prologue(p, (float*)lds_raw);
    if (p.ws == nullptr) grid.sync();
    xcd_barrier(xbar);
#ifdef PROBE_P1
    for (int rep = 0, nrep = (p.ws != nullptr) ? 2 : 1; rep < nrep; ++rep) { if (rep) xcd_barrier(xbar);
#endif
    stage_norm_mod<true>(p, p.x, hb, 0 * D, 1 * D);
    stage_gemv8(mod + 3 * D, NMOD, false, p.w_pq, 2048, nullptr, (float*)(p.ws + WS_BPQ), (float*)lds_raw);
#ifdef PROBE_P1
    }
#endif
    xcd_barrier(xbar);
    gemm_dma<2, 1>((cbf)(p.ws + WS_WIN), D, hb, D, 1280, T, D, 1, 0, 0, lds_raw, EpiProj{p.ws});
    xcd_barrier(xbar);
    gemm_xyT<2, true>((cbf)(p.ws + WS_WQUP), 256, (cbf)(p.ws + WS_QL), 256, 768, T, 256, 1, 0, 0, lds_raw, EpiQup{p.ws});
    gemm_xyT<2, true>((cbf)(p.ws + WS_WKVUP), 128, (cbf)(p.ws + WS_KVL), 128, 1024, T, 128, 1, 0, 0, lds_raw, EpiKVup{p.ws});
    xcd_barrier(xbar);
    stage_attn_flash<64, true>(p, lds_raw);
    stage_attn_flash<96, false>(p, lds_raw);
    xcd_barrier(xbar);
#ifdef PROBE_OUT
    for (int rep = 0, nrep = (p.ws != nullptr) ? 2 : 1; rep < nrep; ++rep) { if (rep) xcd_barrier(xbar);
#endif
    gemm_dma<2, 1>((cbf)(p.ws + WS_WOUT), D, (cbf)(p.ws + WS_OAB), D, D, T, D, 1, 0, 0, lds_raw,
                   EpiOutProj{p.x, mod, p.out, hb, (const float*)(p.ws + WS_SSQO), (float*)(p.ws + WS_SSQ1), {}, {}});
#ifdef PROBE_OUT
    }
#endif
    xcd_barrier(xbar);
    gemm_pq_fused(p, lds_raw);
    xcd_barrier(xbar);
    stage_peer_u(p);
    xcd_barrier(xbar);
    stage_peer_v(p, p.out);
}

extern "C" void kernel_launch(void* const* d_in, const int* in_sizes, int n_in, void* d_out, int out_size, void* d_ws, size_t ws_size, hipStream_t stream) {
    static int grid_blocks = 0;
    if (grid_blocks == 0) {
        if (n_in != 18 || in_sizes[0] != T * D || out_size != T * D || ws_size < WS_END) {
            fprintf(stderr, "kernel_launch: unexpected shapes (n_in %d, in0 %d, out %d, ws %zu); nothing launched\n", n_in, n_in > 0 ? in_sizes[0] : -1, out_size, ws_size);
            grid_blocks = -1; return;
        }
        int dev = 0, cus = 0, per_cu = 0;
        (void)hipGetDevice(&dev);
        (void)hipDeviceGetAttribute(&cus, hipDeviceAttributeMultiprocessorCount, dev);
        if (hipFuncSetAttribute((const void*)fwd_megakernel, hipFuncAttributeMaxDynamicSharedMemorySize, LDS_BYTES) != hipSuccess) { fprintf(stderr, "kernel_launch: hipFuncSetAttribute failed\n"); grid_blocks = -1; return; }
        (void)hipOccupancyMaxActiveBlocksPerMultiprocessor(&per_cu, fwd_megakernel, NTHREADS, LDS_BYTES);
        if (per_cu < 1) { fprintf(stderr, "kernel_launch: occupancy query says %d blocks/CU\n", per_cu); grid_blocks = -1; return; }
        grid_blocks = cus;
    }
    if (grid_blocks < 0) return;
    Params p{};
    p.x = (const float*)d_in[0]; p.c = (const float*)d_in[1]; p.w_ada = (const float*)d_in[2]; p.b_ada = (const float*)d_in[3];
    p.w_in = (const float*)d_in[4]; p.sink = (const float*)d_in[5]; p.qnorm = (const float*)d_in[6]; p.w_qup = (const float*)d_in[7];
    p.kvnorm = (const float*)d_in[8]; p.w_kvup = (const float*)d_in[9]; p.onorm_a = (const float*)d_in[10]; p.onorm_b = (const float*)d_in[11];
    p.w_out = (const float*)d_in[12]; p.w_pq = (const float*)d_in[13]; p.subk = (const float*)d_in[14]; p.eu = (const float*)d_in[15];
    p.ev = (const float*)d_in[16]; p.fnorm = (const float*)d_in[17];
    p.out = (float*)d_out; p.ws = (unsigned char*)d_ws;
    if (hipMemsetAsync((char*)d_ws + WS_BAR, 0, BAR_BYTES, stream) != hipSuccess) { fprintf(stderr, "kernel_launch: hipMemsetAsync failed\n"); return; }
    void* args[] = {&p};
    hipError_t e = hipLaunchCooperativeKernel((void*)fwd_megakernel, dim3(grid_blocks), dim3(NTHREADS), args, LDS_BYTES, stream);
    if (e != hipSuccess) fprintf(stderr, "cooperative launch failed: %s (grid %d)\n", hipGetErrorString(e), grid_blocks);
}
```

```cpp
#include <hip/hip_runtime.h>
#include <hip/hip_cooperative_groups.h>
#include <cstdio>
#include <cstdint>
namespace cg = cooperative_groups;

constexpr int Bsz = 8, S = 4096, D = 1024, T = Bsz * S;
constexpr int INW = 1184;
constexpr int C_QA = 0, C_KA = 512, C_VA = 640, C_QL = 768, C_KVL = 1024, C_KR = 1152;
constexpr int NMOD = 6 * D;
constexpr float EPS = 1e-6f;
constexpr float LOG2E = 1.4426950408889634f;
constexpr float QA_SCALE = 0.125f * LOG2E;
constexpr float QM_SCALE = 0.10206207261596575f * LOG2E;
constexpr int NTHREADS = 512, NWAVES = 8;

constexpr size_t MiB = 1u << 20;
constexpr size_t WS_MOD = 0;
constexpr size_t WS_COSA = 1 * MiB;
constexpr size_t WS_SINA = WS_COSA + 512 * 1024;
constexpr size_t WS_COSB = 2 * MiB;
constexpr size_t WS_SINB = WS_COSB + 256 * 1024;
constexpr size_t WS_WIN = 4 * MiB;
constexpr size_t WS_WQUP = 7 * MiB;
constexpr size_t WS_WKVUP = 7 * MiB + 512 * 1024;
constexpr size_t WS_WOUT = 8 * MiB;
constexpr size_t WS_WPQ = 10 * MiB;
constexpr size_t WS_SUBK = 14 * MiB;
constexpr size_t WS_EU8 = 16 * MiB;
constexpr size_t WS_EV8 = 32 * MiB;
constexpr size_t WS_US = 48 * MiB;
constexpr size_t WS_VS = WS_US + 64 * 1024;
constexpr size_t WS_HB = 52 * MiB;
constexpr size_t WS_QA = 116 * MiB;
constexpr size_t WS_KA = 148 * MiB;
constexpr size_t WS_VAT = 156 * MiB;
constexpr size_t WS_QL = 164 * MiB;
constexpr size_t WS_KVL = 180 * MiB;
constexpr size_t WS_QMB = 192 * MiB;
constexpr size_t WS_K96 = 240 * MiB;
constexpr size_t WS_VT = 288 * MiB;
constexpr size_t WS_OAB = 320 * MiB;
constexpr size_t WS_PQ = 116 * MiB;
constexpr size_t WS_TOPS = 244 * MiB;
constexpr size_t WS_TOPI = 276 * MiB;
constexpr size_t WS_IDX = 284 * MiB;
constexpr size_t WS_G = 292 * MiB;
constexpr size_t WS_SSQO = 49 * MiB;
constexpr size_t WS_SSQ1 = 384 * MiB;
constexpr size_t WS_BPQ = 3 * MiB + 64 * 1024;
constexpr size_t WS_KEEP = 386 * MiB;
constexpr size_t WS_W = 390 * MiB;
constexpr size_t WS_END = 408 * MiB;
constexpr int LDS_BYTES = 148480;
constexpr int NEXP = 16384;

struct Params {
    const float *x, *c, *w_ada, *b_ada, *w_in, *sink, *qnorm, *w_qup, *kvnorm, *w_kvup, *onorm_a, *onorm_b, *w_out, *w_pq, *subk, *eu, *ev, *fnorm;
    float* out;
    unsigned char* ws;
};

typedef short bf16x8 __attribute__((ext_vector_type(8)));
typedef float f32x4 __attribute__((ext_vector_type(4)));
typedef unsigned u32x4 __attribute__((ext_vector_type(4)));
typedef float f32x2 __attribute__((ext_vector_type(2)));

__device__ __forceinline__ int tid_opaque() { int t = threadIdx.x; asm volatile("" : "+v"(t)); return t; }
__device__ __forceinline__ unsigned f2bf(float f) { unsigned u = __builtin_bit_cast(unsigned, f); return (u + 0x7fffu + ((u >> 16) & 1u)) >> 16; }
__device__ __forceinline__ unsigned pk2(float lo, float hi) { return f2bf(lo) | (f2bf(hi) << 16); }
__device__ __forceinline__ float bf2f(unsigned short h) { return __builtin_bit_cast(float, (unsigned)h << 16); }
__device__ __forceinline__ float bflo(unsigned w) { return __builtin_bit_cast(float, w << 16); }
__device__ __forceinline__ float bfhi(unsigned w) { return __builtin_bit_cast(float, w & 0xffff0000u); }
__device__ __forceinline__ float wave_sum(float v) {
#pragma unroll
    for (int o = 1; o < 64; o <<= 1) v += __shfl_xor(v, o);
    return v;
}

__device__ __forceinline__ float wave_max(float v) {
#pragma unroll
    for (int o = 1; o < 64; o <<= 1) v = fmaxf(v, __shfl_xor(v, o));
    return v;
}
template <int CTRL> __device__ __forceinline__ float dpp_add(float s) {
    return s + __builtin_bit_cast(float, __builtin_amdgcn_update_dpp(0, __builtin_bit_cast(int, s), CTRL, 0xF, 0xF, true));
}
__device__ __forceinline__ float group16_sum(float s) { s = dpp_add<0xB1>(s); s = dpp_add<0x4E>(s); s = dpp_add<0x141>(s); s = dpp_add<0x140>(s); return s; }

__device__ void stage_gemv8(const float* vec, int vstride, bool silu, const float* W, int N, const float* bias, float* dst, float* lds) {
    const int tid = threadIdx.x;
    __syncthreads();
    for (int i = tid; i < Bsz * D; i += NTHREADS) { const int b = i >> 10, k = i & 1023; float v = vec[b * vstride + k]; lds[i] = silu ? v / (1.f + __expf(-v)) : v; }
    __syncthreads();
    float* red = lds + Bsz * D;
    const int col_l = tid & 15, slice = tid >> 4;
    for (int item = blockIdx.x; item < N / 16; item += gridDim.x) {
        const int n = item * 16 + col_l;
        float acc[Bsz];
#pragma unroll
        for (int b = 0; b < Bsz; ++b) acc[b] = 0.f;
#pragma unroll 8
        for (int kk = 0; kk < 32; ++kk) {
            const int k = slice * 32 + kk;
            const float w = W[(size_t)k * N + n];
#pragma unroll
            for (int b = 0; b < Bsz; ++b) acc[b] += lds[b * D + k] * w;
        }
#pragma unroll
        for (int b = 0; b < Bsz; ++b) red[(slice * 16 + col_l) * Bsz + b] = acc[b];
        __syncthreads();
        if (tid < 128) {
            const int cc = tid >> 3, b = tid & 7;
            float sacc = 0.f;
#pragma unroll
            for (int sl = 0; sl < 32; ++sl) sacc += red[(sl * 16 + cc) * Bsz + b];
            dst[b * N + item * 16 + cc] = sacc + (bias ? bias[item * 16 + cc] : 0.f);
        }
        __syncthreads();
    }
}

template <int MAP> __device__ __forceinline__ int map_row(int n) {
    if (MAP == 1) { const int h = n / 96, j = n % 96; return j < 64 ? h * 64 + j : 512 + h * 32 + (j - 64); }
    return n;
}
template <int MAP>
__device__ __forceinline__ void transpose_item(const float* W, int K, int N, unsigned short* WT, const float* kgain, float* scr, int item, int lane, const float* kgain2 = nullptr) {
    const int nblk = N / 32, kb = item / nblk, nb = item % nblk, k0 = 64 * kb, n0 = 32 * nb;
#pragma unroll 8
    for (int i = 0; i < 32; ++i) {
        const int kk = 2 * i + (lane >> 5);
        float w = W[(size_t)(k0 + kk) * N + n0 + (lane & 31)];
        if (kgain) w *= (kgain2 && k0 + kk >= 512) ? kgain2[k0 + kk - 512] : kgain[k0 + kk];
        scr[kk * 33 + (lane & 31)] = w;
    }
    asm volatile("s_waitcnt lgkmcnt(0)" ::: "memory");
    const int c = lane & 7;
#pragma unroll
    for (int j = 0; j < 4; ++j) {
        const int n = (lane >> 3) + 8 * j; const float* q = scr + (8 * c) * 33 + n;
        u32x4 o; o.x = pk2(q[0 * 33], q[1 * 33]); o.y = pk2(q[2 * 33], q[3 * 33]); o.z = pk2(q[4 * 33], q[5 * 33]); o.w = pk2(q[6 * 33], q[7 * 33]);
        *(u32x4*)(WT + (size_t)map_row<MAP>(n0 + n) * K + k0 + 8 * c) = o;
    }
    asm volatile("s_waitcnt lgkmcnt(0)" ::: "memory");
}

__device__ void stage_prologue(const Params& p, float* lds) {
    const int tid = threadIdx.x;
    stage_gemv8(p.c, D, true, p.w_ada, NMOD, p.b_ada, (float*)(p.ws + WS_MOD), lds);
    float* cosA = (float*)(p.ws + WS_COSA); float* sinA = (float*)(p.ws + WS_SINA);
    float* cosB = (float*)(p.ws + WS_COSB); float* sinB = (float*)(p.ws + WS_SINB);
    const int gtid = blockIdx.x * NTHREADS + tid, gn = gridDim.x * NTHREADS;
    for (int e = gtid; e < S * 32; e += gn) {
        const int pos = e >> 5, i = e & 31;
        const double inv = exp2(-(double)(2 * i) / 64.0 * 13.287712379549449);
        const double a = (double)pos * inv;
        cosA[e] = (float)cos(a); sinA[e] = (float)sin(a);
    }
    for (int e = gtid; e < S * 16; e += gn) {
        const int pos = e >> 4, i = e & 15;
        const double inv = exp2(-(double)(2 * i) / 32.0 * 13.287712379549449);
        const double a = (double)pos * inv;
        cosB[e] = (float)cos(a); sinB[e] = (float)sin(a);
    }
    {
        const int lane = tid & 63, wave = tid >> 6;
        float* scr = lds + wave * (64 * 33);
        const int gw = blockIdx.x * NWAVES + wave, NGW = gridDim.x * NWAVES;
        constexpr int I_IN = (D / 64) * (INW / 32), I_QU = (256 / 64) * (768 / 32), I_KV = (128 / 64) * (1024 / 32), I_OUT = (D / 64) * (D / 32), I_PQ = (D / 64) * (2048 / 32);
        constexpr int NITEMS = I_IN + I_QU + I_KV + I_OUT + I_PQ;
        __syncthreads();
        for (int it = gw; it < NITEMS; it += NGW) {
            int r = it;
            if (r < I_IN) { transpose_item<0>(p.w_in, D, INW, (unsigned short*)(p.ws + WS_WIN), nullptr, scr, r, lane); continue; } r -= I_IN;
            if (r < I_QU) { transpose_item<1>(p.w_qup, 256, 768, (unsigned short*)(p.ws + WS_WQUP), p.qnorm, scr, r, lane); continue; } r -= I_QU;
            if (r < I_KV) { transpose_item<0>(p.w_kvup, 128, 1024, (unsigned short*)(p.ws + WS_WKVUP), p.kvnorm, scr, r, lane); continue; } r -= I_KV;
            if (r < I_OUT) { transpose_item<0>(p.w_out, D, D, (unsigned short*)(p.ws + WS_WOUT), p.onorm_a, scr, r, lane, p.onorm_b); continue; } r -= I_OUT;
            transpose_item<0>(p.w_pq, D, 2048, (unsigned short*)(p.ws + WS_WPQ), nullptr, scr, r, lane);
        }
        {
            u32x4* z = (u32x4*)(p.ws + WS_WIN + (size_t)INW * D * 2);
            const int nz = (1280 - INW) * D * 2 / 16;
            for (int e = blockIdx.x * NTHREADS + tid; e < nz; e += gridDim.x * NTHREADS) z[e] = (u32x4){0u, 0u, 0u, 0u};
        }
        {
            const f32x4* src = (const f32x4*)p.subk; unsigned long long* dst = (unsigned long long*)(p.ws + WS_SUBK);
            for (int e = blockIdx.x * NTHREADS + tid; e < 16 * 128 * 128 / 4; e += gridDim.x * NTHREADS) {
                const f32x4 v = src[e]; dst[e] = (unsigned long long)pk2(v.x, v.y) | ((unsigned long long)pk2(v.z, v.w) << 32);
            }
        }
    }
    {
        const int lane = tid & 63, wave = tid >> 6;
        for (int r = blockIdx.x * NWAVES + wave; r < 2 * NEXP; r += gridDim.x * NWAVES) {
            const int tab = r >= NEXP, row = r - tab * NEXP;
            const f32x4* src = (const f32x4*)((tab ? p.ev : p.eu) + (size_t)row * D) + lane;
            f32x4 v[4]; float am = 0.f;
#pragma unroll
            for (int j = 0; j < 4; ++j) { v[j] = src[64 * j]; am = fmaxf(am, fmaxf(fmaxf(fabsf(v[j].x), fabsf(v[j].y)), fmaxf(fabsf(v[j].z), fabsf(v[j].w)))); }
            am = wave_max(am);
            int ex = 0; (void)frexpf(am, &ex);
            const float sc = ldexpf(1.f, 8 - ex), isc = ldexpf(1.f, ex - 8);
            unsigned* dst = (unsigned*)(p.ws + (tab ? WS_EV8 : WS_EU8) + (size_t)row * D) + lane;
#pragma unroll
            for (int j = 0; j < 4; ++j) {
                int w = 0;
                w = __builtin_amdgcn_cvt_pk_fp8_f32(v[j].x * sc, v[j].y * sc, w, false);
                w = __builtin_amdgcn_cvt_pk_fp8_f32(v[j].z * sc, v[j].w * sc, w, true);
                dst[64 * j] = (unsigned)w;
            }
            if (lane == 0) ((float*)(p.ws + (tab ? WS_VS : WS_US)))[row] = isc;
        }
    }
}

template <bool BF>
__device__ void stage_norm_mod(const Params& p, const float* src, void* dstv, int sh_off, int sc_off) {
    const float* mod = (const float*)(p.ws + WS_MOD);
    const int lane = threadIdx.x & 63, wave = threadIdx.x >> 6;
    for (int t = blockIdx.x * NWAVES + wave; t < T; t += gridDim.x * NWAVES) {
        const int b = t >> 12;
        const f32x4* xr = (const f32x4*)(src + (size_t)t * D) + lane;
        f32x4 v[4]; float s = 0.f;
#pragma unroll
        for (int j = 0; j < 4; ++j) { v[j] = xr[64 * j]; s += v[j].x * v[j].x + v[j].y * v[j].y + v[j].z * v[j].z + v[j].w * v[j].w; }
        const float rstd = rsqrtf(wave_sum(s) * (1.f / D) + EPS);
#pragma unroll
        for (int j = 0; j < 4; ++j) {
            const f32x4 sh = *((const f32x4*)(mod + b * NMOD + sh_off) + lane + 64 * j);
            const f32x4 sc = *((const f32x4*)(mod + b * NMOD + sc_off) + lane + 64 * j);
            f32x4 r;
            r.x = v[j].x * rstd * (1.f + sc.x) + sh.x; r.y = v[j].y * rstd * (1.f + sc.y) + sh.y;
            r.z = v[j].z * rstd * (1.f + sc.z) + sh.z; r.w = v[j].w * rstd * (1.f + sc.w) + sh.w;
            if (BF) ((unsigned long long*)((unsigned short*)dstv + (size_t)t * D))[lane + 64 * j] = (unsigned long long)pk2(r.x, r.y) | ((unsigned long long)pk2(r.z, r.w) << 32);
            else ((f32x4*)((float*)dstv + (size_t)t * D))[lane + 64 * j] = r;
        }
    }
}

constexpr int TP = 128, TQ = 256, TBK = 64;
constexpr int XS_BYTES = TP * 128, YS_BYTES = TQ * 128, STG_BYTES = XS_BYTES + YS_BYTES;
__device__ __forceinline__ int swz(int r, int c) { return r * 128 + ((c ^ ((r >> 1) & 7)) << 4); }
constexpr int SSQ_OFF = 2 * (TP * 128 + TQ * 128);
__device__ __forceinline__ float ssq8(u32x4 w) {
    const float a0 = bflo(w.x), a1 = bfhi(w.x), a2 = bflo(w.y), a3 = bfhi(w.y), a4 = bflo(w.z), a5 = bfhi(w.z), a6 = bflo(w.w), a7 = bfhi(w.w);
    return (a0 * a0 + a1 * a1) + (a2 * a2 + a3 * a3) + (a4 * a4 + a5 * a5) + (a6 * a6 + a7 * a7);
}
template <int WPN, bool YSSQ, class Epi>
__device__ void gemm_xyT(const unsigned short* X, int ldx, const unsigned short* Y, int ldy, int P, int Q, int K, int nb, size_t xbs, size_t ybs, unsigned char* lds, const Epi& epi) {
    constexpr int WQN = 8 / WPN, FI = TP / (WPN * 16), FJ = TQ / (WQN * 16);
    const int tid = threadIdx.x, lane = tid & 63, wave = tid >> 6;
    const int wp = wave / WQN, wq = wave % WQN, fr = lane & 15, fq = lane >> 4;
    const int nPt = P / TP, nQt = Q / TQ, npb = nPt * nb, nunits = npb * nQt;
    const int G = gridDim.x, bx = blockIdx.x;
    const int vcu = (G % 8 == 0) ? (bx % 8) * (G / 8) + bx / 8 : bx;
    const int srow = tid >> 3, sc = tid & 7;
    const int nk = K / TBK;
    for (int u = vcu; u < nunits; u += G) {
        const int qt = u / npb, rem = u % npb, bi = rem / nPt, pt = rem % nPt, p0 = pt * TP, q0 = qt * TQ;
        f32x4 acc[FI][FJ];
#pragma unroll
        for (int i = 0; i < FI; ++i)
#pragma unroll
            for (int j = 0; j < FJ; ++j) acc[i][j] = (f32x4){0.f, 0.f, 0.f, 0.f};
        const unsigned short* xg = X + (size_t)bi * xbs + (size_t)(p0 + srow) * ldx + sc * 8;
        const unsigned short* yg = Y + (size_t)bi * ybs + (size_t)(q0 + srow) * ldy + sc * 8;
        u32x4 rx[2], ry[4];
        float sq[4] = {0.f, 0.f, 0.f, 0.f};
#pragma unroll
        for (int i = 0; i < 2; ++i) rx[i] = *(const u32x4*)(xg + (size_t)(64 * i) * ldx);
#pragma unroll
        for (int i = 0; i < 4; ++i) ry[i] = *(const u32x4*)(yg + (size_t)(64 * i) * ldy);
        if (YSSQ) {
#pragma unroll
            for (int i = 0; i < 4; ++i) sq[i] += ssq8(ry[i]);
        }
        __syncthreads();
#pragma unroll
        for (int i = 0; i < 2; ++i) *(u32x4*)(lds + swz(srow + 64 * i, sc)) = rx[i];
#pragma unroll
        for (int i = 0; i < 4; ++i) *(u32x4*)(lds + XS_BYTES + swz(srow + 64 * i, sc)) = ry[i];
        __syncthreads();
        for (int kt = 0; kt < nk; ++kt) {
            unsigned char* st = lds + (kt & 1) * STG_BYTES;
            unsigned char* sn = lds + ((kt & 1) ^ 1) * STG_BYTES;
            const bool more = (kt + 1 < nk);
            if (more) {
                const int k1 = (kt + 1) * TBK;
#pragma unroll
                for (int i = 0; i < 2; ++i) rx[i] = *(const u32x4*)(xg + (size_t)(64 * i) * ldx + k1);
#pragma unroll
                for (int i = 0; i < 4; ++i) ry[i] = *(const u32x4*)(yg + (size_t)(64 * i) * ldy + k1);
            }
            if (YSSQ && more) {
#pragma unroll
                for (int i = 0; i < 4; ++i) sq[i] += ssq8(ry[i]);
            }
#pragma unroll
            for (int kk = 0; kk < 2; ++kk) {
                bf16x8 af[FI], bfr[FJ];
#pragma unroll
                for (int i = 0; i < FI; ++i) af[i] = *(const bf16x8*)(st + swz(wp * (FI * 16) + i * 16 + fr, kk * 4 + fq));
#pragma unroll
                for (int j = 0; j < FJ; ++j) bfr[j] = *(const bf16x8*)(st + XS_BYTES + swz(wq * (FJ * 16) + j * 16 + fr, kk * 4 + fq));
#pragma unroll
                for (int i = 0; i < FI; ++i)
#pragma unroll
                    for (int j = 0; j < FJ; ++j) acc[i][j] = __builtin_amdgcn_mfma_f32_16x16x32_bf16(af[i], bfr[j], acc[i][j], 0, 0, 0);
            }
            if (more) {
#pragma unroll
                for (int i = 0; i < 2; ++i) *(u32x4*)(sn + swz(srow + 64 * i, sc)) = rx[i];
#pragma unroll
                for (int i = 0; i < 4; ++i) *(u32x4*)(sn + XS_BYTES + swz(srow + 64 * i, sc)) = ry[i];
            }
            __syncthreads();
        }
        if (YSSQ) {
            float* ssq = (float*)(lds + SSQ_OFF);
#pragma unroll
            for (int i = 0; i < 4; ++i) {
                float v = sq[i];
                v += __shfl_xor(v, 1); v += __shfl_xor(v, 2); v += __shfl_xor(v, 4);
                if (sc == 0) ssq[srow + 64 * i] = v;
            }
            __syncthreads();
        }
        epi(acc, p0 + wp * (FI * 16), q0 + wq * (FJ * 16), lane, (const float*)(lds + SSQ_OFF) + wq * (FJ * 16), bi);
        if (YSSQ) __syncthreads();
    }
}
constexpr int DMA_STAGES = 3;
#define RAW_BARRIER() do { asm volatile("s_waitcnt lgkmcnt(0)" ::: "memory"); __builtin_amdgcn_s_barrier(); } while (0)
template <int WPN, int SUB, class Epi>
__device__ void gemm_dma(const unsigned short* X, int ldx, const unsigned short* Y, int ldy, int P, int Q, int K, int nb, size_t xbs, size_t ybs, unsigned char* lds, Epi epi) {
    constexpr int WQN = 8 / WPN, FI = TP / (WPN * 16), FJ = TQ / (WQN * 16);
    const int tid = threadIdx.x, lane = tid & 63, wave = __builtin_amdgcn_readfirstlane(tid >> 6);
    const int wp = wave / WQN, wq = wave % WQN, fr = lane & 15, fq = lane >> 4;
    const int nPt = P / TP, nQt = Q / TQ, npb = nPt * nb / SUB, nunits = npb * nQt;
    const int G = gridDim.x, bx = blockIdx.x;
    const int vcu = (G % 8 == 0) ? (bx % 8) * (G / 8) + bx / 8 : bx;
    const int srow = wave * 8 + (lane >> 3), pc = lane & 7;
    const int nk = K / TBK;
    const int lc = pc ^ ((srow >> 1) & 7);
    for (int u = vcu; u < nunits; u += G)
#pragma unroll
    for (int sub = 0; sub < SUB; ++sub) {
        const int qt = u / npb, rem = (u % npb) * SUB + sub, bi = rem / nPt, pt = rem % nPt, p0 = pt * TP, q0 = qt * TQ;
        f32x4 acc[FI][FJ];
#pragma unroll
        for (int i = 0; i < FI; ++i)
#pragma unroll
            for (int j = 0; j < FJ; ++j) acc[i][j] = (f32x4){0.f, 0.f, 0.f, 0.f};
        const unsigned short* xg = X + (size_t)bi * xbs + (size_t)(p0 + srow) * ldx + lc * 8;
        const unsigned short* yg = Y + (size_t)bi * ybs + (size_t)(q0 + srow) * ldy + lc * 8;
        epi.pre(q0 + wq * (FJ * 16), lane);
        asm volatile("s_waitcnt vmcnt(0)" ::: "memory");
        RAW_BARRIER();
#define GEMM_DMA_TILE(kt_, stg_) do { \
            unsigned char* _b = lds + (stg_) * STG_BYTES + wave * 1024; const int _k = (kt_) * TBK; \
            _Pragma("unroll") for (int _i = 0; _i < 2; ++_i) __builtin_amdgcn_global_load_lds((const unsigned*)(xg + (size_t)(64 * _i) * ldx + _k), (unsigned*)(_b + _i * 8192), 16, 0, 0); \
            _Pragma("unroll") for (int _i = 0; _i < 4; ++_i) __builtin_amdgcn_global_load_lds((const unsigned*)(yg + (size_t)(64 * _i) * ldy + _k), (unsigned*)(_b + XS_BYTES + _i * 8192), 16, 0, 0); \
        } while (0)
        GEMM_DMA_TILE(0, 0);
        GEMM_DMA_TILE(1, 1);
        int cur = 0;
        for (int kt = 0; kt < nk; ++kt) {
            if (kt + 1 < nk) asm volatile("s_waitcnt vmcnt(6)" ::: "memory");
            else if (Epi::HAS_LATE) asm volatile("s_waitcnt vmcnt(16)" ::: "memory");
            else asm volatile("s_waitcnt vmcnt(0)" ::: "memory");
            RAW_BARRIER();
            if (kt + 2 < nk) { const int nxt = (cur == 0) ? 2 : cur - 1; GEMM_DMA_TILE(kt + 2, nxt); }
            if (Epi::HAS_LATE && kt + 2 == nk) epi.late(p0 + wp * (FI * 16), q0 + wq * (FJ * 16), lane);
            const unsigned char* st = lds + cur * STG_BYTES;
#pragma unroll
            for (int kk = 0; kk < 2; ++kk) {
                bf16x8 af[FI], bfr[FJ];
#pragma unroll
                for (int i = 0; i < FI; ++i) af[i] = *(const bf16x8*)(st + swz(wp * (FI * 16) + i * 16 + fr, kk * 4 + fq));
#pragma unroll
                for (int j = 0; j < FJ; ++j) bfr[j] = *(const bf16x8*)(st + XS_BYTES + swz(wq * (FJ * 16) + j * 16 + fr, kk * 4 + fq));
#pragma unroll
                for (int i = 0; i < FI; ++i)
#pragma unroll
                    for (int j = 0; j < FJ; ++j) acc[i][j] = __builtin_amdgcn_mfma_f32_16x16x32_bf16(af[i], bfr[j], acc[i][j], 0, 0, 0);
            }
            cur = (cur == 2) ? 0 : cur + 1;
            if (Epi::HAS_MID && kt + 1 == (nk >> 1)) epi.mid(acc);
        }
#undef GEMM_DMA_TILE
        epi(acc, p0 + wp * (FI * 16), q0 + wq * (FJ * 16), lane, (const float*)nullptr, bi, sub);
    }
}
__device__ __forceinline__ unsigned long long pk4(float a, float b, float c, float d) { return (unsigned long long)pk2(a, b) | ((unsigned long long)pk2(c, d) << 32); }
struct EpiOutProj {
    static constexpr bool HAS_MID = true;
    static constexpr bool HAS_LATE = true;
    const float* x; const float* mod; float* out; unsigned short* y1; const float* ssqo; float* ssq1;
    float ratio[4], rb[4];
    f32x4 xv[4][4];
    __device__ __forceinline__ void late(int pb, int qb, int lane) {
        const int fr = lane & 15, fq = lane >> 4;
#pragma unroll
        for (int j = 0; j < 4; ++j)
#pragma unroll
            for (int i = 0; i < 4; ++i) xv[j][i] = *(const f32x4*)(x + (size_t)(qb + j * 16 + fr) * D + pb + i * 16 + fq * 4);
    }
    __device__ __forceinline__ void pre(int qb, int lane) {
#pragma unroll
        for (int j = 0; j < 4; ++j) {
            const f32x4* s4 = (const f32x4*)(ssqo + (size_t)(qb + j * 16 + (lane & 15)) * 16);
            const f32x4 a0 = s4[0], a1 = s4[1], b0 = s4[2], b1 = s4[3];
            const float sa = (a0.x + a0.y + a0.z + a0.w) + (a1.x + a1.y + a1.z + a1.w), sb = (b0.x + b0.y + b0.z + b0.w) + (b1.x + b1.y + b1.z + b1.w);
            const float ra = rsqrtf(sa * (1.f / 512.f) + EPS); rb[j] = rsqrtf(sb * (1.f / 512.f) + EPS); ratio[j] = ra / rb[j];
        }
    }
    __device__ __forceinline__ void mid(f32x4 (&acc)[4][4]) {
#pragma unroll
        for (int i = 0; i < 4; ++i)
#pragma unroll
            for (int j = 0; j < 4; ++j) { acc[i][j].x *= ratio[j]; acc[i][j].y *= ratio[j]; acc[i][j].z *= ratio[j]; acc[i][j].w *= ratio[j]; }
    }
    __device__ __forceinline__ void operator()(const f32x4 (&acc)[4][4], int pb, int qb, int lane, const float*, int, int = 0) {
        const int fr = lane & 15, fq = lane >> 4;
        const float* __restrict__ xr = x; float* __restrict__ outr = out; unsigned short* __restrict__ yr = y1; float* __restrict__ sr = ssq1;
        const float* mt = mod + (qb >> 12) * NMOD + pb + fq * 4;
        f32x4 gv[4], scv[4];
#pragma unroll
        for (int i = 0; i < 4; ++i) { gv[i] = *(const f32x4*)(mt + 2 * D + i * 16); scv[i] = *(const f32x4*)(mt + 4 * D + i * 16); }
#pragma unroll
        for (int j = 0; j < 4; ++j) {
            const int t = qb + j * 16 + fr;
            float ss = 0.f;
#pragma unroll
            for (int i = 0; i < 4; ++i) {
                const int n = pb + i * 16 + fq * 4;
                const f32x4 xx = xv[j][i];
                f32x4 r; r.x = xx.x + gv[i].x * (acc[i][j].x * rb[j]); r.y = xx.y + gv[i].y * (acc[i][j].y * rb[j]); r.z = xx.z + gv[i].z * (acc[i][j].z * rb[j]); r.w = xx.w + gv[i].w * (acc[i][j].w * rb[j]);
                *(f32x4*)(outr + (size_t)t * D + n) = r;
                ss += (r.x * r.x + r.y * r.y) + (r.z * r.z + r.w * r.w);
                *(unsigned long long*)(yr + (size_t)t * D + n) = pk4(r.x * (1.f + scv[i].x), r.y * (1.f + scv[i].y), r.z * (1.f + scv[i].z), r.w * (1.f + scv[i].w));
            }
            ss += __shfl_xor(ss, 16); ss += __shfl_xor(ss, 32);
            if (fq == 0) sr[(size_t)t * 16 + (pb >> 6)] = ss;
        }
    }
};
struct EpiPQ {
    static constexpr bool HAS_MID = false, HAS_LATE = false;
    __device__ __forceinline__ void late(int, int, int) {}
    unsigned short* C; const float* ssq1; const float* bias;
    float r1[4];
    __device__ __forceinline__ void pre(int qb, int lane) {
#pragma unroll
        for (int j = 0; j < 4; ++j) {
            const f32x4* s4 = (const f32x4*)(ssq1 + (size_t)(qb + j * 16 + (lane & 15)) * 16);
            const f32x4 a0 = s4[0], a1 = s4[1], a2 = s4[2], a3 = s4[3];
            const float sa = ((a0.x + a0.y + a0.z + a0.w) + (a1.x + a1.y + a1.z + a1.w)) + ((a2.x + a2.y + a2.z + a2.w) + (a3.x + a3.y + a3.z + a3.w));
            r1[j] = rsqrtf(sa * (1.f / D) + EPS);
        }
    }
    template <class A> __device__ __forceinline__ void mid(A&) {}
    __device__ __forceinline__ void operator()(const f32x4 (&acc)[4][4], int pb, int qb, int lane, const float*, int, int = 0) {
        const int fr = lane & 15, fq = lane >> 4;
        unsigned short* __restrict__ Cr = C;
        const float* bt = bias + (qb >> 12) * 2048 + pb + fq * 4;
        f32x4 bv[4];
#pragma unroll
        for (int i = 0; i < 4; ++i) bv[i] = *(const f32x4*)(bt + i * 16);
#pragma unroll
        for (int j = 0; j < 4; ++j) {
            const int t = qb + j * 16 + fr;
#pragma unroll
            for (int i = 0; i < 4; ++i) {
                const int n = pb + i * 16 + fq * 4;
                *(unsigned long long*)(Cr + (size_t)t * 2048 + n) = pk4(acc[i][j].x * r1[j] + bv[i].x, acc[i][j].y * r1[j] + bv[i].y, acc[i][j].z * r1[j] + bv[i].z, acc[i][j].w * r1[j] + bv[i].w);
            }
        }
    }
};

struct EpiProj {
    static constexpr bool HAS_MID = false, HAS_LATE = false;
    __device__ __forceinline__ void late(int, int, int) {}
    __device__ __forceinline__ void pre(int, int) {}
    template <class A> __device__ __forceinline__ void mid(A&) {}
    unsigned char* ws;
    __device__ __forceinline__ void operator()(const f32x4 (&acc)[4][4], int pb, int qb, int lane, const float*, int, int = 0) const {
        const int fr = lane & 15, fq = lane >> 4;
        if (pb >= 1216) return;
        const int t0 = qb + fr, b = t0 >> 12, pos0 = t0 & (S - 1);
        if (pb < C_VA) {
            const float* __restrict__ cosA = (const float*)(ws + WS_COSA); const float* __restrict__ sinA = (const float*)(ws + WS_SINA);
            const bool isq = pb < C_KA;
            const int head = isq ? (pb >> 6) : ((pb - C_KA) >> 6);
            unsigned short* __restrict__ dst0 = isq ? (unsigned short*)(ws + WS_QA) + ((size_t)(b * 8 + head) * S + pos0) * 64 : (unsigned short*)(ws + WS_KA) + ((size_t)(b * 2 + head) * S + pos0) * 64;
            const float sc = isq ? QA_SCALE : 1.f;
#pragma unroll
            for (int jh = 0; jh < 4; jh += 2) {
                f32x4 c[2][2], sn[2][2];
#pragma unroll
                for (int jj = 0; jj < 2; ++jj)
#pragma unroll
                    for (int i = 0; i < 2; ++i) { c[jj][i] = *(const f32x4*)(cosA + (pos0 + 16 * (jh + jj)) * 32 + i * 16 + fq * 4); sn[jj][i] = *(const f32x4*)(sinA + (pos0 + 16 * (jh + jj)) * 32 + i * 16 + fq * 4); }
#pragma unroll
                for (int jj = 0; jj < 2; ++jj)
#pragma unroll
                    for (int i = 0; i < 2; ++i) {
                        const int j = jh + jj, d = i * 16 + fq * 4;
                        const f32x4 x1 = acc[i][j], x2 = acc[i + 2][j], cc = c[jj][i], ss = sn[jj][i];
                        unsigned short* dst = dst0 + (size_t)(16 * j) * 64;
                        *(unsigned long long*)(dst + d) = pk4((x1.x * cc.x - x2.x * ss.x) * sc, (x1.y * cc.y - x2.y * ss.y) * sc, (x1.z * cc.z - x2.z * ss.z) * sc, (x1.w * cc.w - x2.w * ss.w) * sc);
                        *(unsigned long long*)(dst + 32 + d) = pk4((x2.x * cc.x + x1.x * ss.x) * sc, (x2.y * cc.y + x1.y * ss.y) * sc, (x2.z * cc.z + x1.z * ss.z) * sc, (x2.w * cc.w + x1.w * ss.w) * sc);
                    }
            }
        } else if (pb < C_QL) {
            const int kvh = (pb - C_VA) >> 6;
            unsigned short* __restrict__ dst0 = (unsigned short*)(ws + WS_VAT) + (size_t)(b * 2 + kvh) * 64 * S + pos0;
#pragma unroll
            for (int j = 0; j < 4; ++j)
#pragma unroll
                for (int i = 0; i < 4; ++i) {
                    const int dv = i * 16 + fq * 4; unsigned short* dst = dst0 + 16 * j;
                    dst[(size_t)(dv + 0) * S] = (unsigned short)f2bf(acc[i][j].x); dst[(size_t)(dv + 1) * S] = (unsigned short)f2bf(acc[i][j].y);
                    dst[(size_t)(dv + 2) * S] = (unsigned short)f2bf(acc[i][j].z); dst[(size_t)(dv + 3) * S] = (unsigned short)f2bf(acc[i][j].w);
                }
        } else if (pb < C_KR) {
            const bool isq = pb < C_KVL;
            unsigned short* __restrict__ dst0 = isq ? (unsigned short*)(ws + WS_QL) + (size_t)t0 * 256 + (pb - C_QL) : (unsigned short*)(ws + WS_KVL) + (size_t)t0 * 128 + (pb - C_KVL);
            const int ld = isq ? 256 : 128;
#pragma unroll
            for (int j = 0; j < 4; ++j)
#pragma unroll
                for (int i = 0; i < 4; ++i) *(unsigned long long*)(dst0 + (size_t)(16 * j) * ld + i * 16 + fq * 4) = pk4(acc[i][j].x, acc[i][j].y, acc[i][j].z, acc[i][j].w);
        } else {
            const float* __restrict__ cosB = (const float*)(ws + WS_COSB); const float* __restrict__ sinB = (const float*)(ws + WS_SINB);
            unsigned short* __restrict__ K96 = (unsigned short*)(ws + WS_K96);
            const int d = fq * 4;
            f32x4 c[4], sn[4];
#pragma unroll
            for (int j = 0; j < 4; ++j) { c[j] = *(const f32x4*)(cosB + (pos0 + 16 * j) * 16 + d); sn[j] = *(const f32x4*)(sinB + (pos0 + 16 * j) * 16 + d); }
#pragma unroll
            for (int j = 0; j < 4; ++j) {
                const f32x4 x1 = acc[0][j], x2 = acc[1][j], cc = c[j], ss = sn[j];
                const unsigned long long lo = pk4(x1.x * cc.x - x2.x * ss.x, x1.y * cc.y - x2.y * ss.y, x1.z * cc.z - x2.z * ss.z, x1.w * cc.w - x2.w * ss.w);
                const unsigned long long hi = pk4(x2.x * cc.x + x1.x * ss.x, x2.y * cc.y + x1.y * ss.y, x2.z * cc.z + x1.z * ss.z, x2.w * cc.w + x1.w * ss.w);
#pragma unroll
                for (int h = 0; h < 8; ++h) {
                    unsigned short* dst = K96 + ((size_t)(b * 8 + h) * S + pos0 + 16 * j) * 96 + 64 + d;
                    *(unsigned long long*)dst = lo; *(unsigned long long*)(dst + 16) = hi;
                }
            }
        }
    }
};
struct EpiQup {
    unsigned char* ws;
    __device__ __forceinline__ void operator()(const f32x4 (&acc)[4][4], int pb, int qb, int lane, const float* ssq, int, int = 0) const {
        const int fr = lane & 15, fq = lane >> 4;
        unsigned short* __restrict__ QMB = (unsigned short*)(ws + WS_QMB);
        const float* __restrict__ cosB = (const float*)(ws + WS_COSB); const float* __restrict__ sinB = (const float*)(ws + WS_SINB);
        const int t0 = qb + fr, b = t0 >> 12, pos0 = t0 & (S - 1);
        float sc[4];
#pragma unroll
        for (int j = 0; j < 4; ++j) sc[j] = rsqrtf(ssq[j * 16 + fr] * (1.f / 256.f) + EPS) * QM_SCALE;
        if (pb < 512) {
            unsigned short* dst0 = QMB + ((size_t)(b * 8 + (pb >> 6)) * S + pos0) * 96;
#pragma unroll
            for (int j = 0; j < 4; ++j)
#pragma unroll
                for (int i = 0; i < 4; ++i) *(unsigned long long*)(dst0 + (size_t)(16 * j) * 96 + i * 16 + fq * 4) = pk4(acc[i][j].x * sc[j], acc[i][j].y * sc[j], acc[i][j].z * sc[j], acc[i][j].w * sc[j]);
        } else {
            const int d = fq * 4;
            f32x4 c[4], sn[4];
#pragma unroll
            for (int j = 0; j < 4; ++j) { c[j] = *(const f32x4*)(cosB + (pos0 + 16 * j) * 16 + d); sn[j] = *(const f32x4*)(sinB + (pos0 + 16 * j) * 16 + d); }
#pragma unroll
            for (int j = 0; j < 4; ++j)
#pragma unroll
                for (int hh = 0; hh < 2; ++hh) {
                    const int h = ((pb - 512) >> 5) + hh;
                    unsigned short* dst = QMB + ((size_t)(b * 8 + h) * S + pos0 + 16 * j) * 96 + 64 + d;
                    const f32x4 x1 = acc[2 * hh][j], x2 = acc[2 * hh + 1][j], cc = c[j], ss = sn[j]; const float s_ = sc[j];
                    *(unsigned long long*)dst = pk4((x1.x * cc.x - x2.x * ss.x) * s_, (x1.y * cc.y - x2.y * ss.y) * s_, (x1.z * cc.z - x2.z * ss.z) * s_, (x1.w * cc.w - x2.w * ss.w) * s_);
                    *(unsigned long long*)(dst + 16) = pk4((x2.x * cc.x + x1.x * ss.x) * s_, (x2.y * cc.y + x1.y * ss.y) * s_, (x2.z * cc.z + x1.z * ss.z) * s_, (x2.w * cc.w + x1.w * ss.w) * s_);
                }
        }
    }
};
struct EpiKVup {
    unsigned char* ws;
    __device__ __forceinline__ void operator()(const f32x4 (&acc)[4][4], int pb, int qb, int lane, const float* ssq, int, int = 0) const {
        const int fr = lane & 15, fq = lane >> 4;
        unsigned short* K96 = (unsigned short*)(ws + WS_K96); unsigned short* VT = (unsigned short*)(ws + WS_VT);
        const int h = pb >> 7;
#pragma unroll
        for (int j = 0; j < 4; ++j) {
            const int t = qb + j * 16 + fr, b = t >> 12, pos = t & (S - 1);
            const float sc = rsqrtf(ssq[j * 16 + fr] * (1.f / 128.f) + EPS);
            if ((pb & 64) == 0) {
                unsigned short* dst = K96 + ((size_t)(b * 8 + h) * S + pos) * 96;
#pragma unroll
                for (int i = 0; i < 4; ++i) *(unsigned long long*)(dst + i * 16 + fq * 4) = pk4(acc[i][j].x * sc, acc[i][j].y * sc, acc[i][j].z * sc, acc[i][j].w * sc);
            } else {
                unsigned short* dst = VT + (size_t)(b * 8 + h) * 64 * S + pos;
#pragma unroll
                for (int i = 0; i < 4; ++i) {
                    const int dv = i * 16 + fq * 4;
                    dst[(size_t)(dv + 0) * S] = (unsigned short)f2bf(acc[i][j].x * sc); dst[(size_t)(dv + 1) * S] = (unsigned short)f2bf(acc[i][j].y * sc);
                    dst[(size_t)(dv + 2) * S] = (unsigned short)f2bf(acc[i][j].z * sc); dst[(size_t)(dv + 3) * S] = (unsigned short)f2bf(acc[i][j].w * sc);
                }
            }
        }
    }
};

typedef float f32x16 __attribute__((ext_vector_type(16)));
typedef __bf16 bf16x2_t __attribute__((ext_vector_type(2)));
__device__ __forceinline__ unsigned cvtpk(float lo, float hi) { f32x2 v = {lo, hi}; bf16x2_t b = __builtin_convertvector(v, bf16x2_t); return __builtin_bit_cast(unsigned, b); }
__device__ __forceinline__ int crow(int r, int hi) { return (r & 3) + 8 * (r >> 2) + 4 * hi; }
__device__ __forceinline__ int kperm(int rho) { return (rho & 0x13) | ((rho & 4) << 1) | ((rho & 8) >> 1); }

template <int DQK, bool SWA>
__device__ void stage_attn_flash(const Params& p, unsigned char* lds) {
    constexpr int NK = DQK / 16, KCH = DQK / 8, KSTR = (KCH + 1) * 16, VSTR = 144;
    constexpr int KT_BYTES = 64 * KSTR, VT_BYTES = 64 * VSTR, STG = KT_BYTES + VT_BYTES, NKC = 64 * KCH;
    const unsigned short* Qg = (const unsigned short*)(p.ws + (SWA ? WS_QA : WS_QMB));
    const unsigned short* Kg = (const unsigned short*)(p.ws + (SWA ? WS_KA : WS_K96));
    const unsigned short* Vg = (const unsigned short*)(p.ws + (SWA ? WS_VAT : WS_VT));
    unsigned short* O = (unsigned short*)(p.ws + WS_OAB);
    const int tid = threadIdx.x, lane = tid & 63, wave = tid >> 6, r32 = lane & 31, hi = lane >> 5;
    const int G = gridDim.x, bx = blockIdx.x;
    const int vcu = (G % 8 == 0) ? (bx % 8) * (G / 8) + bx / 8 : bx;
    const int nunits = SWA ? Bsz * 2 * 64 : Bsz * 8 * 16;
    const int kro = kperm(r32) * KSTR + hi * 16;
    const int vro = r32 * VSTR + hi * 16;
    const int kid0 = tid, kid1 = tid + 512;
    const int k0row = kid0 / KCH, k0c = kid0 % KCH, k1row = kid1 / KCH, k1c = kid1 % KCH;
    const int vrow = tid >> 3, vc = tid & 7;
    for (int u = vcu; u < nunits; u += G) {
        int b, qb, tlo, thi, sq, ocol; const unsigned short *Qp, *Kb, *Vb; float m, l;
        if (SWA) {
            qb = u & 63; const int kvh = (u >> 6) & 1; b = u >> 7;
            const int head = kvh * 4 + (wave >> 1);
            sq = qb * 64 + (wave & 1) * 32 + r32;
            Qp = Qg + ((size_t)(b * 8 + head) * S + sq) * 64;
            Kb = Kg + (size_t)(b * 2 + kvh) * S * 64; Vb = Vg + (size_t)(b * 2 + kvh) * 64 * S;
            tlo = qb - 2 < 0 ? 0 : qb - 2; thi = qb + 2 > 63 ? 63 : qb + 2;
            m = p.sink[head] * LOG2E; l = 0.5f; ocol = head * 64;
        } else {
            qb = u & 15; const int h = (u >> 4) & 7; b = u >> 7;
            sq = qb * 256 + wave * 32 + r32;
            Qp = Qg + ((size_t)(b * 8 + h) * S + sq) * 96;
            Kb = Kg + (size_t)(b * 8 + h) * S * 96; Vb = Vg + (size_t)(b * 8 + h) * 64 * S;
            tlo = 0; thi = 63; m = 0.f; l = 0.f; ocol = 512 + h * 64;
        }
        bf16x8 qf[NK];
#pragma unroll
        for (int ks = 0; ks < NK; ++ks) qf[ks] = *(const bf16x8*)(Qp + ks * 16 + hi * 8);
        f32x16 o0, o1;
#pragma unroll
        for (int r = 0; r < 16; ++r) { o0[r] = 0.f; o1[r] = 0.f; }
        u32x4 rk0, rk1, rv;
        {
            const unsigned short* kt = Kb + (size_t)tlo * 64 * DQK;
            rk0 = *(const u32x4*)(kt + kid0 * 8);
            if (kid1 < NKC) rk1 = *(const u32x4*)(kt + kid1 * 8);
            rv = *(const u32x4*)(Vb + (size_t)vrow * S + tlo * 64 + vc * 8);
            *(u32x4*)(lds + k0row * KSTR + k0c * 16) = rk0;
            if (kid1 < NKC) *(u32x4*)(lds + k1row * KSTR + k1c * 16) = rk1;
            *(u32x4*)(lds + KT_BYTES + vrow * VSTR + vc * 16) = rv;
        }
        __syncthreads();
        for (int tt = tlo; tt <= thi; ++tt) {
            const unsigned char* Kl = lds + ((tt - tlo) & 1) * STG;
            const unsigned char* Vl = Kl + KT_BYTES;
            unsigned char* Kn = lds + (((tt - tlo) & 1) ^ 1) * STG;
            const bool more = tt < thi;
            if (more) {
                const unsigned short* kt = Kb + (size_t)(tt + 1) * 64 * DQK;
                rk0 = *(const u32x4*)(kt + kid0 * 8);
                if (kid1 < NKC) rk1 = *(const u32x4*)(kt + kid1 * 8);
                rv = *(const u32x4*)(Vb + (size_t)vrow * S + (tt + 1) * 64 + vc * 8);
            }
            f32x16 s0, s1;
            {
                const float nm = -m;
#pragma unroll
                for (int r = 0; r < 16; ++r) { s0[r] = nm; s1[r] = nm; }
            }
#pragma unroll
            for (int ks = 0; ks < NK; ++ks) {
                const bf16x8 kf0 = *(const bf16x8*)(Kl + kro + ks * 32);
                const bf16x8 kf1 = *(const bf16x8*)(Kl + 32 * KSTR + kro + ks * 32);
                s0 = __builtin_amdgcn_mfma_f32_32x32x16_bf16(kf0, qf[ks], s0, 0, 0, 0);
                s1 = __builtin_amdgcn_mfma_f32_32x32x16_bf16(kf1, qf[ks], s1, 0, 0, 0);
            }
            if (SWA) {
                const int rel = tt - qb;
                if (rel == -2 || rel == 2) {
                    const int qi = (wave & 1) * 32 + r32;
#pragma unroll
                    for (int r = 0; r < 16; ++r) {
                        const int kk = kperm(crow(r, hi));
                        const bool v0 = (rel == -2) ? (kk >= qi) : (kk <= qi);
                        const bool v1 = (rel == -2) ? (kk + 32 >= qi) : (kk + 32 <= qi);
                        s0[r] = v0 ? s0[r] : -1e30f; s1[r] = v1 ? s1[r] : -1e30f;
                    }
                }
            }
            if ((!SWA) && (tt == tlo)) {
                float mx = fmaxf(s0[0], s1[0]);
#pragma unroll
                for (int r = 1; r < 16; ++r) mx = fmaxf(mx, fmaxf(s0[r], s1[r]));
                mx = fmaxf(mx, __shfl_xor(mx, 32));
                m = mx;
#pragma unroll
                for (int r = 0; r < 16; ++r) { s0[r] -= mx; s1[r] -= mx; }
            }
            float rs = 0.f;
#pragma unroll
            for (int r = 0; r < 16; ++r) { s0[r] = __builtin_amdgcn_exp2f(s0[r]); s1[r] = __builtin_amdgcn_exp2f(s1[r]); rs += s0[r] + s1[r]; }
            if (!__all(rs <= 1024.f)) {
                float mp = fmaxf(s0[0], s1[0]);
#pragma unroll
                for (int r = 1; r < 16; ++r) mp = fmaxf(mp, fmaxf(s0[r], s1[r]));
                mp = fmaxf(fmaxf(mp, __shfl_xor(mp, 32)), 1.f);
                const float alpha = 1.f / mp;
                m += __builtin_amdgcn_logf(mp);
                l *= alpha; rs *= alpha;
#pragma unroll
                for (int r = 0; r < 16; ++r) { o0[r] *= alpha; o1[r] *= alpha; s0[r] *= alpha; s1[r] *= alpha; }
            }
            l += rs;
#pragma unroll
            for (int st = 0; st < 2; ++st) {
                u32x4 pw;
                pw.x = cvtpk(s0[8 * st + 0], s0[8 * st + 1]); pw.y = cvtpk(s0[8 * st + 2], s0[8 * st + 3]);
                pw.z = cvtpk(s0[8 * st + 4], s0[8 * st + 5]); pw.w = cvtpk(s0[8 * st + 6], s0[8 * st + 7]);
                const bf16x8 pf = __builtin_bit_cast(bf16x8, pw);
                const bf16x8 vf0 = *(const bf16x8*)(Vl + vro + st * 32);
                const bf16x8 vf1 = *(const bf16x8*)(Vl + 32 * VSTR + vro + st * 32);
                o0 = __builtin_amdgcn_mfma_f32_32x32x16_bf16(vf0, pf, o0, 0, 0, 0);
                o1 = __builtin_amdgcn_mfma_f32_32x32x16_bf16(vf1, pf, o1, 0, 0, 0);
            }
#pragma unroll
            for (int st = 0; st < 2; ++st) {
                u32x4 pw;
                pw.x = cvtpk(s1[8 * st + 0], s1[8 * st + 1]); pw.y = cvtpk(s1[8 * st + 2], s1[8 * st + 3]);
                pw.z = cvtpk(s1[8 * st + 4], s1[8 * st + 5]); pw.w = cvtpk(s1[8 * st + 6], s1[8 * st + 7]);
                const bf16x8 pf = __builtin_bit_cast(bf16x8, pw);
                const bf16x8 vf0 = *(const bf16x8*)(Vl + vro + 64 + st * 32);
                const bf16x8 vf1 = *(const bf16x8*)(Vl + 32 * VSTR + vro + 64 + st * 32);
                o0 = __builtin_amdgcn_mfma_f32_32x32x16_bf16(vf0, pf, o0, 0, 0, 0);
                o1 = __builtin_amdgcn_mfma_f32_32x32x16_bf16(vf1, pf, o1, 0, 0, 0);
            }
            if (more) {
                *(u32x4*)(Kn + k0row * KSTR + k0c * 16) = rk0;
                if (kid1 < NKC) *(u32x4*)(Kn + k1row * KSTR + k1c * 16) = rk1;
                *(u32x4*)(Kn + KT_BYTES + vrow * VSTR + vc * 16) = rv;
            }
            __syncthreads();
        }
        const float il = 1.f / (l + __shfl_xor(l, 32));
        {
            float ss = 0.f;
#pragma unroll
            for (int r = 0; r < 16; ++r) { const float a0 = o0[r] * il, a1 = o1[r] * il; ss += a0 * a0 + a1 * a1; }
            ss += __shfl_xor(ss, 32);
            if (hi == 0) ((float*)(p.ws + WS_SSQO))[(size_t)(b * S + sq) * 16 + (ocol >> 6)] = ss;
        }
        unsigned short* orow = O + (size_t)(b * S + sq) * D + ocol + 4 * hi;
#pragma unroll
        for (int g = 0; g < 4; ++g) {
            *(unsigned long long*)(orow + 8 * g) = (unsigned long long)cvtpk(o0[4 * g] * il, o0[4 * g + 1] * il) | ((unsigned long long)cvtpk(o0[4 * g + 2] * il, o0[4 * g + 3] * il) << 32);
            *(unsigned long long*)(orow + 32 + 8 * g) = (unsigned long long)cvtpk(o1[4 * g] * il, o1[4 * g + 1] * il) | ((unsigned long long)cvtpk(o1[4 * g + 2] * il, o1[4 * g + 3] * il) << 32);
        }
    }
}

__device__ __forceinline__ void ce_desc(int& a, int& b) { const int hi = max(a, b), lo = min(a, b); a = hi; b = lo; }
__device__ __forceinline__ void ce_asc(int& a, int& b) { const int hi = max(a, b), lo = min(a, b); a = lo; b = hi; }
template <int N, int OFF> __device__ __forceinline__ void bitonic_sort_desc(int (&a)[32]) {
#pragma unroll
    for (int k = 2; k <= N; k <<= 1)
#pragma unroll
        for (int j = k >> 1; j > 0; j >>= 1)
#pragma unroll
            for (int i = 0; i < N; ++i) {
                const int l = i ^ j;
                if (l > i) { if ((i & k) == 0) ce_desc(a[OFF + i], a[OFF + l]); else ce_asc(a[OFF + i], a[OFF + l]); }
            }
}
__device__ __forceinline__ void bitonic_clean16_desc(int (&a)[32]) {
#pragma unroll
    for (int j = 8; j > 0; j >>= 1)
#pragma unroll
        for (int i = 0; i < 16; ++i) { const int l = i ^ j; if (l > i) ce_desc(a[i], a[l]); }
}
__device__ __forceinline__ int f2sortable(float f) { const int b = __builtin_bit_cast(int, f); return b ^ ((b >> 31) & 0x7fffffff); }
__device__ __forceinline__ float sortable2f(int s) { return __builtin_bit_cast(float, s ^ ((s >> 31) & 0x7fffffff)); }
struct CandTab { int i[52], j[52]; };
constexpr CandTab make_cands() { CandTab t{}; int n = 0; for (int i = 0; i < 16; ++i) for (int j = 0; j < 16; ++j) if ((i + 1) * (j + 1) <= 16) { t.i[n] = i; t.j[n] = j; ++n; } for (; n < 52; ++n) { t.i[n] = -1; t.j[n] = -1; } return t; }
constexpr CandTab CANDS = make_cands();
struct EpiTopkSel {
    static constexpr bool HAS_MID = false, HAS_LATE = false;
    __device__ __forceinline__ void late(int, int, int) {}
    __device__ __forceinline__ void pre(int, int) {}
    template <class A> __device__ __forceinline__ void mid(A&) {}
    unsigned short* idx; float* g;
    int* keepg;
    __device__ __forceinline__ void operator()(const f32x4 (&acc)[8][2], int pb, int qb, int lane, const float*, int hp, int half) {
        const int fr = lane & 15, fq = lane >> 4;
#pragma unroll
        for (int j = 0; j < 2; ++j) {
            int v[32];
#pragma unroll
            for (int i = 0; i < 8; ++i)
#pragma unroll
                for (int r = 0; r < 4; ++r) v[i * 4 + r] = (f2sortable(acc[i][j][r]) & ~127) | (i * 16 + fq * 4 + r);
            bitonic_sort_desc<16, 0>(v); bitonic_sort_desc<16, 16>(v);
#pragma unroll
            for (int i = 0; i < 16; ++i) v[i] = max(v[i], v[31 - i]);
            bitonic_clean16_desc(v);
#pragma unroll
            for (int x = 16; x <= 32; x <<= 1) {
#pragma unroll
                for (int i = 0; i < 16; ++i) v[16 + i] = __shfl_xor(v[i], x);
#pragma unroll
                for (int i = 0; i < 16; ++i) v[i] = max(v[i], v[31 - i]);
                bitonic_clean16_desc(v);
            }
            u32x4* kp = (u32x4*)(keepg + ((qb & 255) + j * 16 + fr) * 16);
            if (half == 0) {
                if (fq == 0) {
#pragma unroll
                    for (int i = 0; i < 4; ++i) kp[i] = (u32x4){(unsigned)v[4 * i], (unsigned)v[4 * i + 1], (unsigned)v[4 * i + 2], (unsigned)v[4 * i + 3]};
                }
            } else {
                float as[16], bs[16]; int ai[16], bi[16];
#pragma unroll
                for (int i = 0; i < 4; ++i) {
                    const u32x4 kv = kp[i];
#pragma unroll
                    for (int c = 0; c < 4; ++c) { as[4 * i + c] = sortable2f((int)kv[c] & ~127); ai[4 * i + c] = ((int)kv[c] & 127) << 7; }
                }
#pragma unroll
                for (int i = 0; i < 16; ++i) { bs[i] = sortable2f(v[i] & ~127); bi[i] = v[i] & 127; }
                int w[32];
#pragma unroll
                for (int sl = 0; sl < 13; ++sl) {
                    int c4[4];
#pragma unroll
                    for (int f = 0; f < 4; ++f) {
                        constexpr int dummy = 0; (void)dummy;
                        const int ci = CANDS.i[sl * 4 + f], cj = CANDS.j[sl * 4 + f];
                        c4[f] = (ci >= 0) ? ((f2sortable(as[ci >= 0 ? ci : 0] + bs[cj >= 0 ? cj : 0]) & ~0x3fff) | (ai[ci >= 0 ? ci : 0] | bi[cj >= 0 ? cj : 0])) : (int)0x80000000;
                    }
                    w[sl] = (fq == 0) ? c4[0] : (fq == 1) ? c4[1] : (fq == 2) ? c4[2] : c4[3];
                }
                w[13] = w[14] = w[15] = (int)0x80000000;
                bitonic_sort_desc<16, 0>(w);
#pragma unroll
                for (int x = 16; x <= 32; x <<= 1) {
#pragma unroll
                    for (int i = 0; i < 16; ++i) w[16 + i] = __shfl_xor(w[i], x);
#pragma unroll
                    for (int i = 0; i < 16; ++i) w[i] = max(w[i], w[31 - i]);
                    bitonic_clean16_desc(w);
                }
                int my[4];
#pragma unroll
                for (int c = 0; c < 4; ++c) my[c] = (fq == 0) ? w[c] : (fq == 1) ? w[4 + c] : (fq == 2) ? w[8 + c] : w[12 + c];
                const float top = sortable2f(w[0] & ~0x3fff);
                float e[4], part = 0.f;
#pragma unroll
                for (int c = 0; c < 4; ++c) { e[c] = __expf(sortable2f(my[c] & ~0x3fff) - top); part += e[c]; }
                part += __shfl_xor(part, 16); part += __shfl_xor(part, 32);
                const float inv = 1.f / part;
                const int t = qb + j * 16 + fr;
                const size_t o = (size_t)t * 128 + (hp >> 1) * 16 + fq * 4;
                *(unsigned long long*)(idx + o) = (unsigned long long)(unsigned)((my[0] & 0x3fff) | ((my[1] & 0x3fff) << 16)) | ((unsigned long long)(unsigned)((my[2] & 0x3fff) | ((my[3] & 0x3fff) << 16)) << 32);
                *(f32x4*)(g + o) = (f32x4){e[0] * inv, e[1] * inv, e[2] * inv, e[3] * inv};
            }
        }
    }
};
__device__ void gemm_pq_fused(const Params& p, unsigned char* lds) {
    const unsigned short* X = (const unsigned short*)(p.ws + WS_WPQ);
    const unsigned short* Y = (const unsigned short*)(p.ws + WS_HB);
    const unsigned short* SK = (const unsigned short*)(p.ws + WS_SUBK);
    const float* ssq1 = (const float*)(p.ws + WS_SSQ1); const float* bias = (const float*)(p.ws + WS_BPQ);
    EpiTopkSel tsel{(unsigned short*)(p.ws + WS_IDX), (float*)(p.ws + WS_G), (int*)(p.ws + WS_KEEP) + (size_t)blockIdx.x * 4096};
    const int tid = threadIdx.x, lane = tid & 63, wave = __builtin_amdgcn_readfirstlane(tid >> 6);
    const int wp = wave >> 2, wq = wave & 3, fr = lane & 15, fq = lane >> 4;
    const int G = gridDim.x, bx = blockIdx.x;
    const int vcu = (G % 8 == 0) ? (bx % 8) * (G / 8) + bx / 8 : bx;
    const int srow = wave * 8 + (lane >> 3), pc = lane & 7, lc = pc ^ ((srow >> 1) & 7);
    constexpr int nk = D / TBK, nunits = 8 * (T / TQ);
    for (int u = vcu; u < nunits; u += G) {
        const int qt = u >> 3, h = u & 7, q0 = qt * TQ;
#pragma unroll
        for (int sub = 0; sub < 2; ++sub) {
            const int hp = h * 2 + sub, p0 = hp * TP;
            f32x4 acc[4][4];
#pragma unroll
            for (int i = 0; i < 4; ++i)
#pragma unroll
                for (int j = 0; j < 4; ++j) acc[i][j] = (f32x4){0.f, 0.f, 0.f, 0.f};
            const unsigned short* xg = X + (size_t)(p0 + srow) * D + lc * 8;
            const unsigned short* yg = Y + (size_t)(q0 + srow) * D + lc * 8;
            asm volatile("s_waitcnt vmcnt(0)" ::: "memory");
            RAW_BARRIER();
#define PQ_DMA_TILE(kt_, stg_) do { \
                unsigned char* _b = lds + (stg_) * STG_BYTES + wave * 1024; const int _k = (kt_) * TBK; \
                _Pragma("unroll") for (int _i = 0; _i < 2; ++_i) __builtin_amdgcn_global_load_lds((const unsigned*)(xg + (size_t)(64 * _i) * D + _k), (unsigned*)(_b + _i * 8192), 16, 0, 0); \
                _Pragma("unroll") for (int _i = 0; _i < 4; ++_i) __builtin_amdgcn_global_load_lds((const unsigned*)(yg + (size_t)(64 * _i) * D + _k), (unsigned*)(_b + XS_BYTES + _i * 8192), 16, 0, 0); \
            } while (0)
            PQ_DMA_TILE(0, 0);
            PQ_DMA_TILE(1, 1);
            int cur = 0;
            for (int kt = 0; kt < nk; ++kt) {
                if (kt + 1 < nk) asm volatile("s_waitcnt vmcnt(6)" ::: "memory"); else asm volatile("s_waitcnt vmcnt(0)" ::: "memory");
                RAW_BARRIER();
                if (kt + 2 < nk) { const int nxt = (cur == 0) ? 2 : cur - 1; PQ_DMA_TILE(kt + 2, nxt); }
                const unsigned char* st = lds + cur * STG_BYTES;
#pragma unroll
                for (int kk = 0; kk < 2; ++kk) {
                    bf16x8 af[4], bfr[4];
#pragma unroll
                    for (int i = 0; i < 4; ++i) af[i] = *(const bf16x8*)(st + swz(wp * 64 + i * 16 + fr, kk * 4 + fq));
#pragma unroll
                    for (int j = 0; j < 4; ++j) bfr[j] = *(const bf16x8*)(st + XS_BYTES + swz(wq * 64 + j * 16 + fr, kk * 4 + fq));
#pragma unroll
                    for (int i = 0; i < 4; ++i)
#pragma unroll
                        for (int j = 0; j < 4; ++j) acc[i][j] = __builtin_amdgcn_mfma_f32_16x16x32_bf16(af[i], bfr[j], acc[i][j], 0, 0, 0);
                }
                cur = (cur == 2) ? 0 : cur + 1;
            }
#undef PQ_DMA_TILE
            RAW_BARRIER();
            {
                float r1[4]; f32x4 bv[4];
#pragma unroll
                for (int j = 0; j < 4; ++j) {
                    const f32x4* s4 = (const f32x4*)(ssq1 + (size_t)(q0 + wq * 64 + j * 16 + fr) * 16);
                    const f32x4 a0 = s4[0], a1 = s4[1], a2 = s4[2], a3 = s4[3];
                    r1[j] = rsqrtf((((a0.x + a0.y + a0.z + a0.w) + (a1.x + a1.y + a1.z + a1.w)) + ((a2.x + a2.y + a2.z + a2.w) + (a3.x + a3.y + a3.z + a3.w))) * (1.f / D) + EPS);
                }
                {
                    const float* bt = bias + (q0 >> 12) * 2048 + p0 + wp * 64 + fq * 4;
#pragma unroll
                    for (int i = 0; i < 4; ++i) bv[i] = *(const f32x4*)(bt + i * 16);
                }
                const unsigned short* kg = SK + (size_t)hp * 128 * 128 + (size_t)srow * 128 + lc * 8;
#pragma unroll
                for (int s2 = 0; s2 < 2; ++s2)
#pragma unroll
                    for (int i = 0; i < 2; ++i) __builtin_amdgcn_global_load_lds((const unsigned*)(kg + (size_t)(64 * i) * 128 + s2 * 64), (unsigned*)(lds + s2 * STG_BYTES + wave * 1024 + i * 8192), 16, 0, 0);
                unsigned char* yb = lds + wp * STG_BYTES + XS_BYTES + (fq & 1) * 8;
#pragma unroll
                for (int j = 0; j < 4; ++j)
#pragma unroll
                    for (int i = 0; i < 4; ++i)
                        *(unsigned long long*)(yb + swz(wq * 64 + j * 16 + fr, 2 * i + (fq >> 1))) =
                            pk4(acc[i][j].x * r1[j] + bv[i].x, acc[i][j].y * r1[j] + bv[i].y, acc[i][j].z * r1[j] + bv[i].z, acc[i][j].w * r1[j] + bv[i].w);
            }
            asm volatile("s_waitcnt vmcnt(0)" ::: "memory");
            RAW_BARRIER();
            f32x4 sc2[8][2];
#pragma unroll
            for (int i = 0; i < 8; ++i)
#pragma unroll
                for (int j = 0; j < 2; ++j) sc2[i][j] = (f32x4){0.f, 0.f, 0.f, 0.f};
#pragma unroll
            for (int s2 = 0; s2 < 2; ++s2) {
                const unsigned char* st = lds + s2 * STG_BYTES;
#pragma unroll
                for (int kk = 0; kk < 2; ++kk) {
                    bf16x8 af[8], bfr[2];
#pragma unroll
                    for (int i = 0; i < 8; ++i) af[i] = *(const bf16x8*)(st + swz(i * 16 + fr, kk * 4 + fq));
#pragma unroll
                    for (int j = 0; j < 2; ++j) bfr[j] = *(const bf16x8*)(st + XS_BYTES + swz(wave * 32 + j * 16 + fr, kk * 4 + fq));
#pragma unroll
                    for (int i = 0; i < 8; ++i)
#pragma unroll
                        for (int j = 0; j < 2; ++j) sc2[i][j] = __builtin_amdgcn_mfma_f32_16x16x32_bf16(af[i], bfr[j], sc2[i][j], 0, 0, 0);
                }
            }
            tsel(sc2, 0, q0 + wave * 32, lane, (const float*)nullptr, hp, sub);
        }
    }
}

__device__ __forceinline__ int rd_lane_i(int v, int l) { return __builtin_amdgcn_readlane(v, l); }
__device__ __forceinline__ float rd_lane_f(float v, int l) { return __builtin_bit_cast(float, __builtin_amdgcn_readlane(__builtin_bit_cast(int, v), l)); }
__device__ void stage_peer_u(const Params& p) {
    const unsigned short* h2 = (const unsigned short*)(p.ws + WS_HB);
    const float* mod = (const float*)(p.ws + WS_MOD);
    const unsigned short* idx = (const unsigned short*)(p.ws + WS_IDX); float* g = (float*)(p.ws + WS_G);
    const unsigned char* eu8 = p.ws + WS_EU8;
    const float* us = (const float*)(p.ws + WS_US);
    const int tid_ = tid_opaque(); const int lane = tid_ & 63, wave = tid_ >> 6;
    for (int t = blockIdx.x * NWAVES + wave; t < T; t += gridDim.x * NWAVES) {
        const int b = t >> 12;
        f32x2 hq[8];
        {
            const float rstd1 = rsqrtf(group16_sum(((const float*)(p.ws + WS_SSQ1))[(size_t)t * 16 + (lane & 15)]) * (1.f / D) + EPS);
            const float* shf = mod + b * NMOD + 3 * D + lane * 16;
            const u32x4 w0 = *(const u32x4*)(h2 + (size_t)t * D + lane * 16), w1 = *(const u32x4*)(h2 + (size_t)t * D + lane * 16 + 8);
            const f32x4 s0 = *(const f32x4*)(shf), s1 = *(const f32x4*)(shf + 4), s2 = *(const f32x4*)(shf + 8), s3 = *(const f32x4*)(shf + 12);
            hq[0] = (f32x2){bflo(w0.x) * rstd1 + s0.x, bfhi(w0.x) * rstd1 + s0.y}; hq[1] = (f32x2){bflo(w0.y) * rstd1 + s0.z, bfhi(w0.y) * rstd1 + s0.w};
            hq[2] = (f32x2){bflo(w0.z) * rstd1 + s1.x, bfhi(w0.z) * rstd1 + s1.y}; hq[3] = (f32x2){bflo(w0.w) * rstd1 + s1.z, bfhi(w0.w) * rstd1 + s1.w};
            hq[4] = (f32x2){bflo(w1.x) * rstd1 + s2.x, bfhi(w1.x) * rstd1 + s2.y}; hq[5] = (f32x2){bflo(w1.y) * rstd1 + s2.z, bfhi(w1.y) * rstd1 + s2.w};
            hq[6] = (f32x2){bflo(w1.z) * rstd1 + s3.x, bfhi(w1.z) * rstd1 + s3.y}; hq[7] = (f32x2){bflo(w1.w) * rstd1 + s3.z, bfhi(w1.w) * rstd1 + s3.w};
        }
        const int idv0 = idx[(size_t)t * 128 + lane], idv1 = idx[(size_t)t * 128 + 64 + lane];
        float wv0 = 0.f, wv1 = 0.f;
        u32x4 cur[8], nxt[8];
#pragma unroll
        for (int i = 0; i < 8; ++i) cur[i] = *(const u32x4*)(eu8 + (size_t)rd_lane_i(idv0, i) * D + lane * 16);
#pragma unroll 2
        for (int b8 = 0; b8 < 16; ++b8) {
            const int bn = (b8 + 1 < 16) ? b8 + 1 : b8;
#pragma unroll
            for (int i = 0; i < 8; ++i) { const int r = bn * 8 + i; nxt[i] = *(const u32x4*)(eu8 + (size_t)rd_lane_i((bn < 8) ? idv0 : idv1, r & 63) * D + lane * 16); }
            float pr[8];
#pragma unroll
            for (int i = 0; i < 8; ++i) {
                f32x2 a = {0.f, 0.f}, c2 = {0.f, 0.f};
#pragma unroll
                for (int c = 0; c < 4; ++c) {
                    const f32x2 lo = __builtin_amdgcn_cvt_pk_f32_fp8((int)cur[i][c], false), hi = __builtin_amdgcn_cvt_pk_f32_fp8((int)cur[i][c], true);
                    a += lo * hq[2 * c]; c2 += hi * hq[2 * c + 1];
                }
                a += c2; pr[i] = a.x + a.y;
            }
            float x4[4], x2[2], x1;
            const bool b5 = (lane & 32) != 0, b4 = (lane & 16) != 0, b3 = (lane & 8) != 0;
#pragma unroll
            for (int i = 0; i < 4; ++i) { const float keep = b5 ? pr[i + 4] : pr[i], give = b5 ? pr[i] : pr[i + 4]; x4[i] = keep + __shfl_xor(give, 32); }
#pragma unroll
            for (int i = 0; i < 2; ++i) { const float keep = b4 ? x4[i + 2] : x4[i], give = b4 ? x4[i] : x4[i + 2]; x2[i] = keep + __shfl_xor(give, 16); }
            { const float keep = b3 ? x2[1] : x2[0], give = b3 ? x2[0] : x2[1]; x1 = keep + __shfl_xor(give, 8); }
            x1 += __shfl_xor(x1, 4); x1 += __shfl_xor(x1, 2); x1 += __shfl_xor(x1, 1);
            const float st = __shfl(x1, (lane & 7) * 8);
            const bool mine = (lane >> 3) == (b8 & 7);
            if (b8 < 8) wv0 = mine ? st : wv0; else wv1 = mine ? st : wv1;
#pragma unroll
            for (int i = 0; i < 8; ++i) cur[i] = nxt[i];
        }
        {
            const float s0 = wv0 * us[idv0], s1 = wv1 * us[idv1];
            const float gv0 = g[(size_t)t * 128 + lane], gv1 = g[(size_t)t * 128 + 64 + lane];
            wv0 = gv0 * (0.5f * s0 * (1.f + erff(s0 * 0.70710678118654752f)));
            wv1 = gv1 * (0.5f * s1 * (1.f + erff(s1 * 0.70710678118654752f)));
        }
        { float* wdst = (float*)(p.ws + WS_W); wdst[(size_t)t * 128 + lane] = wv0; wdst[(size_t)t * 128 + 64 + lane] = wv1; }
    }
}
__device__ void stage_peer_v(const Params& p, float* outp) {
    const float* mod = (const float*)(p.ws + WS_MOD);
    const unsigned short* idx = (const unsigned short*)(p.ws + WS_IDX); const float* g = (const float*)(p.ws + WS_W);
    const unsigned char* ev8 = p.ws + WS_EV8;
    const float* vs = (const float*)(p.ws + WS_VS);
    const int tid_ = tid_opaque(); const int lane = tid_ & 63, wave = tid_ >> 6;
    for (int t = blockIdx.x * NWAVES + wave; t < T; t += gridDim.x * NWAVES) {
        const int b = t >> 12;
        const int idv0 = idx[(size_t)t * 128 + lane], idv1 = idx[(size_t)t * 128 + 64 + lane];
        const float wv0 = g[(size_t)t * 128 + lane] * vs[idv0], wv1 = g[(size_t)t * 128 + 64 + lane] * vs[idv1];
        f32x2 acc[8];
#pragma unroll
        for (int i = 0; i < 8; ++i) acc[i] = (f32x2){0.f, 0.f};
        u32x4 cur[8], nxt[8];
#pragma unroll
        for (int i = 0; i < 8; ++i) cur[i] = *(const u32x4*)(ev8 + (size_t)rd_lane_i(idv0, i) * D + lane * 16);
#pragma unroll 2
        for (int b8 = 0; b8 < 16; ++b8) {
            const int bn = (b8 + 1 < 16) ? b8 + 1 : b8;
#pragma unroll
            for (int i = 0; i < 8; ++i) { const int r = bn * 8 + i; nxt[i] = *(const u32x4*)(ev8 + (size_t)rd_lane_i((bn < 8) ? idv0 : idv1, r & 63) * D + lane * 16); }
#pragma unroll
            for (int i = 0; i < 8; ++i) {
                const int r = b8 * 8 + i;
                const float wr = rd_lane_f((b8 < 8) ? wv0 : wv1, r & 63);
                const f32x2 w2 = {wr, wr};
#pragma unroll
                for (int c = 0; c < 4; ++c) {
                    const f32x2 lo = __builtin_amdgcn_cvt_pk_f32_fp8((int)cur[i][c], false), hi = __builtin_amdgcn_cvt_pk_f32_fp8((int)cur[i][c], true);
                    acc[2 * c] += w2 * lo; acc[2 * c + 1] += w2 * hi;
                }
            }
#pragma unroll
            for (int i = 0; i < 8; ++i) cur[i] = nxt[i];
        }
        const int eoff = lane * 16;
        const float* xin = p.out + (size_t)t * D + eoff;
        float* xr = outp + (size_t)t * D + eoff;
        const float* gf = mod + b * NMOD + 5 * D + eoff;
        float sel[16];
        float ss = 0.f;
#pragma unroll
        for (int c = 0; c < 4; ++c) {
            const f32x4 x1 = *(const f32x4*)(xin + c * 4); const f32x4 gg = *(const f32x4*)(gf + c * 4);
            sel[c * 4 + 0] = x1.x + gg.x * acc[2 * c].x; sel[c * 4 + 1] = x1.y + gg.y * acc[2 * c].y;
            sel[c * 4 + 2] = x1.z + gg.z * acc[2 * c + 1].x; sel[c * 4 + 3] = x1.w + gg.w * acc[2 * c + 1].y;
            ss += sel[c * 4 + 0] * sel[c * 4 + 0] + sel[c * 4 + 1] * sel[c * 4 + 1] + sel[c * 4 + 2] * sel[c * 4 + 2] + sel[c * 4 + 3] * sel[c * 4 + 3];
        }
        const float rstd = rsqrtf(wave_sum(ss) * (1.f / D) + EPS);
#pragma unroll
        for (int c = 0; c < 4; ++c) {
            const f32x4 fn = *(const f32x4*)(p.fnorm + eoff + c * 4);
            f32x4 r; r.x = sel[c * 4 + 0] * rstd * fn.x; r.y = sel[c * 4 + 1] * rstd * fn.y; r.z = sel[c * 4 + 2] * rstd * fn.z; r.w = sel[c * 4 + 3] * rstd * fn.w;
            *(f32x4*)(xr + c * 4) = r;
        }
    }
}

#define LAS __attribute__((address_space(3)))
constexpr size_t WS_BAR = 3 * MiB;
constexpr int BAR_BYTES = 16384;
constexpr int LDS_MISC_OFF = 147456;
#define XB_TMO      128
#define XB_XCNT(j)  (256  + 64 * (j))
#define XB_XSUB(j)  (1280 + 64 * (j))
#define XB_XGEN(j)  (2304 + 64 * (j))
#define XB_TOP      3328
#define XB_TOPGEN   3392
#define XB_SPIN_CAP (1u << 18)
__device__ __forceinline__ unsigned xb_ld(unsigned* p)              { return __hip_atomic_load(p, __ATOMIC_RELAXED, __HIP_MEMORY_SCOPE_AGENT); }
__device__ __forceinline__ unsigned xb_add(unsigned* p, unsigned v) { return __hip_atomic_fetch_add(p, v, __ATOMIC_RELAXED, __HIP_MEMORY_SCOPE_AGENT); }
__device__ __forceinline__ unsigned xb_xcc_id() { return (unsigned)__builtin_amdgcn_s_getreg((3 << 11) | 20) & 0xFu; }
#define XB_SPIN(cond, bar) do { unsigned _sp = 0; while (cond) { __builtin_amdgcn_s_sleep(1); \
    if ((++_sp & 255u) == 0u) { if (xb_ld(&(bar)[XB_TMO])) break; if (_sp > XB_SPIN_CAP) { atomicAdd(&(bar)[XB_TMO], 1u); break; } } } } while (0)
struct XcdBarrier { unsigned* bar; unsigned x; volatile LAS unsigned* st; };
__device__ __forceinline__ XcdBarrier xcd_barrier_post(unsigned* bar, volatile LAS unsigned* st) {
    XcdBarrier b; b.bar = bar; b.x = xb_xcc_id(); b.st = st;
    if (threadIdx.x == 0) (void)xb_add(&bar[XB_XCNT(b.x)], 1u);
    return b;
}
__device__ __forceinline__ void xcd_barrier_complete(unsigned* bar, unsigned x, unsigned& nloc, unsigned& nx) {
    const unsigned G = gridDim.x * gridDim.y * gridDim.z;
    unsigned sum, cnt, mine, sp = 0u;
    for (;;) {
        sum = 0u; cnt = 0u; mine = 0u;
#pragma unroll
        for (unsigned j = 0; j < 16; ++j) { const unsigned c = xb_ld(&bar[XB_XCNT(j)]); sum += c; cnt += (c > 0u) ? 1u : 0u; mine = (j == x) ? c : mine; }
        if (sum == G) break;
        __builtin_amdgcn_s_sleep(1);
        if ((++sp & 255u) == 0u) { if (xb_ld(&bar[XB_TMO])) break; if (sp > XB_SPIN_CAP) { atomicAdd(&bar[XB_TMO], 1u); break; } }
    }
    nloc = mine > 0u ? mine : 1u; nx = cnt > 0u ? cnt : 1u;
}
__device__ __forceinline__ void xcd_barrier(const XcdBarrier& b) {
    asm volatile("s_waitcnt vmcnt(0)" ::: "memory");
    __syncthreads();
    if (threadIdx.x == 0) {
        unsigned* bar = b.bar;
        __builtin_amdgcn_s_waitcnt(0);
        unsigned nloc = b.st[0], nx = b.st[1];
        if (nloc == 0u) { xcd_barrier_complete(bar, b.x, nloc, nx); b.st[0] = nloc; b.st[1] = nx; }
        const unsigned old = xb_add(&bar[XB_XSUB(b.x)], 1u);
        const unsigned gen = old / nloc;
        if (old + 1u == (gen + 1u) * nloc) {
            __builtin_amdgcn_fence(__ATOMIC_RELEASE, "agent");
            asm volatile("s_waitcnt vmcnt(0)" ::: "memory");
            const unsigned og = xb_add(&bar[XB_TOP], 1u);
            const unsigned tg = og / nx;
            if (og + 1u == (tg + 1u) * nx) xb_add(&bar[XB_TOPGEN], 1u);
            else XB_SPIN(xb_ld(&bar[XB_TOPGEN]) == tg, bar);
            __builtin_amdgcn_fence(__ATOMIC_ACQUIRE, "agent");
            xb_add(&bar[XB_XGEN(b.x)], 1u);
            asm volatile("s_waitcnt vmcnt(0)" ::: "memory");
        } else {
            XB_SPIN(xb_ld(&bar[XB_XGEN(b.x)]) == gen, bar);
            __builtin_amdgcn_fence(__ATOMIC_ACQUIRE, "agent");
            asm volatile("s_waitcnt vmcnt(0)" ::: "memory");
        }
    }
    __syncthreads();
}

__global__ void __launch_bounds__(NTHREADS) fwd_megakernel(Params p) {
    extern __shared__ __attribute__((aligned(16))) unsigned char lds_raw[];
    cg::grid_group grid = cg::this_grid();
    unsigned short* hb = (unsigned short*)(p.ws + WS_HB);
    const float* mod = (const float*)(p.ws + WS_MOD);
    typedef const unsigned short* cbf;

    volatile LAS unsigned* bst = (volatile LAS unsigned*)((LAS unsigned char*)lds_raw + LDS_MISC_OFF);
    if (threadIdx.x < 2) bst[threadIdx.x] = 0u;
    __syncthreads();
    const XcdBarrier xbar = xcd_barrier_post((unsigned*)(p.ws + WS_BAR), bst);
    stage_prologue(p, (float*)lds_raw);
    if (p.ws == nullptr) grid.sync();
    xcd_barrier(xbar);
    stage_norm_mod<true>(p, p.x, hb, 0 * D, 1 * D);
    stage_gemv8(mod + 3 * D, NMOD, false, p.w_pq, 2048, nullptr, (float*)(p.ws + WS_BPQ), (float*)lds_raw);
    xcd_barrier(xbar);
    gemm_dma<2, 1>((cbf)(p.ws + WS_WIN), D, hb, D, 1280, T, D, 1, 0, 0, lds_raw, EpiProj{p.ws});
    xcd_barrier(xbar);
    gemm_xyT<2, true>((cbf)(p.ws + WS_WQUP), 256, (cbf)(p.ws + WS_QL), 256, 768, T, 256, 1, 0, 0, lds_raw, EpiQup{p.ws});
    gemm_xyT<2, true>((cbf)(p.ws + WS_WKVUP), 128, (cbf)(p.ws + WS_KVL), 128, 1024, T, 128, 1, 0, 0, lds_raw, EpiKVup{p.ws});
    xcd_barrier(xbar);
    stage_attn_flash<64, true>(p, lds_raw);
    stage_attn_flash<96, false>(p, lds_raw);
    xcd_barrier(xbar);
    gemm_dma<2, 1>((cbf)(p.ws + WS_WOUT), D, (cbf)(p.ws + WS_OAB), D, D, T, D, 1, 0, 0, lds_raw,
                   EpiOutProj{p.x, mod, p.out, hb, (const float*)(p.ws + WS_SSQO), (float*)(p.ws + WS_SSQ1), {}, {}, {}});
    xcd_barrier(xbar);
    gemm_pq_fused(p, lds_raw);
    xcd_barrier(xbar);
    stage_peer_u(p);
    xcd_barrier(xbar);
    stage_peer_v(p, p.out);
}

extern "C" void kernel_launch(void* const* d_in, const int* in_sizes, int n_in, void* d_out, int out_size, void* d_ws, size_t ws_size, hipStream_t stream) {
    static int grid_blocks = 0;
    if (grid_blocks == 0) {
        if (n_in != 18 || in_sizes[0] != T * D || out_size != T * D || ws_size < WS_END) {
            fprintf(stderr, "kernel_launch: unexpected shapes (n_in %d, in0 %d, out %d, ws %zu); nothing launched\n", n_in, n_in > 0 ? in_sizes[0] : -1, out_size, ws_size);
            grid_blocks = -1; return;
        }
        int dev = 0, cus = 0, per_cu = 0;
        (void)hipGetDevice(&dev);
        (void)hipDeviceGetAttribute(&cus, hipDeviceAttributeMultiprocessorCount, dev);
        if (hipFuncSetAttribute((const void*)fwd_megakernel, hipFuncAttributeMaxDynamicSharedMemorySize, LDS_BYTES) != hipSuccess) { fprintf(stderr, "kernel_launch: hipFuncSetAttribute failed\n"); grid_blocks = -1; return; }
        (void)hipOccupancyMaxActiveBlocksPerMultiprocessor(&per_cu, fwd_megakernel, NTHREADS, LDS_BYTES);
        if (per_cu < 1) { fprintf(stderr, "kernel_launch: occupancy query says %d blocks/CU\n", per_cu); grid_blocks = -1; return; }
        grid_blocks = cus < 256 ? cus : 256;
    }
    if (grid_blocks < 0) return;
    Params p{};
    p.x = (const float*)d_in[0]; p.c = (const float*)d_in[1]; p.w_ada = (const float*)d_in[2]; p.b_ada = (const float*)d_in[3];
    p.w_in = (const float*)d_in[4]; p.sink = (const float*)d_in[5]; p.qnorm = (const float*)d_in[6]; p.w_qup = (const float*)d_in[7];
    p.kvnorm = (const float*)d_in[8]; p.w_kvup = (const float*)d_in[9]; p.onorm_a = (const float*)d_in[10]; p.onorm_b = (const float*)d_in[11];
    p.w_out = (const float*)d_in[12]; p.w_pq = (const float*)d_in[13]; p.subk = (const float*)d_in[14]; p.eu = (const float*)d_in[15];
    p.ev = (const float*)d_in[16]; p.fnorm = (const float*)d_in[17];
    p.out = (float*)d_out; p.ws = (unsigned char*)d_ws;
    if (hipMemsetAsync((char*)d_ws + WS_BAR, 0, BAR_BYTES, stream) != hipSuccess) { fprintf(stderr, "kernel_launch: hipMemsetAsync failed\n"); return; }
    void* args[] = {&p};
    hipError_t e = hipLaunchCooperativeKernel((void*)fwd_megakernel, dim3(grid_blocks), dim3(NTHREADS), args, LDS_BYTES, stream);
    if (e != hipSuccess) fprintf(stderr, "cooperative launch failed: %s (grid %d)\n", hipGetErrorString(e), grid_blocks);
}
```

```cpp
#include <hip/hip_runtime.h>
#include <hip/hip_cooperative_groups.h>
#include <cstdio>
#include <cstdint>
namespace cg = cooperative_groups;

constexpr int Bsz = 8, S = 4096, D = 1024, T = Bsz * S;
constexpr int INW = 1184;
constexpr int C_QA = 0, C_KA = 512, C_VA = 640, C_QL = 768, C_KVL = 1024, C_KR = 1152;
constexpr int NMOD = 6 * D;
constexpr float EPS = 1e-6f;
constexpr float LOG2E = 1.4426950408889634f;
constexpr float QA_SCALE = 0.125f * LOG2E;
constexpr float QM_SCALE = 0.10206207261596575f * LOG2E;
constexpr int NTHREADS = 512, NWAVES = 8;

constexpr size_t MiB = 1u << 20;
constexpr size_t WS_MOD = 0;
constexpr size_t WS_COSA = 1 * MiB;
constexpr size_t WS_SINA = WS_COSA + 512 * 1024;
constexpr size_t WS_COSB = 2 * MiB;
constexpr size_t WS_SINB = WS_COSB + 256 * 1024;
constexpr size_t WS_WIN = 4 * MiB;
constexpr size_t WS_WQUP = 7 * MiB;
constexpr size_t WS_WKVUP = 7 * MiB + 512 * 1024;
constexpr size_t WS_WOUT = 8 * MiB;
constexpr size_t WS_WPQ = 10 * MiB;
constexpr size_t WS_SUBK = 14 * MiB;
constexpr size_t WS_EU8 = 16 * MiB;
constexpr size_t WS_EV8 = 32 * MiB;
constexpr size_t WS_US = 48 * MiB;
constexpr size_t WS_VS = WS_US + 64 * 1024;
constexpr size_t WS_HB = 52 * MiB;
constexpr size_t WS_QA = 116 * MiB;
constexpr size_t WS_KA = 148 * MiB;
constexpr size_t WS_VAT = 156 * MiB;
constexpr size_t WS_QL = 164 * MiB;
constexpr size_t WS_KVL = 180 * MiB;
constexpr size_t WS_QMB = 192 * MiB;
constexpr size_t WS_K96 = 240 * MiB;
constexpr size_t WS_VT = 288 * MiB;
constexpr size_t WS_OAB = 320 * MiB;
constexpr size_t WS_PQ = 116 * MiB;
constexpr size_t WS_TOPS = 244 * MiB;
constexpr size_t WS_TOPI = 276 * MiB;
constexpr size_t WS_IDX = 284 * MiB;
constexpr size_t WS_G = 292 * MiB;
constexpr size_t WS_SSQO = 49 * MiB;
constexpr size_t WS_SSQ1 = 384 * MiB;
constexpr size_t WS_BPQ = 3 * MiB + 64 * 1024;
constexpr size_t WS_KEEP = 386 * MiB;
constexpr size_t WS_W = 390 * MiB;
constexpr size_t WS_END = 408 * MiB;
constexpr int LDS_BYTES = 148480;
constexpr int NEXP = 16384;

struct Params {
    const float *x, *c, *w_ada, *b_ada, *w_in, *sink, *qnorm, *w_qup, *kvnorm, *w_kvup, *onorm_a, *onorm_b, *w_out, *w_pq, *subk, *eu, *ev, *fnorm;
    float* out;
    unsigned char* ws;
};

typedef short bf16x8 __attribute__((ext_vector_type(8)));
typedef float f32x4 __attribute__((ext_vector_type(4)));
typedef unsigned u32x4 __attribute__((ext_vector_type(4)));
typedef float f32x2 __attribute__((ext_vector_type(2)));
typedef int i32x8 __attribute__((ext_vector_type(8)));

__device__ __forceinline__ int tid_opaque() { int t = threadIdx.x; asm volatile("" : "+v"(t)); return t; }
__device__ __forceinline__ unsigned f2bf(float f) { unsigned u = __builtin_bit_cast(unsigned, f); return (u + 0x7fffu + ((u >> 16) & 1u)) >> 16; }
__device__ __forceinline__ unsigned pk2(float lo, float hi) { return f2bf(lo) | (f2bf(hi) << 16); }
__device__ __forceinline__ float bf2f(unsigned short h) { return __builtin_bit_cast(float, (unsigned)h << 16); }
__device__ __forceinline__ float bflo(unsigned w) { return __builtin_bit_cast(float, w << 16); }
__device__ __forceinline__ float bfhi(unsigned w) { return __builtin_bit_cast(float, w & 0xffff0000u); }
__device__ __forceinline__ float wave_sum(float v) {
#pragma unroll
    for (int o = 1; o < 64; o <<= 1) v += __shfl_xor(v, o);
    return v;
}

__device__ __forceinline__ float wave_max(float v) {
#pragma unroll
    for (int o = 1; o < 64; o <<= 1) v = fmaxf(v, __shfl_xor(v, o));
    return v;
}
template <int CTRL> __device__ __forceinline__ float dpp_add(float s) {
    return s + __builtin_bit_cast(float, __builtin_amdgcn_update_dpp(0, __builtin_bit_cast(int, s), CTRL, 0xF, 0xF, true));
}
__device__ __forceinline__ float group16_sum(float s) { s = dpp_add<0xB1>(s); s = dpp_add<0x4E>(s); s = dpp_add<0x141>(s); s = dpp_add<0x140>(s); return s; }

__device__ void stage_gemv8(const float* vec, int vstride, bool silu, const float* W, int N, const float* bias, float* dst, float* lds) {
    const int tid = threadIdx.x;
    __syncthreads();
    for (int i = tid; i < Bsz * D; i += NTHREADS) { const int b = i >> 10, k = i & 1023; float v = vec[b * vstride + k]; lds[i] = silu ? v / (1.f + __expf(-v)) : v; }
    __syncthreads();
    float* red = lds + Bsz * D;
    const int col_l = tid & 15, slice = tid >> 4;
    for (int item = blockIdx.x; item < N / 16; item += gridDim.x) {
        const int n = item * 16 + col_l;
        float acc[Bsz];
#pragma unroll
        for (int b = 0; b < Bsz; ++b) acc[b] = 0.f;
#pragma unroll 8
        for (int kk = 0; kk < 32; ++kk) {
            const int k = slice * 32 + kk;
            const float w = W[(size_t)k * N + n];
#pragma unroll
            for (int b = 0; b < Bsz; ++b) acc[b] += lds[b * D + k] * w;
        }
#pragma unroll
        for (int b = 0; b < Bsz; ++b) red[(slice * 16 + col_l) * Bsz + b] = acc[b];
        __syncthreads();
        if (tid < 128) {
            const int cc = tid >> 3, b = tid & 7;
            float sacc = 0.f;
#pragma unroll
            for (int sl = 0; sl < 32; ++sl) sacc += red[(sl * 16 + cc) * Bsz + b];
            dst[b * N + item * 16 + cc] = sacc + (bias ? bias[item * 16 + cc] : 0.f);
        }
        __syncthreads();
    }
}

template <int MAP> __device__ __forceinline__ int map_row(int n) {
    if (MAP == 1) { const int h = n / 96, j = n % 96; return j < 64 ? h * 64 + j : 512 + h * 32 + (j - 64); }
    return n;
}
template <int MAP>
__device__ __forceinline__ void transpose_item(const float* W, int K, int N, unsigned short* WT, const float* kgain, float* scr, int item, int lane, const float* kgain2 = nullptr) {
    const int nblk = N / 32, kb = item / nblk, nb = item % nblk, k0 = 64 * kb, n0 = 32 * nb;
#pragma unroll 8
    for (int i = 0; i < 32; ++i) {
        const int kk = 2 * i + (lane >> 5);
        float w = W[(size_t)(k0 + kk) * N + n0 + (lane & 31)];
        if (kgain) w *= (kgain2 && k0 + kk >= 512) ? kgain2[k0 + kk - 512] : kgain[k0 + kk];
        scr[kk * 33 + (lane & 31)] = w;
    }
    asm volatile("s_waitcnt lgkmcnt(0)" ::: "memory");
    const int c = lane & 7;
#pragma unroll
    for (int j = 0; j < 4; ++j) {
        const int n = (lane >> 3) + 8 * j; const float* q = scr + (8 * c) * 33 + n;
        u32x4 o; o.x = pk2(q[0 * 33], q[1 * 33]); o.y = pk2(q[2 * 33], q[3 * 33]); o.z = pk2(q[4 * 33], q[5 * 33]); o.w = pk2(q[6 * 33], q[7 * 33]);
        *(u32x4*)(WT + (size_t)map_row<MAP>(n0 + n) * K + k0 + 8 * c) = o;
    }
    asm volatile("s_waitcnt lgkmcnt(0)" ::: "memory");
}

__device__ void stage_prologue(const Params& p, float* lds) {
    const int tid = threadIdx.x;
    stage_gemv8(p.c, D, true, p.w_ada, NMOD, p.b_ada, (float*)(p.ws + WS_MOD), lds);
    float* cosA = (float*)(p.ws + WS_COSA); float* sinA = (float*)(p.ws + WS_SINA);
    float* cosB = (float*)(p.ws + WS_COSB); float* sinB = (float*)(p.ws + WS_SINB);
    const int gtid = blockIdx.x * NTHREADS + tid, gn = gridDim.x * NTHREADS;
    for (int e = gtid; e < S * 32; e += gn) {
        const int pos = e >> 5, i = e & 31;
        const double inv = exp2(-(double)(2 * i) / 64.0 * 13.287712379549449);
        const double a = (double)pos * inv;
        cosA[e] = (float)cos(a); sinA[e] = (float)sin(a);
    }
    for (int e = gtid; e < S * 16; e += gn) {
        const int pos = e >> 4, i = e & 15;
        const double inv = exp2(-(double)(2 * i) / 32.0 * 13.287712379549449);
        const double a = (double)pos * inv;
        cosB[e] = (float)cos(a); sinB[e] = (float)sin(a);
    }
    {
        const int lane = tid & 63, wave = tid >> 6;
        float* scr = lds + wave * (64 * 33);
        const int gw = blockIdx.x * NWAVES + wave, NGW = gridDim.x * NWAVES;
        constexpr int I_IN = (D / 64) * (INW / 32), I_QU = (256 / 64) * (768 / 32), I_KV = (128 / 64) * (1024 / 32), I_OUT = (D / 64) * (D / 32), I_PQ = (D / 64) * (2048 / 32);
        constexpr int NITEMS = I_IN + I_QU + I_KV + I_OUT + I_PQ;
        __syncthreads();
        for (int it = gw; it < NITEMS; it += NGW) {
            int r = it;
            if (r < I_IN) { transpose_item<0>(p.w_in, D, INW, (unsigned short*)(p.ws + WS_WIN), nullptr, scr, r, lane); continue; } r -= I_IN;
            if (r < I_QU) { transpose_item<1>(p.w_qup, 256, 768, (unsigned short*)(p.ws + WS_WQUP), p.qnorm, scr, r, lane); continue; } r -= I_QU;
            if (r < I_KV) { transpose_item<0>(p.w_kvup, 128, 1024, (unsigned short*)(p.ws + WS_WKVUP), p.kvnorm, scr, r, lane); continue; } r -= I_KV;
            if (r < I_OUT) { transpose_item<0>(p.w_out, D, D, (unsigned short*)(p.ws + WS_WOUT), p.onorm_a, scr, r, lane, p.onorm_b); continue; } r -= I_OUT;
            transpose_item<0>(p.w_pq, D, 2048, (unsigned short*)(p.ws + WS_WPQ), nullptr, scr, r, lane);
        }
        {
            u32x4* z = (u32x4*)(p.ws + WS_WIN + (size_t)INW * D * 2);
            const int nz = (1280 - INW) * D * 2 / 16;
            for (int e = blockIdx.x * NTHREADS + tid; e < nz; e += gridDim.x * NTHREADS) z[e] = (u32x4){0u, 0u, 0u, 0u};
        }
        {
            const f32x4* src = (const f32x4*)p.subk; unsigned long long* dst = (unsigned long long*)(p.ws + WS_SUBK);
            for (int e = blockIdx.x * NTHREADS + tid; e < 16 * 128 * 128 / 4; e += gridDim.x * NTHREADS) {
                const f32x4 v = src[e]; dst[e] = (unsigned long long)pk2(v.x, v.y) | ((unsigned long long)pk2(v.z, v.w) << 32);
            }
        }
    }
    {
        const int lane = tid & 63, wave = tid >> 6;
        for (int r = blockIdx.x * NWAVES + wave; r < 2 * NEXP; r += gridDim.x * NWAVES) {
            const int tab = r >= NEXP, row = r - tab * NEXP;
            const f32x4* src = (const f32x4*)((tab ? p.ev : p.eu) + (size_t)row * D) + lane;
            f32x4 v[4]; float am = 0.f;
#pragma unroll
            for (int j = 0; j < 4; ++j) { v[j] = src[64 * j]; am = fmaxf(am, fmaxf(fmaxf(fabsf(v[j].x), fabsf(v[j].y)), fmaxf(fabsf(v[j].z), fabsf(v[j].w)))); }
            am = wave_max(am);
            int ex = 0; (void)frexpf(am, &ex);
            const float sc = ldexpf(1.f, 8 - ex), isc = ldexpf(1.f, ex - 8);
            unsigned* dst = (unsigned*)(p.ws + (tab ? WS_EV8 : WS_EU8) + (size_t)row * D) + lane;
#pragma unroll
            for (int j = 0; j < 4; ++j) {
                int w = 0;
                w = __builtin_amdgcn_cvt_pk_fp8_f32(v[j].x * sc, v[j].y * sc, w, false);
                w = __builtin_amdgcn_cvt_pk_fp8_f32(v[j].z * sc, v[j].w * sc, w, true);
                dst[64 * j] = (unsigned)w;
            }
            if (lane == 0) ((float*)(p.ws + (tab ? WS_VS : WS_US)))[row] = isc;
        }
    }
}

template <bool BF>
__device__ void stage_norm_mod(const Params& p, const float* src, void* dstv, int sh_off, int sc_off) {
    const float* mod = (const float*)(p.ws + WS_MOD);
    const int lane = threadIdx.x & 63, wave = threadIdx.x >> 6;
    for (int t = blockIdx.x * NWAVES + wave; t < T; t += gridDim.x * NWAVES) {
        const int b = t >> 12;
        const f32x4* xr = (const f32x4*)(src + (size_t)t * D) + lane;
        f32x4 v[4]; float s = 0.f;
#pragma unroll
        for (int j = 0; j < 4; ++j) { v[j] = xr[64 * j]; s += v[j].x * v[j].x + v[j].y * v[j].y + v[j].z * v[j].z + v[j].w * v[j].w; }
        const float rstd = rsqrtf(wave_sum(s) * (1.f / D) + EPS);
#pragma unroll
        for (int j = 0; j < 4; ++j) {
            const f32x4 sh = *((const f32x4*)(mod + b * NMOD + sh_off) + lane + 64 * j);
            const f32x4 sc = *((const f32x4*)(mod + b * NMOD + sc_off) + lane + 64 * j);
            f32x4 r;
            r.x = v[j].x * rstd * (1.f + sc.x) + sh.x; r.y = v[j].y * rstd * (1.f + sc.y) + sh.y;
            r.z = v[j].z * rstd * (1.f + sc.z) + sh.z; r.w = v[j].w * rstd * (1.f + sc.w) + sh.w;
            if (BF) ((unsigned long long*)((unsigned short*)dstv + (size_t)t * D))[lane + 64 * j] = (unsigned long long)pk2(r.x, r.y) | ((unsigned long long)pk2(r.z, r.w) << 32);
            else ((f32x4*)((float*)dstv + (size_t)t * D))[lane + 64 * j] = r;
        }
    }
}

constexpr int TP = 128, TQ = 256, TBK = 64;
constexpr int XS_BYTES = TP * 128, YS_BYTES = TQ * 128, STG_BYTES = XS_BYTES + YS_BYTES;
__device__ __forceinline__ int swz(int r, int c) { return r * 128 + ((c ^ ((r >> 1) & 7)) << 4); }
constexpr int SSQ_OFF = 2 * (TP * 128 + TQ * 128);
__device__ __forceinline__ float ssq8(u32x4 w) {
    const float a0 = bflo(w.x), a1 = bfhi(w.x), a2 = bflo(w.y), a3 = bfhi(w.y), a4 = bflo(w.z), a5 = bfhi(w.z), a6 = bflo(w.w), a7 = bfhi(w.w);
    return (a0 * a0 + a1 * a1) + (a2 * a2 + a3 * a3) + (a4 * a4 + a5 * a5) + (a6 * a6 + a7 * a7);
}
template <int WPN, bool YSSQ, class Epi>
__device__ void gemm_xyT(const unsigned short* X, int ldx, const unsigned short* Y, int ldy, int P, int Q, int K, int nb, size_t xbs, size_t ybs, unsigned char* lds, const Epi& epi) {
    constexpr int WQN = 8 / WPN, FI = TP / (WPN * 16), FJ = TQ / (WQN * 16);
    const int tid = threadIdx.x, lane = tid & 63, wave = tid >> 6;
    const int wp = wave / WQN, wq = wave % WQN, fr = lane & 15, fq = lane >> 4;
    const int nPt = P / TP, nQt = Q / TQ, npb = nPt * nb, nunits = npb * nQt;
    const int G = gridDim.x, bx = blockIdx.x;
    const int vcu = (G % 8 == 0) ? (bx % 8) * (G / 8) + bx / 8 : bx;
    const int srow = tid >> 3, sc = tid & 7;
    const int nk = K / TBK;
    for (int u = vcu; u < nunits; u += G) {
        const int qt = u / npb, rem = u % npb, bi = rem / nPt, pt = rem % nPt, p0 = pt * TP, q0 = qt * TQ;
        f32x4 acc[FI][FJ];
#pragma unroll
        for (int i = 0; i < FI; ++i)
#pragma unroll
            for (int j = 0; j < FJ; ++j) acc[i][j] = (f32x4){0.f, 0.f, 0.f, 0.f};
        const unsigned short* xg = X + (size_t)bi * xbs + (size_t)(p0 + srow) * ldx + sc * 8;
        const unsigned short* yg = Y + (size_t)bi * ybs + (size_t)(q0 + srow) * ldy + sc * 8;
        u32x4 rx[2], ry[4];
        float sq[4] = {0.f, 0.f, 0.f, 0.f};
#pragma unroll
        for (int i = 0; i < 2; ++i) rx[i] = *(const u32x4*)(xg + (size_t)(64 * i) * ldx);
#pragma unroll
        for (int i = 0; i < 4; ++i) ry[i] = *(const u32x4*)(yg + (size_t)(64 * i) * ldy);
        if (YSSQ) {
#pragma unroll
            for (int i = 0; i < 4; ++i) sq[i] += ssq8(ry[i]);
        }
        __syncthreads();
#pragma unroll
        for (int i = 0; i < 2; ++i) *(u32x4*)(lds + swz(srow + 64 * i, sc)) = rx[i];
#pragma unroll
        for (int i = 0; i < 4; ++i) *(u32x4*)(lds + XS_BYTES + swz(srow + 64 * i, sc)) = ry[i];
        __syncthreads();
        for (int kt = 0; kt < nk; ++kt) {
            unsigned char* st = lds + (kt & 1) * STG_BYTES;
            unsigned char* sn = lds + ((kt & 1) ^ 1) * STG_BYTES;
            const bool more = (kt + 1 < nk);
            if (more) {
                const int k1 = (kt + 1) * TBK;
#pragma unroll
                for (int i = 0; i < 2; ++i) rx[i] = *(const u32x4*)(xg + (size_t)(64 * i) * ldx + k1);
#pragma unroll
                for (int i = 0; i < 4; ++i) ry[i] = *(const u32x4*)(yg + (size_t)(64 * i) * ldy + k1);
            }
            if (YSSQ && more) {
#pragma unroll
                for (int i = 0; i < 4; ++i) sq[i] += ssq8(ry[i]);
            }
#pragma unroll
            for (int kk = 0; kk < 2; ++kk) {
                bf16x8 af[FI], bfr[FJ];
#pragma unroll
                for (int i = 0; i < FI; ++i) af[i] = *(const bf16x8*)(st + swz(wp * (FI * 16) + i * 16 + fr, kk * 4 + fq));
#pragma unroll
                for (int j = 0; j < FJ; ++j) bfr[j] = *(const bf16x8*)(st + XS_BYTES + swz(wq * (FJ * 16) + j * 16 + fr, kk * 4 + fq));
#pragma unroll
                for (int i = 0; i < FI; ++i)
#pragma unroll
                    for (int j = 0; j < FJ; ++j) acc[i][j] = __builtin_amdgcn_mfma_f32_16x16x32_bf16(af[i], bfr[j], acc[i][j], 0, 0, 0);
            }
            if (more) {
#pragma unroll
                for (int i = 0; i < 2; ++i) *(u32x4*)(sn + swz(srow + 64 * i, sc)) = rx[i];
#pragma unroll
                for (int i = 0; i < 4; ++i) *(u32x4*)(sn + XS_BYTES + swz(srow + 64 * i, sc)) = ry[i];
            }
            __syncthreads();
        }
        if (YSSQ) {
            float* ssq = (float*)(lds + SSQ_OFF);
#pragma unroll
            for (int i = 0; i < 4; ++i) {
                float v = sq[i];
                v += __shfl_xor(v, 1); v += __shfl_xor(v, 2); v += __shfl_xor(v, 4);
                if (sc == 0) ssq[srow + 64 * i] = v;
            }
            __syncthreads();
        }
        epi(acc, p0 + wp * (FI * 16), q0 + wq * (FJ * 16), lane, (const float*)(lds + SSQ_OFF) + wq * (FJ * 16), bi);
        if (YSSQ) __syncthreads();
    }
}
constexpr int DMA_STAGES = 3;
#define RAW_BARRIER() do { asm volatile("s_waitcnt lgkmcnt(0)" ::: "memory"); __builtin_amdgcn_s_barrier(); } while (0)
template <int WPN, int SUB, class Epi>
__device__ void gemm_dma(const unsigned short* X, int ldx, const unsigned short* Y, int ldy, int P, int Q, int K, int nb, size_t xbs, size_t ybs, unsigned char* lds, Epi epi) {
    constexpr int WQN = 8 / WPN, FI = TP / (WPN * 16), FJ = TQ / (WQN * 16);
    const int tid = threadIdx.x, lane = tid & 63, wave = __builtin_amdgcn_readfirstlane(tid >> 6);
    const int wp = wave / WQN, wq = wave % WQN, fr = lane & 15, fq = lane >> 4;
    const int nPt = P / TP, nQt = Q / TQ, npb = nPt * nb / SUB, nunits = npb * nQt;
    const int G = gridDim.x, bx = blockIdx.x;
    const int vcu = (G % 8 == 0) ? (bx % 8) * (G / 8) + bx / 8 : bx;
    const int srow = wave * 8 + (lane >> 3), pc = lane & 7;
    const int nk = K / TBK;
    const int lc = pc ^ ((srow >> 1) & 7);
    for (int u = vcu; u < nunits; u += G)
#pragma unroll
    for (int sub = 0; sub < SUB; ++sub) {
        const int qt = u / npb, rem = (u % npb) * SUB + sub, bi = rem / nPt, pt = rem % nPt, p0 = pt * TP, q0 = qt * TQ;
        f32x4 acc[FI][FJ];
#pragma unroll
        for (int i = 0; i < FI; ++i)
#pragma unroll
            for (int j = 0; j < FJ; ++j) acc[i][j] = (f32x4){0.f, 0.f, 0.f, 0.f};
        const unsigned short* xg = X + (size_t)bi * xbs + (size_t)(p0 + srow) * ldx + lc * 8;
        const unsigned short* yg = Y + (size_t)bi * ybs + (size_t)(q0 + srow) * ldy + lc * 8;
        epi.pre(q0 + wq * (FJ * 16), lane);
        asm volatile("s_waitcnt vmcnt(0)" ::: "memory");
        RAW_BARRIER();
#define GEMM_DMA_TILE(kt_, stg_) do { \
            unsigned char* _b = lds + (stg_) * STG_BYTES + wave * 1024; const int _k = (kt_) * TBK; \
            _Pragma("unroll") for (int _i = 0; _i < 2; ++_i) __builtin_amdgcn_global_load_lds((const unsigned*)(xg + (size_t)(64 * _i) * ldx + _k), (unsigned*)(_b + _i * 8192), 16, 0, 0); \
            _Pragma("unroll") for (int _i = 0; _i < 4; ++_i) __builtin_amdgcn_global_load_lds((const unsigned*)(yg + (size_t)(64 * _i) * ldy + _k), (unsigned*)(_b + XS_BYTES + _i * 8192), 16, 0, 0); \
        } while (0)
        GEMM_DMA_TILE(0, 0);
        GEMM_DMA_TILE(1, 1);
        int cur = 0;
        for (int kt = 0; kt < nk; ++kt) {
            if (kt + 1 < nk) asm volatile("s_waitcnt vmcnt(6)" ::: "memory");
            else if (Epi::HAS_LATE) asm volatile("s_waitcnt vmcnt(16)" ::: "memory");
            else asm volatile("s_waitcnt vmcnt(0)" ::: "memory");
            RAW_BARRIER();
            if (kt + 2 < nk) { const int nxt = (cur == 0) ? 2 : cur - 1; GEMM_DMA_TILE(kt + 2, nxt); }
            if (Epi::HAS_LATE && kt + 2 == nk) epi.late(p0 + wp * (FI * 16), q0 + wq * (FJ * 16), lane);
            const unsigned char* st = lds + cur * STG_BYTES;
#pragma unroll
            for (int kk = 0; kk < 2; ++kk) {
                bf16x8 af[FI], bfr[FJ];
#pragma unroll
                for (int i = 0; i < FI; ++i) af[i] = *(const bf16x8*)(st + swz(wp * (FI * 16) + i * 16 + fr, kk * 4 + fq));
#pragma unroll
                for (int j = 0; j < FJ; ++j) bfr[j] = *(const bf16x8*)(st + XS_BYTES + swz(wq * (FJ * 16) + j * 16 + fr, kk * 4 + fq));
#pragma unroll
                for (int i = 0; i < FI; ++i)
#pragma unroll
                    for (int j = 0; j < FJ; ++j) acc[i][j] = __builtin_amdgcn_mfma_f32_16x16x32_bf16(af[i], bfr[j], acc[i][j], 0, 0, 0);
            }
            cur = (cur == 2) ? 0 : cur + 1;
            if (Epi::HAS_MID && kt + 1 == (nk >> 1)) epi.mid(acc);
        }
#undef GEMM_DMA_TILE
        epi(acc, p0 + wp * (FI * 16), q0 + wq * (FJ * 16), lane, (const float*)nullptr, bi, sub);
    }
}
__device__ __forceinline__ unsigned long long pk4(float a, float b, float c, float d) { return (unsigned long long)pk2(a, b) | ((unsigned long long)pk2(c, d) << 32); }
struct EpiOutProj {
    static constexpr bool HAS_MID = true;
    static constexpr bool HAS_LATE = true;
    const float* x; const float* mod; float* out; unsigned short* y1; const float* ssqo; float* ssq1;
    float ratio[4], rb[4];
    f32x4 xv[4][4];
    __device__ __forceinline__ void late(int pb, int qb, int lane) {
        const int fr = lane & 15, fq = lane >> 4;
#pragma unroll
        for (int j = 0; j < 4; ++j)
#pragma unroll
            for (int i = 0; i < 4; ++i) xv[j][i] = *(const f32x4*)(x + (size_t)(qb + j * 16 + fr) * D + pb + i * 16 + fq * 4);
    }
    __device__ __forceinline__ void pre(int qb, int lane) {
#pragma unroll
        for (int j = 0; j < 4; ++j) {
            const f32x4* s4 = (const f32x4*)(ssqo + (size_t)(qb + j * 16 + (lane & 15)) * 16);
            const f32x4 a0 = s4[0], a1 = s4[1], b0 = s4[2], b1 = s4[3];
            const float sa = (a0.x + a0.y + a0.z + a0.w) + (a1.x + a1.y + a1.z + a1.w), sb = (b0.x + b0.y + b0.z + b0.w) + (b1.x + b1.y + b1.z + b1.w);
            const float ra = rsqrtf(sa * (1.f / 512.f) + EPS); rb[j] = rsqrtf(sb * (1.f / 512.f) + EPS); ratio[j] = ra / rb[j];
        }
    }
    __device__ __forceinline__ void mid(f32x4 (&acc)[4][4]) {
#pragma unroll
        for (int i = 0; i < 4; ++i)
#pragma unroll
            for (int j = 0; j < 4; ++j) { acc[i][j].x *= ratio[j]; acc[i][j].y *= ratio[j]; acc[i][j].z *= ratio[j]; acc[i][j].w *= ratio[j]; }
    }
    __device__ __forceinline__ void operator()(const f32x4 (&acc)[4][4], int pb, int qb, int lane, const float*, int, int = 0) {
        const int fr = lane & 15, fq = lane >> 4;
        const float* __restrict__ xr = x; float* __restrict__ outr = out; unsigned short* __restrict__ yr = y1; float* __restrict__ sr = ssq1;
        const float* mt = mod + (qb >> 12) * NMOD + pb + fq * 4;
        f32x4 gv[4], scv[4];
#pragma unroll
        for (int i = 0; i < 4; ++i) { gv[i] = *(const f32x4*)(mt + 2 * D + i * 16); scv[i] = *(const f32x4*)(mt + 4 * D + i * 16); }
#pragma unroll
        for (int j = 0; j < 4; ++j) {
            const int t = qb + j * 16 + fr;
            float ss = 0.f;
#pragma unroll
            for (int i = 0; i < 4; ++i) {
                const int n = pb + i * 16 + fq * 4;
                const f32x4 xx = xv[j][i];
                f32x4 r; r.x = xx.x + gv[i].x * (acc[i][j].x * rb[j]); r.y = xx.y + gv[i].y * (acc[i][j].y * rb[j]); r.z = xx.z + gv[i].z * (acc[i][j].z * rb[j]); r.w = xx.w + gv[i].w * (acc[i][j].w * rb[j]);
                *(f32x4*)(outr + (size_t)t * D + n) = r;
                ss += (r.x * r.x + r.y * r.y) + (r.z * r.z + r.w * r.w);
                *(unsigned long long*)(yr + (size_t)t * D + n) = pk4(r.x * (1.f + scv[i].x), r.y * (1.f + scv[i].y), r.z * (1.f + scv[i].z), r.w * (1.f + scv[i].w));
            }
            ss += __shfl_xor(ss, 16); ss += __shfl_xor(ss, 32);
            if (fq == 0) sr[(size_t)t * 16 + (pb >> 6)] = ss;
        }
    }
};
struct EpiPQ {
    static constexpr bool HAS_MID = false, HAS_LATE = false;
    __device__ __forceinline__ void late(int, int, int) {}
    unsigned short* C; const float* ssq1; const float* bias;
    float r1[4];
    __device__ __forceinline__ void pre(int qb, int lane) {
#pragma unroll
        for (int j = 0; j < 4; ++j) {
            const f32x4* s4 = (const f32x4*)(ssq1 + (size_t)(qb + j * 16 + (lane & 15)) * 16);
            const f32x4 a0 = s4[0], a1 = s4[1], a2 = s4[2], a3 = s4[3];
            const float sa = ((a0.x + a0.y + a0.z + a0.w) + (a1.x + a1.y + a1.z + a1.w)) + ((a2.x + a2.y + a2.z + a2.w) + (a3.x + a3.y + a3.z + a3.w));
            r1[j] = rsqrtf(sa * (1.f / D) + EPS);
        }
    }
    template <class A> __device__ __forceinline__ void mid(A&) {}
    __device__ __forceinline__ void operator()(const f32x4 (&acc)[4][4], int pb, int qb, int lane, const float*, int, int = 0) {
        const int fr = lane & 15, fq = lane >> 4;
        unsigned short* __restrict__ Cr = C;
        const float* bt = bias + (qb >> 12) * 2048 + pb + fq * 4;
        f32x4 bv[4];
#pragma unroll
        for (int i = 0; i < 4; ++i) bv[i] = *(const f32x4*)(bt + i * 16);
#pragma unroll
        for (int j = 0; j < 4; ++j) {
            const int t = qb + j * 16 + fr;
#pragma unroll
            for (int i = 0; i < 4; ++i) {
                const int n = pb + i * 16 + fq * 4;
                *(unsigned long long*)(Cr + (size_t)t * 2048 + n) = pk4(acc[i][j].x * r1[j] + bv[i].x, acc[i][j].y * r1[j] + bv[i].y, acc[i][j].z * r1[j] + bv[i].z, acc[i][j].w * r1[j] + bv[i].w);
            }
        }
    }
};

struct EpiProj {
    static constexpr bool HAS_MID = false, HAS_LATE = false;
    __device__ __forceinline__ void late(int, int, int) {}
    __device__ __forceinline__ void pre(int, int) {}
    template <class A> __device__ __forceinline__ void mid(A&) {}
    unsigned char* ws;
    __device__ __forceinline__ void operator()(const f32x4 (&acc)[4][4], int pb, int qb, int lane, const float*, int, int = 0) const {
        const int fr = lane & 15, fq = lane >> 4;
        if (pb >= 1216) return;
        const int t0 = qb + fr, b = t0 >> 12, pos0 = t0 & (S - 1);
        if (pb < C_VA) {
            const float* __restrict__ cosA = (const float*)(ws + WS_COSA); const float* __restrict__ sinA = (const float*)(ws + WS_SINA);
            const bool isq = pb < C_KA;
            const int head = isq ? (pb >> 6) : ((pb - C_KA) >> 6);
            unsigned short* __restrict__ dst0 = isq ? (unsigned short*)(ws + WS_QA) + ((size_t)(b * 8 + head) * S + pos0) * 64 : (unsigned short*)(ws + WS_KA) + ((size_t)(b * 2 + head) * S + pos0) * 64;
            const float sc = isq ? QA_SCALE : 1.f;
#pragma unroll
            for (int jh = 0; jh < 4; jh += 2) {
                f32x4 c[2][2], sn[2][2];
#pragma unroll
                for (int jj = 0; jj < 2; ++jj)
#pragma unroll
                    for (int i = 0; i < 2; ++i) { c[jj][i] = *(const f32x4*)(cosA + (pos0 + 16 * (jh + jj)) * 32 + i * 16 + fq * 4); sn[jj][i] = *(const f32x4*)(sinA + (pos0 + 16 * (jh + jj)) * 32 + i * 16 + fq * 4); }
#pragma unroll
                for (int jj = 0; jj < 2; ++jj)
#pragma unroll
                    for (int i = 0; i < 2; ++i) {
                        const int j = jh + jj, d = i * 16 + fq * 4;
                        const f32x4 x1 = acc[i][j], x2 = acc[i + 2][j], cc = c[jj][i], ss = sn[jj][i];
                        unsigned short* dst = dst0 + (size_t)(16 * j) * 64;
                        *(unsigned long long*)(dst + d) = pk4((x1.x * cc.x - x2.x * ss.x) * sc, (x1.y * cc.y - x2.y * ss.y) * sc, (x1.z * cc.z - x2.z * ss.z) * sc, (x1.w * cc.w - x2.w * ss.w) * sc);
                        *(unsigned long long*)(dst + 32 + d) = pk4((x2.x * cc.x + x1.x * ss.x) * sc, (x2.y * cc.y + x1.y * ss.y) * sc, (x2.z * cc.z + x1.z * ss.z) * sc, (x2.w * cc.w + x1.w * ss.w) * sc);
                    }
            }
        } else if (pb < C_QL) {
            const int kvh = (pb - C_VA) >> 6;
            unsigned short* __restrict__ dst0 = (unsigned short*)(ws + WS_VAT) + (size_t)(b * 2 + kvh) * 64 * S + pos0;
#pragma unroll
            for (int j = 0; j < 4; ++j)
#pragma unroll
                for (int i = 0; i < 4; ++i) {
                    const int dv = i * 16 + fq * 4; unsigned short* dst = dst0 + 16 * j;
                    dst[(size_t)(dv + 0) * S] = (unsigned short)f2bf(acc[i][j].x); dst[(size_t)(dv + 1) * S] = (unsigned short)f2bf(acc[i][j].y);
                    dst[(size_t)(dv + 2) * S] = (unsigned short)f2bf(acc[i][j].z); dst[(size_t)(dv + 3) * S] = (unsigned short)f2bf(acc[i][j].w);
                }
        } else if (pb < C_KR) {
            const bool isq = pb < C_KVL;
            unsigned short* __restrict__ dst0 = isq ? (unsigned short*)(ws + WS_QL) + (size_t)t0 * 256 + (pb - C_QL) : (unsigned short*)(ws + WS_KVL) + (size_t)t0 * 128 + (pb - C_KVL);
            const int ld = isq ? 256 : 128;
#pragma unroll
            for (int j = 0; j < 4; ++j)
#pragma unroll
                for (int i = 0; i < 4; ++i) *(unsigned long long*)(dst0 + (size_t)(16 * j) * ld + i * 16 + fq * 4) = pk4(acc[i][j].x, acc[i][j].y, acc[i][j].z, acc[i][j].w);
        } else {
            const float* __restrict__ cosB = (const float*)(ws + WS_COSB); const float* __restrict__ sinB = (const float*)(ws + WS_SINB);
            unsigned short* __restrict__ K96 = (unsigned short*)(ws + WS_K96);
            const int d = fq * 4;
            f32x4 c[4], sn[4];
#pragma unroll
            for (int j = 0; j < 4; ++j) { c[j] = *(const f32x4*)(cosB + (pos0 + 16 * j) * 16 + d); sn[j] = *(const f32x4*)(sinB + (pos0 + 16 * j) * 16 + d); }
#pragma unroll
            for (int j = 0; j < 4; ++j) {
                const f32x4 x1 = acc[0][j], x2 = acc[1][j], cc = c[j], ss = sn[j];
                const unsigned long long lo = pk4(x1.x * cc.x - x2.x * ss.x, x1.y * cc.y - x2.y * ss.y, x1.z * cc.z - x2.z * ss.z, x1.w * cc.w - x2.w * ss.w);
                const unsigned long long hi = pk4(x2.x * cc.x + x1.x * ss.x, x2.y * cc.y + x1.y * ss.y, x2.z * cc.z + x1.z * ss.z, x2.w * cc.w + x1.w * ss.w);
#pragma unroll
                for (int h = 0; h < 8; ++h) {
                    unsigned short* dst = K96 + ((size_t)(b * 8 + h) * S + pos0 + 16 * j) * 64 + 32 + d;
                    *(unsigned long long*)dst = lo; *(unsigned long long*)(dst + 16) = hi;
                }
            }
        }
    }
};
struct EpiQup {
    unsigned char* ws;
    __device__ __forceinline__ void operator()(const f32x4 (&acc)[4][4], int pb, int qb, int lane, const float* ssq, int, int = 0) const {
        const int fr = lane & 15, fq = lane >> 4;
        unsigned short* __restrict__ QMB = (unsigned short*)(ws + WS_QMB);
        const float* __restrict__ cosB = (const float*)(ws + WS_COSB); const float* __restrict__ sinB = (const float*)(ws + WS_SINB);
        const int t0 = qb + fr, b = t0 >> 12, pos0 = t0 & (S - 1);
        float sc[4];
#pragma unroll
        for (int j = 0; j < 4; ++j) sc[j] = rsqrtf(ssq[j * 16 + fr] * (1.f / 256.f) + EPS) * QM_SCALE;
        if (pb < 512) {
            unsigned char* dst0 = (unsigned char*)(QMB + ((size_t)(b * 8 + (pb >> 6)) * S + pos0) * 64);
#pragma unroll
            for (int j = 0; j < 4; ++j)
#pragma unroll
                for (int i = 0; i < 4; ++i) {
                    const float s8 = sc[j] * 8.f; int w = 0;
                    w = __builtin_amdgcn_cvt_pk_fp8_f32(acc[i][j].x * s8, acc[i][j].y * s8, w, false); w = __builtin_amdgcn_cvt_pk_fp8_f32(acc[i][j].z * s8, acc[i][j].w * s8, w, true);
                    *(unsigned*)(dst0 + (size_t)(16 * j) * 128 + i * 16 + fq * 4) = (unsigned)w;
                }
        } else {
            const int d = fq * 4;
            f32x4 c[4], sn[4];
#pragma unroll
            for (int j = 0; j < 4; ++j) { c[j] = *(const f32x4*)(cosB + (pos0 + 16 * j) * 16 + d); sn[j] = *(const f32x4*)(sinB + (pos0 + 16 * j) * 16 + d); }
#pragma unroll
            for (int j = 0; j < 4; ++j)
#pragma unroll
                for (int hh = 0; hh < 2; ++hh) {
                    const int h = ((pb - 512) >> 5) + hh;
                    unsigned short* dst = QMB + ((size_t)(b * 8 + h) * S + pos0 + 16 * j) * 64 + 32 + d;
                    const f32x4 x1 = acc[2 * hh][j], x2 = acc[2 * hh + 1][j], cc = c[j], ss = sn[j]; const float s_ = sc[j];
                    *(unsigned long long*)dst = pk4((x1.x * cc.x - x2.x * ss.x) * s_, (x1.y * cc.y - x2.y * ss.y) * s_, (x1.z * cc.z - x2.z * ss.z) * s_, (x1.w * cc.w - x2.w * ss.w) * s_);
                    *(unsigned long long*)(dst + 16) = pk4((x2.x * cc.x + x1.x * ss.x) * s_, (x2.y * cc.y + x1.y * ss.y) * s_, (x2.z * cc.z + x1.z * ss.z) * s_, (x2.w * cc.w + x1.w * ss.w) * s_);
                }
        }
    }
};
struct EpiKVup {
    unsigned char* ws;
    __device__ __forceinline__ void operator()(const f32x4 (&acc)[4][4], int pb, int qb, int lane, const float* ssq, int, int = 0) const {
        const int fr = lane & 15, fq = lane >> 4;
        unsigned short* K96 = (unsigned short*)(ws + WS_K96); unsigned short* VT = (unsigned short*)(ws + WS_VT);
        const int h = pb >> 7;
#pragma unroll
        for (int j = 0; j < 4; ++j) {
            const int t = qb + j * 16 + fr, b = t >> 12, pos = t & (S - 1);
            const float sc = rsqrtf(ssq[j * 16 + fr] * (1.f / 128.f) + EPS);
            if ((pb & 64) == 0) {
                unsigned char* dst = (unsigned char*)(K96 + ((size_t)(b * 8 + h) * S + pos) * 64);
#pragma unroll
                for (int i = 0; i < 4; ++i) {
                    int w = 0;
                    w = __builtin_amdgcn_cvt_pk_fp8_f32(acc[i][j].x * sc, acc[i][j].y * sc, w, false); w = __builtin_amdgcn_cvt_pk_fp8_f32(acc[i][j].z * sc, acc[i][j].w * sc, w, true);
                    *(unsigned*)(dst + i * 16 + fq * 4) = (unsigned)w;
                }
            } else {
                unsigned char* dst = (unsigned char*)VT + (size_t)(b * 8 + h) * 64 * S + pos;
#pragma unroll
                for (int i = 0; i < 4; ++i) {
                    const int dv = i * 16 + fq * 4;
                    const int w0 = __builtin_amdgcn_cvt_pk_fp8_f32(acc[i][j].x * sc, acc[i][j].y * sc, 0, false), w1 = __builtin_amdgcn_cvt_pk_fp8_f32(acc[i][j].z * sc, acc[i][j].w * sc, 0, false);
                    dst[(size_t)(dv + 0) * S] = (unsigned char)(w0 & 0xff); dst[(size_t)(dv + 1) * S] = (unsigned char)((w0 >> 8) & 0xff);
                    dst[(size_t)(dv + 2) * S] = (unsigned char)(w1 & 0xff); dst[(size_t)(dv + 3) * S] = (unsigned char)((w1 >> 8) & 0xff);
                }
            }
        }
    }
};

typedef float f32x16 __attribute__((ext_vector_type(16)));
typedef __bf16 bf16x2_t __attribute__((ext_vector_type(2)));
__device__ __forceinline__ unsigned cvtpk(float lo, float hi) { f32x2 v = {lo, hi}; bf16x2_t b = __builtin_convertvector(v, bf16x2_t); return __builtin_bit_cast(unsigned, b); }
__device__ __forceinline__ int crow(int r, int hi) { return (r & 3) + 8 * (r >> 2) + 4 * hi; }
__device__ __forceinline__ int kperm(int rho) { return (rho & 0x13) | ((rho & 4) << 1) | ((rho & 8) >> 1); }

template <int DQK, bool SWA>
__device__ void stage_attn_flash(const Params& p, unsigned char* lds) {
    constexpr bool V8 = !SWA;
    constexpr bool Q8 = !SWA;
    constexpr int NK = DQK / 16, KCH = DQK / 8, KSTR = Q8 ? 80 : (KCH + 1) * 16, VSTR = V8 ? 80 : 144;
    constexpr int KT_BYTES = Q8 ? 2 * 64 * 80 : 64 * KSTR, VT_BYTES = 64 * VSTR, STG = KT_BYTES + VT_BYTES, NKC = 64 * KCH;
    const unsigned short* Qg = (const unsigned short*)(p.ws + (SWA ? WS_QA : WS_QMB));
    const unsigned short* Kg = (const unsigned short*)(p.ws + (SWA ? WS_KA : WS_K96));
    const unsigned short* Vg = (const unsigned short*)(p.ws + (SWA ? WS_VAT : WS_VT));
    unsigned short* O = (unsigned short*)(p.ws + WS_OAB);
    const int tid = threadIdx.x, lane = tid & 63, wave = tid >> 6, r32 = lane & 31, hi = lane >> 5;
    const int G = gridDim.x, bx = blockIdx.x;
    const int vcu = (G % 8 == 0) ? (bx % 8) * (G / 8) + bx / 8 : bx;
    const int nunits = SWA ? Bsz * 2 * 64 : Bsz * 8 * 16;
    const int kro = kperm(r32) * KSTR + hi * (Q8 ? 32 : 16);
    const int krr = 64 * 80 + kperm(r32) * 80 + hi * 16;
    const int k8lds = ((tid & 7) < 4) ? ((tid >> 3) * 80 + (tid & 7) * 16) : (64 * 80 + (tid >> 3) * 80 + ((tid & 7) - 4) * 16);
    const int vro = r32 * VSTR + hi * (V8 ? 32 : 16);
    const int kid0 = tid, kid1 = tid + 512;
    const int k0row = kid0 / KCH, k0c = kid0 % KCH, k1row = kid1 / KCH, k1c = kid1 % KCH;
    const int vrow = V8 ? (tid >> 2) : (tid >> 3), vc = V8 ? (tid & 3) : (tid & 7);
    for (int u = vcu; u < nunits; u += G) {
        int b, qb, tlo, thi, sq, ocol; const unsigned short *Qp, *Kb, *Vb; float m, l;
        if (SWA) {
            qb = u & 63; const int kvh = (u >> 6) & 1; b = u >> 7;
            const int head = kvh * 4 + (wave >> 1);
            sq = qb * 64 + (wave & 1) * 32 + r32;
            Qp = Qg + ((size_t)(b * 8 + head) * S + sq) * 64;
            Kb = Kg + (size_t)(b * 2 + kvh) * S * 64; Vb = Vg + (size_t)(b * 2 + kvh) * 64 * S;
            tlo = qb - 2 < 0 ? 0 : qb - 2; thi = qb + 2 > 63 ? 63 : qb + 2;
            m = p.sink[head] * LOG2E; l = 0.5f; ocol = head * 64;
        } else {
            qb = u & 15; const int h = (u >> 4) & 7; b = u >> 7;
            sq = qb * 256 + wave * 32 + r32;
            Qp = Qg + ((size_t)(b * 8 + h) * S + sq) * 64;
            Kb = Kg + (size_t)(b * 8 + h) * S * 64; Vb = (const unsigned short*)((const unsigned char*)Vg + (size_t)(b * 8 + h) * 64 * S);
            tlo = 0; thi = 63; m = 0.f; l = 0.f; ocol = 512 + h * 64;
        }
        bf16x8 qf[NK];
        i32x8 qn = {0, 0, 0, 0, 0, 0, 0, 0};
        if (Q8) {
            const u32x4 q0 = *(const u32x4*)((const unsigned char*)Qp + hi * 32), q1 = *(const u32x4*)((const unsigned char*)Qp + hi * 32 + 16);
            qn = (i32x8){(int)q0.x, (int)q0.y, (int)q0.z, (int)q0.w, (int)q1.x, (int)q1.y, (int)q1.z, (int)q1.w};
            qf[0] = *(const bf16x8*)(Qp + 32 + hi * 8); qf[1] = *(const bf16x8*)(Qp + 48 + hi * 8);
        } else {
#pragma unroll
            for (int ks = 0; ks < NK; ++ks) qf[ks] = *(const bf16x8*)(Qp + ks * 16 + hi * 8);
        }
        f32x16 o0, o1, negm;
        i32x8 pb = {0, 0, 0, 0, 0, 0, 0, 0};
#pragma unroll
        for (int r = 0; r < 16; ++r) { o0[r] = 0.f; o1[r] = 0.f; negm[r] = -m; }
        u32x4 rk0, rk1, rv;
        {
            const unsigned short* kt = Kb + (size_t)tlo * 64 * (Q8 ? 64 : DQK);
            rk0 = *(const u32x4*)(kt + kid0 * 8);
            if (!Q8 && kid1 < NKC) rk1 = *(const u32x4*)(kt + kid1 * 8);
            if (!V8 || tid < 256) rv = *(const u32x4*)((const unsigned char*)Vb + (V8 ? 1 : 2) * ((size_t)vrow * S + tlo * 64) + vc * 16);
            if (Q8) *(u32x4*)(lds + k8lds) = rk0;
            else { *(u32x4*)(lds + k0row * KSTR + k0c * 16) = rk0; if (kid1 < NKC) *(u32x4*)(lds + k1row * KSTR + k1c * 16) = rk1; }
            if (V8) { if (tid < 256) { unsigned long long* vd = (unsigned long long*)(lds + KT_BYTES + vrow * VSTR + vc * 8); vd[0] = (unsigned long long)rv.x | ((unsigned long long)rv.y << 32); vd[4] = (unsigned long long)rv.z | ((unsigned long long)rv.w << 32); } }
            else *(u32x4*)(lds + KT_BYTES + vrow * VSTR + vc * 16) = rv;
        }
        __syncthreads();
        for (int tt = tlo; tt <= thi; ++tt) {
            const unsigned char* Kl = lds + ((tt - tlo) & 1) * STG;
            const unsigned char* Vl = Kl + KT_BYTES;
            unsigned char* Kn = lds + (((tt - tlo) & 1) ^ 1) * STG;
            const bool more = tt < thi;
            if (more) {
                const unsigned short* kt = Kb + (size_t)(tt + 1) * 64 * (Q8 ? 64 : DQK);
                rk0 = *(const u32x4*)(kt + kid0 * 8);
                if (!Q8 && kid1 < NKC) rk1 = *(const u32x4*)(kt + kid1 * 8);
                if (!V8 || tid < 256) rv = *(const u32x4*)((const unsigned char*)Vb + (V8 ? 1 : 2) * ((size_t)vrow * S + (tt + 1) * 64) + vc * 16);
            }
            f32x16 s0, s1;
            if (!Q8) {
                const float nm = -m;
#pragma unroll
                for (int r = 0; r < 16; ++r) { s0[r] = nm; s1[r] = nm; }
            }
            if (Q8) {
                const u32x4 k00 = *(const u32x4*)(Kl + kro), k01 = *(const u32x4*)(Kl + kro + 16), k10 = *(const u32x4*)(Kl + 32 * 80 + kro), k11 = *(const u32x4*)(Kl + 32 * 80 + kro + 16);
                const i32x8 ka0 = {(int)k00.x, (int)k00.y, (int)k00.z, (int)k00.w, (int)k01.x, (int)k01.y, (int)k01.z, (int)k01.w};
                const i32x8 ka1 = {(int)k10.x, (int)k10.y, (int)k10.z, (int)k10.w, (int)k11.x, (int)k11.y, (int)k11.z, (int)k11.w};
                s0 = __builtin_amdgcn_mfma_scale_f32_32x32x64_f8f6f4(ka0, qn, negm, 0, 0, 0, 0x7f7f7f7f, 0, 0x7c7c7c7c);
                s1 = __builtin_amdgcn_mfma_scale_f32_32x32x64_f8f6f4(ka1, qn, negm, 0, 0, 0, 0x7f7f7f7f, 0, 0x7c7c7c7c);
#pragma unroll
                for (int ks = 0; ks < 2; ++ks) {
                    const bf16x8 kf0 = *(const bf16x8*)(Kl + krr + ks * 32);
                    const bf16x8 kf1 = *(const bf16x8*)(Kl + 32 * 80 + krr + ks * 32);
                    s0 = __builtin_amdgcn_mfma_f32_32x32x16_bf16(kf0, qf[ks], s0, 0, 0, 0);
                    s1 = __builtin_amdgcn_mfma_f32_32x32x16_bf16(kf1, qf[ks], s1, 0, 0, 0);
                }
            } else {
#pragma unroll
            for (int ks = 0; ks < NK; ++ks) {
                const bf16x8 kf0 = *(const bf16x8*)(Kl + kro + ks * 32);
                const bf16x8 kf1 = *(const bf16x8*)(Kl + 32 * KSTR + kro + ks * 32);
                s0 = __builtin_amdgcn_mfma_f32_32x32x16_bf16(kf0, qf[ks], s0, 0, 0, 0);
                s1 = __builtin_amdgcn_mfma_f32_32x32x16_bf16(kf1, qf[ks], s1, 0, 0, 0);
            }
            }
            if (SWA) {
                const int rel = tt - qb;
                if (rel == -2 || rel == 2) {
                    const int qi = (wave & 1) * 32 + r32;
#pragma unroll
                    for (int r = 0; r < 16; ++r) {
                        const int kk = kperm(crow(r, hi));
                        const bool v0 = (rel == -2) ? (kk >= qi) : (kk <= qi);
                        const bool v1 = (rel == -2) ? (kk + 32 >= qi) : (kk + 32 <= qi);
                        s0[r] = v0 ? s0[r] : -1e30f; s1[r] = v1 ? s1[r] : -1e30f;
                    }
                }
            }
            if ((!SWA) && (tt == tlo)) {
                float mx = fmaxf(s0[0], s1[0]);
#pragma unroll
                for (int r = 1; r < 16; ++r) mx = fmaxf(mx, fmaxf(s0[r], s1[r]));
                mx = fmaxf(mx, __shfl_xor(mx, 32));
                m = mx;
#pragma unroll
                for (int r = 0; r < 16; ++r) { s0[r] -= mx; s1[r] -= mx; negm[r] = -mx; }
            }
            float rs = 0.f;
#pragma unroll
            for (int r = 0; r < 16; ++r) { s0[r] = __builtin_amdgcn_exp2f(s0[r]); s1[r] = __builtin_amdgcn_exp2f(s1[r]); rs += s0[r] + s1[r]; }
            if (!__all(rs <= 1024.f)) {
                float mp = fmaxf(s0[0], s1[0]);
#pragma unroll
                for (int r = 1; r < 16; ++r) mp = fmaxf(mp, fmaxf(s0[r], s1[r]));
                mp = fmaxf(fmaxf(mp, __shfl_xor(mp, 32)), 1.f);
                const float alpha = 1.f / mp;
                m += __builtin_amdgcn_logf(mp);
                l *= alpha; rs *= alpha;
#pragma unroll
                for (int r = 0; r < 16; ++r) { o0[r] *= alpha; o1[r] *= alpha; s0[r] *= alpha; s1[r] *= alpha; negm[r] = -m; }
            }
            l += rs;
            if (V8) {
#pragma unroll
                for (int q = 0; q < 4; ++q) {
                    pb[q] = __builtin_amdgcn_cvt_pk_bf8_f32(s0[4 * q + 0], s0[4 * q + 1], pb[q], false); pb[q] = __builtin_amdgcn_cvt_pk_bf8_f32(s0[4 * q + 2], s0[4 * q + 3], pb[q], true);
                    pb[4 + q] = __builtin_amdgcn_cvt_pk_bf8_f32(s1[4 * q + 0], s1[4 * q + 1], pb[4 + q], false); pb[4 + q] = __builtin_amdgcn_cvt_pk_bf8_f32(s1[4 * q + 2], s1[4 * q + 3], pb[4 + q], true);
                }
                const u32x4 a00 = *(const u32x4*)(Vl + vro), a01 = *(const u32x4*)(Vl + vro + 16), a10 = *(const u32x4*)(Vl + 32 * VSTR + vro), a11 = *(const u32x4*)(Vl + 32 * VSTR + vro + 16);
                const i32x8 va0 = {(int)a00.x, (int)a00.y, (int)a00.z, (int)a00.w, (int)a01.x, (int)a01.y, (int)a01.z, (int)a01.w};
                const i32x8 va1 = {(int)a10.x, (int)a10.y, (int)a10.z, (int)a10.w, (int)a11.x, (int)a11.y, (int)a11.z, (int)a11.w};
                o0 = __builtin_amdgcn_mfma_scale_f32_32x32x64_f8f6f4(va0, pb, o0, 0, 1, 0, 0x7f7f7f7f, 0, 0x7f7f7f7f);
                o1 = __builtin_amdgcn_mfma_scale_f32_32x32x64_f8f6f4(va1, pb, o1, 0, 1, 0, 0x7f7f7f7f, 0, 0x7f7f7f7f);
            } else {
#pragma unroll
            for (int st = 0; st < 2; ++st) {
                u32x4 pw;
                pw.x = cvtpk(s0[8 * st + 0], s0[8 * st + 1]); pw.y = cvtpk(s0[8 * st + 2], s0[8 * st + 3]);
                pw.z = cvtpk(s0[8 * st + 4], s0[8 * st + 5]); pw.w = cvtpk(s0[8 * st + 6], s0[8 * st + 7]);
                const bf16x8 pf = __builtin_bit_cast(bf16x8, pw);
                const bf16x8 vf0 = *(const bf16x8*)(Vl + vro + st * 32);
                const bf16x8 vf1 = *(const bf16x8*)(Vl + 32 * VSTR + vro + st * 32);
                o0 = __builtin_amdgcn_mfma_f32_32x32x16_bf16(vf0, pf, o0, 0, 0, 0);
                o1 = __builtin_amdgcn_mfma_f32_32x32x16_bf16(vf1, pf, o1, 0, 0, 0);
            }
#pragma unroll
            for (int st = 0; st < 2; ++st) {
                u32x4 pw;
                pw.x = cvtpk(s1[8 * st + 0], s1[8 * st + 1]); pw.y = cvtpk(s1[8 * st + 2], s1[8 * st + 3]);
                pw.z = cvtpk(s1[8 * st + 4], s1[8 * st + 5]); pw.w = cvtpk(s1[8 * st + 6], s1[8 * st + 7]);
                const bf16x8 pf = __builtin_bit_cast(bf16x8, pw);
                const bf16x8 vf0 = *(const bf16x8*)(Vl + vro + 64 + st * 32);
                const bf16x8 vf1 = *(const bf16x8*)(Vl + 32 * VSTR + vro + 64 + st * 32);
                o0 = __builtin_amdgcn_mfma_f32_32x32x16_bf16(vf0, pf, o0, 0, 0, 0);
                o1 = __builtin_amdgcn_mfma_f32_32x32x16_bf16(vf1, pf, o1, 0, 0, 0);
            }
            }
            if (more) {
                if (Q8) *(u32x4*)(Kn + k8lds) = rk0;
                else { *(u32x4*)(Kn + k0row * KSTR + k0c * 16) = rk0; if (kid1 < NKC) *(u32x4*)(Kn + k1row * KSTR + k1c * 16) = rk1; }
                if (V8) { if (tid < 256) { unsigned long long* vd = (unsigned long long*)(Kn + KT_BYTES + vrow * VSTR + vc * 8); vd[0] = (unsigned long long)rv.x | ((unsigned long long)rv.y << 32); vd[4] = (unsigned long long)rv.z | ((unsigned long long)rv.w << 32); } }
                else *(u32x4*)(Kn + KT_BYTES + vrow * VSTR + vc * 16) = rv;
            }
            __syncthreads();
        }
        const float il = 1.f / (l + __shfl_xor(l, 32));
        {
            float ss = 0.f;
#pragma unroll
            for (int r = 0; r < 16; ++r) { const float a0 = o0[r] * il, a1 = o1[r] * il; ss += a0 * a0 + a1 * a1; }
            ss += __shfl_xor(ss, 32);
            if (hi == 0) ((float*)(p.ws + WS_SSQO))[(size_t)(b * S + sq) * 16 + (ocol >> 6)] = ss;
        }
        unsigned short* orow = O + (size_t)(b * S + sq) * D + ocol + 4 * hi;
#pragma unroll
        for (int g = 0; g < 4; ++g) {
            *(unsigned long long*)(orow + 8 * g) = (unsigned long long)cvtpk(o0[4 * g] * il, o0[4 * g + 1] * il) | ((unsigned long long)cvtpk(o0[4 * g + 2] * il, o0[4 * g + 3] * il) << 32);
            *(unsigned long long*)(orow + 32 + 8 * g) = (unsigned long long)cvtpk(o1[4 * g] * il, o1[4 * g + 1] * il) | ((unsigned long long)cvtpk(o1[4 * g + 2] * il, o1[4 * g + 3] * il) << 32);
        }
    }
}

__device__ __forceinline__ int kmax(int a, int b) { return __builtin_bit_cast(int, __builtin_fmaxf(__builtin_bit_cast(float, a), __builtin_bit_cast(float, b))); }
__device__ __forceinline__ int kmin(int a, int b) { return __builtin_bit_cast(int, __builtin_fminf(__builtin_bit_cast(float, a), __builtin_bit_cast(float, b))); }
__device__ __forceinline__ void ce_desc(int& a, int& b) { const int hi = kmax(a, b), lo = kmin(a, b); a = hi; b = lo; }
__device__ __forceinline__ void ce_asc(int& a, int& b) { const int hi = kmax(a, b), lo = kmin(a, b); a = lo; b = hi; }
template <int OFF> __device__ __forceinline__ void sort16_desc(int (&a)[32]) {
#define CE_(i_, j_) ce_desc(a[OFF + (i_)], a[OFF + (j_)]);
    CE_(0,13) CE_(1,12) CE_(2,15) CE_(3,14) CE_(4,8) CE_(5,6) CE_(7,11) CE_(9,10)
    CE_(0,5) CE_(1,7) CE_(2,9) CE_(3,4) CE_(6,13) CE_(8,14) CE_(10,15) CE_(11,12)
    CE_(0,1) CE_(2,3) CE_(4,5) CE_(6,8) CE_(7,9) CE_(10,11) CE_(12,13) CE_(14,15)
    CE_(0,2) CE_(1,3) CE_(4,10) CE_(5,11) CE_(6,7) CE_(8,9) CE_(12,14) CE_(13,15)
    CE_(1,2) CE_(3,12) CE_(4,6) CE_(5,7) CE_(8,10) CE_(9,11) CE_(13,14)
    CE_(1,4) CE_(2,6) CE_(5,8) CE_(7,10) CE_(9,13) CE_(11,14)
    CE_(2,4) CE_(3,6) CE_(9,12) CE_(11,13)
    CE_(3,5) CE_(6,8) CE_(7,9) CE_(10,12)
    CE_(3,4) CE_(5,6) CE_(7,8) CE_(9,10) CE_(11,12)
    CE_(6,7) CE_(8,9)
#undef CE_
}
template <int N, int OFF> __device__ __forceinline__ void bitonic_sort_desc(int (&a)[32]) {
#pragma unroll
    for (int k = 2; k <= N; k <<= 1)
#pragma unroll
        for (int j = k >> 1; j > 0; j >>= 1)
#pragma unroll
            for (int i = 0; i < N; ++i) {
                const int l = i ^ j;
                if (l > i) { if ((i & k) == 0) ce_desc(a[OFF + i], a[OFF + l]); else ce_asc(a[OFF + i], a[OFF + l]); }
            }
}
__device__ __forceinline__ void bitonic_clean16_desc(int (&a)[32]) {
#pragma unroll
    for (int j = 8; j > 0; j >>= 1)
#pragma unroll
        for (int i = 0; i < 16; ++i) { const int l = i ^ j; if (l > i) ce_desc(a[i], a[l]); }
}
__device__ __forceinline__ int f2sortable(float f) { return __builtin_bit_cast(int, f); }
__device__ __forceinline__ float sortable2f(int s) { return __builtin_bit_cast(float, s); }
constexpr int KEY_LOWEST = (int)0xff800000;
struct CandTab { int i[52], j[52]; };
constexpr CandTab make_cands() { CandTab t{}; int n = 0; for (int i = 0; i < 16; ++i) for (int j = 0; j < 16; ++j) if ((i + 1) * (j + 1) <= 16) { t.i[n] = i; t.j[n] = j; ++n; } for (; n < 52; ++n) { t.i[n] = -1; t.j[n] = -1; } return t; }
constexpr CandTab CANDS = make_cands();
struct EpiTopkSel {
    static constexpr bool HAS_MID = false, HAS_LATE = false;
    __device__ __forceinline__ void late(int, int, int) {}
    __device__ __forceinline__ void pre(int, int) {}
    template <class A> __device__ __forceinline__ void mid(A&) {}
    unsigned short* idx; float* g;
    int* keepg;
    __device__ __forceinline__ void operator()(const f32x4 (&acc)[8][2], int pb, int qb, int lane, const float*, int hp, int half) {
        const int fr = lane & 15, fq = lane >> 4;
#pragma unroll
        for (int j = 0; j < 2; ++j) {
            int v[32];
#pragma unroll
            for (int i = 0; i < 8; ++i)
#pragma unroll
                for (int r = 0; r < 4; ++r) v[i * 4 + r] = (f2sortable(acc[i][j][r]) & ~127) | (i * 16 + fq * 4 + r);
            sort16_desc<0>(v); sort16_desc<16>(v);
#pragma unroll
            for (int i = 0; i < 16; ++i) v[i] = kmax(v[i], v[31 - i]);
            bitonic_clean16_desc(v);
#pragma unroll
            for (int x = 16; x <= 32; x <<= 1) {
#pragma unroll
                for (int i = 0; i < 16; ++i) v[16 + i] = __shfl_xor(v[i], x);
#pragma unroll
                for (int i = 0; i < 16; ++i) v[i] = kmax(v[i], v[31 - i]);
                bitonic_clean16_desc(v);
            }
            u32x4* kp = (u32x4*)(keepg + ((qb & 255) + j * 16 + fr) * 16);
            if (half == 0) {
                if (fq == 0) {
#pragma unroll
                    for (int i = 0; i < 4; ++i) kp[i] = (u32x4){(unsigned)v[4 * i], (unsigned)v[4 * i + 1], (unsigned)v[4 * i + 2], (unsigned)v[4 * i + 3]};
                }
            } else {
                float as[16], bs[16]; int ai[16], bi[16];
#pragma unroll
                for (int i = 0; i < 4; ++i) {
                    const u32x4 kv = kp[i];
#pragma unroll
                    for (int c = 0; c < 4; ++c) { as[4 * i + c] = sortable2f((int)kv[c] & ~127); ai[4 * i + c] = ((int)kv[c] & 127) << 7; }
                }
#pragma unroll
                for (int i = 0; i < 16; ++i) { bs[i] = sortable2f(v[i] & ~127); bi[i] = v[i] & 127; }
                int w[32];
#pragma unroll
                for (int sl = 0; sl < 13; ++sl) {
                    int c4[4];
#pragma unroll
                    for (int f = 0; f < 4; ++f) {
                        constexpr int dummy = 0; (void)dummy;
                        const int ci = CANDS.i[sl * 4 + f], cj = CANDS.j[sl * 4 + f];
                        c4[f] = (ci >= 0) ? ((f2sortable(as[ci >= 0 ? ci : 0] + bs[cj >= 0 ? cj : 0]) & ~0x3fff) | (ai[ci >= 0 ? ci : 0] | bi[cj >= 0 ? cj : 0])) : KEY_LOWEST;
                    }
                    w[sl] = (fq == 0) ? c4[0] : (fq == 1) ? c4[1] : (fq == 2) ? c4[2] : c4[3];
                }
                w[13] = w[14] = w[15] = KEY_LOWEST;
                sort16_desc<0>(w);
#pragma unroll
                for (int x = 16; x <= 32; x <<= 1) {
#pragma unroll
                    for (int i = 0; i < 16; ++i) w[16 + i] = __shfl_xor(w[i], x);
#pragma unroll
                    for (int i = 0; i < 16; ++i) w[i] = kmax(w[i], w[31 - i]);
                    bitonic_clean16_desc(w);
                }
                int my[4];
#pragma unroll
                for (int c = 0; c < 4; ++c) my[c] = (fq == 0) ? w[c] : (fq == 1) ? w[4 + c] : (fq == 2) ? w[8 + c] : w[12 + c];
                const float top = sortable2f(w[0] & ~0x3fff);
                float e[4], part = 0.f;
#pragma unroll
                for (int c = 0; c < 4; ++c) { e[c] = __expf(sortable2f(my[c] & ~0x3fff) - top); part += e[c]; }
                part += __shfl_xor(part, 16); part += __shfl_xor(part, 32);
                const float inv = 1.f / part;
                const int t = qb + j * 16 + fr;
                const size_t o = (size_t)t * 128 + (hp >> 1) * 16 + fq * 4;
                *(unsigned long long*)(idx + o) = (unsigned long long)(unsigned)((my[0] & 0x3fff) | ((my[1] & 0x3fff) << 16)) | ((unsigned long long)(unsigned)((my[2] & 0x3fff) | ((my[3] & 0x3fff) << 16)) << 32);
                *(f32x4*)(g + o) = (f32x4){e[0] * inv, e[1] * inv, e[2] * inv, e[3] * inv};
            }
        }
    }
};
__device__ void gemm_pq_fused(const Params& p, unsigned char* lds) {
    const unsigned short* X = (const unsigned short*)(p.ws + WS_WPQ);
    const unsigned short* Y = (const unsigned short*)(p.ws + WS_HB);
    const unsigned short* SK = (const unsigned short*)(p.ws + WS_SUBK);
    const float* ssq1 = (const float*)(p.ws + WS_SSQ1); const float* bias = (const float*)(p.ws + WS_BPQ);
    EpiTopkSel tsel{(unsigned short*)(p.ws + WS_IDX), (float*)(p.ws + WS_G), (int*)(p.ws + WS_KEEP) + (size_t)blockIdx.x * 4096};
    const int tid = threadIdx.x, lane = tid & 63, wave = __builtin_amdgcn_readfirstlane(tid >> 6);
    const int wp = wave >> 2, wq = wave & 3, fr = lane & 15, fq = lane >> 4;
    const int G = gridDim.x, bx = blockIdx.x;
    const int vcu = (G % 8 == 0) ? (bx % 8) * (G / 8) + bx / 8 : bx;
    const int srow = wave * 8 + (lane >> 3), pc = lane & 7, lc = pc ^ ((srow >> 1) & 7);
    constexpr int nk = D / TBK, nunits = 8 * (T / TQ);
    for (int u = vcu; u < nunits; u += G) {
        const int qt = u >> 3, h = u & 7, q0 = qt * TQ;
#pragma unroll
        for (int sub = 0; sub < 2; ++sub) {
            const int hp = h * 2 + sub, p0 = hp * TP;
            f32x4 acc[4][4];
#pragma unroll
            for (int i = 0; i < 4; ++i)
#pragma unroll
                for (int j = 0; j < 4; ++j) acc[i][j] = (f32x4){0.f, 0.f, 0.f, 0.f};
            const unsigned short* xg = X + (size_t)(p0 + srow) * D + lc * 8;
            const unsigned short* yg = Y + (size_t)(q0 + srow) * D + lc * 8;
            asm volatile("s_waitcnt vmcnt(0)" ::: "memory");
            RAW_BARRIER();
#define PQ_DMA_TILE(kt_, stg_) do { \
                unsigned char* _b = lds + (stg_) * STG_BYTES + wave * 1024; const int _k = (kt_) * TBK; \
                _Pragma("unroll") for (int _i = 0; _i < 2; ++_i) __builtin_amdgcn_global_load_lds((const unsigned*)(xg + (size_t)(64 * _i) * D + _k), (unsigned*)(_b + _i * 8192), 16, 0, 0); \
                _Pragma("unroll") for (int _i = 0; _i < 4; ++_i) __builtin_amdgcn_global_load_lds((const unsigned*)(yg + (size_t)(64 * _i) * D + _k), (unsigned*)(_b + XS_BYTES + _i * 8192), 16, 0, 0); \
            } while (0)
            PQ_DMA_TILE(0, 0);
            PQ_DMA_TILE(1, 1);
            int cur = 0;
            for (int kt = 0; kt < nk; ++kt) {
                if (kt + 1 < nk) asm volatile("s_waitcnt vmcnt(6)" ::: "memory"); else asm volatile("s_waitcnt vmcnt(0)" ::: "memory");
                RAW_BARRIER();
                if (kt + 2 < nk) { const int nxt = (cur == 0) ? 2 : cur - 1; PQ_DMA_TILE(kt + 2, nxt); }
                const unsigned char* st = lds + cur * STG_BYTES;
#pragma unroll
                for (int kk = 0; kk < 2; ++kk) {
                    bf16x8 af[4], bfr[4];
#pragma unroll
                    for (int i = 0; i < 4; ++i) af[i] = *(const bf16x8*)(st + swz(wp * 64 + i * 16 + fr, kk * 4 + fq));
#pragma unroll
                    for (int j = 0; j < 4; ++j) bfr[j] = *(const bf16x8*)(st + XS_BYTES + swz(wq * 64 + j * 16 + fr, kk * 4 + fq));
#pragma unroll
                    for (int i = 0; i < 4; ++i)
#pragma unroll
                        for (int j = 0; j < 4; ++j) acc[i][j] = __builtin_amdgcn_mfma_f32_16x16x32_bf16(af[i], bfr[j], acc[i][j], 0, 0, 0);
                }
                cur = (cur == 2) ? 0 : cur + 1;
            }
#undef PQ_DMA_TILE
            RAW_BARRIER();
            {
                float r1[4]; f32x4 bv[4];
#pragma unroll
                for (int j = 0; j < 4; ++j) {
                    const f32x4* s4 = (const f32x4*)(ssq1 + (size_t)(q0 + wq * 64 + j * 16 + fr) * 16);
                    const f32x4 a0 = s4[0], a1 = s4[1], a2 = s4[2], a3 = s4[3];
                    r1[j] = rsqrtf((((a0.x + a0.y + a0.z + a0.w) + (a1.x + a1.y + a1.z + a1.w)) + ((a2.x + a2.y + a2.z + a2.w) + (a3.x + a3.y + a3.z + a3.w))) * (1.f / D) + EPS);
                }
                {
                    const float* bt = bias + (q0 >> 12) * 2048 + p0 + wp * 64 + fq * 4;
#pragma unroll
                    for (int i = 0; i < 4; ++i) bv[i] = *(const f32x4*)(bt + i * 16);
                }
                const unsigned short* kg = SK + (size_t)hp * 128 * 128 + (size_t)srow * 128 + lc * 8;
#pragma unroll
                for (int s2 = 0; s2 < 2; ++s2)
#pragma unroll
                    for (int i = 0; i < 2; ++i) __builtin_amdgcn_global_load_lds((const unsigned*)(kg + (size_t)(64 * i) * 128 + s2 * 64), (unsigned*)(lds + s2 * STG_BYTES + wave * 1024 + i * 8192), 16, 0, 0);
                unsigned char* yb = lds + wp * STG_BYTES + XS_BYTES + (fq & 1) * 8;
#pragma unroll
                for (int j = 0; j < 4; ++j)
#pragma unroll
                    for (int i = 0; i < 4; ++i)
                        *(unsigned long long*)(yb + swz(wq * 64 + j * 16 + fr, 2 * i + (fq >> 1))) =
                            pk4(acc[i][j].x * r1[j] + bv[i].x, acc[i][j].y * r1[j] + bv[i].y, acc[i][j].z * r1[j] + bv[i].z, acc[i][j].w * r1[j] + bv[i].w);
            }
            asm volatile("s_waitcnt vmcnt(0)" ::: "memory");
            RAW_BARRIER();
            f32x4 sc2[8][2];
#pragma unroll
            for (int i = 0; i < 8; ++i)
#pragma unroll
                for (int j = 0; j < 2; ++j) sc2[i][j] = (f32x4){0.f, 0.f, 0.f, 0.f};
#pragma unroll
            for (int s2 = 0; s2 < 2; ++s2) {
                const unsigned char* st = lds + s2 * STG_BYTES;
#pragma unroll
                for (int kk = 0; kk < 2; ++kk) {
                    bf16x8 af[8], bfr[2];
#pragma unroll
                    for (int i = 0; i < 8; ++i) af[i] = *(const bf16x8*)(st + swz(i * 16 + fr, kk * 4 + fq));
#pragma unroll
                    for (int j = 0; j < 2; ++j) bfr[j] = *(const bf16x8*)(st + XS_BYTES + swz(wave * 32 + j * 16 + fr, kk * 4 + fq));
#pragma unroll
                    for (int i = 0; i < 8; ++i)
#pragma unroll
                        for (int j = 0; j < 2; ++j) sc2[i][j] = __builtin_amdgcn_mfma_f32_16x16x32_bf16(af[i], bfr[j], sc2[i][j], 0, 0, 0);
                }
            }
            tsel(sc2, 0, q0 + wave * 32, lane, (const float*)nullptr, hp, sub);
        }
    }
}

__device__ __forceinline__ int rd_lane_i(int v, int l) { return __builtin_amdgcn_readlane(v, l); }
__device__ __forceinline__ float rd_lane_f(float v, int l) { return __builtin_bit_cast(float, __builtin_amdgcn_readlane(__builtin_bit_cast(int, v), l)); }
__device__ void stage_peer_u(const Params& p) {
    const unsigned short* h2 = (const unsigned short*)(p.ws + WS_HB);
    const float* mod = (const float*)(p.ws + WS_MOD);
    const unsigned short* idx = (const unsigned short*)(p.ws + WS_IDX); float* g = (float*)(p.ws + WS_G);
    const unsigned char* eu8 = p.ws + WS_EU8;
    const float* us = (const float*)(p.ws + WS_US);
    const int tid_ = tid_opaque(); const int lane = tid_ & 63, wave = tid_ >> 6;
    for (int t = blockIdx.x * NWAVES + wave; t < T; t += gridDim.x * NWAVES) {
        const int b = t >> 12;
        f32x2 hq[8];
        {
            const float rstd1 = rsqrtf(group16_sum(((const float*)(p.ws + WS_SSQ1))[(size_t)t * 16 + (lane & 15)]) * (1.f / D) + EPS);
            const float* shf = mod + b * NMOD + 3 * D + lane * 16;
            const u32x4 w0 = *(const u32x4*)(h2 + (size_t)t * D + lane * 16), w1 = *(const u32x4*)(h2 + (size_t)t * D + lane * 16 + 8);
            const f32x4 s0 = *(const f32x4*)(shf), s1 = *(const f32x4*)(shf + 4), s2 = *(const f32x4*)(shf + 8), s3 = *(const f32x4*)(shf + 12);
            hq[0] = (f32x2){bflo(w0.x) * rstd1 + s0.x, bfhi(w0.x) * rstd1 + s0.y}; hq[1] = (f32x2){bflo(w0.y) * rstd1 + s0.z, bfhi(w0.y) * rstd1 + s0.w};
            hq[2] = (f32x2){bflo(w0.z) * rstd1 + s1.x, bfhi(w0.z) * rstd1 + s1.y}; hq[3] = (f32x2){bflo(w0.w) * rstd1 + s1.z, bfhi(w0.w) * rstd1 + s1.w};
            hq[4] = (f32x2){bflo(w1.x) * rstd1 + s2.x, bfhi(w1.x) * rstd1 + s2.y}; hq[5] = (f32x2){bflo(w1.y) * rstd1 + s2.z, bfhi(w1.y) * rstd1 + s2.w};
            hq[6] = (f32x2){bflo(w1.z) * rstd1 + s3.x, bfhi(w1.z) * rstd1 + s3.y}; hq[7] = (f32x2){bflo(w1.w) * rstd1 + s3.z, bfhi(w1.w) * rstd1 + s3.w};
        }
        const int idv0 = idx[(size_t)t * 128 + lane], idv1 = idx[(size_t)t * 128 + 64 + lane];
        float wv0 = 0.f, wv1 = 0.f;
        u32x4 cur[8], nxt[8];
#pragma unroll
        for (int i = 0; i < 8; ++i) cur[i] = *(const u32x4*)(eu8 + (size_t)rd_lane_i(idv0, i) * D + lane * 16);
#pragma unroll 2
        for (int b8 = 0; b8 < 16; ++b8) {
            const int bn = (b8 + 1 < 16) ? b8 + 1 : b8;
#pragma unroll
            for (int i = 0; i < 8; ++i) { const int r = bn * 8 + i; nxt[i] = *(const u32x4*)(eu8 + (size_t)rd_lane_i((bn < 8) ? idv0 : idv1, r & 63) * D + lane * 16); }
            float pr[8];
#pragma unroll
            for (int i = 0; i < 8; ++i) {
                f32x2 a = {0.f, 0.f}, c2 = {0.f, 0.f};
#pragma unroll
                for (int c = 0; c < 4; ++c) {
                    const f32x2 lo = __builtin_amdgcn_cvt_pk_f32_fp8((int)cur[i][c], false), hi = __builtin_amdgcn_cvt_pk_f32_fp8((int)cur[i][c], true);
                    a += lo * hq[2 * c]; c2 += hi * hq[2 * c + 1];
                }
                a += c2; pr[i] = a.x + a.y;
            }
            float x4[4], x2[2], x1;
            const bool b5 = (lane & 32) != 0, b4 = (lane & 16) != 0, b3 = (lane & 8) != 0;
#pragma unroll
            for (int i = 0; i < 4; ++i) { const float keep = b5 ? pr[i + 4] : pr[i], give = b5 ? pr[i] : pr[i + 4]; x4[i] = keep + __shfl_xor(give, 32); }
#pragma unroll
            for (int i = 0; i < 2; ++i) { const float keep = b4 ? x4[i + 2] : x4[i], give = b4 ? x4[i] : x4[i + 2]; x2[i] = keep + __shfl_xor(give, 16); }
            { const float keep = b3 ? x2[1] : x2[0], give = b3 ? x2[0] : x2[1]; x1 = keep + __shfl_xor(give, 8); }
            x1 += __shfl_xor(x1, 4); x1 += __shfl_xor(x1, 2); x1 += __shfl_xor(x1, 1);
            const float st = __shfl(x1, (lane & 7) * 8);
            const bool mine = (lane >> 3) == (b8 & 7);
            if (b8 < 8) wv0 = mine ? st : wv0; else wv1 = mine ? st : wv1;
#pragma unroll
            for (int i = 0; i < 8; ++i) cur[i] = nxt[i];
        }
        {
            const float s0 = wv0 * us[idv0], s1 = wv1 * us[idv1];
            const float gv0 = g[(size_t)t * 128 + lane], gv1 = g[(size_t)t * 128 + 64 + lane];
            wv0 = gv0 * (0.5f * s0 * (1.f + erff(s0 * 0.70710678118654752f)));
            wv1 = gv1 * (0.5f * s1 * (1.f + erff(s1 * 0.70710678118654752f)));
        }
        { float* wdst = (float*)(p.ws + WS_W); wdst[(size_t)t * 128 + lane] = wv0; wdst[(size_t)t * 128 + 64 + lane] = wv1; }
    }
}
__device__ void stage_peer_v(const Params& p, float* outp) {
    const float* mod = (const float*)(p.ws + WS_MOD);
    const unsigned short* idx = (const unsigned short*)(p.ws + WS_IDX); const float* g = (const float*)(p.ws + WS_W);
    const unsigned char* ev8 = p.ws + WS_EV8;
    const float* vs = (const float*)(p.ws + WS_VS);
    const int tid_ = tid_opaque(); const int lane = tid_ & 63, wave = tid_ >> 6;
    for (int t = blockIdx.x * NWAVES + wave; t < T; t += gridDim.x * NWAVES) {
        const int b = t >> 12;
        const int idv0 = idx[(size_t)t * 128 + lane], idv1 = idx[(size_t)t * 128 + 64 + lane];
        const float wv0 = g[(size_t)t * 128 + lane] * vs[idv0], wv1 = g[(size_t)t * 128 + 64 + lane] * vs[idv1];
        f32x2 acc[8];
#pragma unroll
        for (int i = 0; i < 8; ++i) acc[i] = (f32x2){0.f, 0.f};
        u32x4 cur[8], nxt[8];
#pragma unroll
        for (int i = 0; i < 8; ++i) cur[i] = *(const u32x4*)(ev8 + (size_t)rd_lane_i(idv0, i) * D + lane * 16);
#pragma unroll 2
        for (int b8 = 0; b8 < 16; ++b8) {
            const int bn = (b8 + 1 < 16) ? b8 + 1 : b8;
#pragma unroll
            for (int i = 0; i < 8; ++i) { const int r = bn * 8 + i; nxt[i] = *(const u32x4*)(ev8 + (size_t)rd_lane_i((bn < 8) ? idv0 : idv1, r & 63) * D + lane * 16); }
#pragma unroll
            for (int i = 0; i < 8; ++i) {
                const int r = b8 * 8 + i;
                const float wr = rd_lane_f((b8 < 8) ? wv0 : wv1, r & 63);
                const f32x2 w2 = {wr, wr};
#pragma unroll
                for (int c = 0; c < 4; ++c) {
                    const f32x2 lo = __builtin_amdgcn_cvt_pk_f32_fp8((int)cur[i][c], false), hi = __builtin_amdgcn_cvt_pk_f32_fp8((int)cur[i][c], true);
                    acc[2 * c] += w2 * lo; acc[2 * c + 1] += w2 * hi;
                }
            }
#pragma unroll
            for (int i = 0; i < 8; ++i) cur[i] = nxt[i];
        }
        const int eoff = lane * 16;
        const float* xin = p.out + (size_t)t * D + eoff;
        float* xr = outp + (size_t)t * D + eoff;
        const float* gf = mod + b * NMOD + 5 * D + eoff;
        float sel[16];
        float ss = 0.f;
#pragma unroll
        for (int c = 0; c < 4; ++c) {
            const f32x4 x1 = *(const f32x4*)(xin + c * 4); const f32x4 gg = *(const f32x4*)(gf + c * 4);
            sel[c * 4 + 0] = x1.x + gg.x * acc[2 * c].x; sel[c * 4 + 1] = x1.y + gg.y * acc[2 * c].y;
            sel[c * 4 + 2] = x1.z + gg.z * acc[2 * c + 1].x; sel[c * 4 + 3] = x1.w + gg.w * acc[2 * c + 1].y;
            ss += sel[c * 4 + 0] * sel[c * 4 + 0] + sel[c * 4 + 1] * sel[c * 4 + 1] + sel[c * 4 + 2] * sel[c * 4 + 2] + sel[c * 4 + 3] * sel[c * 4 + 3];
        }
        const float rstd = rsqrtf(wave_sum(ss) * (1.f / D) + EPS);
#pragma unroll
        for (int c = 0; c < 4; ++c) {
            const f32x4 fn = *(const f32x4*)(p.fnorm + eoff + c * 4);
            f32x4 r; r.x = sel[c * 4 + 0] * rstd * fn.x; r.y = sel[c * 4 + 1] * rstd * fn.y; r.z = sel[c * 4 + 2] * rstd * fn.z; r.w = sel[c * 4 + 3] * rstd * fn.w;
            *(f32x4*)(xr + c * 4) = r;
        }
    }
}

#define LAS __attribute__((address_space(3)))
constexpr size_t WS_BAR = 3 * MiB;
constexpr int BAR_BYTES = 16384;
constexpr int LDS_MISC_OFF = 147456;
#define XB_TMO      128
#define XB_XCNT(j)  (256  + 64 * (j))
#define XB_XSUB(j)  (1280 + 64 * (j))
#define XB_XGEN(j)  (2304 + 64 * (j))
#define XB_TOP      3328
#define XB_TOPGEN   3392
#define XB_SPIN_CAP (1u << 18)
__device__ __forceinline__ unsigned xb_ld(unsigned* p)              { return __hip_atomic_load(p, __ATOMIC_RELAXED, __HIP_MEMORY_SCOPE_AGENT); }
__device__ __forceinline__ unsigned xb_add(unsigned* p, unsigned v) { return __hip_atomic_fetch_add(p, v, __ATOMIC_RELAXED, __HIP_MEMORY_SCOPE_AGENT); }
__device__ __forceinline__ unsigned xb_xcc_id() { return (unsigned)__builtin_amdgcn_s_getreg((3 << 11) | 20) & 0xFu; }
#define XB_SPIN(cond, bar) do { unsigned _sp = 0; while (cond) { __builtin_amdgcn_s_sleep(1); \
    if ((++_sp & 255u) == 0u) { if (xb_ld(&(bar)[XB_TMO])) break; if (_sp > XB_SPIN_CAP) { atomicAdd(&(bar)[XB_TMO], 1u); break; } } } } while (0)
struct XcdBarrier { unsigned* bar; unsigned x; volatile LAS unsigned* st; };
__device__ __forceinline__ XcdBarrier xcd_barrier_post(unsigned* bar, volatile LAS unsigned* st) {
    XcdBarrier b; b.bar = bar; b.x = xb_xcc_id(); b.st = st;
    if (threadIdx.x == 0) (void)xb_add(&bar[XB_XCNT(b.x)], 1u);
    return b;
}
__device__ __forceinline__ void xcd_barrier_complete(unsigned* bar, unsigned x, unsigned& nloc, unsigned& nx) {
    const unsigned G = gridDim.x * gridDim.y * gridDim.z;
    unsigned sum, cnt, mine, sp = 0u;
    for (;;) {
        sum = 0u; cnt = 0u; mine = 0u;
#pragma unroll
        for (unsigned j = 0; j < 16; ++j) { const unsigned c = xb_ld(&bar[XB_XCNT(j)]); sum += c; cnt += (c > 0u) ? 1u : 0u; mine = (j == x) ? c : mine; }
        if (sum == G) break;
        __builtin_amdgcn_s_sleep(1);
        if ((++sp & 255u) == 0u) { if (xb_ld(&bar[XB_TMO])) break; if (sp > XB_SPIN_CAP) { atomicAdd(&bar[XB_TMO], 1u); break; } }
    }
    nloc = mine > 0u ? mine : 1u; nx = cnt > 0u ? cnt : 1u;
}
__device__ __forceinline__ void xcd_barrier(const XcdBarrier& b) {
    asm volatile("s_waitcnt vmcnt(0)" ::: "memory");
    __syncthreads();
    if (threadIdx.x == 0) {
        unsigned* bar = b.bar;
        __builtin_amdgcn_s_waitcnt(0);
        unsigned nloc = b.st[0], nx = b.st[1];
        if (nloc == 0u) { xcd_barrier_complete(bar, b.x, nloc, nx); b.st[0] = nloc; b.st[1] = nx; }
        const unsigned old = xb_add(&bar[XB_XSUB(b.x)], 1u);
        const unsigned gen = old / nloc;
        if (old + 1u == (gen + 1u) * nloc) {
            __builtin_amdgcn_fence(__ATOMIC_RELEASE, "agent");
            asm volatile("s_waitcnt vmcnt(0)" ::: "memory");
            const unsigned og = xb_add(&bar[XB_TOP], 1u);
            const unsigned tg = og / nx;
            if (og + 1u == (tg + 1u) * nx) xb_add(&bar[XB_TOPGEN], 1u);
            else XB_SPIN(xb_ld(&bar[XB_TOPGEN]) == tg, bar);
            __builtin_amdgcn_fence(__ATOMIC_ACQUIRE, "agent");
            xb_add(&bar[XB_XGEN(b.x)], 1u);
            asm volatile("s_waitcnt vmcnt(0)" ::: "memory");
        } else {
            XB_SPIN(xb_ld(&bar[XB_XGEN(b.x)]) == gen, bar);
            __builtin_amdgcn_fence(__ATOMIC_ACQUIRE, "agent");
            asm volatile("s_waitcnt vmcnt(0)" ::: "memory");
        }
    }
    __syncthreads();
}

__global__ void __launch_bounds__(NTHREADS) fwd_megakernel(Params p) {
    extern __shared__ __attribute__((aligned(16))) unsigned char lds_raw[];
    cg::grid_group grid = cg::this_grid();
    unsigned short* hb = (unsigned short*)(p.ws + WS_HB);
    const float* mod = (const float*)(p.ws + WS_MOD);
    typedef const unsigned short* cbf;

    volatile LAS unsigned* bst = (volatile LAS unsigned*)((LAS unsigned char*)lds_raw + LDS_MISC_OFF);
    if (threadIdx.x < 2) bst[threadIdx.x] = 0u;
    __syncthreads();
    const XcdBarrier xbar = xcd_barrier_post((unsigned*)(p.ws + WS_BAR), bst);
    stage_prologue(p, (float*)lds_raw);
    if (p.ws == nullptr) grid.sync();
    xcd_barrier(xbar);
    stage_norm_mod<true>(p, p.x, hb, 0 * D, 1 * D);
    stage_gemv8(mod + 3 * D, NMOD, false, p.w_pq, 2048, nullptr, (float*)(p.ws + WS_BPQ), (float*)lds_raw);
    xcd_barrier(xbar);
    gemm_dma<2, 1>((cbf)(p.ws + WS_WIN), D, hb, D, 1280, T, D, 1, 0, 0, lds_raw, EpiProj{p.ws});
    xcd_barrier(xbar);
    gemm_xyT<2, true>((cbf)(p.ws + WS_WQUP), 256, (cbf)(p.ws + WS_QL), 256, 768, T, 256, 1, 0, 0, lds_raw, EpiQup{p.ws});
    gemm_xyT<2, true>((cbf)(p.ws + WS_WKVUP), 128, (cbf)(p.ws + WS_KVL), 128, 1024, T, 128, 1, 0, 0, lds_raw, EpiKVup{p.ws});
    xcd_barrier(xbar);
    stage_attn_flash<64, true>(p, lds_raw);
    stage_attn_flash<96, false>(p, lds_raw);
    xcd_barrier(xbar);
    gemm_dma<2, 1>((cbf)(p.ws + WS_WOUT), D, (cbf)(p.ws + WS_OAB), D, D, T, D, 1, 0, 0, lds_raw,
                   EpiOutProj{p.x, mod, p.out, hb, (const float*)(p.ws + WS_SSQO), (float*)(p.ws + WS_SSQ1), {}, {}, {}});
    xcd_barrier(xbar);
    gemm_pq_fused(p, lds_raw);
    xcd_barrier(xbar);
    stage_peer_u(p);
    xcd_barrier(xbar);
    stage_peer_v(p, p.out);
}

extern "C" void kernel_launch(void* const* d_in, const int* in_sizes, int n_in, void* d_out, int out_size, void* d_ws, size_t ws_size, hipStream_t stream) {
    static int grid_blocks = 0;
    if (grid_blocks == 0) {
        if (n_in != 18 || in_sizes[0] != T * D || out_size != T * D || ws_size < WS_END) {
            fprintf(stderr, "kernel_launch: unexpected shapes (n_in %d, in0 %d, out %d, ws %zu); nothing launched\n", n_in, n_in > 0 ? in_sizes[0] : -1, out_size, ws_size);
            grid_blocks = -1; return;
        }
        int dev = 0, cus = 0, per_cu = 0;
        (void)hipGetDevice(&dev);
        (void)hipDeviceGetAttribute(&cus, hipDeviceAttributeMultiprocessorCount, dev);
        if (hipFuncSetAttribute((const void*)fwd_megakernel, hipFuncAttributeMaxDynamicSharedMemorySize, LDS_BYTES) != hipSuccess) { fprintf(stderr, "kernel_launch: hipFuncSetAttribute failed\n"); grid_blocks = -1; return; }
        (void)hipOccupancyMaxActiveBlocksPerMultiprocessor(&per_cu, fwd_megakernel, NTHREADS, LDS_BYTES);
        if (per_cu < 1) { fprintf(stderr, "kernel_launch: occupancy query says %d blocks/CU\n", per_cu); grid_blocks = -1; return; }
        grid_blocks = cus < 256 ? cus : 256;
    }
    if (grid_blocks < 0) return;
    Params p{};
    p.x = (const float*)d_in[0]; p.c = (const float*)d_in[1]; p.w_ada = (const float*)d_in[2]; p.b_ada = (const float*)d_in[3];
    p.w_in = (const float*)d_in[4]; p.sink = (const float*)d_in[5]; p.qnorm = (const float*)d_in[6]; p.w_qup = (const float*)d_in[7];
    p.kvnorm = (const float*)d_in[8]; p.w_kvup = (const float*)d_in[9]; p.onorm_a = (const float*)d_in[10]; p.onorm_b = (const float*)d_in[11];
    p.w_out = (const float*)d_in[12]; p.w_pq = (const float*)d_in[13]; p.subk = (const float*)d_in[14]; p.eu = (const float*)d_in[15];
    p.ev = (const float*)d_in[16]; p.fnorm = (const float*)d_in[17];
    p.out = (float*)d_out; p.ws = (unsigned char*)d_ws;
    if (hipMemsetAsync((char*)d_ws + WS_BAR, 0, BAR_BYTES, stream) != hipSuccess) { fprintf(stderr, "kernel_launch: hipMemsetAsync failed\n"); return; }
    void* args[] = {&p};
    hipError_t e = hipLaunchCooperativeKernel((void*)fwd_megakernel, dim3(grid_blocks), dim3(NTHREADS), args, LDS_BYTES, stream);
    if (e != hipSuccess) fprintf(stderr, "cooperative launch failed: %s (grid %d)\n", hipGetErrorString(e), grid_blocks);
}
```

```cpp
#include <hip/hip_runtime.h>
#include <hip/hip_cooperative_groups.h>
#include <cstdio>
#include <cstdint>
namespace cg = cooperative_groups;

constexpr int Bsz = 8, S = 4096, D = 1024, T = Bsz * S;
constexpr int INW = 1184;
constexpr int C_QA = 0, C_KA = 512, C_VA = 640, C_QL = 768, C_KVL = 1024, C_KR = 1152;
constexpr int NMOD = 6 * D;
constexpr float EPS = 1e-6f;
constexpr float LOG2E = 1.4426950408889634f;
constexpr float QA_SCALE = 0.125f * LOG2E;
constexpr float QM_SCALE = 0.10206207261596575f * LOG2E;
constexpr int NTHREADS = 512, NWAVES = 8;

constexpr size_t MiB = 1u << 20;
constexpr size_t WS_MOD = 0;
constexpr size_t WS_COSA = 1 * MiB;
constexpr size_t WS_SINA = WS_COSA + 512 * 1024;
constexpr size_t WS_COSB = 2 * MiB;
constexpr size_t WS_SINB = WS_COSB + 256 * 1024;
constexpr size_t WS_WIN = 4 * MiB;
constexpr size_t WS_WQUP = 7 * MiB;
constexpr size_t WS_WKVUP = 7 * MiB + 512 * 1024;
constexpr size_t WS_WOUT = 8 * MiB;
constexpr size_t WS_WPQ = 10 * MiB;
constexpr size_t WS_SUBK = 14 * MiB;
constexpr size_t WS_EU8 = 16 * MiB;
constexpr size_t WS_EV8 = 32 * MiB;
constexpr size_t WS_US = 48 * MiB;
constexpr size_t WS_VS = WS_US + 64 * 1024;
constexpr size_t WS_HB = 52 * MiB;
constexpr size_t WS_QA = 116 * MiB;
constexpr size_t WS_KA = 148 * MiB;
constexpr size_t WS_VAT = 156 * MiB;
constexpr size_t WS_QL = 164 * MiB;
constexpr size_t WS_KVL = 180 * MiB;
constexpr size_t WS_QMB = 192 * MiB;
constexpr size_t WS_K96 = 240 * MiB;
constexpr size_t WS_VT = 288 * MiB;
constexpr size_t WS_OAB = 320 * MiB;
constexpr size_t WS_PQ = 116 * MiB;
constexpr size_t WS_TOPS = 244 * MiB;
constexpr size_t WS_TOPI = 276 * MiB;
constexpr size_t WS_IDX = 284 * MiB;
constexpr size_t WS_G = 292 * MiB;
constexpr size_t WS_SSQO = 49 * MiB;
constexpr size_t WS_SSQ1 = 384 * MiB;
constexpr size_t WS_BPQ = 3 * MiB + 64 * 1024;
constexpr size_t WS_KEEP = 386 * MiB;
constexpr size_t WS_W = 390 * MiB;
constexpr size_t WS_END = 408 * MiB;
constexpr int LDS_BYTES = 148480;
constexpr int NEXP = 16384;

struct Params {
    const float *x, *c, *w_ada, *b_ada, *w_in, *sink, *qnorm, *w_qup, *kvnorm, *w_kvup, *onorm_a, *onorm_b, *w_out, *w_pq, *subk, *eu, *ev, *fnorm;
    float* out;
    unsigned char* ws;
};

typedef short bf16x8 __attribute__((ext_vector_type(8)));
typedef float f32x4 __attribute__((ext_vector_type(4)));
typedef unsigned u32x4 __attribute__((ext_vector_type(4)));
typedef float f32x2 __attribute__((ext_vector_type(2)));
typedef int i32x8 __attribute__((ext_vector_type(8)));

__device__ __forceinline__ int tid_opaque() { int t = threadIdx.x; asm volatile("" : "+v"(t)); return t; }
__device__ __forceinline__ unsigned f2bf(float f) { unsigned u = __builtin_bit_cast(unsigned, f); return (u + 0x7fffu + ((u >> 16) & 1u)) >> 16; }
__device__ __forceinline__ unsigned pk2(float lo, float hi) { return f2bf(lo) | (f2bf(hi) << 16); }
__device__ __forceinline__ float bf2f(unsigned short h) { return __builtin_bit_cast(float, (unsigned)h << 16); }
__device__ __forceinline__ float bflo(unsigned w) { return __builtin_bit_cast(float, w << 16); }
__device__ __forceinline__ float bfhi(unsigned w) { return __builtin_bit_cast(float, w & 0xffff0000u); }
__device__ __forceinline__ float wave_sum(float v) {
#pragma unroll
    for (int o = 1; o < 64; o <<= 1) v += __shfl_xor(v, o);
    return v;
}

__device__ __forceinline__ float wave_max(float v) {
#pragma unroll
    for (int o = 1; o < 64; o <<= 1) v = fmaxf(v, __shfl_xor(v, o));
    return v;
}
template <int CTRL> __device__ __forceinline__ float dpp_add(float s) {
    return s + __builtin_bit_cast(float, __builtin_amdgcn_update_dpp(0, __builtin_bit_cast(int, s), CTRL, 0xF, 0xF, true));
}
__device__ __forceinline__ float group16_sum(float s) { s = dpp_add<0xB1>(s); s = dpp_add<0x4E>(s); s = dpp_add<0x141>(s); s = dpp_add<0x140>(s); return s; }

__device__ void stage_gemv8(const float* vec, int vstride, bool silu, const float* W, int N, const float* bias, float* dst, float* lds) {
    const int tid = threadIdx.x;
    __syncthreads();
    for (int i = tid; i < Bsz * D; i += NTHREADS) { const int b = i >> 10, k = i & 1023; float v = vec[b * vstride + k]; lds[i] = silu ? v / (1.f + __expf(-v)) : v; }
    __syncthreads();
    float* red = lds + Bsz * D;
    const int col_l = tid & 15, slice = tid >> 4;
    for (int item = blockIdx.x; item < N / 16; item += gridDim.x) {
        const int n = item * 16 + col_l;
        float acc[Bsz];
#pragma unroll
        for (int b = 0; b < Bsz; ++b) acc[b] = 0.f;
#pragma unroll 8
        for (int kk = 0; kk < 32; ++kk) {
            const int k = slice * 32 + kk;
            const float w = W[(size_t)k * N + n];
#pragma unroll
            for (int b = 0; b < Bsz; ++b) acc[b] += lds[b * D + k] * w;
        }
#pragma unroll
        for (int b = 0; b < Bsz; ++b) red[(slice * 16 + col_l) * Bsz + b] = acc[b];
        __syncthreads();
        if (tid < 128) {
            const int cc = tid >> 3, b = tid & 7;
            float sacc = 0.f;
#pragma unroll
            for (int sl = 0; sl < 32; ++sl) sacc += red[(sl * 16 + cc) * Bsz + b];
            dst[b * N + item * 16 + cc] = sacc + (bias ? bias[item * 16 + cc] : 0.f);
        }
        __syncthreads();
    }
}

template <int MAP> __device__ __forceinline__ int map_row(int n) {
    if (MAP == 1) { const int h = n / 96, j = n % 96; return j < 64 ? h * 64 + j : 512 + h * 32 + (j - 64); }
    return n;
}
template <int MAP>
__device__ __forceinline__ void transpose_item(const float* W, int K, int N, unsigned short* WT, const float* kgain, float* scr, int item, int lane, const float* kgain2 = nullptr) {
    const int nblk = N / 32, kb = item / nblk, nb = item % nblk, k0 = 64 * kb, n0 = 32 * nb;
#pragma unroll 8
    for (int i = 0; i < 32; ++i) {
        const int kk = 2 * i + (lane >> 5);
        float w = W[(size_t)(k0 + kk) * N + n0 + (lane & 31)];
        if (kgain) w *= (kgain2 && k0 + kk >= 512) ? kgain2[k0 + kk - 512] : kgain[k0 + kk];
        scr[kk * 33 + (lane & 31)] = w;
    }
    asm volatile("s_waitcnt lgkmcnt(0)" ::: "memory");
    const int c = lane & 7;
#pragma unroll
    for (int j = 0; j < 4; ++j) {
        const int n = (lane >> 3) + 8 * j; const float* q = scr + (8 * c) * 33 + n;
        u32x4 o; o.x = pk2(q[0 * 33], q[1 * 33]); o.y = pk2(q[2 * 33], q[3 * 33]); o.z = pk2(q[4 * 33], q[5 * 33]); o.w = pk2(q[6 * 33], q[7 * 33]);
        *(u32x4*)(WT + (size_t)map_row<MAP>(n0 + n) * K + k0 + 8 * c) = o;
    }
    asm volatile("s_waitcnt lgkmcnt(0)" ::: "memory");
}

__device__ void stage_prologue(const Params& p, float* lds) {
    const int tid = threadIdx.x;
    stage_gemv8(p.c, D, true, p.w_ada, NMOD, p.b_ada, (float*)(p.ws + WS_MOD), lds);
    float* cosA = (float*)(p.ws + WS_COSA); float* sinA = (float*)(p.ws + WS_SINA);
    float* cosB = (float*)(p.ws + WS_COSB); float* sinB = (float*)(p.ws + WS_SINB);
    const int gtid = blockIdx.x * NTHREADS + tid, gn = gridDim.x * NTHREADS;
    for (int e = gtid; e < S * 32; e += gn) {
        const int pos = e >> 5, i = e & 31;
        const double inv = exp2(-(double)(2 * i) / 64.0 * 13.287712379549449);
        const double a = (double)pos * inv;
        const float r = (float)(a - 6.283185307179586476925 * rint(a * 0.15915494309189533577));
        cosA[e] = cosf(r); sinA[e] = sinf(r);
    }
    for (int e = gtid; e < S * 16; e += gn) {
        const int pos = e >> 4, i = e & 15;
        const double inv = exp2(-(double)(2 * i) / 32.0 * 13.287712379549449);
        const double a = (double)pos * inv;
        const float r = (float)(a - 6.283185307179586476925 * rint(a * 0.15915494309189533577));
        cosB[e] = cosf(r); sinB[e] = sinf(r);
    }
    {
        const int lane = tid & 63, wave = tid >> 6;
        float* scr = lds + wave * (64 * 33);
        const int gw = blockIdx.x * NWAVES + wave, NGW = gridDim.x * NWAVES;
        constexpr int I_IN = (D / 64) * (INW / 32), I_QU = (256 / 64) * (768 / 32), I_KV = (128 / 64) * (1024 / 32), I_OUT = (D / 64) * (D / 32), I_PQ = (D / 64) * (2048 / 32);
        constexpr int NITEMS = I_IN + I_QU + I_KV + I_OUT + I_PQ;
        __syncthreads();
        for (int it = gw; it < NITEMS; it += NGW) {
            int r = it;
            if (r < I_IN) { transpose_item<0>(p.w_in, D, INW, (unsigned short*)(p.ws + WS_WIN), nullptr, scr, r, lane); continue; } r -= I_IN;
            if (r < I_QU) { transpose_item<1>(p.w_qup, 256, 768, (unsigned short*)(p.ws + WS_WQUP), p.qnorm, scr, r, lane); continue; } r -= I_QU;
            if (r < I_KV) { transpose_item<0>(p.w_kvup, 128, 1024, (unsigned short*)(p.ws + WS_WKVUP), p.kvnorm, scr, r, lane); continue; } r -= I_KV;
            if (r < I_OUT) { transpose_item<0>(p.w_out, D, D, (unsigned short*)(p.ws + WS_WOUT), p.onorm_a, scr, r, lane, p.onorm_b); continue; } r -= I_OUT;
            transpose_item<0>(p.w_pq, D, 2048, (unsigned short*)(p.ws + WS_WPQ), nullptr, scr, r, lane);
        }
        {
            u32x4* z = (u32x4*)(p.ws + WS_WIN + (size_t)INW * D * 2);
            const int nz = (1280 - INW) * D * 2 / 16;
            for (int e = blockIdx.x * NTHREADS + tid; e < nz; e += gridDim.x * NTHREADS) z[e] = (u32x4){0u, 0u, 0u, 0u};
        }
        {
            const f32x4* src = (const f32x4*)p.subk; unsigned long long* dst = (unsigned long long*)(p.ws + WS_SUBK);
            for (int e = blockIdx.x * NTHREADS + tid; e < 16 * 128 * 128 / 4; e += gridDim.x * NTHREADS) {
                const f32x4 v = src[e]; dst[e] = (unsigned long long)pk2(v.x, v.y) | ((unsigned long long)pk2(v.z, v.w) << 32);
            }
        }
    }
    {
        const int lane = tid & 63, wave = tid >> 6;
        for (int r = blockIdx.x * NWAVES + wave; r < 2 * NEXP; r += gridDim.x * NWAVES) {
            const int tab = r >= NEXP, row = r - tab * NEXP;
            const f32x4* src = (const f32x4*)((tab ? p.ev : p.eu) + (size_t)row * D) + lane;
            f32x4 v[4]; float am = 0.f;
#pragma unroll
            for (int j = 0; j < 4; ++j) { v[j] = src[64 * j]; am = fmaxf(am, fmaxf(fmaxf(fabsf(v[j].x), fabsf(v[j].y)), fmaxf(fabsf(v[j].z), fabsf(v[j].w)))); }
            am = wave_max(am);
            int ex = 0; (void)frexpf(am, &ex);
            const float sc = ldexpf(1.f, 8 - ex), isc = ldexpf(1.f, ex - 8);
            unsigned* dst = (unsigned*)(p.ws + (tab ? WS_EV8 : WS_EU8) + (size_t)row * D) + lane;
#pragma unroll
            for (int j = 0; j < 4; ++j) {
                int w = 0;
                w = __builtin_amdgcn_cvt_pk_fp8_f32(v[j].x * sc, v[j].y * sc, w, false);
                w = __builtin_amdgcn_cvt_pk_fp8_f32(v[j].z * sc, v[j].w * sc, w, true);
                dst[64 * j] = (unsigned)w;
            }
            if (lane == 0) ((float*)(p.ws + (tab ? WS_VS : WS_US)))[row] = isc;
        }
    }
}

template <bool BF>
__device__ void stage_norm_mod(const Params& p, const float* src, void* dstv, int sh_off, int sc_off) {
    const float* mod = (const float*)(p.ws + WS_MOD);
    const int lane = threadIdx.x & 63, wave = threadIdx.x >> 6;
    for (int t = blockIdx.x * NWAVES + wave; t < T; t += gridDim.x * NWAVES) {
        const int b = t >> 12;
        const f32x4* xr = (const f32x4*)(src + (size_t)t * D) + lane;
        f32x4 v[4]; float s = 0.f;
#pragma unroll
        for (int j = 0; j < 4; ++j) { v[j] = xr[64 * j]; s += v[j].x * v[j].x + v[j].y * v[j].y + v[j].z * v[j].z + v[j].w * v[j].w; }
        const float rstd = rsqrtf(wave_sum(s) * (1.f / D) + EPS);
#pragma unroll
        for (int j = 0; j < 4; ++j) {
            const f32x4 sh = *((const f32x4*)(mod + b * NMOD + sh_off) + lane + 64 * j);
            const f32x4 sc = *((const f32x4*)(mod + b * NMOD + sc_off) + lane + 64 * j);
            f32x4 r;
            r.x = v[j].x * rstd * (1.f + sc.x) + sh.x; r.y = v[j].y * rstd * (1.f + sc.y) + sh.y;
            r.z = v[j].z * rstd * (1.f + sc.z) + sh.z; r.w = v[j].w * rstd * (1.f + sc.w) + sh.w;
            if (BF) ((unsigned long long*)((unsigned short*)dstv + (size_t)t * D))[lane + 64 * j] = (unsigned long long)pk2(r.x, r.y) | ((unsigned long long)pk2(r.z, r.w) << 32);
            else ((f32x4*)((float*)dstv + (size_t)t * D))[lane + 64 * j] = r;
        }
    }
}

constexpr int TP = 128, TQ = 256, TBK = 64;
constexpr int XS_BYTES = TP * 128, YS_BYTES = TQ * 128, STG_BYTES = XS_BYTES + YS_BYTES;
__device__ __forceinline__ int swz(int r, int c) { return r * 128 + ((c ^ ((r >> 1) & 7)) << 4); }
constexpr int SSQ_OFF = 2 * (TP * 128 + TQ * 128);
__device__ __forceinline__ float ssq8(u32x4 w) {
    const float a0 = bflo(w.x), a1 = bfhi(w.x), a2 = bflo(w.y), a3 = bfhi(w.y), a4 = bflo(w.z), a5 = bfhi(w.z), a6 = bflo(w.w), a7 = bfhi(w.w);
    return (a0 * a0 + a1 * a1) + (a2 * a2 + a3 * a3) + (a4 * a4 + a5 * a5) + (a6 * a6 + a7 * a7);
}
template <int WPN, bool YSSQ, class Epi>
__device__ void gemm_xyT(const unsigned short* X, int ldx, const unsigned short* Y, int ldy, int P, int Q, int K, int nb, size_t xbs, size_t ybs, unsigned char* lds, const Epi& epi) {
    constexpr int WQN = 8 / WPN, FI = TP / (WPN * 16), FJ = TQ / (WQN * 16);
    const int tid = threadIdx.x, lane = tid & 63, wave = tid >> 6;
    const int wp = wave / WQN, wq = wave % WQN, fr = lane & 15, fq = lane >> 4;
    const int nPt = P / TP, nQt = Q / TQ, npb = nPt * nb, nunits = npb * nQt;
    const int G = gridDim.x, bx = blockIdx.x;
    const int vcu = (G % 8 == 0) ? (bx % 8) * (G / 8) + bx / 8 : bx;
    const int srow = tid >> 3, sc = tid & 7;
    const int nk = K / TBK;
    for (int u = vcu; u < nunits; u += G) {
        const int qt = u / npb, rem = u % npb, bi = rem / nPt, pt = rem % nPt, p0 = pt * TP, q0 = qt * TQ;
        f32x4 acc[FI][FJ];
#pragma unroll
        for (int i = 0; i < FI; ++i)
#pragma unroll
            for (int j = 0; j < FJ; ++j) acc[i][j] = (f32x4){0.f, 0.f, 0.f, 0.f};
        const unsigned short* xg = X + (size_t)bi * xbs + (size_t)(p0 + srow) * ldx + sc * 8;
        const unsigned short* yg = Y + (size_t)bi * ybs + (size_t)(q0 + srow) * ldy + sc * 8;
        u32x4 rx[2], ry[4];
        float sq[4] = {0.f, 0.f, 0.f, 0.f};
#pragma unroll
        for (int i = 0; i < 2; ++i) rx[i] = *(const u32x4*)(xg + (size_t)(64 * i) * ldx);
#pragma unroll
        for (int i = 0; i < 4; ++i) ry[i] = *(const u32x4*)(yg + (size_t)(64 * i) * ldy);
        if (YSSQ) {
#pragma unroll
            for (int i = 0; i < 4; ++i) sq[i] += ssq8(ry[i]);
        }
        __syncthreads();
#pragma unroll
        for (int i = 0; i < 2; ++i) *(u32x4*)(lds + swz(srow + 64 * i, sc)) = rx[i];
#pragma unroll
        for (int i = 0; i < 4; ++i) *(u32x4*)(lds + XS_BYTES + swz(srow + 64 * i, sc)) = ry[i];
        __syncthreads();
        for (int kt = 0; kt < nk; ++kt) {
            unsigned char* st = lds + (kt & 1) * STG_BYTES;
            unsigned char* sn = lds + ((kt & 1) ^ 1) * STG_BYTES;
            const bool more = (kt + 1 < nk);
            if (more) {
                const int k1 = (kt + 1) * TBK;
#pragma unroll
                for (int i = 0; i < 2; ++i) rx[i] = *(const u32x4*)(xg + (size_t)(64 * i) * ldx + k1);
#pragma unroll
                for (int i = 0; i < 4; ++i) ry[i] = *(const u32x4*)(yg + (size_t)(64 * i) * ldy + k1);
            }
            if (YSSQ && more) {
#pragma unroll
                for (int i = 0; i < 4; ++i) sq[i] += ssq8(ry[i]);
            }
#pragma unroll
            for (int kk = 0; kk < 2; ++kk) {
                bf16x8 af[FI], bfr[FJ];
#pragma unroll
                for (int i = 0; i < FI; ++i) af[i] = *(const bf16x8*)(st + swz(wp * (FI * 16) + i * 16 + fr, kk * 4 + fq));
#pragma unroll
                for (int j = 0; j < FJ; ++j) bfr[j] = *(const bf16x8*)(st + XS_BYTES + swz(wq * (FJ * 16) + j * 16 + fr, kk * 4 + fq));
#pragma unroll
                for (int i = 0; i < FI; ++i)
#pragma unroll
                    for (int j = 0; j < FJ; ++j) acc[i][j] = __builtin_amdgcn_mfma_f32_16x16x32_bf16(af[i], bfr[j], acc[i][j], 0, 0, 0);
            }
            if (more) {
#pragma unroll
                for (int i = 0; i < 2; ++i) *(u32x4*)(sn + swz(srow + 64 * i, sc)) = rx[i];
#pragma unroll
                for (int i = 0; i < 4; ++i) *(u32x4*)(sn + XS_BYTES + swz(srow + 64 * i, sc)) = ry[i];
            }
            __syncthreads();
        }
        if (YSSQ) {
            float* ssq = (float*)(lds + SSQ_OFF);
#pragma unroll
            for (int i = 0; i < 4; ++i) {
                float v = sq[i];
                v += __shfl_xor(v, 1); v += __shfl_xor(v, 2); v += __shfl_xor(v, 4);
                if (sc == 0) ssq[srow + 64 * i] = v;
            }
            __syncthreads();
        }
        epi(acc, p0 + wp * (FI * 16), q0 + wq * (FJ * 16), lane, (const float*)(lds + SSQ_OFF) + wq * (FJ * 16), bi);
        if (YSSQ) __syncthreads();
    }
}
constexpr int DMA_STAGES = 3;
#define RAW_BARRIER() do { asm volatile("s_waitcnt lgkmcnt(0)" ::: "memory"); __builtin_amdgcn_s_barrier(); } while (0)
template <int WPN, int SUB, class Epi>
__device__ void gemm_dma(const unsigned short* X, int ldx, const unsigned short* Y, int ldy, int P, int Q, int K, int nb, size_t xbs, size_t ybs, unsigned char* lds, Epi epi) {
    constexpr int WQN = 8 / WPN, FI = TP / (WPN * 16), FJ = TQ / (WQN * 16);
    const int tid = threadIdx.x, lane = tid & 63, wave = __builtin_amdgcn_readfirstlane(tid >> 6);
    const int wp = wave / WQN, wq = wave % WQN, fr = lane & 15, fq = lane >> 4;
    const int nPt = P / TP, nQt = Q / TQ, npb = nPt * nb / SUB, nunits = npb * nQt;
    const int G = gridDim.x, bx = blockIdx.x;
    const int vcu = (G % 8 == 0) ? (bx % 8) * (G / 8) + bx / 8 : bx;
    const int srow = wave * 8 + (lane >> 3), pc = lane & 7;
    const int nk = K / TBK;
    const int lc = pc ^ ((srow >> 1) & 7);
    for (int u = vcu; u < nunits; u += G)
#pragma unroll
    for (int sub = 0; sub < SUB; ++sub) {
        const int qt = u / npb, rem = (u % npb) * SUB + sub, bi = rem / nPt, pt = rem % nPt, p0 = pt * TP, q0 = qt * TQ;
        f32x4 acc[FI][FJ];
#pragma unroll
        for (int i = 0; i < FI; ++i)
#pragma unroll
            for (int j = 0; j < FJ; ++j) acc[i][j] = (f32x4){0.f, 0.f, 0.f, 0.f};
        const unsigned short* xg = X + (size_t)bi * xbs + (size_t)(p0 + srow) * ldx + lc * 8;
        const unsigned short* yg = Y + (size_t)bi * ybs + (size_t)(q0 + srow) * ldy + lc * 8;
        epi.pre(q0 + wq * (FJ * 16), lane);
        asm volatile("s_waitcnt vmcnt(0)" ::: "memory");
        RAW_BARRIER();
#define GEMM_DMA_TILE(kt_, stg_) do { \
            unsigned char* _b = lds + (stg_) * STG_BYTES + wave * 1024; const int _k = (kt_) * TBK; \
            _Pragma("unroll") for (int _i = 0; _i < 2; ++_i) __builtin_amdgcn_global_load_lds((const unsigned*)(xg + (size_t)(64 * _i) * ldx + _k), (unsigned*)(_b + _i * 8192), 16, 0, 0); \
            _Pragma("unroll") for (int _i = 0; _i < 4; ++_i) __builtin_amdgcn_global_load_lds((const unsigned*)(yg + (size_t)(64 * _i) * ldy + _k), (unsigned*)(_b + XS_BYTES + _i * 8192), 16, 0, 0); \
        } while (0)
        GEMM_DMA_TILE(0, 0);
        GEMM_DMA_TILE(1, 1);
        int cur = 0;
        for (int kt = 0; kt < nk; ++kt) {
            if (kt + 1 < nk) asm volatile("s_waitcnt vmcnt(6)" ::: "memory");
            else if (Epi::HAS_LATE) asm volatile("s_waitcnt vmcnt(16)" ::: "memory");
            else asm volatile("s_waitcnt vmcnt(0)" ::: "memory");
            RAW_BARRIER();
            if (kt + 2 < nk) { const int nxt = (cur == 0) ? 2 : cur - 1; GEMM_DMA_TILE(kt + 2, nxt); }
            if (Epi::HAS_LATE && kt + 2 == nk) epi.late(p0 + wp * (FI * 16), q0 + wq * (FJ * 16), lane);
            const unsigned char* st = lds + cur * STG_BYTES;
#pragma unroll
            for (int kk = 0; kk < 2; ++kk) {
                bf16x8 af[FI], bfr[FJ];
#pragma unroll
                for (int i = 0; i < FI; ++i) af[i] = *(const bf16x8*)(st + swz(wp * (FI * 16) + i * 16 + fr, kk * 4 + fq));
#pragma unroll
                for (int j = 0; j < FJ; ++j) bfr[j] = *(const bf16x8*)(st + XS_BYTES + swz(wq * (FJ * 16) + j * 16 + fr, kk * 4 + fq));
#pragma unroll
                for (int i = 0; i < FI; ++i)
#pragma unroll
                    for (int j = 0; j < FJ; ++j) acc[i][j] = __builtin_amdgcn_mfma_f32_16x16x32_bf16(af[i], bfr[j], acc[i][j], 0, 0, 0);
            }
            cur = (cur == 2) ? 0 : cur + 1;
            if (Epi::HAS_MID && kt + 1 == (nk >> 1)) epi.mid(acc);
        }
#undef GEMM_DMA_TILE
        epi(acc, p0 + wp * (FI * 16), q0 + wq * (FJ * 16), lane, (const float*)nullptr, bi, sub);
    }
}
__device__ __forceinline__ unsigned long long pk4(float a, float b, float c, float d) { return (unsigned long long)pk2(a, b) | ((unsigned long long)pk2(c, d) << 32); }
struct EpiOutProj {
    static constexpr bool HAS_MID = true;
    static constexpr bool HAS_LATE = true;
    const float* x; const float* mod; float* out; unsigned short* y1; const float* ssqo; float* ssq1;
    float ratio[4], rb[4];
    f32x4 xv[4][4];
    __device__ __forceinline__ void late(int pb, int qb, int lane) {
        const int fr = lane & 15, fq = lane >> 4;
#pragma unroll
        for (int j = 0; j < 4; ++j)
#pragma unroll
            for (int i = 0; i < 4; ++i) xv[j][i] = *(const f32x4*)(x + (size_t)(qb + j * 16 + fr) * D + pb + i * 16 + fq * 4);
    }
    __device__ __forceinline__ void pre(int qb, int lane) {
#pragma unroll
        for (int j = 0; j < 4; ++j) {
            const f32x4* s4 = (const f32x4*)(ssqo + (size_t)(qb + j * 16 + (lane & 15)) * 16);
            const f32x4 a0 = s4[0], a1 = s4[1], b0 = s4[2], b1 = s4[3];
            const float sa = (a0.x + a0.y + a0.z + a0.w) + (a1.x + a1.y + a1.z + a1.w), sb = (b0.x + b0.y + b0.z + b0.w) + (b1.x + b1.y + b1.z + b1.w);
            const float ra = rsqrtf(sa * (1.f / 512.f) + EPS); rb[j] = rsqrtf(sb * (1.f / 512.f) + EPS); ratio[j] = ra / rb[j];
        }
    }
    __device__ __forceinline__ void mid(f32x4 (&acc)[4][4]) {
#pragma unroll
        for (int i = 0; i < 4; ++i)
#pragma unroll
            for (int j = 0; j < 4; ++j) { acc[i][j].x *= ratio[j]; acc[i][j].y *= ratio[j]; acc[i][j].z *= ratio[j]; acc[i][j].w *= ratio[j]; }
    }
    __device__ __forceinline__ void operator()(const f32x4 (&acc)[4][4], int pb, int qb, int lane, const float*, int, int = 0) {
        const int fr = lane & 15, fq = lane >> 4;
        const float* __restrict__ xr = x; float* __restrict__ outr = out; unsigned short* __restrict__ yr = y1; float* __restrict__ sr = ssq1;
        const float* mt = mod + (qb >> 12) * NMOD + pb + fq * 4;
        f32x4 gv[4], scv[4];
#pragma unroll
        for (int i = 0; i < 4; ++i) { gv[i] = *(const f32x4*)(mt + 2 * D + i * 16); scv[i] = *(const f32x4*)(mt + 4 * D + i * 16); }
#pragma unroll
        for (int j = 0; j < 4; ++j) {
            const int t = qb + j * 16 + fr;
            float ss = 0.f;
#pragma unroll
            for (int i = 0; i < 4; ++i) {
                const int n = pb + i * 16 + fq * 4;
                const f32x4 xx = xv[j][i];
                f32x4 r; r.x = xx.x + gv[i].x * (acc[i][j].x * rb[j]); r.y = xx.y + gv[i].y * (acc[i][j].y * rb[j]); r.z = xx.z + gv[i].z * (acc[i][j].z * rb[j]); r.w = xx.w + gv[i].w * (acc[i][j].w * rb[j]);
                *(f32x4*)(outr + (size_t)t * D + n) = r;
                ss += (r.x * r.x + r.y * r.y) + (r.z * r.z + r.w * r.w);
                *(unsigned long long*)(yr + (size_t)t * D + n) = pk4(r.x * (1.f + scv[i].x), r.y * (1.f + scv[i].y), r.z * (1.f + scv[i].z), r.w * (1.f + scv[i].w));
            }
            ss += __shfl_xor(ss, 16); ss += __shfl_xor(ss, 32);
            if (fq == 0) sr[(size_t)t * 16 + (pb >> 6)] = ss;
        }
    }
};
struct EpiPQ {
    static constexpr bool HAS_MID = false, HAS_LATE = false;
    __device__ __forceinline__ void late(int, int, int) {}
    unsigned short* C; const float* ssq1; const float* bias;
    float r1[4];
    __device__ __forceinline__ void pre(int qb, int lane) {
#pragma unroll
        for (int j = 0; j < 4; ++j) {
            const f32x4* s4 = (const f32x4*)(ssq1 + (size_t)(qb + j * 16 + (lane & 15)) * 16);
            const f32x4 a0 = s4[0], a1 = s4[1], a2 = s4[2], a3 = s4[3];
            const float sa = ((a0.x + a0.y + a0.z + a0.w) + (a1.x + a1.y + a1.z + a1.w)) + ((a2.x + a2.y + a2.z + a2.w) + (a3.x + a3.y + a3.z + a3.w));
            r1[j] = rsqrtf(sa * (1.f / D) + EPS);
        }
    }
    template <class A> __device__ __forceinline__ void mid(A&) {}
    __device__ __forceinline__ void operator()(const f32x4 (&acc)[4][4], int pb, int qb, int lane, const float*, int, int = 0) {
        const int fr = lane & 15, fq = lane >> 4;
        unsigned short* __restrict__ Cr = C;
        const float* bt = bias + (qb >> 12) * 2048 + pb + fq * 4;
        f32x4 bv[4];
#pragma unroll
        for (int i = 0; i < 4; ++i) bv[i] = *(const f32x4*)(bt + i * 16);
#pragma unroll
        for (int j = 0; j < 4; ++j) {
            const int t = qb + j * 16 + fr;
#pragma unroll
            for (int i = 0; i < 4; ++i) {
                const int n = pb + i * 16 + fq * 4;
                *(unsigned long long*)(Cr + (size_t)t * 2048 + n) = pk4(acc[i][j].x * r1[j] + bv[i].x, acc[i][j].y * r1[j] + bv[i].y, acc[i][j].z * r1[j] + bv[i].z, acc[i][j].w * r1[j] + bv[i].w);
            }
        }
    }
};

struct EpiProj {
    static constexpr bool HAS_MID = false, HAS_LATE = false;
    __device__ __forceinline__ void late(int, int, int) {}
    __device__ __forceinline__ void pre(int, int) {}
    template <class A> __device__ __forceinline__ void mid(A&) {}
    unsigned char* ws;
    __device__ __forceinline__ void operator()(const f32x4 (&acc)[4][4], int pb, int qb, int lane, const float*, int, int = 0) const {
        const int fr = lane & 15, fq = lane >> 4;
        if (pb >= 1216) return;
        const int t0 = qb + fr, b = t0 >> 12, pos0 = t0 & (S - 1);
        if (pb < C_VA) {
            const float* __restrict__ cosA = (const float*)(ws + WS_COSA); const float* __restrict__ sinA = (const float*)(ws + WS_SINA);
            const bool isq = pb < C_KA;
            const int head = isq ? (pb >> 6) : ((pb - C_KA) >> 6);
            unsigned short* __restrict__ dst0 = isq ? (unsigned short*)(ws + WS_QA) + ((size_t)(b * 8 + head) * S + pos0) * 64 : (unsigned short*)(ws + WS_KA) + ((size_t)(b * 2 + head) * S + pos0) * 64;
            const float sc = isq ? QA_SCALE : 1.f;
#pragma unroll
            for (int jh = 0; jh < 4; jh += 2) {
                f32x4 c[2][2], sn[2][2];
#pragma unroll
                for (int jj = 0; jj < 2; ++jj)
#pragma unroll
                    for (int i = 0; i < 2; ++i) { c[jj][i] = *(const f32x4*)(cosA + (pos0 + 16 * (jh + jj)) * 32 + i * 16 + fq * 4); sn[jj][i] = *(const f32x4*)(sinA + (pos0 + 16 * (jh + jj)) * 32 + i * 16 + fq * 4); }
#pragma unroll
                for (int jj = 0; jj < 2; ++jj)
#pragma unroll
                    for (int i = 0; i < 2; ++i) {
                        const int j = jh + jj, d = i * 16 + fq * 4;
                        const f32x4 x1 = acc[i][j], x2 = acc[i + 2][j], cc = c[jj][i], ss = sn[jj][i];
                        unsigned short* dst = dst0 + (size_t)(16 * j) * 64;
                        *(unsigned long long*)(dst + d) = pk4((x1.x * cc.x - x2.x * ss.x) * sc, (x1.y * cc.y - x2.y * ss.y) * sc, (x1.z * cc.z - x2.z * ss.z) * sc, (x1.w * cc.w - x2.w * ss.w) * sc);
                        *(unsigned long long*)(dst + 32 + d) = pk4((x2.x * cc.x + x1.x * ss.x) * sc, (x2.y * cc.y + x1.y * ss.y) * sc, (x2.z * cc.z + x1.z * ss.z) * sc, (x2.w * cc.w + x1.w * ss.w) * sc);
                    }
            }
        } else if (pb < C_QL) {
            const int kvh = (pb - C_VA) >> 6;
            unsigned short* __restrict__ dst0 = (unsigned short*)(ws + WS_VAT) + (size_t)(b * 2 + kvh) * 64 * S + pos0;
#pragma unroll
            for (int j = 0; j < 4; ++j)
#pragma unroll
                for (int i = 0; i < 4; ++i) {
                    const int dv = i * 16 + fq * 4; unsigned short* dst = dst0 + 16 * j;
                    dst[(size_t)(dv + 0) * S] = (unsigned short)f2bf(acc[i][j].x); dst[(size_t)(dv + 1) * S] = (unsigned short)f2bf(acc[i][j].y);
                    dst[(size_t)(dv + 2) * S] = (unsigned short)f2bf(acc[i][j].z); dst[(size_t)(dv + 3) * S] = (unsigned short)f2bf(acc[i][j].w);
                }
        } else if (pb < C_KR) {
            const bool isq = pb < C_KVL;
            unsigned short* __restrict__ dst0 = isq ? (unsigned short*)(ws + WS_QL) + (size_t)t0 * 256 + (pb - C_QL) : (unsigned short*)(ws + WS_KVL) + (size_t)t0 * 128 + (pb - C_KVL);
            const int ld = isq ? 256 : 128;
#pragma unroll
            for (int j = 0; j < 4; ++j)
#pragma unroll
                for (int i = 0; i < 4; ++i) *(unsigned long long*)(dst0 + (size_t)(16 * j) * ld + i * 16 + fq * 4) = pk4(acc[i][j].x, acc[i][j].y, acc[i][j].z, acc[i][j].w);
        } else {
            const float* __restrict__ cosB = (const float*)(ws + WS_COSB); const float* __restrict__ sinB = (const float*)(ws + WS_SINB);
            unsigned short* __restrict__ K96 = (unsigned short*)(ws + WS_K96);
            const int d = fq * 4;
            f32x4 c[4], sn[4];
#pragma unroll
            for (int j = 0; j < 4; ++j) { c[j] = *(const f32x4*)(cosB + (pos0 + 16 * j) * 16 + d); sn[j] = *(const f32x4*)(sinB + (pos0 + 16 * j) * 16 + d); }
#pragma unroll
            for (int j = 0; j < 4; ++j) {
                const f32x4 x1 = acc[0][j], x2 = acc[1][j], cc = c[j], ss = sn[j];
                const unsigned long long lo = pk4(x1.x * cc.x - x2.x * ss.x, x1.y * cc.y - x2.y * ss.y, x1.z * cc.z - x2.z * ss.z, x1.w * cc.w - x2.w * ss.w);
                const unsigned long long hi = pk4(x2.x * cc.x + x1.x * ss.x, x2.y * cc.y + x1.y * ss.y, x2.z * cc.z + x1.z * ss.z, x2.w * cc.w + x1.w * ss.w);
#pragma unroll
                for (int h = 0; h < 8; ++h) {
                    unsigned short* dst = K96 + ((size_t)(b * 8 + h) * S + pos0 + 16 * j) * 64 + 32 + d;
                    *(unsigned long long*)dst = lo; *(unsigned long long*)(dst + 16) = hi;
                }
            }
        }
    }
};
struct EpiQup {
    unsigned char* ws;
    __device__ __forceinline__ void operator()(const f32x4 (&acc)[4][4], int pb, int qb, int lane, const float* ssq, int, int = 0) const {
        const int fr = lane & 15, fq = lane >> 4;
        unsigned short* __restrict__ QMB = (unsigned short*)(ws + WS_QMB);
        const float* __restrict__ cosB = (const float*)(ws + WS_COSB); const float* __restrict__ sinB = (const float*)(ws + WS_SINB);
        const int t0 = qb + fr, b = t0 >> 12, pos0 = t0 & (S - 1);
        float sc[4];
#pragma unroll
        for (int j = 0; j < 4; ++j) sc[j] = rsqrtf(ssq[j * 16 + fr] * (1.f / 256.f) + EPS) * QM_SCALE;
        if (pb < 512) {
            unsigned char* dst0 = (unsigned char*)(QMB + ((size_t)(b * 8 + (pb >> 6)) * S + pos0) * 64);
#pragma unroll
            for (int j = 0; j < 4; ++j)
#pragma unroll
                for (int i = 0; i < 4; ++i) {
                    const float s8 = sc[j] * 8.f; int w = 0;
                    w = __builtin_amdgcn_cvt_pk_fp8_f32(acc[i][j].x * s8, acc[i][j].y * s8, w, false); w = __builtin_amdgcn_cvt_pk_fp8_f32(acc[i][j].z * s8, acc[i][j].w * s8, w, true);
                    *(unsigned*)(dst0 + (size_t)(16 * j) * 128 + i * 16 + fq * 4) = (unsigned)w;
                }
        } else {
            const int d = fq * 4;
            f32x4 c[4], sn[4];
#pragma unroll
            for (int j = 0; j < 4; ++j) { c[j] = *(const f32x4*)(cosB + (pos0 + 16 * j) * 16 + d); sn[j] = *(const f32x4*)(sinB + (pos0 + 16 * j) * 16 + d); }
#pragma unroll
            for (int j = 0; j < 4; ++j)
#pragma unroll
                for (int hh = 0; hh < 2; ++hh) {
                    const int h = ((pb - 512) >> 5) + hh;
                    unsigned short* dst = QMB + ((size_t)(b * 8 + h) * S + pos0 + 16 * j) * 64 + 32 + d;
                    const f32x4 x1 = acc[2 * hh][j], x2 = acc[2 * hh + 1][j], cc = c[j], ss = sn[j]; const float s_ = sc[j];
                    *(unsigned long long*)dst = pk4((x1.x * cc.x - x2.x * ss.x) * s_, (x1.y * cc.y - x2.y * ss.y) * s_, (x1.z * cc.z - x2.z * ss.z) * s_, (x1.w * cc.w - x2.w * ss.w) * s_);
                    *(unsigned long long*)(dst + 16) = pk4((x2.x * cc.x + x1.x * ss.x) * s_, (x2.y * cc.y + x1.y * ss.y) * s_, (x2.z * cc.z + x1.z * ss.z) * s_, (x2.w * cc.w + x1.w * ss.w) * s_);
                }
        }
    }
};
struct EpiKVup {
    unsigned char* ws;
    __device__ __forceinline__ void operator()(const f32x4 (&acc)[4][4], int pb, int qb, int lane, const float* ssq, int, int = 0) const {
        const int fr = lane & 15, fq = lane >> 4;
        unsigned short* K96 = (unsigned short*)(ws + WS_K96); unsigned short* VT = (unsigned short*)(ws + WS_VT);
        const int h = pb >> 7;
#pragma unroll
        for (int j = 0; j < 4; ++j) {
            const int t = qb + j * 16 + fr, b = t >> 12, pos = t & (S - 1);
            const float sc = rsqrtf(ssq[j * 16 + fr] * (1.f / 128.f) + EPS);
            if ((pb & 64) == 0) {
                unsigned char* dst = (unsigned char*)(K96 + ((size_t)(b * 8 + h) * S + pos) * 64);
#pragma unroll
                for (int i = 0; i < 4; ++i) {
                    int w = 0;
                    w = __builtin_amdgcn_cvt_pk_fp8_f32(acc[i][j].x * sc, acc[i][j].y * sc, w, false); w = __builtin_amdgcn_cvt_pk_fp8_f32(acc[i][j].z * sc, acc[i][j].w * sc, w, true);
                    *(unsigned*)(dst + i * 16 + fq * 4) = (unsigned)w;
                }
            } else {
                unsigned char* dst = (unsigned char*)VT + (size_t)(b * 8 + h) * 64 * S + pos;
#pragma unroll
                for (int i = 0; i < 4; ++i) {
                    const int dv = i * 16 + fq * 4;
                    const int w0 = __builtin_amdgcn_cvt_pk_fp8_f32(acc[i][j].x * sc, acc[i][j].y * sc, 0, false), w1 = __builtin_amdgcn_cvt_pk_fp8_f32(acc[i][j].z * sc, acc[i][j].w * sc, 0, false);
                    dst[(size_t)(dv + 0) * S] = (unsigned char)(w0 & 0xff); dst[(size_t)(dv + 1) * S] = (unsigned char)((w0 >> 8) & 0xff);
                    dst[(size_t)(dv + 2) * S] = (unsigned char)(w1 & 0xff); dst[(size_t)(dv + 3) * S] = (unsigned char)((w1 >> 8) & 0xff);
                }
            }
        }
    }
};

typedef float f32x16 __attribute__((ext_vector_type(16)));
typedef __bf16 bf16x2_t __attribute__((ext_vector_type(2)));
__device__ __forceinline__ unsigned cvtpk(float lo, float hi) { f32x2 v = {lo, hi}; bf16x2_t b = __builtin_convertvector(v, bf16x2_t); return __builtin_bit_cast(unsigned, b); }
__device__ __forceinline__ int crow(int r, int hi) { return (r & 3) + 8 * (r >> 2) + 4 * hi; }
__device__ __forceinline__ int kperm(int rho) { return (rho & 0x13) | ((rho & 4) << 1) | ((rho & 8) >> 1); }

template <int DQK, bool SWA>
__device__ void stage_attn_flash(const Params& p, unsigned char* lds) {
    constexpr bool V8 = !SWA;
    constexpr bool Q8 = !SWA;
    constexpr int NK = DQK / 16, KCH = DQK / 8, KSTR = Q8 ? 80 : (KCH + 1) * 16, VSTR = V8 ? 80 : 144;
    constexpr int KT_BYTES = Q8 ? 2 * 64 * 80 : 64 * KSTR, VT_BYTES = 64 * VSTR, STG = KT_BYTES + VT_BYTES, NKC = 64 * KCH;
    const unsigned short* Qg = (const unsigned short*)(p.ws + (SWA ? WS_QA : WS_QMB));
    const unsigned short* Kg = (const unsigned short*)(p.ws + (SWA ? WS_KA : WS_K96));
    const unsigned short* Vg = (const unsigned short*)(p.ws + (SWA ? WS_VAT : WS_VT));
    unsigned short* O = (unsigned short*)(p.ws + WS_OAB);
    const int tid = threadIdx.x, lane = tid & 63, wave = tid >> 6, r32 = lane & 31, hi = lane >> 5;
    const int G = gridDim.x, bx = blockIdx.x;
    const int vcu = (G % 8 == 0) ? (bx % 8) * (G / 8) + bx / 8 : bx;
    const int nunits = SWA ? Bsz * 2 * 64 : Bsz * 8 * 16;
    const int kro = kperm(r32) * KSTR + hi * (Q8 ? 32 : 16);
    const int krr = 64 * 80 + kperm(r32) * 80 + hi * 16;
    const int k8lds = ((tid & 7) < 4) ? ((tid >> 3) * 80 + (tid & 7) * 16) : (64 * 80 + (tid >> 3) * 80 + ((tid & 7) - 4) * 16);
    const int vro = r32 * VSTR + hi * (V8 ? 32 : 16);
    const int kid0 = tid, kid1 = tid + 512;
    const int k0row = kid0 / KCH, k0c = kid0 % KCH, k1row = kid1 / KCH, k1c = kid1 % KCH;
    const int vrow = V8 ? (tid >> 2) : (tid >> 3), vc = V8 ? (tid & 3) : (tid & 7);
    for (int u = vcu; u < nunits; u += G) {
        int b, qb, tlo, thi, sq, ocol; const unsigned short *Qp, *Kb, *Vb; float m, l;
        if (SWA) {
            qb = u & 63; const int kvh = (u >> 6) & 1; b = u >> 7;
            const int head = kvh * 4 + (wave >> 1);
            sq = qb * 64 + (wave & 1) * 32 + r32;
            Qp = Qg + ((size_t)(b * 8 + head) * S + sq) * 64;
            Kb = Kg + (size_t)(b * 2 + kvh) * S * 64; Vb = Vg + (size_t)(b * 2 + kvh) * 64 * S;
            tlo = qb - 2 < 0 ? 0 : qb - 2; thi = qb + 2 > 63 ? 63 : qb + 2;
            m = p.sink[head] * LOG2E; l = 0.5f; ocol = head * 64;
        } else {
            qb = u & 15; const int h = (u >> 4) & 7; b = u >> 7;
            sq = qb * 256 + wave * 32 + r32;
            Qp = Qg + ((size_t)(b * 8 + h) * S + sq) * 64;
            Kb = Kg + (size_t)(b * 8 + h) * S * 64; Vb = (const unsigned short*)((const unsigned char*)Vg + (size_t)(b * 8 + h) * 64 * S);
            tlo = 0; thi = 63; m = 0.f; l = 0.f; ocol = 512 + h * 64;
        }
        bf16x8 qf[NK];
        i32x8 qn = {0, 0, 0, 0, 0, 0, 0, 0};
        if (Q8) {
            const u32x4 q0 = *(const u32x4*)((const unsigned char*)Qp + hi * 32), q1 = *(const u32x4*)((const unsigned char*)Qp + hi * 32 + 16);
            qn = (i32x8){(int)q0.x, (int)q0.y, (int)q0.z, (int)q0.w, (int)q1.x, (int)q1.y, (int)q1.z, (int)q1.w};
            qf[0] = *(const bf16x8*)(Qp + 32 + hi * 8); qf[1] = *(const bf16x8*)(Qp + 48 + hi * 8);
        } else {
#pragma unroll
            for (int ks = 0; ks < NK; ++ks) qf[ks] = *(const bf16x8*)(Qp + ks * 16 + hi * 8);
        }
        f32x16 o0, o1, negm;
        i32x8 pb = {0, 0, 0, 0, 0, 0, 0, 0};
#pragma unroll
        for (int r = 0; r < 16; ++r) { o0[r] = 0.f; o1[r] = 0.f; negm[r] = -m; }
        u32x4 rk0, rk1, rv;
        {
            const unsigned short* kt = Kb + (size_t)tlo * 64 * (Q8 ? 64 : DQK);
            rk0 = *(const u32x4*)(kt + kid0 * 8);
            if (!Q8 && kid1 < NKC) rk1 = *(const u32x4*)(kt + kid1 * 8);
            if (!V8 || tid < 256) rv = *(const u32x4*)((const unsigned char*)Vb + (V8 ? 1 : 2) * ((size_t)vrow * S + tlo * 64) + vc * 16);
            if (Q8) *(u32x4*)(lds + k8lds) = rk0;
            else { *(u32x4*)(lds + k0row * KSTR + k0c * 16) = rk0; if (kid1 < NKC) *(u32x4*)(lds + k1row * KSTR + k1c * 16) = rk1; }
            if (V8) { if (tid < 256) { unsigned long long* vd = (unsigned long long*)(lds + KT_BYTES + vrow * VSTR + vc * 8); vd[0] = (unsigned long long)rv.x | ((unsigned long long)rv.y << 32); vd[4] = (unsigned long long)rv.z | ((unsigned long long)rv.w << 32); } }
            else *(u32x4*)(lds + KT_BYTES + vrow * VSTR + vc * 16) = rv;
        }
        __syncthreads();
        for (int tt = tlo; tt <= thi; ++tt) {
            const unsigned char* Kl = lds + ((tt - tlo) & 1) * STG;
            const unsigned char* Vl = Kl + KT_BYTES;
            unsigned char* Kn = lds + (((tt - tlo) & 1) ^ 1) * STG;
            const bool more = tt < thi;
            if (more) {
                const unsigned short* kt = Kb + (size_t)(tt + 1) * 64 * (Q8 ? 64 : DQK);
                rk0 = *(const u32x4*)(kt + kid0 * 8);
                if (!Q8 && kid1 < NKC) rk1 = *(const u32x4*)(kt + kid1 * 8);
                if (!V8 || tid < 256) rv = *(const u32x4*)((const unsigned char*)Vb + (V8 ? 1 : 2) * ((size_t)vrow * S + (tt + 1) * 64) + vc * 16);
            }
            f32x16 s0, s1;
            if (!Q8) {
                const float nm = -m;
#pragma unroll
                for (int r = 0; r < 16; ++r) { s0[r] = nm; s1[r] = nm; }
            }
            if (Q8) {
                const u32x4 k00 = *(const u32x4*)(Kl + kro), k01 = *(const u32x4*)(Kl + kro + 16), k10 = *(const u32x4*)(Kl + 32 * 80 + kro), k11 = *(const u32x4*)(Kl + 32 * 80 + kro + 16);
                const i32x8 ka0 = {(int)k00.x, (int)k00.y, (int)k00.z, (int)k00.w, (int)k01.x, (int)k01.y, (int)k01.z, (int)k01.w};
                const i32x8 ka1 = {(int)k10.x, (int)k10.y, (int)k10.z, (int)k10.w, (int)k11.x, (int)k11.y, (int)k11.z, (int)k11.w};
                s0 = __builtin_amdgcn_mfma_scale_f32_32x32x64_f8f6f4(ka0, qn, negm, 0, 0, 0, 0x7f7f7f7f, 0, 0x7c7c7c7c);
                s1 = __builtin_amdgcn_mfma_scale_f32_32x32x64_f8f6f4(ka1, qn, negm, 0, 0, 0, 0x7f7f7f7f, 0, 0x7c7c7c7c);
#pragma unroll
                for (int ks = 0; ks < 2; ++ks) {
                    const bf16x8 kf0 = *(const bf16x8*)(Kl + krr + ks * 32);
                    const bf16x8 kf1 = *(const bf16x8*)(Kl + 32 * 80 + krr + ks * 32);
                    s0 = __builtin_amdgcn_mfma_f32_32x32x16_bf16(kf0, qf[ks], s0, 0, 0, 0);
                    s1 = __builtin_amdgcn_mfma_f32_32x32x16_bf16(kf1, qf[ks], s1, 0, 0, 0);
                }
            } else {
#pragma unroll
            for (int ks = 0; ks < NK; ++ks) {
                const bf16x8 kf0 = *(const bf16x8*)(Kl + kro + ks * 32);
                const bf16x8 kf1 = *(const bf16x8*)(Kl + 32 * KSTR + kro + ks * 32);
                s0 = __builtin_amdgcn_mfma_f32_32x32x16_bf16(kf0, qf[ks], s0, 0, 0, 0);
                s1 = __builtin_amdgcn_mfma_f32_32x32x16_bf16(kf1, qf[ks], s1, 0, 0, 0);
            }
            }
            if (SWA) {
                const int rel = tt - qb;
                if (rel == -2 || rel == 2) {
                    const int qi = (wave & 1) * 32 + r32;
#pragma unroll
                    for (int r = 0; r < 16; ++r) {
                        const int kk = kperm(crow(r, hi));
                        const bool v0 = (rel == -2) ? (kk >= qi) : (kk <= qi);
                        const bool v1 = (rel == -2) ? (kk + 32 >= qi) : (kk + 32 <= qi);
                        s0[r] = v0 ? s0[r] : -1e30f; s1[r] = v1 ? s1[r] : -1e30f;
                    }
                }
            }
            if ((!SWA) && (tt == tlo)) {
                float mx = fmaxf(s0[0], s1[0]);
#pragma unroll
                for (int r = 1; r < 16; ++r) mx = fmaxf(mx, fmaxf(s0[r], s1[r]));
                mx = fmaxf(mx, __shfl_xor(mx, 32));
                m = mx;
#pragma unroll
                for (int r = 0; r < 16; ++r) { s0[r] -= mx; s1[r] -= mx; negm[r] = -mx; }
            }
            float rs = 0.f;
#pragma unroll
            for (int r = 0; r < 16; ++r) { s0[r] = __builtin_amdgcn_exp2f(s0[r]); s1[r] = __builtin_amdgcn_exp2f(s1[r]); rs += s0[r] + s1[r]; }
            if (!__all(rs <= 1024.f)) {
                float mp = fmaxf(s0[0], s1[0]);
#pragma unroll
                for (int r = 1; r < 16; ++r) mp = fmaxf(mp, fmaxf(s0[r], s1[r]));
                mp = fmaxf(fmaxf(mp, __shfl_xor(mp, 32)), 1.f);
                const float alpha = 1.f / mp;
                m += __builtin_amdgcn_logf(mp);
                l *= alpha; rs *= alpha;
#pragma unroll
                for (int r = 0; r < 16; ++r) { o0[r] *= alpha; o1[r] *= alpha; s0[r] *= alpha; s1[r] *= alpha; negm[r] = -m; }
            }
            l += rs;
            if (V8) {
#pragma unroll
                for (int q = 0; q < 4; ++q) {
                    pb[q] = __builtin_amdgcn_cvt_pk_bf8_f32(s0[4 * q + 0], s0[4 * q + 1], pb[q], false); pb[q] = __builtin_amdgcn_cvt_pk_bf8_f32(s0[4 * q + 2], s0[4 * q + 3], pb[q], true);
                    pb[4 + q] = __builtin_amdgcn_cvt_pk_bf8_f32(s1[4 * q + 0], s1[4 * q + 1], pb[4 + q], false); pb[4 + q] = __builtin_amdgcn_cvt_pk_bf8_f32(s1[4 * q + 2], s1[4 * q + 3], pb[4 + q], true);
                }
                const u32x4 a00 = *(const u32x4*)(Vl + vro), a01 = *(const u32x4*)(Vl + vro + 16), a10 = *(const u32x4*)(Vl + 32 * VSTR + vro), a11 = *(const u32x4*)(Vl + 32 * VSTR + vro + 16);
                const i32x8 va0 = {(int)a00.x, (int)a00.y, (int)a00.z, (int)a00.w, (int)a01.x, (int)a01.y, (int)a01.z, (int)a01.w};
                const i32x8 va1 = {(int)a10.x, (int)a10.y, (int)a10.z, (int)a10.w, (int)a11.x, (int)a11.y, (int)a11.z, (int)a11.w};
                o0 = __builtin_amdgcn_mfma_scale_f32_32x32x64_f8f6f4(va0, pb, o0, 0, 1, 0, 0x7f7f7f7f, 0, 0x7f7f7f7f);
                o1 = __builtin_amdgcn_mfma_scale_f32_32x32x64_f8f6f4(va1, pb, o1, 0, 1, 0, 0x7f7f7f7f, 0, 0x7f7f7f7f);
            } else {
#pragma unroll
            for (int st = 0; st < 2; ++st) {
                u32x4 pw;
                pw.x = cvtpk(s0[8 * st + 0], s0[8 * st + 1]); pw.y = cvtpk(s0[8 * st + 2], s0[8 * st + 3]);
                pw.z = cvtpk(s0[8 * st + 4], s0[8 * st + 5]); pw.w = cvtpk(s0[8 * st + 6], s0[8 * st + 7]);
                const bf16x8 pf = __builtin_bit_cast(bf16x8, pw);
                const bf16x8 vf0 = *(const bf16x8*)(Vl + vro + st * 32);
                const bf16x8 vf1 = *(const bf16x8*)(Vl + 32 * VSTR + vro + st * 32);
                o0 = __builtin_amdgcn_mfma_f32_32x32x16_bf16(vf0, pf, o0, 0, 0, 0);
                o1 = __builtin_amdgcn_mfma_f32_32x32x16_bf16(vf1, pf, o1, 0, 0, 0);
            }
#pragma unroll
            for (int st = 0; st < 2; ++st) {
                u32x4 pw;
                pw.x = cvtpk(s1[8 * st + 0], s1[8 * st + 1]); pw.y = cvtpk(s1[8 * st + 2], s1[8 * st + 3]);
                pw.z = cvtpk(s1[8 * st + 4], s1[8 * st + 5]); pw.w = cvtpk(s1[8 * st + 6], s1[8 * st + 7]);
                const bf16x8 pf = __builtin_bit_cast(bf16x8, pw);
                const bf16x8 vf0 = *(const bf16x8*)(Vl + vro + 64 + st * 32);
                const bf16x8 vf1 = *(const bf16x8*)(Vl + 32 * VSTR + vro + 64 + st * 32);
                o0 = __builtin_amdgcn_mfma_f32_32x32x16_bf16(vf0, pf, o0, 0, 0, 0);
                o1 = __builtin_amdgcn_mfma_f32_32x32x16_bf16(vf1, pf, o1, 0, 0, 0);
            }
            }
            if (more) {
                if (Q8) *(u32x4*)(Kn + k8lds) = rk0;
                else { *(u32x4*)(Kn + k0row * KSTR + k0c * 16) = rk0; if (kid1 < NKC) *(u32x4*)(Kn + k1row * KSTR + k1c * 16) = rk1; }
                if (V8) { if (tid < 256) { unsigned long long* vd = (unsigned long long*)(Kn + KT_BYTES + vrow * VSTR + vc * 8); vd[0] = (unsigned long long)rv.x | ((unsigned long long)rv.y << 32); vd[4] = (unsigned long long)rv.z | ((unsigned long long)rv.w << 32); } }
                else *(u32x4*)(Kn + KT_BYTES + vrow * VSTR + vc * 16) = rv;
            }
            __syncthreads();
        }
        const float il = 1.f / (l + __shfl_xor(l, 32));
        {
            float ss = 0.f;
#pragma unroll
            for (int r = 0; r < 16; ++r) { const float a0 = o0[r] * il, a1 = o1[r] * il; ss += a0 * a0 + a1 * a1; }
            ss += __shfl_xor(ss, 32);
            if (hi == 0) ((float*)(p.ws + WS_SSQO))[(size_t)(b * S + sq) * 16 + (ocol >> 6)] = ss;
        }
        unsigned short* orow = O + (size_t)(b * S + sq) * D + ocol + 4 * hi;
#pragma unroll
        for (int g = 0; g < 4; ++g) {
            *(unsigned long long*)(orow + 8 * g) = (unsigned long long)cvtpk(o0[4 * g] * il, o0[4 * g + 1] * il) | ((unsigned long long)cvtpk(o0[4 * g + 2] * il, o0[4 * g + 3] * il) << 32);
            *(unsigned long long*)(orow + 32 + 8 * g) = (unsigned long long)cvtpk(o1[4 * g] * il, o1[4 * g + 1] * il) | ((unsigned long long)cvtpk(o1[4 * g + 2] * il, o1[4 * g + 3] * il) << 32);
        }
    }
}

__device__ __forceinline__ int kmax(int a, int b) { return __builtin_bit_cast(int, __builtin_fmaxf(__builtin_bit_cast(float, a), __builtin_bit_cast(float, b))); }
__device__ __forceinline__ int kmin(int a, int b) { return __builtin_bit_cast(int, __builtin_fminf(__builtin_bit_cast(float, a), __builtin_bit_cast(float, b))); }
__device__ __forceinline__ void ce_desc(int& a, int& b) { const int hi = kmax(a, b), lo = kmin(a, b); a = hi; b = lo; }
__device__ __forceinline__ void ce_asc(int& a, int& b) { const int hi = kmax(a, b), lo = kmin(a, b); a = lo; b = hi; }
template <int OFF> __device__ __forceinline__ void sort16_desc(int (&a)[32]) {
#define CE_(i_, j_) ce_desc(a[OFF + (i_)], a[OFF + (j_)]);
    CE_(0,13) CE_(1,12) CE_(2,15) CE_(3,14) CE_(4,8) CE_(5,6) CE_(7,11) CE_(9,10)
    CE_(0,5) CE_(1,7) CE_(2,9) CE_(3,4) CE_(6,13) CE_(8,14) CE_(10,15) CE_(11,12)
    CE_(0,1) CE_(2,3) CE_(4,5) CE_(6,8) CE_(7,9) CE_(10,11) CE_(12,13) CE_(14,15)
    CE_(0,2) CE_(1,3) CE_(4,10) CE_(5,11) CE_(6,7) CE_(8,9) CE_(12,14) CE_(13,15)
    CE_(1,2) CE_(3,12) CE_(4,6) CE_(5,7) CE_(8,10) CE_(9,11) CE_(13,14)
    CE_(1,4) CE_(2,6) CE_(5,8) CE_(7,10) CE_(9,13) CE_(11,14)
    CE_(2,4) CE_(3,6) CE_(9,12) CE_(11,13)
    CE_(3,5) CE_(6,8) CE_(7,9) CE_(10,12)
    CE_(3,4) CE_(5,6) CE_(7,8) CE_(9,10) CE_(11,12)
    CE_(6,7) CE_(8,9)
#undef CE_
}
template <int N, int OFF> __device__ __forceinline__ void bitonic_sort_desc(int (&a)[32]) {
#pragma unroll
    for (int k = 2; k <= N; k <<= 1)
#pragma unroll
        for (int j = k >> 1; j > 0; j >>= 1)
#pragma unroll
            for (int i = 0; i < N; ++i) {
                const int l = i ^ j;
                if (l > i) { if ((i & k) == 0) ce_desc(a[OFF + i], a[OFF + l]); else ce_asc(a[OFF + i], a[OFF + l]); }
            }
}
__device__ __forceinline__ void bitonic_clean16_desc(int (&a)[32]) {
#pragma unroll
    for (int j = 8; j > 0; j >>= 1)
#pragma unroll
        for (int i = 0; i < 16; ++i) { const int l = i ^ j; if (l > i) ce_desc(a[i], a[l]); }
}
__device__ __forceinline__ int f2sortable(float f) { return __builtin_bit_cast(int, f); }
__device__ __forceinline__ float sortable2f(int s) { return __builtin_bit_cast(float, s); }
constexpr int KEY_LOWEST = (int)0xff800000;
struct CandTab { int i[52], j[52]; };
constexpr CandTab make_cands() { CandTab t{}; int n = 0; for (int i = 0; i < 16; ++i) for (int j = 0; j < 16; ++j) if ((i + 1) * (j + 1) <= 16) { t.i[n] = i; t.j[n] = j; ++n; } for (; n < 52; ++n) { t.i[n] = -1; t.j[n] = -1; } return t; }
constexpr CandTab CANDS = make_cands();
struct EpiTopkSel {
    static constexpr bool HAS_MID = false, HAS_LATE = false;
    __device__ __forceinline__ void late(int, int, int) {}
    __device__ __forceinline__ void pre(int, int) {}
    template <class A> __device__ __forceinline__ void mid(A&) {}
    unsigned short* idx; float* g;
    int* keepg;
    __device__ __forceinline__ void operator()(const f32x4 (&acc)[8][2], int pb, int qb, int lane, const float*, int hp, int half) {
        const int fr = lane & 15, fq = lane >> 4;
#pragma unroll
        for (int j = 0; j < 2; ++j) {
            int v[32];
#pragma unroll
            for (int i = 0; i < 8; ++i)
#pragma unroll
                for (int r = 0; r < 4; ++r) v[i * 4 + r] = (f2sortable(acc[i][j][r]) & ~127) | (i * 16 + fq * 4 + r);
            sort16_desc<0>(v); sort16_desc<16>(v);
#pragma unroll
            for (int i = 0; i < 16; ++i) v[i] = kmax(v[i], v[31 - i]);
            bitonic_clean16_desc(v);
#pragma unroll
            for (int x = 16; x <= 32; x <<= 1) {
#pragma unroll
                for (int i = 0; i < 16; ++i) v[16 + i] = __shfl_xor(v[i], x);
#pragma unroll
                for (int i = 0; i < 16; ++i) v[i] = kmax(v[i], v[31 - i]);
                bitonic_clean16_desc(v);
            }
            u32x4* kp = (u32x4*)(keepg + ((qb & 255) + j * 16 + fr) * 16);
            if (half == 0) {
                if (fq == 0) {
#pragma unroll
                    for (int i = 0; i < 4; ++i) kp[i] = (u32x4){(unsigned)v[4 * i], (unsigned)v[4 * i + 1], (unsigned)v[4 * i + 2], (unsigned)v[4 * i + 3]};
                }
            } else {
                float as[16], bs[16]; int ai[16], bi[16];
#pragma unroll
                for (int i = 0; i < 4; ++i) {
                    const u32x4 kv = kp[i];
#pragma unroll
                    for (int c = 0; c < 4; ++c) { as[4 * i + c] = sortable2f((int)kv[c] & ~127); ai[4 * i + c] = ((int)kv[c] & 127) << 7; }
                }
#pragma unroll
                for (int i = 0; i < 16; ++i) { bs[i] = sortable2f(v[i] & ~127); bi[i] = v[i] & 127; }
                int w[32];
#pragma unroll
                for (int sl = 0; sl < 13; ++sl) {
                    int c4[4];
#pragma unroll
                    for (int f = 0; f < 4; ++f) {
                        constexpr int dummy = 0; (void)dummy;
                        const int ci = CANDS.i[sl * 4 + f], cj = CANDS.j[sl * 4 + f];
                        c4[f] = (ci >= 0) ? ((f2sortable(as[ci >= 0 ? ci : 0] + bs[cj >= 0 ? cj : 0]) & ~0x3fff) | (ai[ci >= 0 ? ci : 0] | bi[cj >= 0 ? cj : 0])) : KEY_LOWEST;
                    }
                    w[sl] = (fq == 0) ? c4[0] : (fq == 1) ? c4[1] : (fq == 2) ? c4[2] : c4[3];
                }
                w[13] = w[14] = w[15] = KEY_LOWEST;
                sort16_desc<0>(w);
#pragma unroll
                for (int x = 16; x <= 32; x <<= 1) {
#pragma unroll
                    for (int i = 0; i < 16; ++i) w[16 + i] = __shfl_xor(w[i], x);
#pragma unroll
                    for (int i = 0; i < 16; ++i) w[i] = kmax(w[i], w[31 - i]);
                    bitonic_clean16_desc(w);
                }
                int my[4];
#pragma unroll
                for (int c = 0; c < 4; ++c) my[c] = (fq == 0) ? w[c] : (fq == 1) ? w[4 + c] : (fq == 2) ? w[8 + c] : w[12 + c];
                const float top = sortable2f(w[0] & ~0x3fff);
                float e[4], part = 0.f;
#pragma unroll
                for (int c = 0; c < 4; ++c) { e[c] = __expf(sortable2f(my[c] & ~0x3fff) - top); part += e[c]; }
                part += __shfl_xor(part, 16); part += __shfl_xor(part, 32);
                const float inv = 1.f / part;
                const int t = qb + j * 16 + fr;
                const size_t o = (size_t)t * 128 + (hp >> 1) * 16 + fq * 4;
                *(unsigned long long*)(idx + o) = (unsigned long long)(unsigned)((my[0] & 0x3fff) | ((my[1] & 0x3fff) << 16)) | ((unsigned long long)(unsigned)((my[2] & 0x3fff) | ((my[3] & 0x3fff) << 16)) << 32);
                *(f32x4*)(g + o) = (f32x4){e[0] * inv, e[1] * inv, e[2] * inv, e[3] * inv};
            }
        }
    }
};
__device__ void gemm_pq_fused(const Params& p, unsigned char* lds) {
    const unsigned short* X = (const unsigned short*)(p.ws + WS_WPQ);
    const unsigned short* Y = (const unsigned short*)(p.ws + WS_HB);
    const unsigned short* SK = (const unsigned short*)(p.ws + WS_SUBK);
    const float* ssq1 = (const float*)(p.ws + WS_SSQ1); const float* bias = (const float*)(p.ws + WS_BPQ);
    EpiTopkSel tsel{(unsigned short*)(p.ws + WS_IDX), (float*)(p.ws + WS_G), (int*)(p.ws + WS_KEEP) + (size_t)blockIdx.x * 4096};
    const int tid = threadIdx.x, lane = tid & 63, wave = __builtin_amdgcn_readfirstlane(tid >> 6);
    const int wp = wave >> 2, wq = wave & 3, fr = lane & 15, fq = lane >> 4;
    const int G = gridDim.x, bx = blockIdx.x;
    const int vcu = (G % 8 == 0) ? (bx % 8) * (G / 8) + bx / 8 : bx;
    const int srow = wave * 8 + (lane >> 3), pc = lane & 7, lc = pc ^ ((srow >> 1) & 7);
    constexpr int nk = D / TBK, nunits = 8 * (T / TQ);
    for (int u = vcu; u < nunits; u += G) {
        const int qt = u >> 3, h = u & 7, q0 = qt * TQ;
#pragma unroll
        for (int sub = 0; sub < 2; ++sub) {
            const int hp = h * 2 + sub, p0 = hp * TP;
            f32x4 acc[4][4];
#pragma unroll
            for (int i = 0; i < 4; ++i)
#pragma unroll
                for (int j = 0; j < 4; ++j) acc[i][j] = (f32x4){0.f, 0.f, 0.f, 0.f};
            const unsigned short* xg = X + (size_t)(p0 + srow) * D + lc * 8;
            const unsigned short* yg = Y + (size_t)(q0 + srow) * D + lc * 8;
            asm volatile("s_waitcnt vmcnt(0)" ::: "memory");
            RAW_BARRIER();
#define PQ_DMA_TILE(kt_, stg_) do { \
                unsigned char* _b = lds + (stg_) * STG_BYTES + wave * 1024; const int _k = (kt_) * TBK; \
                _Pragma("unroll") for (int _i = 0; _i < 2; ++_i) __builtin_amdgcn_global_load_lds((const unsigned*)(xg + (size_t)(64 * _i) * D + _k), (unsigned*)(_b + _i * 8192), 16, 0, 0); \
                _Pragma("unroll") for (int _i = 0; _i < 4; ++_i) __builtin_amdgcn_global_load_lds((const unsigned*)(yg + (size_t)(64 * _i) * D + _k), (unsigned*)(_b + XS_BYTES + _i * 8192), 16, 0, 0); \
            } while (0)
            PQ_DMA_TILE(0, 0);
            PQ_DMA_TILE(1, 1);
            int cur = 0;
            for (int kt = 0; kt < nk; ++kt) {
                if (kt + 1 < nk) asm volatile("s_waitcnt vmcnt(6)" ::: "memory"); else asm volatile("s_waitcnt vmcnt(0)" ::: "memory");
                RAW_BARRIER();
                if (kt + 2 < nk) { const int nxt = (cur == 0) ? 2 : cur - 1; PQ_DMA_TILE(kt + 2, nxt); }
                const unsigned char* st = lds + cur * STG_BYTES;
#pragma unroll
                for (int kk = 0; kk < 2; ++kk) {
                    bf16x8 af[4], bfr[4];
#pragma unroll
                    for (int i = 0; i < 4; ++i) af[i] = *(const bf16x8*)(st + swz(wp * 64 + i * 16 + fr, kk * 4 + fq));
#pragma unroll
                    for (int j = 0; j < 4; ++j) bfr[j] = *(const bf16x8*)(st + XS_BYTES + swz(wq * 64 + j * 16 + fr, kk * 4 + fq));
#pragma unroll
                    for (int i = 0; i < 4; ++i)
#pragma unroll
                        for (int j = 0; j < 4; ++j) acc[i][j] = __builtin_amdgcn_mfma_f32_16x16x32_bf16(af[i], bfr[j], acc[i][j], 0, 0, 0);
                }
                cur = (cur == 2) ? 0 : cur + 1;
            }
#undef PQ_DMA_TILE
            RAW_BARRIER();
            {
                float r1[4]; f32x4 bv[4];
#pragma unroll
                for (int j = 0; j < 4; ++j) {
                    const f32x4* s4 = (const f32x4*)(ssq1 + (size_t)(q0 + wq * 64 + j * 16 + fr) * 16);
                    const f32x4 a0 = s4[0], a1 = s4[1], a2 = s4[2], a3 = s4[3];
                    r1[j] = rsqrtf((((a0.x + a0.y + a0.z + a0.w) + (a1.x + a1.y + a1.z + a1.w)) + ((a2.x + a2.y + a2.z + a2.w) + (a3.x + a3.y + a3.z + a3.w))) * (1.f / D) + EPS);
                }
                {
                    const float* bt = bias + (q0 >> 12) * 2048 + p0 + wp * 64 + fq * 4;
#pragma unroll
                    for (int i = 0; i < 4; ++i) bv[i] = *(const f32x4*)(bt + i * 16);
                }
                const unsigned short* kg = SK + (size_t)hp * 128 * 128 + (size_t)srow * 128 + lc * 8;
#pragma unroll
                for (int s2 = 0; s2 < 2; ++s2)
#pragma unroll
                    for (int i = 0; i < 2; ++i) __builtin_amdgcn_global_load_lds((const unsigned*)(kg + (size_t)(64 * i) * 128 + s2 * 64), (unsigned*)(lds + s2 * STG_BYTES + wave * 1024 + i * 8192), 16, 0, 0);
                unsigned char* yb = lds + wp * STG_BYTES + XS_BYTES + (fq & 1) * 8;
#pragma unroll
                for (int j = 0; j < 4; ++j)
#pragma unroll
                    for (int i = 0; i < 4; ++i)
                        *(unsigned long long*)(yb + swz(wq * 64 + j * 16 + fr, 2 * i + (fq >> 1))) =
                            pk4(acc[i][j].x * r1[j] + bv[i].x, acc[i][j].y * r1[j] + bv[i].y, acc[i][j].z * r1[j] + bv[i].z, acc[i][j].w * r1[j] + bv[i].w);
            }
            asm volatile("s_waitcnt vmcnt(0)" ::: "memory");
            RAW_BARRIER();
            f32x4 sc2[8][2];
#pragma unroll
            for (int i = 0; i < 8; ++i)
#pragma unroll
                for (int j = 0; j < 2; ++j) sc2[i][j] = (f32x4){0.f, 0.f, 0.f, 0.f};
#pragma unroll
            for (int s2 = 0; s2 < 2; ++s2) {
                const unsigned char* st = lds + s2 * STG_BYTES;
#pragma unroll
                for (int kk = 0; kk < 2; ++kk) {
                    bf16x8 af[8], bfr[2];
#pragma unroll
                    for (int i = 0; i < 8; ++i) af[i] = *(const bf16x8*)(st + swz(i * 16 + fr, kk * 4 + fq));
#pragma unroll
                    for (int j = 0; j < 2; ++j) bfr[j] = *(const bf16x8*)(st + XS_BYTES + swz(wave * 32 + j * 16 + fr, kk * 4 + fq));
#pragma unroll
                    for (int i = 0; i < 8; ++i)
#pragma unroll
                        for (int j = 0; j < 2; ++j) sc2[i][j] = __builtin_amdgcn_mfma_f32_16x16x32_bf16(af[i], bfr[j], sc2[i][j], 0, 0, 0);
                }
            }
            tsel(sc2, 0, q0 + wave * 32, lane, (const float*)nullptr, hp, sub);
        }
    }
}

__device__ __forceinline__ int rd_lane_i(int v, int l) { return __builtin_amdgcn_readlane(v, l); }
__device__ __forceinline__ float rd_lane_f(float v, int l) { return __builtin_bit_cast(float, __builtin_amdgcn_readlane(__builtin_bit_cast(int, v), l)); }
__device__ void stage_peer_u(const Params& p) {
    const unsigned short* h2 = (const unsigned short*)(p.ws + WS_HB);
    const float* mod = (const float*)(p.ws + WS_MOD);
    const unsigned short* idx = (const unsigned short*)(p.ws + WS_IDX); float* g = (float*)(p.ws + WS_G);
    const unsigned char* eu8 = p.ws + WS_EU8;
    const float* us = (const float*)(p.ws + WS_US);
    const int tid_ = tid_opaque(); const int lane = tid_ & 63, wave = tid_ >> 6;
    for (int t = blockIdx.x * NWAVES + wave; t < T; t += gridDim.x * NWAVES) {
        const int b = t >> 12;
        f32x2 hq[8];
        {
            const float rstd1 = rsqrtf(group16_sum(((const float*)(p.ws + WS_SSQ1))[(size_t)t * 16 + (lane & 15)]) * (1.f / D) + EPS);
            const float* shf = mod + b * NMOD + 3 * D + lane * 16;
            const u32x4 w0 = *(const u32x4*)(h2 + (size_t)t * D + lane * 16), w1 = *(const u32x4*)(h2 + (size_t)t * D + lane * 16 + 8);
            const f32x4 s0 = *(const f32x4*)(shf), s1 = *(const f32x4*)(shf + 4), s2 = *(const f32x4*)(shf + 8), s3 = *(const f32x4*)(shf + 12);
            hq[0] = (f32x2){bflo(w0.x) * rstd1 + s0.x, bfhi(w0.x) * rstd1 + s0.y}; hq[1] = (f32x2){bflo(w0.y) * rstd1 + s0.z, bfhi(w0.y) * rstd1 + s0.w};
            hq[2] = (f32x2){bflo(w0.z) * rstd1 + s1.x, bfhi(w0.z) * rstd1 + s1.y}; hq[3] = (f32x2){bflo(w0.w) * rstd1 + s1.z, bfhi(w0.w) * rstd1 + s1.w};
            hq[4] = (f32x2){bflo(w1.x) * rstd1 + s2.x, bfhi(w1.x) * rstd1 + s2.y}; hq[5] = (f32x2){bflo(w1.y) * rstd1 + s2.z, bfhi(w1.y) * rstd1 + s2.w};
            hq[6] = (f32x2){bflo(w1.z) * rstd1 + s3.x, bfhi(w1.z) * rstd1 + s3.y}; hq[7] = (f32x2){bflo(w1.w) * rstd1 + s3.z, bfhi(w1.w) * rstd1 + s3.w};
        }
        const int idv0 = idx[(size_t)t * 128 + lane], idv1 = idx[(size_t)t * 128 + 64 + lane];
        float wv0 = 0.f, wv1 = 0.f;
        u32x4 cur[8], nxt[8];
#pragma unroll
        for (int i = 0; i < 8; ++i) cur[i] = *(const u32x4*)(eu8 + (size_t)rd_lane_i(idv0, i) * D + lane * 16);
#pragma unroll 2
        for (int b8 = 0; b8 < 16; ++b8) {
            const int bn = (b8 + 1 < 16) ? b8 + 1 : b8;
#pragma unroll
            for (int i = 0; i < 8; ++i) { const int r = bn * 8 + i; nxt[i] = *(const u32x4*)(eu8 + (size_t)rd_lane_i((bn < 8) ? idv0 : idv1, r & 63) * D + lane * 16); }
            float pr[8];
#pragma unroll
            for (int i = 0; i < 8; ++i) {
                f32x2 a = {0.f, 0.f}, c2 = {0.f, 0.f};
#pragma unroll
                for (int c = 0; c < 4; ++c) {
                    const f32x2 lo = __builtin_amdgcn_cvt_pk_f32_fp8((int)cur[i][c], false), hi = __builtin_amdgcn_cvt_pk_f32_fp8((int)cur[i][c], true);
                    a += lo * hq[2 * c]; c2 += hi * hq[2 * c + 1];
                }
                a += c2; pr[i] = a.x + a.y;
            }
            float x4[4], x2[2], x1;
            const bool b5 = (lane & 32) != 0, b4 = (lane & 16) != 0, b3 = (lane & 8) != 0;
#pragma unroll
            for (int i = 0; i < 4; ++i) { const float keep = b5 ? pr[i + 4] : pr[i], give = b5 ? pr[i] : pr[i + 4]; x4[i] = keep + __shfl_xor(give, 32); }
#pragma unroll
            for (int i = 0; i < 2; ++i) { const float keep = b4 ? x4[i + 2] : x4[i], give = b4 ? x4[i] : x4[i + 2]; x2[i] = keep + __shfl_xor(give, 16); }
            { const float keep = b3 ? x2[1] : x2[0], give = b3 ? x2[0] : x2[1]; x1 = keep + __shfl_xor(give, 8); }
            x1 += __shfl_xor(x1, 4); x1 += __shfl_xor(x1, 2); x1 += __shfl_xor(x1, 1);
            const float st = __shfl(x1, (lane & 7) * 8);
            const bool mine = (lane >> 3) == (b8 & 7);
            if (b8 < 8) wv0 = mine ? st : wv0; else wv1 = mine ? st : wv1;
#pragma unroll
            for (int i = 0; i < 8; ++i) cur[i] = nxt[i];
        }
        {
            const float s0 = wv0 * us[idv0], s1 = wv1 * us[idv1];
            const float gv0 = g[(size_t)t * 128 + lane], gv1 = g[(size_t)t * 128 + 64 + lane];
            wv0 = gv0 * (0.5f * s0 * (1.f + erff(s0 * 0.70710678118654752f)));
            wv1 = gv1 * (0.5f * s1 * (1.f + erff(s1 * 0.70710678118654752f)));
        }
        { float* wdst = (float*)(p.ws + WS_W); wdst[(size_t)t * 128 + lane] = wv0; wdst[(size_t)t * 128 + 64 + lane] = wv1; }
    }
}
__device__ void stage_peer_v(const Params& p, float* outp) {
    const float* mod = (const float*)(p.ws + WS_MOD);
    const unsigned short* idx = (const unsigned short*)(p.ws + WS_IDX); const float* g = (const float*)(p.ws + WS_W);
    const unsigned char* ev8 = p.ws + WS_EV8;
    const float* vs = (const float*)(p.ws + WS_VS);
    const int tid_ = tid_opaque(); const int lane = tid_ & 63, wave = tid_ >> 6;
    for (int t = blockIdx.x * NWAVES + wave; t < T; t += gridDim.x * NWAVES) {
        const int b = t >> 12;
        const int idv0 = idx[(size_t)t * 128 + lane], idv1 = idx[(size_t)t * 128 + 64 + lane];
        const float wv0 = g[(size_t)t * 128 + lane] * vs[idv0], wv1 = g[(size_t)t * 128 + 64 + lane] * vs[idv1];
        f32x2 acc[8];
#pragma unroll
        for (int i = 0; i < 8; ++i) acc[i] = (f32x2){0.f, 0.f};
        u32x4 cur[8], nxt[8];
#pragma unroll
        for (int i = 0; i < 8; ++i) cur[i] = *(const u32x4*)(ev8 + (size_t)rd_lane_i(idv0, i) * D + lane * 16);
#pragma unroll 2
        for (int b8 = 0; b8 < 16; ++b8) {
            const int bn = (b8 + 1 < 16) ? b8 + 1 : b8;
#pragma unroll
            for (int i = 0; i < 8; ++i) { const int r = bn * 8 + i; nxt[i] = *(const u32x4*)(ev8 + (size_t)rd_lane_i((bn < 8) ? idv0 : idv1, r & 63) * D + lane * 16); }
#pragma unroll
            for (int i = 0; i < 8; ++i) {
                const int r = b8 * 8 + i;
                const float wr = rd_lane_f((b8 < 8) ? wv0 : wv1, r & 63);
                const f32x2 w2 = {wr, wr};
#pragma unroll
                for (int c = 0; c < 4; ++c) {
                    const f32x2 lo = __builtin_amdgcn_cvt_pk_f32_fp8((int)cur[i][c], false), hi = __builtin_amdgcn_cvt_pk_f32_fp8((int)cur[i][c], true);
                    acc[2 * c] += w2 * lo; acc[2 * c + 1] += w2 * hi;
                }
            }
#pragma unroll
            for (int i = 0; i < 8; ++i) cur[i] = nxt[i];
        }
        const int eoff = lane * 16;
        const float* xin = p.out + (size_t)t * D + eoff;
        float* xr = outp + (size_t)t * D + eoff;
        const float* gf = mod + b * NMOD + 5 * D + eoff;
        float sel[16];
        float ss = 0.f;
#pragma unroll
        for (int c = 0; c < 4; ++c) {
            const f32x4 x1 = *(const f32x4*)(xin + c * 4); const f32x4 gg = *(const f32x4*)(gf + c * 4);
            sel[c * 4 + 0] = x1.x + gg.x * acc[2 * c].x; sel[c * 4 + 1] = x1.y + gg.y * acc[2 * c].y;
            sel[c * 4 + 2] = x1.z + gg.z * acc[2 * c + 1].x; sel[c * 4 + 3] = x1.w + gg.w * acc[2 * c + 1].y;
            ss += sel[c * 4 + 0] * sel[c * 4 + 0] + sel[c * 4 + 1] * sel[c * 4 + 1] + sel[c * 4 + 2] * sel[c * 4 + 2] + sel[c * 4 + 3] * sel[c * 4 + 3];
        }
        const float rstd = rsqrtf(wave_sum(ss) * (1.f / D) + EPS);
#pragma unroll
        for (int c = 0; c < 4; ++c) {
            const f32x4 fn = *(const f32x4*)(p.fnorm + eoff + c * 4);
            f32x4 r; r.x = sel[c * 4 + 0] * rstd * fn.x; r.y = sel[c * 4 + 1] * rstd * fn.y; r.z = sel[c * 4 + 2] * rstd * fn.z; r.w = sel[c * 4 + 3] * rstd * fn.w;
            *(f32x4*)(xr + c * 4) = r;
        }
    }
}

#define LAS __attribute__((address_space(3)))
constexpr size_t WS_BAR = 3 * MiB;
constexpr int BAR_BYTES = 16384;
constexpr int LDS_MISC_OFF = 147456;
#define XB_TMO      128
#define XB_XCNT(j)  (256  + 64 * (j))
#define XB_XSUB(j)  (1280 + 64 * (j))
#define XB_XGEN(j)  (2304 + 64 * (j))
#define XB_TOP      3328
#define XB_TOPGEN   3392
#define XB_SPIN_CAP (1u << 18)
__device__ __forceinline__ unsigned xb_ld(unsigned* p)              { return __hip_atomic_load(p, __ATOMIC_RELAXED, __HIP_MEMORY_SCOPE_AGENT); }
__device__ __forceinline__ unsigned xb_add(unsigned* p, unsigned v) { return __hip_atomic_fetch_add(p, v, __ATOMIC_RELAXED, __HIP_MEMORY_SCOPE_AGENT); }
__device__ __forceinline__ unsigned xb_xcc_id() { return (unsigned)__builtin_amdgcn_s_getreg((3 << 11) | 20) & 0xFu; }
#define XB_SPIN(cond, bar) do { unsigned _sp = 0; while (cond) { __builtin_amdgcn_s_sleep(1); \
    if ((++_sp & 255u) == 0u) { if (xb_ld(&(bar)[XB_TMO])) break; if (_sp > XB_SPIN_CAP) { atomicAdd(&(bar)[XB_TMO], 1u); break; } } } } while (0)
struct XcdBarrier { unsigned* bar; unsigned x; volatile LAS unsigned* st; };
__device__ __forceinline__ XcdBarrier xcd_barrier_post(unsigned* bar, volatile LAS unsigned* st) {
    XcdBarrier b; b.bar = bar; b.x = xb_xcc_id(); b.st = st;
    if (threadIdx.x == 0) (void)xb_add(&bar[XB_XCNT(b.x)], 1u);
    return b;
}
__device__ __forceinline__ void xcd_barrier_complete(unsigned* bar, unsigned x, unsigned& nloc, unsigned& nx) {
    const unsigned G = gridDim.x * gridDim.y * gridDim.z;
    unsigned sum, cnt, mine, sp = 0u;
    for (;;) {
        sum = 0u; cnt = 0u; mine = 0u;
#pragma unroll
        for (unsigned j = 0; j < 16; ++j) { const unsigned c = xb_ld(&bar[XB_XCNT(j)]); sum += c; cnt += (c > 0u) ? 1u : 0u; mine = (j == x) ? c : mine; }
        if (sum == G) break;
        __builtin_amdgcn_s_sleep(1);
        if ((++sp & 255u) == 0u) { if (xb_ld(&bar[XB_TMO])) break; if (sp > XB_SPIN_CAP) { atomicAdd(&bar[XB_TMO], 1u); break; } }
    }
    nloc = mine > 0u ? mine : 1u; nx = cnt > 0u ? cnt : 1u;
}
__device__ __forceinline__ void xcd_barrier(const XcdBarrier& b) {
    asm volatile("s_waitcnt vmcnt(0)" ::: "memory");
    __syncthreads();
    if (threadIdx.x == 0) {
        unsigned* bar = b.bar;
        __builtin_amdgcn_s_waitcnt(0);
        unsigned nloc = b.st[0], nx = b.st[1];
        if (nloc == 0u) { xcd_barrier_complete(bar, b.x, nloc, nx); b.st[0] = nloc; b.st[1] = nx; }
        const unsigned old = xb_add(&bar[XB_XSUB(b.x)], 1u);
        const unsigned gen = old / nloc;
        if (old + 1u == (gen + 1u) * nloc) {
            __builtin_amdgcn_fence(__ATOMIC_RELEASE, "agent");
            asm volatile("s_waitcnt vmcnt(0)" ::: "memory");
            const unsigned og = xb_add(&bar[XB_TOP], 1u);
            const unsigned tg = og / nx;
            if (og + 1u == (tg + 1u) * nx) xb_add(&bar[XB_TOPGEN], 1u);
            else XB_SPIN(xb_ld(&bar[XB_TOPGEN]) == tg, bar);
            __builtin_amdgcn_fence(__ATOMIC_ACQUIRE, "agent");
            xb_add(&bar[XB_XGEN(b.x)], 1u);
            asm volatile("s_waitcnt vmcnt(0)" ::: "memory");
        } else {
            XB_SPIN(xb_ld(&bar[XB_XGEN(b.x)]) == gen, bar);
            __builtin_amdgcn_fence(__ATOMIC_ACQUIRE, "agent");
            asm volatile("s_waitcnt vmcnt(0)" ::: "memory");
        }
    }
    __syncthreads();
}

__global__ void __launch_bounds__(NTHREADS) fwd_megakernel(Params p) {
    extern __shared__ __attribute__((aligned(16))) unsigned char lds_raw[];
    cg::grid_group grid = cg::this_grid();
    unsigned short* hb = (unsigned short*)(p.ws + WS_HB);
    const float* mod = (const float*)(p.ws + WS_MOD);
    typedef const unsigned short* cbf;

    volatile LAS unsigned* bst = (volatile LAS unsigned*)((LAS unsigned char*)lds_raw + LDS_MISC_OFF);
    if (threadIdx.x < 2) bst[threadIdx.x] = 0u;
    __syncthreads();
    const XcdBarrier xbar = xcd_barrier_post((unsigned*)(p.ws + WS_BAR), bst);
    stage_prologue(p, (float*)lds_raw);
    if (p.ws == nullptr) grid.sync();
    xcd_barrier(xbar);
    stage_norm_mod<true>(p, p.x, hb, 0 * D, 1 * D);
    stage_gemv8(mod + 3 * D, NMOD, false, p.w_pq, 2048, nullptr, (float*)(p.ws + WS_BPQ), (float*)lds_raw);
    xcd_barrier(xbar);
    gemm_dma<2, 1>((cbf)(p.ws + WS_WIN), D, hb, D, 1280, T, D, 1, 0, 0, lds_raw, EpiProj{p.ws});
    xcd_barrier(xbar);
    gemm_xyT<2, true>((cbf)(p.ws + WS_WQUP), 256, (cbf)(p.ws + WS_QL), 256, 768, T, 256, 1, 0, 0, lds_raw, EpiQup{p.ws});
    gemm_xyT<2, true>((cbf)(p.ws + WS_WKVUP), 128, (cbf)(p.ws + WS_KVL), 128, 1024, T, 128, 1, 0, 0, lds_raw, EpiKVup{p.ws});
    xcd_barrier(xbar);
    stage_attn_flash<64, true>(p, lds_raw);
    stage_attn_flash<96, false>(p, lds_raw);
    xcd_barrier(xbar);
    gemm_dma<2, 1>((cbf)(p.ws + WS_WOUT), D, (cbf)(p.ws + WS_OAB), D, D, T, D, 1, 0, 0, lds_raw,
                   EpiOutProj{p.x, mod, p.out, hb, (const float*)(p.ws + WS_SSQO), (float*)(p.ws + WS_SSQ1), {}, {}, {}});
    xcd_barrier(xbar);
    gemm_pq_fused(p, lds_raw);
    xcd_barrier(xbar);
    stage_peer_u(p);
    xcd_barrier(xbar);
    stage_peer_v(p, p.out);
}

extern "C" void kernel_launch(void* const* d_in, const int* in_sizes, int n_in, void* d_out, int out_size, void* d_ws, size_t ws_size, hipStream_t stream) {
    static int grid_blocks = 0;
    if (grid_blocks == 0) {
        if (n_in != 18 || in_sizes[0] != T * D || out_size != T * D || ws_size < WS_END) {
            fprintf(stderr, "kernel_launch: unexpected shapes (n_in %d, in0 %d, out %d, ws %zu); nothing launched\n", n_in, n_in > 0 ? in_sizes[0] : -1, out_size, ws_size);
            grid_blocks = -1; return;
        }
        int dev = 0, cus = 0, per_cu = 0;
        (void)hipGetDevice(&dev);
        (void)hipDeviceGetAttribute(&cus, hipDeviceAttributeMultiprocessorCount, dev);
        if (hipFuncSetAttribute((const void*)fwd_megakernel, hipFuncAttributeMaxDynamicSharedMemorySize, LDS_BYTES) != hipSuccess) { fprintf(stderr, "kernel_launch: hipFuncSetAttribute failed\n"); grid_blocks = -1; return; }
        (void)hipOccupancyMaxActiveBlocksPerMultiprocessor(&per_cu, fwd_megakernel, NTHREADS, LDS_BYTES);
        if (per_cu < 1) { fprintf(stderr, "kernel_launch: occupancy query says %d blocks/CU\n", per_cu); grid_blocks = -1; return; }
        grid_blocks = cus < 256 ? cus : 256;
    }
    if (grid_blocks < 0) return;
    Params p{};
    p.x = (const float*)d_in[0]; p.c = (const float*)d_in[1]; p.w_ada = (const float*)d_in[2]; p.b_ada = (const float*)d_in[3];
    p.w_in = (const float*)d_in[4]; p.sink = (const float*)d_in[5]; p.qnorm = (const float*)d_in[6]; p.w_qup = (const float*)d_in[7];
    p.kvnorm = (const float*)d_in[8]; p.w_kvup = (const float*)d_in[9]; p.onorm_a = (const float*)d_in[10]; p.onorm_b = (const float*)d_in[11];
    p.w_out = (const float*)d_in[12]; p.w_pq = (const float*)d_in[13]; p.subk = (const float*)d_in[14]; p.eu = (const float*)d_in[15];
    p.ev = (const float*)d_in[16]; p.fnorm = (const float*)d_in[17];
    p.out = (float*)d_out; p.ws = (unsigned char*)d_ws;
    if (hipMemsetAsync((char*)d_ws + WS_BAR, 0, BAR_BYTES, stream) != hipSuccess) { fprintf(stderr, "kernel_launch: hipMemsetAsync failed\n"); return; }
    void* args[] = {&p};
    hipError_t e = hipLaunchCooperativeKernel((void*)fwd_megakernel, dim3(grid_blocks), dim3(NTHREADS), args, LDS_BYTES, stream);
    if (e != hipSuccess) fprintf(stderr, "cooperative launch failed: %s (grid %d)\n", hipGetErrorString(e), grid_blocks);
}
```

```cpp
#include <hip/hip_runtime.h>
#include <hip/hip_cooperative_groups.h>
#include <cstdio>
#include <cstdint>
namespace cg = cooperative_groups;

constexpr int Bsz = 8, S = 4096, D = 1024, T = Bsz * S;
constexpr int INW = 1184;
constexpr int C_QA = 0, C_KA = 512, C_VA = 640, C_QL = 768, C_KVL = 1024, C_KR = 1152;
constexpr int NMOD = 6 * D;
constexpr float EPS = 1e-6f;
constexpr float LOG2E = 1.4426950408889634f;
constexpr float QA_SCALE = 0.125f * LOG2E;
constexpr float QM_SCALE = 0.10206207261596575f * LOG2E;
constexpr int NTHREADS = 512, NWAVES = 8;

constexpr size_t MiB = 1u << 20;
constexpr size_t WS_MOD = 0;
constexpr size_t WS_COSA = 1 * MiB;
constexpr size_t WS_SINA = WS_COSA + 512 * 1024;
constexpr size_t WS_COSB = 2 * MiB;
constexpr size_t WS_SINB = WS_COSB + 256 * 1024;
constexpr size_t WS_WIN = 4 * MiB;
constexpr size_t WS_WQUP = 7 * MiB;
constexpr size_t WS_WKVUP = 7 * MiB + 512 * 1024;
constexpr size_t WS_WOUT = 8 * MiB;
constexpr size_t WS_WPQ = 10 * MiB;
constexpr size_t WS_SUBK = 14 * MiB;
constexpr size_t WS_EU8 = 16 * MiB;
constexpr size_t WS_EV8 = 32 * MiB;
constexpr size_t WS_US = 48 * MiB;
constexpr size_t WS_VS = WS_US + 64 * 1024;
constexpr size_t WS_HB = 52 * MiB;
constexpr size_t WS_QA = 116 * MiB;
constexpr size_t WS_KA = 148 * MiB;
constexpr size_t WS_VAT = 156 * MiB;
constexpr size_t WS_QL = 164 * MiB;
constexpr size_t WS_KVL = 180 * MiB;
constexpr size_t WS_QMB = 192 * MiB;
constexpr size_t WS_K96 = 240 * MiB;
constexpr size_t WS_VT = 288 * MiB;
constexpr size_t WS_OAB = 320 * MiB;
constexpr size_t WS_PQ = 116 * MiB;
constexpr size_t WS_TOPS = 244 * MiB;
constexpr size_t WS_TOPI = 276 * MiB;
constexpr size_t WS_IDX = 284 * MiB;
constexpr size_t WS_G = 292 * MiB;
constexpr size_t WS_SSQO = 49 * MiB;
constexpr size_t WS_SSQ1 = 384 * MiB;
constexpr size_t WS_BPQ = 3 * MiB + 64 * 1024;
constexpr size_t WS_KEEP = 386 * MiB;
constexpr size_t WS_W = 390 * MiB;
constexpr size_t WS_END = 408 * MiB;
constexpr int LDS_BYTES = 148480;
constexpr int NEXP = 16384;

struct Params {
    const float *x, *c, *w_ada, *b_ada, *w_in, *sink, *qnorm, *w_qup, *kvnorm, *w_kvup, *onorm_a, *onorm_b, *w_out, *w_pq, *subk, *eu, *ev, *fnorm;
    float* out;
    unsigned char* ws;
};

typedef short bf16x8 __attribute__((ext_vector_type(8)));
typedef float f32x4 __attribute__((ext_vector_type(4)));
typedef unsigned u32x4 __attribute__((ext_vector_type(4)));
typedef float f32x2 __attribute__((ext_vector_type(2)));
typedef int i32x8 __attribute__((ext_vector_type(8)));

__device__ __forceinline__ int tid_opaque() { int t = threadIdx.x; asm volatile("" : "+v"(t)); return t; }
__device__ __forceinline__ unsigned f2bf(float f) { unsigned u = __builtin_bit_cast(unsigned, f); return (u + 0x7fffu + ((u >> 16) & 1u)) >> 16; }
__device__ __forceinline__ unsigned pk2(float lo, float hi) { return f2bf(lo) | (f2bf(hi) << 16); }
__device__ __forceinline__ float bf2f(unsigned short h) { return __builtin_bit_cast(float, (unsigned)h << 16); }
__device__ __forceinline__ float bflo(unsigned w) { return __builtin_bit_cast(float, w << 16); }
__device__ __forceinline__ float bfhi(unsigned w) { return __builtin_bit_cast(float, w & 0xffff0000u); }
__device__ __forceinline__ float wave_sum(float v) {
#pragma unroll
    for (int o = 1; o < 64; o <<= 1) v += __shfl_xor(v, o);
    return v;
}

__device__ __forceinline__ float wave_max(float v) {
#pragma unroll
    for (int o = 1; o < 64; o <<= 1) v = fmaxf(v, __shfl_xor(v, o));
    return v;
}
template <int CTRL> __device__ __forceinline__ float dpp_add(float s) {
    return s + __builtin_bit_cast(float, __builtin_amdgcn_update_dpp(0, __builtin_bit_cast(int, s), CTRL, 0xF, 0xF, true));
}
__device__ __forceinline__ float group16_sum(float s) { s = dpp_add<0xB1>(s); s = dpp_add<0x4E>(s); s = dpp_add<0x141>(s); s = dpp_add<0x140>(s); return s; }

__device__ void stage_gemv8(const float* vec, int vstride, bool silu, const float* W, int N, const float* bias, float* dst, float* lds) {
    const int tid = threadIdx.x;
    __syncthreads();
    for (int i = tid; i < Bsz * D; i += NTHREADS) { const int b = i >> 10, k = i & 1023; float v = vec[b * vstride + k]; lds[i] = silu ? v / (1.f + __expf(-v)) : v; }
    __syncthreads();
    float* red = lds + Bsz * D;
    const int col_l = tid & 15, slice = tid >> 4;
    for (int item = blockIdx.x; item < N / 16; item += gridDim.x) {
        const int n = item * 16 + col_l;
        float acc[Bsz];
#pragma unroll
        for (int b = 0; b < Bsz; ++b) acc[b] = 0.f;
#pragma unroll 8
        for (int kk = 0; kk < 32; ++kk) {
            const int k = slice * 32 + kk;
            const float w = W[(size_t)k * N + n];
#pragma unroll
            for (int b = 0; b < Bsz; ++b) acc[b] += lds[b * D + k] * w;
        }
#pragma unroll
        for (int b = 0; b < Bsz; ++b) red[(slice * 16 + col_l) * Bsz + b] = acc[b];
        __syncthreads();
        if (tid < 128) {
            const int cc = tid >> 3, b = tid & 7;
            float sacc = 0.f;
#pragma unroll
            for (int sl = 0; sl < 32; ++sl) sacc += red[(sl * 16 + cc) * Bsz + b];
            dst[b * N + item * 16 + cc] = sacc + (bias ? bias[item * 16 + cc] : 0.f);
        }
        __syncthreads();
    }
}

template <int MAP> __device__ __forceinline__ int map_row(int n) {
    if (MAP == 1) { const int h = n / 96, j = n % 96; return j < 64 ? h * 64 + j : 512 + h * 32 + (j - 64); }
    return n;
}
template <int MAP>
__device__ __forceinline__ void transpose_item(const float* W, int K, int N, unsigned short* WT, const float* kgain, float* scr, int item, int lane, const float* kgain2 = nullptr) {
    const int nblk = N / 32, kb = item / nblk, nb = item % nblk, k0 = 64 * kb, n0 = 32 * nb;
#pragma unroll 8
    for (int i = 0; i < 32; ++i) {
        const int kk = 2 * i + (lane >> 5);
        float w = W[(size_t)(k0 + kk) * N + n0 + (lane & 31)];
        if (kgain) w *= (kgain2 && k0 + kk >= 512) ? kgain2[k0 + kk - 512] : kgain[k0 + kk];
        scr[kk * 33 + (lane & 31)] = w;
    }
    asm volatile("s_waitcnt lgkmcnt(0)" ::: "memory");
    const int c = lane & 7;
#pragma unroll
    for (int j = 0; j < 4; ++j) {
        const int n = (lane >> 3) + 8 * j; const float* q = scr + (8 * c) * 33 + n;
        u32x4 o; o.x = pk2(q[0 * 33], q[1 * 33]); o.y = pk2(q[2 * 33], q[3 * 33]); o.z = pk2(q[4 * 33], q[5 * 33]); o.w = pk2(q[6 * 33], q[7 * 33]);
        *(u32x4*)(WT + (size_t)map_row<MAP>(n0 + n) * K + k0 + 8 * c) = o;
    }
    asm volatile("s_waitcnt lgkmcnt(0)" ::: "memory");
}

__device__ void stage_prologue(const Params& p, float* lds) {
    const int tid = threadIdx.x;
    stage_gemv8(p.c, D, true, p.w_ada, NMOD, p.b_ada, (float*)(p.ws + WS_MOD), lds);
    float* cosA = (float*)(p.ws + WS_COSA); float* sinA = (float*)(p.ws + WS_SINA);
    float* cosB = (float*)(p.ws + WS_COSB); float* sinB = (float*)(p.ws + WS_SINB);
    const int gtid = blockIdx.x * NTHREADS + tid, gn = gridDim.x * NTHREADS;
    for (int e = gtid; e < S * 32; e += gn) {
        const int pos = e >> 5, i = e & 31;
        const double inv = exp2(-(double)(2 * i) / 64.0 * 13.287712379549449);
        const double a = (double)pos * inv;
        const float r = (float)(a - 6.283185307179586476925 * rint(a * 0.15915494309189533577));
        cosA[e] = cosf(r); sinA[e] = sinf(r);
    }
    for (int e = gtid; e < S * 16; e += gn) {
        const int pos = e >> 4, i = e & 15;
        const double inv = exp2(-(double)(2 * i) / 32.0 * 13.287712379549449);
        const double a = (double)pos * inv;
        const float r = (float)(a - 6.283185307179586476925 * rint(a * 0.15915494309189533577));
        cosB[e] = cosf(r); sinB[e] = sinf(r);
    }
    {
        const int lane = tid & 63, wave = tid >> 6;
        float* scr = lds + wave * (64 * 33);
        const int gw = blockIdx.x * NWAVES + wave, NGW = gridDim.x * NWAVES;
        constexpr int I_IN = (D / 64) * (INW / 32), I_QU = (256 / 64) * (768 / 32), I_KV = (128 / 64) * (1024 / 32), I_OUT = (D / 64) * (D / 32), I_PQ = (D / 64) * (2048 / 32);
        constexpr int NITEMS = I_IN + I_QU + I_KV + I_OUT + I_PQ;
        __syncthreads();
        for (int it = gw; it < NITEMS; it += NGW) {
            int r = it;
            if (r < I_IN) { transpose_item<0>(p.w_in, D, INW, (unsigned short*)(p.ws + WS_WIN), nullptr, scr, r, lane); continue; } r -= I_IN;
            if (r < I_QU) { transpose_item<1>(p.w_qup, 256, 768, (unsigned short*)(p.ws + WS_WQUP), p.qnorm, scr, r, lane); continue; } r -= I_QU;
            if (r < I_KV) { transpose_item<0>(p.w_kvup, 128, 1024, (unsigned short*)(p.ws + WS_WKVUP), p.kvnorm, scr, r, lane); continue; } r -= I_KV;
            if (r < I_OUT) { transpose_item<0>(p.w_out, D, D, (unsigned short*)(p.ws + WS_WOUT), p.onorm_a, scr, r, lane, p.onorm_b); continue; } r -= I_OUT;
            transpose_item<0>(p.w_pq, D, 2048, (unsigned short*)(p.ws + WS_WPQ), nullptr, scr, r, lane);
        }
        {
            u32x4* z = (u32x4*)(p.ws + WS_WIN + (size_t)INW * D * 2);
            const int nz = (1280 - INW) * D * 2 / 16;
            for (int e = blockIdx.x * NTHREADS + tid; e < nz; e += gridDim.x * NTHREADS) z[e] = (u32x4){0u, 0u, 0u, 0u};
        }
        {
            const f32x4* src = (const f32x4*)p.subk; unsigned long long* dst = (unsigned long long*)(p.ws + WS_SUBK);
            for (int e = blockIdx.x * NTHREADS + tid; e < 16 * 128 * 128 / 4; e += gridDim.x * NTHREADS) {
                const f32x4 v = src[e]; dst[e] = (unsigned long long)pk2(v.x, v.y) | ((unsigned long long)pk2(v.z, v.w) << 32);
            }
        }
    }
    {
        const int lane = tid & 63, wave = tid >> 6;
        for (int r = blockIdx.x * NWAVES + wave; r < 2 * NEXP; r += gridDim.x * NWAVES) {
            const int tab = r >= NEXP, row = r - tab * NEXP;
            const f32x4* src = (const f32x4*)((tab ? p.ev : p.eu) + (size_t)row * D) + lane;
            f32x4 v[4]; float am = 0.f;
#pragma unroll
            for (int j = 0; j < 4; ++j) { v[j] = src[64 * j]; am = fmaxf(am, fmaxf(fmaxf(fabsf(v[j].x), fabsf(v[j].y)), fmaxf(fabsf(v[j].z), fabsf(v[j].w)))); }
            am = wave_max(am);
            int ex = 0; (void)frexpf(am, &ex);
            const float sc = ldexpf(1.f, 8 - ex), isc = ldexpf(1.f, ex - 8);
            unsigned* dst = (unsigned*)(p.ws + (tab ? WS_EV8 : WS_EU8) + (size_t)row * D) + lane;
#pragma unroll
            for (int j = 0; j < 4; ++j) {
                int w = 0;
                w = __builtin_amdgcn_cvt_pk_fp8_f32(v[j].x * sc, v[j].y * sc, w, false);
                w = __builtin_amdgcn_cvt_pk_fp8_f32(v[j].z * sc, v[j].w * sc, w, true);
                dst[64 * j] = (unsigned)w;
            }
            if (lane == 0) ((float*)(p.ws + (tab ? WS_VS : WS_US)))[row] = isc;
        }
    }
}

template <bool BF>
__device__ void stage_norm_mod(const Params& p, const float* src, void* dstv, int sh_off, int sc_off) {
    const float* mod = (const float*)(p.ws + WS_MOD);
    const int lane = threadIdx.x & 63, wave = threadIdx.x >> 6;
    const int tstride = gridDim.x * NWAVES;
    int t = blockIdx.x * NWAVES + wave;
    if (t >= T) return;
    f32x4 v[4], vn[4];
#pragma unroll
    for (int j = 0; j < 4; ++j) v[j] = ((const f32x4*)(src + (size_t)t * D) + lane)[64 * j];
    for (; t < T; t += tstride) {
        const int tn = (t + tstride < T) ? t + tstride : t;
#pragma unroll
        for (int j = 0; j < 4; ++j) vn[j] = ((const f32x4*)(src + (size_t)tn * D) + lane)[64 * j];
        const int b = t >> 12;
        f32x4 shv[4], scv[4];
#pragma unroll
        for (int j = 0; j < 4; ++j) { shv[j] = *((const f32x4*)(mod + b * NMOD + sh_off) + lane + 64 * j); scv[j] = *((const f32x4*)(mod + b * NMOD + sc_off) + lane + 64 * j); }
        float s = 0.f;
#pragma unroll
        for (int j = 0; j < 4; ++j) s += v[j].x * v[j].x + v[j].y * v[j].y + v[j].z * v[j].z + v[j].w * v[j].w;
        const float rstd = rsqrtf(wave_sum(s) * (1.f / D) + EPS);
#pragma unroll
        for (int j = 0; j < 4; ++j) {
            const f32x4 sh = shv[j], sc = scv[j];
            f32x4 r;
            r.x = v[j].x * rstd * (1.f + sc.x) + sh.x; r.y = v[j].y * rstd * (1.f + sc.y) + sh.y;
            r.z = v[j].z * rstd * (1.f + sc.z) + sh.z; r.w = v[j].w * rstd * (1.f + sc.w) + sh.w;
            if (BF) ((unsigned long long*)((unsigned short*)dstv + (size_t)t * D))[lane + 64 * j] = (unsigned long long)pk2(r.x, r.y) | ((unsigned long long)pk2(r.z, r.w) << 32);
            else ((f32x4*)((float*)dstv + (size_t)t * D))[lane + 64 * j] = r;
        }
#pragma unroll
        for (int j = 0; j < 4; ++j) v[j] = vn[j];
    }
}

constexpr int TP = 128, TQ = 256, TBK = 64;
constexpr int XS_BYTES = TP * 128, YS_BYTES = TQ * 128, STG_BYTES = XS_BYTES + YS_BYTES;
__device__ __forceinline__ int swz(int r, int c) { return r * 128 + ((c ^ ((r >> 1) & 7)) << 4); }
constexpr int SSQ_OFF = 2 * (TP * 128 + TQ * 128);
__device__ __forceinline__ float ssq8(u32x4 w) {
    const float a0 = bflo(w.x), a1 = bfhi(w.x), a2 = bflo(w.y), a3 = bfhi(w.y), a4 = bflo(w.z), a5 = bfhi(w.z), a6 = bflo(w.w), a7 = bfhi(w.w);
    return (a0 * a0 + a1 * a1) + (a2 * a2 + a3 * a3) + (a4 * a4 + a5 * a5) + (a6 * a6 + a7 * a7);
}
template <int WPN, bool YSSQ, class Epi>
__device__ void gemm_xyT(const unsigned short* X, int ldx, const unsigned short* Y, int ldy, int P, int Q, int K, int nb, size_t xbs, size_t ybs, unsigned char* lds, const Epi& epi) {
    constexpr int WQN = 8 / WPN, FI = TP / (WPN * 16), FJ = TQ / (WQN * 16);
    const int tid = threadIdx.x, lane = tid & 63, wave = tid >> 6;
    const int wp = wave / WQN, wq = wave % WQN, fr = lane & 15, fq = lane >> 4;
    const int nPt = P / TP, nQt = Q / TQ, npb = nPt * nb, nunits = npb * nQt;
    const int G = gridDim.x, bx = blockIdx.x;
    const int vcu = (G % 8 == 0) ? (bx % 8) * (G / 8) + bx / 8 : bx;
    const int srow = tid >> 3, sc = tid & 7;
    const int nk = K / TBK;
    for (int u = vcu; u < nunits; u += G) {
        const int qt = u / npb, rem = u % npb, bi = rem / nPt, pt = rem % nPt, p0 = pt * TP, q0 = qt * TQ;
        f32x4 acc[FI][FJ];
#pragma unroll
        for (int i = 0; i < FI; ++i)
#pragma unroll
            for (int j = 0; j < FJ; ++j) acc[i][j] = (f32x4){0.f, 0.f, 0.f, 0.f};
        const unsigned short* xg = X + (size_t)bi * xbs + (size_t)(p0 + srow) * ldx + sc * 8;
        const unsigned short* yg = Y + (size_t)bi * ybs + (size_t)(q0 + srow) * ldy + sc * 8;
        u32x4 rx[2], ry[4];
        float sq[4] = {0.f, 0.f, 0.f, 0.f};
#pragma unroll
        for (int i = 0; i < 2; ++i) rx[i] = *(const u32x4*)(xg + (size_t)(64 * i) * ldx);
#pragma unroll
        for (int i = 0; i < 4; ++i) ry[i] = *(const u32x4*)(yg + (size_t)(64 * i) * ldy);
        if (YSSQ) {
#pragma unroll
            for (int i = 0; i < 4; ++i) sq[i] += ssq8(ry[i]);
        }
        __syncthreads();
#pragma unroll
        for (int i = 0; i < 2; ++i) *(u32x4*)(lds + swz(srow + 64 * i, sc)) = rx[i];
#pragma unroll
        for (int i = 0; i < 4; ++i) *(u32x4*)(lds + XS_BYTES + swz(srow + 64 * i, sc)) = ry[i];
        __syncthreads();
        for (int kt = 0; kt < nk; ++kt) {
            unsigned char* st = lds + (kt & 1) * STG_BYTES;
            unsigned char* sn = lds + ((kt & 1) ^ 1) * STG_BYTES;
            const bool more = (kt + 1 < nk);
            if (more) {
                const int k1 = (kt + 1) * TBK;
#pragma unroll
                for (int i = 0; i < 2; ++i) rx[i] = *(const u32x4*)(xg + (size_t)(64 * i) * ldx + k1);
#pragma unroll
                for (int i = 0; i < 4; ++i) ry[i] = *(const u32x4*)(yg + (size_t)(64 * i) * ldy + k1);
            }
            if (YSSQ && more) {
#pragma unroll
                for (int i = 0; i < 4; ++i) sq[i] += ssq8(ry[i]);
            }
#pragma unroll
            for (int kk = 0; kk < 2; ++kk) {
                bf16x8 af[FI], bfr[FJ];
#pragma unroll
                for (int i = 0; i < FI; ++i) af[i] = *(const bf16x8*)(st + swz(wp * (FI * 16) + i * 16 + fr, kk * 4 + fq));
#pragma unroll
                for (int j = 0; j < FJ; ++j) bfr[j] = *(const bf16x8*)(st + XS_BYTES + swz(wq * (FJ * 16) + j * 16 + fr, kk * 4 + fq));
#pragma unroll
                for (int i = 0; i < FI; ++i)
#pragma unroll
                    for (int j = 0; j < FJ; ++j) acc[i][j] = __builtin_amdgcn_mfma_f32_16x16x32_bf16(af[i], bfr[j], acc[i][j], 0, 0, 0);
            }
            if (more) {
#pragma unroll
                for (int i = 0; i < 2; ++i) *(u32x4*)(sn + swz(srow + 64 * i, sc)) = rx[i];
#pragma unroll
                for (int i = 0; i < 4; ++i) *(u32x4*)(sn + XS_BYTES + swz(srow + 64 * i, sc)) = ry[i];
            }
            __syncthreads();
        }
        if (YSSQ) {
            float* ssq = (float*)(lds + SSQ_OFF);
#pragma unroll
            for (int i = 0; i < 4; ++i) {
                float v = sq[i];
                v += __shfl_xor(v, 1); v += __shfl_xor(v, 2); v += __shfl_xor(v, 4);
                if (sc == 0) ssq[srow + 64 * i] = v;
            }
            __syncthreads();
        }
        epi(acc, p0 + wp * (FI * 16), q0 + wq * (FJ * 16), lane, (const float*)(lds + SSQ_OFF) + wq * (FJ * 16), bi);
        if (YSSQ) __syncthreads();
    }
}
constexpr int DMA_STAGES = 3;
#define RAW_BARRIER() do { asm volatile("s_waitcnt lgkmcnt(0)" ::: "memory"); __builtin_amdgcn_s_barrier(); } while (0)
template <int WPN, int SUB, class Epi>
__device__ void gemm_dma(const unsigned short* X, int ldx, const unsigned short* Y, int ldy, int P, int Q, int K, int nb, size_t xbs, size_t ybs, unsigned char* lds, Epi epi) {
    constexpr int WQN = 8 / WPN, FI = TP / (WPN * 16), FJ = TQ / (WQN * 16);
    const int tid = threadIdx.x, lane = tid & 63, wave = __builtin_amdgcn_readfirstlane(tid >> 6);
    const int wp = wave / WQN, wq = wave % WQN, fr = lane & 15, fq = lane >> 4;
    const int nPt = P / TP, nQt = Q / TQ, npb = nPt * nb / SUB, nunits = npb * nQt;
    const int G = gridDim.x, bx = blockIdx.x;
    const int vcu = (G % 8 == 0) ? (bx % 8) * (G / 8) + bx / 8 : bx;
    const int srow = wave * 8 + (lane >> 3), pc = lane & 7;
    const int nk = K / TBK;
    const int lc = pc ^ ((srow >> 1) & 7);
    for (int u = vcu; u < nunits; u += G)
#pragma unroll
    for (int sub = 0; sub < SUB; ++sub) {
        const int qt = u / npb, rem = (u % npb) * SUB + sub, bi = rem / nPt, pt = rem % nPt, p0 = pt * TP, q0 = qt * TQ;
        f32x4 acc[FI][FJ];
#pragma unroll
        for (int i = 0; i < FI; ++i)
#pragma unroll
            for (int j = 0; j < FJ; ++j) acc[i][j] = (f32x4){0.f, 0.f, 0.f, 0.f};
        const unsigned short* xg = X + (size_t)bi * xbs + (size_t)(p0 + srow) * ldx + lc * 8;
        const unsigned short* yg = Y + (size_t)bi * ybs + (size_t)(q0 + srow) * ldy + lc * 8;
        epi.pre(q0 + wq * (FJ * 16), lane);
        asm volatile("s_waitcnt vmcnt(0)" ::: "memory");
        RAW_BARRIER();
#define GEMM_DMA_TILE(kt_, stg_) do { \
            unsigned char* _b = lds + (stg_) * STG_BYTES + wave * 1024; const int _k = (kt_) * TBK; \
            _Pragma("unroll") for (int _i = 0; _i < 2; ++_i) __builtin_amdgcn_global_load_lds((const unsigned*)(xg + (size_t)(64 * _i) * ldx + _k), (unsigned*)(_b + _i * 8192), 16, 0, 0); \
            _Pragma("unroll") for (int _i = 0; _i < 4; ++_i) __builtin_amdgcn_global_load_lds((const unsigned*)(yg + (size_t)(64 * _i) * ldy + _k), (unsigned*)(_b + XS_BYTES + _i * 8192), 16, 0, 0); \
        } while (0)
        GEMM_DMA_TILE(0, 0);
        GEMM_DMA_TILE(1, 1);
        int cur = 0;
        for (int kt = 0; kt < nk; ++kt) {
            if (kt + 1 < nk) asm volatile("s_waitcnt vmcnt(6)" ::: "memory");
            else if (Epi::HAS_LATE) asm volatile("s_waitcnt vmcnt(16)" ::: "memory");
            else asm volatile("s_waitcnt vmcnt(0)" ::: "memory");
            RAW_BARRIER();
            if (kt + 2 < nk) { const int nxt = (cur == 0) ? 2 : cur - 1; GEMM_DMA_TILE(kt + 2, nxt); }
            if (Epi::HAS_LATE && kt + 2 == nk) epi.late(p0 + wp * (FI * 16), q0 + wq * (FJ * 16), lane);
            const unsigned char* st = lds + cur * STG_BYTES;
#pragma unroll
            for (int kk = 0; kk < 2; ++kk) {
                bf16x8 af[FI], bfr[FJ];
#pragma unroll
                for (int i = 0; i < FI; ++i) af[i] = *(const bf16x8*)(st + swz(wp * (FI * 16) + i * 16 + fr, kk * 4 + fq));
#pragma unroll
                for (int j = 0; j < FJ; ++j) bfr[j] = *(const bf16x8*)(st + XS_BYTES + swz(wq * (FJ * 16) + j * 16 + fr, kk * 4 + fq));
#pragma unroll
                for (int i = 0; i < FI; ++i)
#pragma unroll
                    for (int j = 0; j < FJ; ++j) acc[i][j] = __builtin_amdgcn_mfma_f32_16x16x32_bf16(af[i], bfr[j], acc[i][j], 0, 0, 0);
            }
            cur = (cur == 2) ? 0 : cur + 1;
            if (Epi::HAS_MID && kt + 1 == (nk >> 1)) epi.mid(acc);
        }
#undef GEMM_DMA_TILE
        epi(acc, p0 + wp * (FI * 16), q0 + wq * (FJ * 16), lane, (const float*)nullptr, bi, sub);
    }
}
__device__ __forceinline__ unsigned long long pk4(float a, float b, float c, float d) { return (unsigned long long)pk2(a, b) | ((unsigned long long)pk2(c, d) << 32); }
struct EpiOutProj {
    static constexpr bool HAS_MID = true;
    static constexpr bool HAS_LATE = true;
    const float* x; const float* mod; float* out; unsigned short* y1; const float* ssqo; float* ssq1;
    float ratio[4], rb[4];
    f32x4 xv[4][4];
    __device__ __forceinline__ void late(int pb, int qb, int lane) {
        const int fr = lane & 15, fq = lane >> 4;
#pragma unroll
        for (int j = 0; j < 4; ++j)
#pragma unroll
            for (int i = 0; i < 4; ++i) xv[j][i] = *(const f32x4*)(x + (size_t)(qb + j * 16 + fr) * D + pb + i * 16 + fq * 4);
    }
    __device__ __forceinline__ void pre(int qb, int lane) {
#pragma unroll
        for (int j = 0; j < 4; ++j) {
            const f32x4* s4 = (const f32x4*)(ssqo + (size_t)(qb + j * 16 + (lane & 15)) * 16);
            const f32x4 a0 = s4[0], a1 = s4[1], b0 = s4[2], b1 = s4[3];
            const float sa = (a0.x + a0.y + a0.z + a0.w) + (a1.x + a1.y + a1.z + a1.w), sb = (b0.x + b0.y + b0.z + b0.w) + (b1.x + b1.y + b1.z + b1.w);
            const float ra = rsqrtf(sa * (1.f / 512.f) + EPS); rb[j] = rsqrtf(sb * (1.f / 512.f) + EPS); ratio[j] = ra / rb[j];
        }
    }
    __device__ __forceinline__ void mid(f32x4 (&acc)[4][4]) {
#pragma unroll
        for (int i = 0; i < 4; ++i)
#pragma unroll
            for (int j = 0; j < 4; ++j) { acc[i][j].x *= ratio[j]; acc[i][j].y *= ratio[j]; acc[i][j].z *= ratio[j]; acc[i][j].w *= ratio[j]; }
    }
    __device__ __forceinline__ void operator()(const f32x4 (&acc)[4][4], int pb, int qb, int lane, const float*, int, int = 0) {
        const int fr = lane & 15, fq = lane >> 4;
        const float* __restrict__ xr = x; float* __restrict__ outr = out; unsigned short* __restrict__ yr = y1; float* __restrict__ sr = ssq1;
        const float* mt = mod + (qb >> 12) * NMOD + pb + fq * 4;
        f32x4 gv[4], scv[4];
#pragma unroll
        for (int i = 0; i < 4; ++i) { gv[i] = *(const f32x4*)(mt + 2 * D + i * 16); scv[i] = *(const f32x4*)(mt + 4 * D + i * 16); }
#pragma unroll
        for (int j = 0; j < 4; ++j) {
            const int t = qb + j * 16 + fr;
            float ss = 0.f;
#pragma unroll
            for (int i = 0; i < 4; ++i) {
                const int n = pb + i * 16 + fq * 4;
                const f32x4 xx = xv[j][i];
                f32x4 r; r.x = xx.x + gv[i].x * (acc[i][j].x * rb[j]); r.y = xx.y + gv[i].y * (acc[i][j].y * rb[j]); r.z = xx.z + gv[i].z * (acc[i][j].z * rb[j]); r.w = xx.w + gv[i].w * (acc[i][j].w * rb[j]);
                *(f32x4*)(outr + (size_t)t * D + n) = r;
                ss += (r.x * r.x + r.y * r.y) + (r.z * r.z + r.w * r.w);
                *(unsigned long long*)(yr + (size_t)t * D + n) = pk4(r.x * (1.f + scv[i].x), r.y * (1.f + scv[i].y), r.z * (1.f + scv[i].z), r.w * (1.f + scv[i].w));
            }
            ss += __shfl_xor(ss, 16); ss += __shfl_xor(ss, 32);
            if (fq == 0) sr[(size_t)t * 16 + (pb >> 6)] = ss;
        }
    }
};
struct EpiPQ {
    static constexpr bool HAS_MID = false, HAS_LATE = false;
    __device__ __forceinline__ void late(int, int, int) {}
    unsigned short* C; const float* ssq1; const float* bias;
    float r1[4];
    __device__ __forceinline__ void pre(int qb, int lane) {
#pragma unroll
        for (int j = 0; j < 4; ++j) {
            const f32x4* s4 = (const f32x4*)(ssq1 + (size_t)(qb + j * 16 + (lane & 15)) * 16);
            const f32x4 a0 = s4[0], a1 = s4[1], a2 = s4[2], a3 = s4[3];
            const float sa = ((a0.x + a0.y + a0.z + a0.w) + (a1.x + a1.y + a1.z + a1.w)) + ((a2.x + a2.y + a2.z + a2.w) + (a3.x + a3.y + a3.z + a3.w));
            r1[j] = rsqrtf(sa * (1.f / D) + EPS);
        }
    }
    template <class A> __device__ __forceinline__ void mid(A&) {}
    __device__ __forceinline__ void operator()(const f32x4 (&acc)[4][4], int pb, int qb, int lane, const float*, int, int = 0) {
        const int fr = lane & 15, fq = lane >> 4;
        unsigned short* __restrict__ Cr = C;
        const float* bt = bias + (qb >> 12) * 2048 + pb + fq * 4;
        f32x4 bv[4];
#pragma unroll
        for (int i = 0; i < 4; ++i) bv[i] = *(const f32x4*)(bt + i * 16);
#pragma unroll
        for (int j = 0; j < 4; ++j) {
            const int t = qb + j * 16 + fr;
#pragma unroll
            for (int i = 0; i < 4; ++i) {
                const int n = pb + i * 16 + fq * 4;
                *(unsigned long long*)(Cr + (size_t)t * 2048 + n) = pk4(acc[i][j].x * r1[j] + bv[i].x, acc[i][j].y * r1[j] + bv[i].y, acc[i][j].z * r1[j] + bv[i].z, acc[i][j].w * r1[j] + bv[i].w);
            }
        }
    }
};

struct EpiProj {
    static constexpr bool HAS_MID = false, HAS_LATE = false;
    __device__ __forceinline__ void late(int, int, int) {}
    __device__ __forceinline__ void pre(int, int) {}
    template <class A> __device__ __forceinline__ void mid(A&) {}
    unsigned char* ws;
    __device__ __forceinline__ void operator()(const f32x4 (&acc)[4][4], int pb, int qb, int lane, const float*, int, int = 0) const {
        const int fr = lane & 15, fq = lane >> 4;
        if (pb >= 1216) return;
        const int t0 = qb + fr, b = t0 >> 12, pos0 = t0 & (S - 1);
        if (pb < C_VA) {
            const float* __restrict__ cosA = (const float*)(ws + WS_COSA); const float* __restrict__ sinA = (const float*)(ws + WS_SINA);
            const bool isq = pb < C_KA;
            const int head = isq ? (pb >> 6) : ((pb - C_KA) >> 6);
            unsigned short* __restrict__ dst0 = isq ? (unsigned short*)(ws + WS_QA) + ((size_t)(b * 8 + head) * S + pos0) * 64 : (unsigned short*)(ws + WS_KA) + ((size_t)(b * 2 + head) * S + pos0) * 64;
            const float sc = isq ? QA_SCALE : 1.f;
#pragma unroll
            for (int jh = 0; jh < 4; jh += 2) {
                f32x4 c[2][2], sn[2][2];
#pragma unroll
                for (int jj = 0; jj < 2; ++jj)
#pragma unroll
                    for (int i = 0; i < 2; ++i) { c[jj][i] = *(const f32x4*)(cosA + (pos0 + 16 * (jh + jj)) * 32 + i * 16 + fq * 4); sn[jj][i] = *(const f32x4*)(sinA + (pos0 + 16 * (jh + jj)) * 32 + i * 16 + fq * 4); }
#pragma unroll
                for (int jj = 0; jj < 2; ++jj)
#pragma unroll
                    for (int i = 0; i < 2; ++i) {
                        const int j = jh + jj, d = i * 16 + fq * 4;
                        const f32x4 x1 = acc[i][j], x2 = acc[i + 2][j], cc = c[jj][i], ss = sn[jj][i];
                        unsigned short* dst = dst0 + (size_t)(16 * j) * 64;
                        *(unsigned long long*)(dst + d) = pk4((x1.x * cc.x - x2.x * ss.x) * sc, (x1.y * cc.y - x2.y * ss.y) * sc, (x1.z * cc.z - x2.z * ss.z) * sc, (x1.w * cc.w - x2.w * ss.w) * sc);
                        *(unsigned long long*)(dst + 32 + d) = pk4((x2.x * cc.x + x1.x * ss.x) * sc, (x2.y * cc.y + x1.y * ss.y) * sc, (x2.z * cc.z + x1.z * ss.z) * sc, (x2.w * cc.w + x1.w * ss.w) * sc);
                    }
            }
        } else if (pb < C_QL) {
            const int kvh = (pb - C_VA) >> 6;
            unsigned short* __restrict__ dst0 = (unsigned short*)(ws + WS_VAT) + (size_t)(b * 2 + kvh) * 64 * S + pos0;
#pragma unroll
            for (int j = 0; j < 4; ++j)
#pragma unroll
                for (int i = 0; i < 4; ++i) {
                    const int dv = i * 16 + fq * 4; unsigned short* dst = dst0 + 16 * j;
                    dst[(size_t)(dv + 0) * S] = (unsigned short)f2bf(acc[i][j].x); dst[(size_t)(dv + 1) * S] = (unsigned short)f2bf(acc[i][j].y);
                    dst[(size_t)(dv + 2) * S] = (unsigned short)f2bf(acc[i][j].z); dst[(size_t)(dv + 3) * S] = (unsigned short)f2bf(acc[i][j].w);
                }
        } else if (pb < C_KR) {
            const bool isq = pb < C_KVL;
            unsigned short* __restrict__ dst0 = isq ? (unsigned short*)(ws + WS_QL) + (size_t)t0 * 256 + (pb - C_QL) : (unsigned short*)(ws + WS_KVL) + (size_t)t0 * 128 + (pb - C_KVL);
            const int ld = isq ? 256 : 128;
#pragma unroll
            for (int j = 0; j < 4; ++j)
#pragma unroll
                for (int i = 0; i < 4; ++i) *(unsigned long long*)(dst0 + (size_t)(16 * j) * ld + i * 16 + fq * 4) = pk4(acc[i][j].x, acc[i][j].y, acc[i][j].z, acc[i][j].w);
        } else {
            const float* __restrict__ cosB = (const float*)(ws + WS_COSB); const float* __restrict__ sinB = (const float*)(ws + WS_SINB);
            unsigned short* __restrict__ K96 = (unsigned short*)(ws + WS_K96);
            const int d = fq * 4;
            f32x4 c[4], sn[4];
#pragma unroll
            for (int j = 0; j < 4; ++j) { c[j] = *(const f32x4*)(cosB + (pos0 + 16 * j) * 16 + d); sn[j] = *(const f32x4*)(sinB + (pos0 + 16 * j) * 16 + d); }
#pragma unroll
            for (int j = 0; j < 4; ++j) {
                const f32x4 x1 = acc[0][j], x2 = acc[1][j], cc = c[j], ss = sn[j];
                const unsigned long long lo = pk4(x1.x * cc.x - x2.x * ss.x, x1.y * cc.y - x2.y * ss.y, x1.z * cc.z - x2.z * ss.z, x1.w * cc.w - x2.w * ss.w);
                const unsigned long long hi = pk4(x2.x * cc.x + x1.x * ss.x, x2.y * cc.y + x1.y * ss.y, x2.z * cc.z + x1.z * ss.z, x2.w * cc.w + x1.w * ss.w);
#pragma unroll
                for (int h = 0; h < 8; ++h) {
                    unsigned short* dst = K96 + ((size_t)(b * 8 + h) * S + pos0 + 16 * j) * 64 + 32 + d;
                    *(unsigned long long*)dst = lo; *(unsigned long long*)(dst + 16) = hi;
                }
            }
        }
    }
};
struct EpiQup {
    unsigned char* ws;
    __device__ __forceinline__ void operator()(const f32x4 (&acc)[4][4], int pb, int qb, int lane, const float* ssq, int, int = 0) const {
        const int fr = lane & 15, fq = lane >> 4;
        unsigned short* __restrict__ QMB = (unsigned short*)(ws + WS_QMB);
        const float* __restrict__ cosB = (const float*)(ws + WS_COSB); const float* __restrict__ sinB = (const float*)(ws + WS_SINB);
        const int t0 = qb + fr, b = t0 >> 12, pos0 = t0 & (S - 1);
        float sc[4];
#pragma unroll
        for (int j = 0; j < 4; ++j) sc[j] = rsqrtf(ssq[j * 16 + fr] * (1.f / 256.f) + EPS) * QM_SCALE;
        if (pb < 512) {
            unsigned char* dst0 = (unsigned char*)(QMB + ((size_t)(b * 8 + (pb >> 6)) * S + pos0) * 64);
#pragma unroll
            for (int j = 0; j < 4; ++j)
#pragma unroll
                for (int i = 0; i < 4; ++i) {
                    const float s8 = sc[j] * 8.f; int w = 0;
                    w = __builtin_amdgcn_cvt_pk_fp8_f32(acc[i][j].x * s8, acc[i][j].y * s8, w, false); w = __builtin_amdgcn_cvt_pk_fp8_f32(acc[i][j].z * s8, acc[i][j].w * s8, w, true);
                    *(unsigned*)(dst0 + (size_t)(16 * j) * 128 + i * 16 + fq * 4) = (unsigned)w;
                }
        } else {
            const int d = fq * 4;
            f32x4 c[4], sn[4];
#pragma unroll
            for (int j = 0; j < 4; ++j) { c[j] = *(const f32x4*)(cosB + (pos0 + 16 * j) * 16 + d); sn[j] = *(const f32x4*)(sinB + (pos0 + 16 * j) * 16 + d); }
#pragma unroll
            for (int j = 0; j < 4; ++j)
#pragma unroll
                for (int hh = 0; hh < 2; ++hh) {
                    const int h = ((pb - 512) >> 5) + hh;
                    unsigned short* dst = QMB + ((size_t)(b * 8 + h) * S + pos0 + 16 * j) * 64 + 32 + d;
                    const f32x4 x1 = acc[2 * hh][j], x2 = acc[2 * hh + 1][j], cc = c[j], ss = sn[j]; const float s_ = sc[j];
                    *(unsigned long long*)dst = pk4((x1.x * cc.x - x2.x * ss.x) * s_, (x1.y * cc.y - x2.y * ss.y) * s_, (x1.z * cc.z - x2.z * ss.z) * s_, (x1.w * cc.w - x2.w * ss.w) * s_);
                    *(unsigned long long*)(dst + 16) = pk4((x2.x * cc.x + x1.x * ss.x) * s_, (x2.y * cc.y + x1.y * ss.y) * s_, (x2.z * cc.z + x1.z * ss.z) * s_, (x2.w * cc.w + x1.w * ss.w) * s_);
                }
        }
    }
};
struct EpiKVup {
    unsigned char* ws;
    __device__ __forceinline__ void operator()(const f32x4 (&acc)[4][4], int pb, int qb, int lane, const float* ssq, int, int = 0) const {
        const int fr = lane & 15, fq = lane >> 4;
        unsigned short* K96 = (unsigned short*)(ws + WS_K96); unsigned short* VT = (unsigned short*)(ws + WS_VT);
        const int h = pb >> 7;
#pragma unroll
        for (int j = 0; j < 4; ++j) {
            const int t = qb + j * 16 + fr, b = t >> 12, pos = t & (S - 1);
            const float sc = rsqrtf(ssq[j * 16 + fr] * (1.f / 128.f) + EPS);
            if ((pb & 64) == 0) {
                unsigned char* dst = (unsigned char*)(K96 + ((size_t)(b * 8 + h) * S + pos) * 64);
#pragma unroll
                for (int i = 0; i < 4; ++i) {
                    int w = 0;
                    w = __builtin_amdgcn_cvt_pk_fp8_f32(acc[i][j].x * sc, acc[i][j].y * sc, w, false); w = __builtin_amdgcn_cvt_pk_fp8_f32(acc[i][j].z * sc, acc[i][j].w * sc, w, true);
                    *(unsigned*)(dst + i * 16 + fq * 4) = (unsigned)w;
                }
            } else {
                unsigned char* dst = (unsigned char*)VT + (size_t)(b * 8 + h) * 64 * S + pos;
#pragma unroll
                for (int i = 0; i < 4; ++i) {
                    const int dv = i * 16 + fq * 4;
                    const int w0 = __builtin_amdgcn_cvt_pk_fp8_f32(acc[i][j].x * sc, acc[i][j].y * sc, 0, false), w1 = __builtin_amdgcn_cvt_pk_fp8_f32(acc[i][j].z * sc, acc[i][j].w * sc, 0, false);
                    dst[(size_t)(dv + 0) * S] = (unsigned char)(w0 & 0xff); dst[(size_t)(dv + 1) * S] = (unsigned char)((w0 >> 8) & 0xff);
                    dst[(size_t)(dv + 2) * S] = (unsigned char)(w1 & 0xff); dst[(size_t)(dv + 3) * S] = (unsigned char)((w1 >> 8) & 0xff);
                }
            }
        }
    }
};

typedef float f32x16 __attribute__((ext_vector_type(16)));
typedef __bf16 bf16x2_t __attribute__((ext_vector_type(2)));
__device__ __forceinline__ unsigned cvtpk(float lo, float hi) { f32x2 v = {lo, hi}; bf16x2_t b = __builtin_convertvector(v, bf16x2_t); return __builtin_bit_cast(unsigned, b); }
__device__ __forceinline__ int crow(int r, int hi) { return (r & 3) + 8 * (r >> 2) + 4 * hi; }
__device__ __forceinline__ int kperm(int rho) { return (rho & 0x13) | ((rho & 4) << 1) | ((rho & 8) >> 1); }

template <int DQK, bool SWA>
__device__ void stage_attn_flash(const Params& p, unsigned char* lds) {
    constexpr bool V8 = !SWA;
    constexpr bool Q8 = !SWA;
    constexpr int NK = DQK / 16, KCH = DQK / 8, KSTR = Q8 ? 80 : (KCH + 1) * 16, VSTR = V8 ? 80 : 144;
    constexpr int KT_BYTES = Q8 ? 2 * 64 * 80 : 64 * KSTR, VT_BYTES = 64 * VSTR, STG = KT_BYTES + VT_BYTES, NKC = 64 * KCH;
    const unsigned short* Qg = (const unsigned short*)(p.ws + (SWA ? WS_QA : WS_QMB));
    const unsigned short* Kg = (const unsigned short*)(p.ws + (SWA ? WS_KA : WS_K96));
    const unsigned short* Vg = (const unsigned short*)(p.ws + (SWA ? WS_VAT : WS_VT));
    unsigned short* O = (unsigned short*)(p.ws + WS_OAB);
    const int tid = threadIdx.x, lane = tid & 63, wave = tid >> 6, r32 = lane & 31, hi = lane >> 5;
    const int G = gridDim.x, bx = blockIdx.x;
    const int vcu = (G % 8 == 0) ? (bx % 8) * (G / 8) + bx / 8 : bx;
    const int nunits = SWA ? Bsz * 2 * 64 : Bsz * 8 * 16;
    const int kro = kperm(r32) * KSTR + hi * (Q8 ? 32 : 16);
    const int krr = 64 * 80 + kperm(r32) * 80 + hi * 16;
    const int k8lds = ((tid & 7) < 4) ? ((tid >> 3) * 80 + (tid & 7) * 16) : (64 * 80 + (tid >> 3) * 80 + ((tid & 7) - 4) * 16);
    const int vro = r32 * VSTR + hi * (V8 ? 32 : 16);
    const int kid0 = tid, kid1 = tid + 512;
    const int k0row = kid0 / KCH, k0c = kid0 % KCH, k1row = kid1 / KCH, k1c = kid1 % KCH;
    const int vrow = V8 ? (tid >> 2) : (tid >> 3), vc = V8 ? (tid & 3) : (tid & 7);
    for (int u = vcu; u < nunits; u += G) {
        int b, qb, tlo, thi, sq, ocol; const unsigned short *Qp, *Kb, *Vb; float m, l;
        if (SWA) {
            qb = u & 63; const int kvh = (u >> 6) & 1; b = u >> 7;
            const int head = kvh * 4 + (wave >> 1);
            sq = qb * 64 + (wave & 1) * 32 + r32;
            Qp = Qg + ((size_t)(b * 8 + head) * S + sq) * 64;
            Kb = Kg + (size_t)(b * 2 + kvh) * S * 64; Vb = Vg + (size_t)(b * 2 + kvh) * 64 * S;
            tlo = qb - 2 < 0 ? 0 : qb - 2; thi = qb + 2 > 63 ? 63 : qb + 2;
            m = p.sink[head] * LOG2E; l = 0.5f; ocol = head * 64;
        } else {
            qb = u & 15; const int h = (u >> 4) & 7; b = u >> 7;
            sq = qb * 256 + wave * 32 + r32;
            Qp = Qg + ((size_t)(b * 8 + h) * S + sq) * 64;
            Kb = Kg + (size_t)(b * 8 + h) * S * 64; Vb = (const unsigned short*)((const unsigned char*)Vg + (size_t)(b * 8 + h) * 64 * S);
            tlo = 0; thi = 63; m = 0.f; l = 0.f; ocol = 512 + h * 64;
        }
        bf16x8 qf[NK];
        i32x8 qn = {0, 0, 0, 0, 0, 0, 0, 0};
        if (Q8) {
            const u32x4 q0 = *(const u32x4*)((const unsigned char*)Qp + hi * 32), q1 = *(const u32x4*)((const unsigned char*)Qp + hi * 32 + 16);
            qn = (i32x8){(int)q0.x, (int)q0.y, (int)q0.z, (int)q0.w, (int)q1.x, (int)q1.y, (int)q1.z, (int)q1.w};
            qf[0] = *(const bf16x8*)(Qp + 32 + hi * 8); qf[1] = *(const bf16x8*)(Qp + 48 + hi * 8);
        } else {
#pragma unroll
            for (int ks = 0; ks < NK; ++ks) qf[ks] = *(const bf16x8*)(Qp + ks * 16 + hi * 8);
        }
        f32x16 o0, o1, negm;
        i32x8 pb = {0, 0, 0, 0, 0, 0, 0, 0};
#pragma unroll
        for (int r = 0; r < 16; ++r) { o0[r] = 0.f; o1[r] = 0.f; negm[r] = -m; }
        u32x4 rk0, rk1, rv;
        {
            const unsigned short* kt = Kb + (size_t)tlo * 64 * (Q8 ? 64 : DQK);
            rk0 = *(const u32x4*)(kt + kid0 * 8);
            if (!Q8 && kid1 < NKC) rk1 = *(const u32x4*)(kt + kid1 * 8);
            if (!V8 || tid < 256) rv = *(const u32x4*)((const unsigned char*)Vb + (V8 ? 1 : 2) * ((size_t)vrow * S + tlo * 64) + vc * 16);
            if (Q8) *(u32x4*)(lds + k8lds) = rk0;
            else { *(u32x4*)(lds + k0row * KSTR + k0c * 16) = rk0; if (kid1 < NKC) *(u32x4*)(lds + k1row * KSTR + k1c * 16) = rk1; }
            if (V8) { if (tid < 256) { unsigned long long* vd = (unsigned long long*)(lds + KT_BYTES + vrow * VSTR + vc * 8); vd[0] = (unsigned long long)rv.x | ((unsigned long long)rv.y << 32); vd[4] = (unsigned long long)rv.z | ((unsigned long long)rv.w << 32); } }
            else *(u32x4*)(lds + KT_BYTES + vrow * VSTR + vc * 16) = rv;
        }
        __syncthreads();
        for (int tt = tlo; tt <= thi; ++tt) {
            const unsigned char* Kl = lds + ((tt - tlo) & 1) * STG;
            const unsigned char* Vl = Kl + KT_BYTES;
            unsigned char* Kn = lds + (((tt - tlo) & 1) ^ 1) * STG;
            const bool more = tt < thi;
            if (more) {
                const unsigned short* kt = Kb + (size_t)(tt + 1) * 64 * (Q8 ? 64 : DQK);
                rk0 = *(const u32x4*)(kt + kid0 * 8);
                if (!Q8 && kid1 < NKC) rk1 = *(const u32x4*)(kt + kid1 * 8);
                if (!V8 || tid < 256) rv = *(const u32x4*)((const unsigned char*)Vb + (V8 ? 1 : 2) * ((size_t)vrow * S + (tt + 1) * 64) + vc * 16);
            }
            f32x16 s0, s1;
            if (!Q8) {
                const float nm = -m;
#pragma unroll
                for (int r = 0; r < 16; ++r) { s0[r] = nm; s1[r] = nm; }
            }
            if (Q8) {
                const u32x4 k00 = *(const u32x4*)(Kl + kro), k01 = *(const u32x4*)(Kl + kro + 16), k10 = *(const u32x4*)(Kl + 32 * 80 + kro), k11 = *(const u32x4*)(Kl + 32 * 80 + kro + 16);
                const i32x8 ka0 = {(int)k00.x, (int)k00.y, (int)k00.z, (int)k00.w, (int)k01.x, (int)k01.y, (int)k01.z, (int)k01.w};
                const i32x8 ka1 = {(int)k10.x, (int)k10.y, (int)k10.z, (int)k10.w, (int)k11.x, (int)k11.y, (int)k11.z, (int)k11.w};
                s0 = __builtin_amdgcn_mfma_scale_f32_32x32x64_f8f6f4(ka0, qn, negm, 0, 0, 0, 0x7f7f7f7f, 0, 0x7c7c7c7c);
                s1 = __builtin_amdgcn_mfma_scale_f32_32x32x64_f8f6f4(ka1, qn, negm, 0, 0, 0, 0x7f7f7f7f, 0, 0x7c7c7c7c);
#pragma unroll
                for (int ks = 0; ks < 2; ++ks) {
                    const bf16x8 kf0 = *(const bf16x8*)(Kl + krr + ks * 32);
                    const bf16x8 kf1 = *(const bf16x8*)(Kl + 32 * 80 + krr + ks * 32);
                    s0 = __builtin_amdgcn_mfma_f32_32x32x16_bf16(kf0, qf[ks], s0, 0, 0, 0);
                    s1 = __builtin_amdgcn_mfma_f32_32x32x16_bf16(kf1, qf[ks], s1, 0, 0, 0);
                }
            } else {
#pragma unroll
            for (int ks = 0; ks < NK; ++ks) {
                const bf16x8 kf0 = *(const bf16x8*)(Kl + kro + ks * 32);
                const bf16x8 kf1 = *(const bf16x8*)(Kl + 32 * KSTR + kro + ks * 32);
                s0 = __builtin_amdgcn_mfma_f32_32x32x16_bf16(kf0, qf[ks], s0, 0, 0, 0);
                s1 = __builtin_amdgcn_mfma_f32_32x32x16_bf16(kf1, qf[ks], s1, 0, 0, 0);
            }
            }
            if (SWA) {
                const int rel = tt - qb;
                if (rel == -2 || rel == 2) {
                    const int qi = (wave & 1) * 32 + r32;
#pragma unroll
                    for (int r = 0; r < 16; ++r) {
                        const int kk = kperm(crow(r, hi));
                        const bool v0 = (rel == -2) ? (kk >= qi) : (kk <= qi);
                        const bool v1 = (rel == -2) ? (kk + 32 >= qi) : (kk + 32 <= qi);
                        s0[r] = v0 ? s0[r] : -1e30f; s1[r] = v1 ? s1[r] : -1e30f;
                    }
                }
            }
            if ((!SWA) && (tt == tlo)) {
                float mx = fmaxf(s0[0], s1[0]);
#pragma unroll
                for (int r = 1; r < 16; ++r) mx = fmaxf(mx, fmaxf(s0[r], s1[r]));
                mx = fmaxf(mx, __shfl_xor(mx, 32));
                m = mx;
#pragma unroll
                for (int r = 0; r < 16; ++r) { s0[r] -= mx; s1[r] -= mx; negm[r] = -mx; }
            }
            float rs = 0.f;
#pragma unroll
            for (int r = 0; r < 16; ++r) { s0[r] = __builtin_amdgcn_exp2f(s0[r]); s1[r] = __builtin_amdgcn_exp2f(s1[r]); rs += s0[r] + s1[r]; }
            if (!__all(rs <= 1024.f)) {
                float mp = fmaxf(s0[0], s1[0]);
#pragma unroll
                for (int r = 1; r < 16; ++r) mp = fmaxf(mp, fmaxf(s0[r], s1[r]));
                mp = fmaxf(fmaxf(mp, __shfl_xor(mp, 32)), 1.f);
                const float alpha = 1.f / mp;
                m += __builtin_amdgcn_logf(mp);
                l *= alpha; rs *= alpha;
#pragma unroll
                for (int r = 0; r < 16; ++r) { o0[r] *= alpha; o1[r] *= alpha; s0[r] *= alpha; s1[r] *= alpha; negm[r] = -m; }
            }
            l += rs;
            if (V8) {
#pragma unroll
                for (int q = 0; q < 4; ++q) {
                    pb[q] = __builtin_amdgcn_cvt_pk_bf8_f32(s0[4 * q + 0], s0[4 * q + 1], pb[q], false); pb[q] = __builtin_amdgcn_cvt_pk_bf8_f32(s0[4 * q + 2], s0[4 * q + 3], pb[q], true);
                    pb[4 + q] = __builtin_amdgcn_cvt_pk_bf8_f32(s1[4 * q + 0], s1[4 * q + 1], pb[4 + q], false); pb[4 + q] = __builtin_amdgcn_cvt_pk_bf8_f32(s1[4 * q + 2], s1[4 * q + 3], pb[4 + q], true);
                }
                const u32x4 a00 = *(const u32x4*)(Vl + vro), a01 = *(const u32x4*)(Vl + vro + 16), a10 = *(const u32x4*)(Vl + 32 * VSTR + vro), a11 = *(const u32x4*)(Vl + 32 * VSTR + vro + 16);
                const i32x8 va0 = {(int)a00.x, (int)a00.y, (int)a00.z, (int)a00.w, (int)a01.x, (int)a01.y, (int)a01.z, (int)a01.w};
                const i32x8 va1 = {(int)a10.x, (int)a10.y, (int)a10.z, (int)a10.w, (int)a11.x, (int)a11.y, (int)a11.z, (int)a11.w};
                o0 = __builtin_amdgcn_mfma_scale_f32_32x32x64_f8f6f4(va0, pb, o0, 0, 1, 0, 0x7f7f7f7f, 0, 0x7f7f7f7f);
                o1 = __builtin_amdgcn_mfma_scale_f32_32x32x64_f8f6f4(va1, pb, o1, 0, 1, 0, 0x7f7f7f7f, 0, 0x7f7f7f7f);
            } else {
#pragma unroll
            for (int st = 0; st < 2; ++st) {
                u32x4 pw;
                pw.x = cvtpk(s0[8 * st + 0], s0[8 * st + 1]); pw.y = cvtpk(s0[8 * st + 2], s0[8 * st + 3]);
                pw.z = cvtpk(s0[8 * st + 4], s0[8 * st + 5]); pw.w = cvtpk(s0[8 * st + 6], s0[8 * st + 7]);
                const bf16x8 pf = __builtin_bit_cast(bf16x8, pw);
                const bf16x8 vf0 = *(const bf16x8*)(Vl + vro + st * 32);
                const bf16x8 vf1 = *(const bf16x8*)(Vl + 32 * VSTR + vro + st * 32);
                o0 = __builtin_amdgcn_mfma_f32_32x32x16_bf16(vf0, pf, o0, 0, 0, 0);
                o1 = __builtin_amdgcn_mfma_f32_32x32x16_bf16(vf1, pf, o1, 0, 0, 0);
            }
#pragma unroll
            for (int st = 0; st < 2; ++st) {
                u32x4 pw;
                pw.x = cvtpk(s1[8 * st + 0], s1[8 * st + 1]); pw.y = cvtpk(s1[8 * st + 2], s1[8 * st + 3]);
                pw.z = cvtpk(s1[8 * st + 4], s1[8 * st + 5]); pw.w = cvtpk(s1[8 * st + 6], s1[8 * st + 7]);
                const bf16x8 pf = __builtin_bit_cast(bf16x8, pw);
                const bf16x8 vf0 = *(const bf16x8*)(Vl + vro + 64 + st * 32);
                const bf16x8 vf1 = *(const bf16x8*)(Vl + 32 * VSTR + vro + 64 + st * 32);
                o0 = __builtin_amdgcn_mfma_f32_32x32x16_bf16(vf0, pf, o0, 0, 0, 0);
                o1 = __builtin_amdgcn_mfma_f32_32x32x16_bf16(vf1, pf, o1, 0, 0, 0);
            }
            }
            if (more) {
                if (Q8) *(u32x4*)(Kn + k8lds) = rk0;
                else { *(u32x4*)(Kn + k0row * KSTR + k0c * 16) = rk0; if (kid1 < NKC) *(u32x4*)(Kn + k1row * KSTR + k1c * 16) = rk1; }
                if (V8) { if (tid < 256) { unsigned long long* vd = (unsigned long long*)(Kn + KT_BYTES + vrow * VSTR + vc * 8); vd[0] = (unsigned long long)rv.x | ((unsigned long long)rv.y << 32); vd[4] = (unsigned long long)rv.z | ((unsigned long long)rv.w << 32); } }
                else *(u32x4*)(Kn + KT_BYTES + vrow * VSTR + vc * 16) = rv;
            }
            __syncthreads();
        }
        const float il = 1.f / (l + __shfl_xor(l, 32));
        {
            float ss = 0.f;
#pragma unroll
            for (int r = 0; r < 16; ++r) { const float a0 = o0[r] * il, a1 = o1[r] * il; ss += a0 * a0 + a1 * a1; }
            ss += __shfl_xor(ss, 32);
            if (hi == 0) ((float*)(p.ws + WS_SSQO))[(size_t)(b * S + sq) * 16 + (ocol >> 6)] = ss;
        }
        unsigned short* orow = O + (size_t)(b * S + sq) * D + ocol + 4 * hi;
#pragma unroll
        for (int g = 0; g < 4; ++g) {
            *(unsigned long long*)(orow + 8 * g) = (unsigned long long)cvtpk(o0[4 * g] * il, o0[4 * g + 1] * il) | ((unsigned long long)cvtpk(o0[4 * g + 2] * il, o0[4 * g + 3] * il) << 32);
            *(unsigned long long*)(orow + 32 + 8 * g) = (unsigned long long)cvtpk(o1[4 * g] * il, o1[4 * g + 1] * il) | ((unsigned long long)cvtpk(o1[4 * g + 2] * il, o1[4 * g + 3] * il) << 32);
        }
    }
}

__device__ __forceinline__ int kmax(int a, int b) { return __builtin_bit_cast(int, __builtin_fmaxf(__builtin_bit_cast(float, a), __builtin_bit_cast(float, b))); }
__device__ __forceinline__ int kmin(int a, int b) { return __builtin_bit_cast(int, __builtin_fminf(__builtin_bit_cast(float, a), __builtin_bit_cast(float, b))); }
__device__ __forceinline__ void ce_desc(int& a, int& b) { const int hi = kmax(a, b), lo = kmin(a, b); a = hi; b = lo; }
__device__ __forceinline__ void ce_asc(int& a, int& b) { const int hi = kmax(a, b), lo = kmin(a, b); a = lo; b = hi; }
template <int OFF> __device__ __forceinline__ void sort16_desc(int (&a)[32]) {
#define CE_(i_, j_) ce_desc(a[OFF + (i_)], a[OFF + (j_)]);
    CE_(0,13) CE_(1,12) CE_(2,15) CE_(3,14) CE_(4,8) CE_(5,6) CE_(7,11) CE_(9,10)
    CE_(0,5) CE_(1,7) CE_(2,9) CE_(3,4) CE_(6,13) CE_(8,14) CE_(10,15) CE_(11,12)
    CE_(0,1) CE_(2,3) CE_(4,5) CE_(6,8) CE_(7,9) CE_(10,11) CE_(12,13) CE_(14,15)
    CE_(0,2) CE_(1,3) CE_(4,10) CE_(5,11) CE_(6,7) CE_(8,9) CE_(12,14) CE_(13,15)
    CE_(1,2) CE_(3,12) CE_(4,6) CE_(5,7) CE_(8,10) CE_(9,11) CE_(13,14)
    CE_(1,4) CE_(2,6) CE_(5,8) CE_(7,10) CE_(9,13) CE_(11,14)
    CE_(2,4) CE_(3,6) CE_(9,12) CE_(11,13)
    CE_(3,5) CE_(6,8) CE_(7,9) CE_(10,12)
    CE_(3,4) CE_(5,6) CE_(7,8) CE_(9,10) CE_(11,12)
    CE_(6,7) CE_(8,9)
#undef CE_
}
template <int N, int OFF> __device__ __forceinline__ void bitonic_sort_desc(int (&a)[32]) {
#pragma unroll
    for (int k = 2; k <= N; k <<= 1)
#pragma unroll
        for (int j = k >> 1; j > 0; j >>= 1)
#pragma unroll
            for (int i = 0; i < N; ++i) {
                const int l = i ^ j;
                if (l > i) { if ((i & k) == 0) ce_desc(a[OFF + i], a[OFF + l]); else ce_asc(a[OFF + i], a[OFF + l]); }
            }
}
__device__ __forceinline__ void bitonic_clean16_desc(int (&a)[32]) {
#pragma unroll
    for (int j = 8; j > 0; j >>= 1)
#pragma unroll
        for (int i = 0; i < 16; ++i) { const int l = i ^ j; if (l > i) ce_desc(a[i], a[l]); }
}
__device__ __forceinline__ int f2sortable(float f) { return __builtin_bit_cast(int, f); }
__device__ __forceinline__ float sortable2f(int s) { return __builtin_bit_cast(float, s); }
constexpr int KEY_LOWEST = (int)0xff800000;
struct CandTab { int i[52], j[52]; };
constexpr CandTab make_cands() { CandTab t{}; int n = 0; for (int i = 0; i < 16; ++i) for (int j = 0; j < 16; ++j) if ((i + 1) * (j + 1) <= 16) { t.i[n] = i; t.j[n] = j; ++n; } for (; n < 52; ++n) { t.i[n] = -1; t.j[n] = -1; } return t; }
constexpr CandTab CANDS = make_cands();
struct EpiTopkSel {
    static constexpr bool HAS_MID = false, HAS_LATE = false;
    __device__ __forceinline__ void late(int, int, int) {}
    __device__ __forceinline__ void pre(int, int) {}
    template <class A> __device__ __forceinline__ void mid(A&) {}
    unsigned short* idx; float* g;
    int* keepg;
    __device__ __forceinline__ void operator()(const f32x4 (&acc)[8][2], int pb, int qb, int lane, const float*, int hp, int half) {
        const int fr = lane & 15, fq = lane >> 4;
#pragma unroll
        for (int j = 0; j < 2; ++j) {
            int v[32];
#pragma unroll
            for (int i = 0; i < 8; ++i)
#pragma unroll
                for (int r = 0; r < 4; ++r) v[i * 4 + r] = (f2sortable(acc[i][j][r]) & ~127) | (i * 16 + fq * 4 + r);
            sort16_desc<0>(v); sort16_desc<16>(v);
#pragma unroll
            for (int i = 0; i < 16; ++i) v[i] = kmax(v[i], v[31 - i]);
            bitonic_clean16_desc(v);
#pragma unroll
            for (int x = 16; x <= 32; x <<= 1) {
#pragma unroll
                for (int i = 0; i < 16; ++i) v[16 + i] = __shfl_xor(v[i], x);
#pragma unroll
                for (int i = 0; i < 16; ++i) v[i] = kmax(v[i], v[31 - i]);
                bitonic_clean16_desc(v);
            }
            u32x4* kp = (u32x4*)(keepg + ((qb & 255) + j * 16 + fr) * 16);
            if (half == 0) {
                if (fq == 0) {
#pragma unroll
                    for (int i = 0; i < 4; ++i) kp[i] = (u32x4){(unsigned)v[4 * i], (unsigned)v[4 * i + 1], (unsigned)v[4 * i + 2], (unsigned)v[4 * i + 3]};
                }
            } else {
                float as[16], bs[16]; int ai[16], bi[16];
#pragma unroll
                for (int i = 0; i < 4; ++i) {
                    const u32x4 kv = kp[i];
#pragma unroll
                    for (int c = 0; c < 4; ++c) { as[4 * i + c] = sortable2f((int)kv[c] & ~127); ai[4 * i + c] = ((int)kv[c] & 127) << 7; }
                }
#pragma unroll
                for (int i = 0; i < 16; ++i) { bs[i] = sortable2f(v[i] & ~127); bi[i] = v[i] & 127; }
                int w[32];
#pragma unroll
                for (int sl = 0; sl < 13; ++sl) {
                    int c4[4];
#pragma unroll
                    for (int f = 0; f < 4; ++f) {
                        constexpr int dummy = 0; (void)dummy;
                        const int ci = CANDS.i[sl * 4 + f], cj = CANDS.j[sl * 4 + f];
                        c4[f] = (ci >= 0) ? ((f2sortable(as[ci >= 0 ? ci : 0] + bs[cj >= 0 ? cj : 0]) & ~0x3fff) | (ai[ci >= 0 ? ci : 0] | bi[cj >= 0 ? cj : 0])) : KEY_LOWEST;
                    }
                    w[sl] = (fq == 0) ? c4[0] : (fq == 1) ? c4[1] : (fq == 2) ? c4[2] : c4[3];
                }
                w[13] = w[14] = w[15] = KEY_LOWEST;
                sort16_desc<0>(w);
#pragma unroll
                for (int x = 16; x <= 32; x <<= 1) {
#pragma unroll
                    for (int i = 0; i < 16; ++i) w[16 + i] = __shfl_xor(w[i], x);
#pragma unroll
                    for (int i = 0; i < 16; ++i) w[i] = kmax(w[i], w[31 - i]);
                    bitonic_clean16_desc(w);
                }
                int my[4];
#pragma unroll
                for (int c = 0; c < 4; ++c) my[c] = (fq == 0) ? w[c] : (fq == 1) ? w[4 + c] : (fq == 2) ? w[8 + c] : w[12 + c];
                const float top = sortable2f(w[0] & ~0x3fff);
                float e[4], part = 0.f;
#pragma unroll
                for (int c = 0; c < 4; ++c) { e[c] = __expf(sortable2f(my[c] & ~0x3fff) - top); part += e[c]; }
                part += __shfl_xor(part, 16); part += __shfl_xor(part, 32);
                const float inv = 1.f / part;
                const int t = qb + j * 16 + fr;
                const size_t o = (size_t)t * 128 + (hp >> 1) * 16 + fq * 4;
                *(unsigned long long*)(idx + o) = (unsigned long long)(unsigned)((my[0] & 0x3fff) | ((my[1] & 0x3fff) << 16)) | ((unsigned long long)(unsigned)((my[2] & 0x3fff) | ((my[3] & 0x3fff) << 16)) << 32);
                *(f32x4*)(g + o) = (f32x4){e[0] * inv, e[1] * inv, e[2] * inv, e[3] * inv};
            }
        }
    }
};
__device__ void gemm_pq_fused(const Params& p, unsigned char* lds) {
    const unsigned short* X = (const unsigned short*)(p.ws + WS_WPQ);
    const unsigned short* Y = (const unsigned short*)(p.ws + WS_HB);
    const unsigned short* SK = (const unsigned short*)(p.ws + WS_SUBK);
    const float* ssq1 = (const float*)(p.ws + WS_SSQ1); const float* bias = (const float*)(p.ws + WS_BPQ);
    EpiTopkSel tsel{(unsigned short*)(p.ws + WS_IDX), (float*)(p.ws + WS_G), (int*)(p.ws + WS_KEEP) + (size_t)blockIdx.x * 4096};
    const int tid = threadIdx.x, lane = tid & 63, wave = __builtin_amdgcn_readfirstlane(tid >> 6);
    const int wp = wave >> 2, wq = wave & 3, fr = lane & 15, fq = lane >> 4;
    const int G = gridDim.x, bx = blockIdx.x;
    const int vcu = (G % 8 == 0) ? (bx % 8) * (G / 8) + bx / 8 : bx;
    const int srow = wave * 8 + (lane >> 3), pc = lane & 7, lc = pc ^ ((srow >> 1) & 7);
    constexpr int nk = D / TBK, nunits = 8 * (T / TQ);
    for (int u = vcu; u < nunits; u += G) {
        const int qt = u >> 3, h = u & 7, q0 = qt * TQ;
#pragma unroll
        for (int sub = 0; sub < 2; ++sub) {
            const int hp = h * 2 + sub, p0 = hp * TP;
            f32x4 acc[4][4];
#pragma unroll
            for (int i = 0; i < 4; ++i)
#pragma unroll
                for (int j = 0; j < 4; ++j) acc[i][j] = (f32x4){0.f, 0.f, 0.f, 0.f};
            const unsigned short* xg = X + (size_t)(p0 + srow) * D + lc * 8;
            const unsigned short* yg = Y + (size_t)(q0 + srow) * D + lc * 8;
            asm volatile("s_waitcnt vmcnt(0)" ::: "memory");
            RAW_BARRIER();
#define PQ_DMA_TILE(kt_, stg_) do { \
                unsigned char* _b = lds + (stg_) * STG_BYTES + wave * 1024; const int _k = (kt_) * TBK; \
                _Pragma("unroll") for (int _i = 0; _i < 2; ++_i) __builtin_amdgcn_global_load_lds((const unsigned*)(xg + (size_t)(64 * _i) * D + _k), (unsigned*)(_b + _i * 8192), 16, 0, 0); \
                _Pragma("unroll") for (int _i = 0; _i < 4; ++_i) __builtin_amdgcn_global_load_lds((const unsigned*)(yg + (size_t)(64 * _i) * D + _k), (unsigned*)(_b + XS_BYTES + _i * 8192), 16, 0, 0); \
            } while (0)
            PQ_DMA_TILE(0, 0);
            PQ_DMA_TILE(1, 1);
            int cur = 0;
            for (int kt = 0; kt < nk; ++kt) {
                if (kt + 1 < nk) asm volatile("s_waitcnt vmcnt(6)" ::: "memory"); else asm volatile("s_waitcnt vmcnt(0)" ::: "memory");
                RAW_BARRIER();
                if (kt + 2 < nk) { const int nxt = (cur == 0) ? 2 : cur - 1; PQ_DMA_TILE(kt + 2, nxt); }
                const unsigned char* st = lds + cur * STG_BYTES;
#pragma unroll
                for (int kk = 0; kk < 2; ++kk) {
                    bf16x8 af[4], bfr[4];
#pragma unroll
                    for (int i = 0; i < 4; ++i) af[i] = *(const bf16x8*)(st + swz(wp * 64 + i * 16 + fr, kk * 4 + fq));
#pragma unroll
                    for (int j = 0; j < 4; ++j) bfr[j] = *(const bf16x8*)(st + XS_BYTES + swz(wq * 64 + j * 16 + fr, kk * 4 + fq));
#pragma unroll
                    for (int i = 0; i < 4; ++i)
#pragma unroll
                        for (int j = 0; j < 4; ++j) acc[i][j] = __builtin_amdgcn_mfma_f32_16x16x32_bf16(af[i], bfr[j], acc[i][j], 0, 0, 0);
                }
                cur = (cur == 2) ? 0 : cur + 1;
            }
#undef PQ_DMA_TILE
            RAW_BARRIER();
            {
                float r1[4]; f32x4 bv[4];
#pragma unroll
                for (int j = 0; j < 4; ++j) {
                    const f32x4* s4 = (const f32x4*)(ssq1 + (size_t)(q0 + wq * 64 + j * 16 + fr) * 16);
                    const f32x4 a0 = s4[0], a1 = s4[1], a2 = s4[2], a3 = s4[3];
                    r1[j] = rsqrtf((((a0.x + a0.y + a0.z + a0.w) + (a1.x + a1.y + a1.z + a1.w)) + ((a2.x + a2.y + a2.z + a2.w) + (a3.x + a3.y + a3.z + a3.w))) * (1.f / D) + EPS);
                }
                {
                    const float* bt = bias + (q0 >> 12) * 2048 + p0 + wp * 64 + fq * 4;
#pragma unroll
                    for (int i = 0; i < 4; ++i) bv[i] = *(const f32x4*)(bt + i * 16);
                }
                const unsigned short* kg = SK + (size_t)hp * 128 * 128 + (size_t)srow * 128 + lc * 8;
#pragma unroll
                for (int s2 = 0; s2 < 2; ++s2)
#pragma unroll
                    for (int i = 0; i < 2; ++i) __builtin_amdgcn_global_load_lds((const unsigned*)(kg + (size_t)(64 * i) * 128 + s2 * 64), (unsigned*)(lds + s2 * STG_BYTES + wave * 1024 + i * 8192), 16, 0, 0);
                unsigned char* yb = lds + wp * STG_BYTES + XS_BYTES + (fq & 1) * 8;
#pragma unroll
                for (int j = 0; j < 4; ++j)
#pragma unroll
                    for (int i = 0; i < 4; ++i)
                        *(unsigned long long*)(yb + swz(wq * 64 + j * 16 + fr, 2 * i + (fq >> 1))) =
                            pk4(acc[i][j].x * r1[j] + bv[i].x, acc[i][j].y * r1[j] + bv[i].y, acc[i][j].z * r1[j] + bv[i].z, acc[i][j].w * r1[j] + bv[i].w);
            }
            asm volatile("s_waitcnt vmcnt(0)" ::: "memory");
            RAW_BARRIER();
            f32x4 sc2[8][2];
#pragma unroll
            for (int i = 0; i < 8; ++i)
#pragma unroll
                for (int j = 0; j < 2; ++j) sc2[i][j] = (f32x4){0.f, 0.f, 0.f, 0.f};
#pragma unroll
            for (int s2 = 0; s2 < 2; ++s2) {
                const unsigned char* st = lds + s2 * STG_BYTES;
#pragma unroll
                for (int kk = 0; kk < 2; ++kk) {
                    bf16x8 af[8], bfr[2];
#pragma unroll
                    for (int i = 0; i < 8; ++i) af[i] = *(const bf16x8*)(st + swz(i * 16 + fr, kk * 4 + fq));
#pragma unroll
                    for (int j = 0; j < 2; ++j) bfr[j] = *(const bf16x8*)(st + XS_BYTES + swz(wave * 32 + j * 16 + fr, kk * 4 + fq));
#pragma unroll
                    for (int i = 0; i < 8; ++i)
#pragma unroll
                        for (int j = 0; j < 2; ++j) sc2[i][j] = __builtin_amdgcn_mfma_f32_16x16x32_bf16(af[i], bfr[j], sc2[i][j], 0, 0, 0);
                }
            }
            tsel(sc2, 0, q0 + wave * 32, lane, (const float*)nullptr, hp, sub);
        }
    }
}

__device__ __forceinline__ int rd_lane_i(int v, int l) { return __builtin_amdgcn_readlane(v, l); }
__device__ __forceinline__ float rd_lane_f(float v, int l) { return __builtin_bit_cast(float, __builtin_amdgcn_readlane(__builtin_bit_cast(int, v), l)); }
__device__ void stage_peer_u(const Params& p) {
    const unsigned short* h2 = (const unsigned short*)(p.ws + WS_HB);
    const float* mod = (const float*)(p.ws + WS_MOD);
    const unsigned short* idx = (const unsigned short*)(p.ws + WS_IDX); float* g = (float*)(p.ws + WS_G);
    const unsigned char* eu8 = p.ws + WS_EU8;
    const float* us = (const float*)(p.ws + WS_US);
    const int tid_ = tid_opaque(); const int lane = tid_ & 63, wave = tid_ >> 6;
    for (int t = blockIdx.x * NWAVES + wave; t < T; t += gridDim.x * NWAVES) {
        const int b = t >> 12;
        f32x2 hq[8];
        {
            const float rstd1 = rsqrtf(group16_sum(((const float*)(p.ws + WS_SSQ1))[(size_t)t * 16 + (lane & 15)]) * (1.f / D) + EPS);
            const float* shf = mod + b * NMOD + 3 * D + lane * 16;
            const u32x4 w0 = *(const u32x4*)(h2 + (size_t)t * D + lane * 16), w1 = *(const u32x4*)(h2 + (size_t)t * D + lane * 16 + 8);
            const f32x4 s0 = *(const f32x4*)(shf), s1 = *(const f32x4*)(shf + 4), s2 = *(const f32x4*)(shf + 8), s3 = *(const f32x4*)(shf + 12);
            hq[0] = (f32x2){bflo(w0.x) * rstd1 + s0.x, bfhi(w0.x) * rstd1 + s0.y}; hq[1] = (f32x2){bflo(w0.y) * rstd1 + s0.z, bfhi(w0.y) * rstd1 + s0.w};
            hq[2] = (f32x2){bflo(w0.z) * rstd1 + s1.x, bfhi(w0.z) * rstd1 + s1.y}; hq[3] = (f32x2){bflo(w0.w) * rstd1 + s1.z, bfhi(w0.w) * rstd1 + s1.w};
            hq[4] = (f32x2){bflo(w1.x) * rstd1 + s2.x, bfhi(w1.x) * rstd1 + s2.y}; hq[5] = (f32x2){bflo(w1.y) * rstd1 + s2.z, bfhi(w1.y) * rstd1 + s2.w};
            hq[6] = (f32x2){bflo(w1.z) * rstd1 + s3.x, bfhi(w1.z) * rstd1 + s3.y}; hq[7] = (f32x2){bflo(w1.w) * rstd1 + s3.z, bfhi(w1.w) * rstd1 + s3.w};
        }
        const int idv0 = idx[(size_t)t * 128 + lane], idv1 = idx[(size_t)t * 128 + 64 + lane];
        float wv0 = 0.f, wv1 = 0.f;
        u32x4 cur[8], nxt[8];
#pragma unroll
        for (int i = 0; i < 8; ++i) cur[i] = *(const u32x4*)(eu8 + (size_t)rd_lane_i(idv0, i) * D + lane * 16);
#pragma unroll 2
        for (int b8 = 0; b8 < 16; ++b8) {
            const int bn = (b8 + 1 < 16) ? b8 + 1 : b8;
#pragma unroll
            for (int i = 0; i < 8; ++i) { const int r = bn * 8 + i; nxt[i] = *(const u32x4*)(eu8 + (size_t)rd_lane_i((bn < 8) ? idv0 : idv1, r & 63) * D + lane * 16); }
            float pr[8];
#pragma unroll
            for (int i = 0; i < 8; ++i) {
                f32x2 a = {0.f, 0.f}, c2 = {0.f, 0.f};
#pragma unroll
                for (int c = 0; c < 4; ++c) {
                    const f32x2 lo = __builtin_amdgcn_cvt_pk_f32_fp8((int)cur[i][c], false), hi = __builtin_amdgcn_cvt_pk_f32_fp8((int)cur[i][c], true);
                    a += lo * hq[2 * c]; c2 += hi * hq[2 * c + 1];
                }
                a += c2; pr[i] = a.x + a.y;
            }
            float x4[4], x2[2], x1;
            const bool b5 = (lane & 32) != 0, b4 = (lane & 16) != 0, b3 = (lane & 8) != 0;
#pragma unroll
            for (int i = 0; i < 4; ++i) { const float keep = b5 ? pr[i + 4] : pr[i], give = b5 ? pr[i] : pr[i + 4]; x4[i] = keep + __shfl_xor(give, 32); }
#pragma unroll
            for (int i = 0; i < 2; ++i) { const float keep = b4 ? x4[i + 2] : x4[i], give = b4 ? x4[i] : x4[i + 2]; x2[i] = keep + __shfl_xor(give, 16); }
            { const float keep = b3 ? x2[1] : x2[0], give = b3 ? x2[0] : x2[1]; x1 = keep + __shfl_xor(give, 8); }
            x1 += __shfl_xor(x1, 4); x1 += __shfl_xor(x1, 2); x1 += __shfl_xor(x1, 1);
            const float st = __shfl(x1, (lane & 7) * 8);
            const bool mine = (lane >> 3) == (b8 & 7);
            if (b8 < 8) wv0 = mine ? st : wv0; else wv1 = mine ? st : wv1;
#pragma unroll
            for (int i = 0; i < 8; ++i) cur[i] = nxt[i];
        }
        {
            const float s0 = wv0 * us[idv0], s1 = wv1 * us[idv1];
            const float gv0 = g[(size_t)t * 128 + lane], gv1 = g[(size_t)t * 128 + 64 + lane];
            wv0 = gv0 * (0.5f * s0 * (1.f + erff(s0 * 0.70710678118654752f)));
            wv1 = gv1 * (0.5f * s1 * (1.f + erff(s1 * 0.70710678118654752f)));
        }
        { float* wdst = (float*)(p.ws + WS_W); wdst[(size_t)t * 128 + lane] = wv0; wdst[(size_t)t * 128 + 64 + lane] = wv1; }
    }
}
__device__ void stage_peer_v(const Params& p, float* outp) {
    const float* mod = (const float*)(p.ws + WS_MOD);
    const unsigned short* idx = (const unsigned short*)(p.ws + WS_IDX); const float* g = (const float*)(p.ws + WS_W);
    const unsigned char* ev8 = p.ws + WS_EV8;
    const float* vs = (const float*)(p.ws + WS_VS);
    const int tid_ = tid_opaque(); const int lane = tid_ & 63, wave = tid_ >> 6;
    for (int t = blockIdx.x * NWAVES + wave; t < T; t += gridDim.x * NWAVES) {
        const int b = t >> 12;
        const int idv0 = idx[(size_t)t * 128 + lane], idv1 = idx[(size_t)t * 128 + 64 + lane];
        const float wv0 = g[(size_t)t * 128 + lane] * vs[idv0], wv1 = g[(size_t)t * 128 + 64 + lane] * vs[idv1];
        f32x2 acc[8];
#pragma unroll
        for (int i = 0; i < 8; ++i) acc[i] = (f32x2){0.f, 0.f};
        u32x4 cur[8], nxt[8];
#pragma unroll
        for (int i = 0; i < 8; ++i) cur[i] = *(const u32x4*)(ev8 + (size_t)rd_lane_i(idv0, i) * D + lane * 16);
#pragma unroll 2
        for (int b8 = 0; b8 < 16; ++b8) {
            const int bn = (b8 + 1 < 16) ? b8 + 1 : b8;
#pragma unroll
            for (int i = 0; i < 8; ++i) { const int r = bn * 8 + i; nxt[i] = *(const u32x4*)(ev8 + (size_t)rd_lane_i((bn < 8) ? idv0 : idv1, r & 63) * D + lane * 16); }
#pragma unroll
            for (int i = 0; i < 8; ++i) {
                const int r = b8 * 8 + i;
                const float wr = rd_lane_f((b8 < 8) ? wv0 : wv1, r & 63);
                const f32x2 w2 = {wr, wr};
#pragma unroll
                for (int c = 0; c < 4; ++c) {
                    const f32x2 lo = __builtin_amdgcn_cvt_pk_f32_fp8((int)cur[i][c], false), hi = __builtin_amdgcn_cvt_pk_f32_fp8((int)cur[i][c], true);
                    acc[2 * c] += w2 * lo; acc[2 * c + 1] += w2 * hi;
                }
            }
#pragma unroll
            for (int i = 0; i < 8; ++i) cur[i] = nxt[i];
        }
        const int eoff = lane * 16;
        const float* xin = p.out + (size_t)t * D + eoff;
        float* xr = outp + (size_t)t * D + eoff;
        const float* gf = mod + b * NMOD + 5 * D + eoff;
        float sel[16];
        float ss = 0.f;
#pragma unroll
        for (int c = 0; c < 4; ++c) {
            const f32x4 x1 = *(const f32x4*)(xin + c * 4); const f32x4 gg = *(const f32x4*)(gf + c * 4);
            sel[c * 4 + 0] = x1.x + gg.x * acc[2 * c].x; sel[c * 4 + 1] = x1.y + gg.y * acc[2 * c].y;
            sel[c * 4 + 2] = x1.z + gg.z * acc[2 * c + 1].x; sel[c * 4 + 3] = x1.w + gg.w * acc[2 * c + 1].y;
            ss += sel[c * 4 + 0] * sel[c * 4 + 0] + sel[c * 4 + 1] * sel[c * 4 + 1] + sel[c * 4 + 2] * sel[c * 4 + 2] + sel[c * 4 + 3] * sel[c * 4 + 3];
        }
        const float rstd = rsqrtf(wave_sum(ss) * (1.f / D) + EPS);
#pragma unroll
        for (int c = 0; c < 4; ++c) {
            const f32x4 fn = *(const f32x4*)(p.fnorm + eoff + c * 4);
            f32x4 r; r.x = sel[c * 4 + 0] * rstd * fn.x; r.y = sel[c * 4 + 1] * rstd * fn.y; r.z = sel[c * 4 + 2] * rstd * fn.z; r.w = sel[c * 4 + 3] * rstd * fn.w;
            *(f32x4*)(xr + c * 4) = r;
        }
    }
}

#define LAS __attribute__((address_space(3)))
constexpr size_t WS_BAR = 3 * MiB;
constexpr int BAR_BYTES = 16384;
constexpr int LDS_MISC_OFF = 147456;
#define XB_TMO      128
#define XB_XCNT(j)  (256  + 64 * (j))
#define XB_XSUB(j)  (1280 + 64 * (j))
#define XB_XGEN(j)  (2304 + 64 * (j))
#define XB_TOP      3328
#define XB_TOPGEN   3392
#define XB_SPIN_CAP (1u << 18)
__device__ __forceinline__ unsigned xb_ld(unsigned* p)              { return __hip_atomic_load(p, __ATOMIC_RELAXED, __HIP_MEMORY_SCOPE_AGENT); }
__device__ __forceinline__ unsigned xb_add(unsigned* p, unsigned v) { return __hip_atomic_fetch_add(p, v, __ATOMIC_RELAXED, __HIP_MEMORY_SCOPE_AGENT); }
__device__ __forceinline__ unsigned xb_xcc_id() { return (unsigned)__builtin_amdgcn_s_getreg((3 << 11) | 20) & 0xFu; }
#define XB_SPIN(cond, bar) do { unsigned _sp = 0; while (cond) { __builtin_amdgcn_s_sleep(1); \
    if ((++_sp & 255u) == 0u) { if (xb_ld(&(bar)[XB_TMO])) break; if (_sp > XB_SPIN_CAP) { atomicAdd(&(bar)[XB_TMO], 1u); break; } } } } while (0)
struct XcdBarrier { unsigned* bar; unsigned x; volatile LAS unsigned* st; };
__device__ __forceinline__ XcdBarrier xcd_barrier_post(unsigned* bar, volatile LAS unsigned* st) {
    XcdBarrier b; b.bar = bar; b.x = xb_xcc_id(); b.st = st;
    if (threadIdx.x == 0) (void)xb_add(&bar[XB_XCNT(b.x)], 1u);
    return b;
}
__device__ __forceinline__ void xcd_barrier_complete(unsigned* bar, unsigned x, unsigned& nloc, unsigned& nx) {
    const unsigned G = gridDim.x * gridDim.y * gridDim.z;
    unsigned sum, cnt, mine, sp = 0u;
    for (;;) {
        sum = 0u; cnt = 0u; mine = 0u;
#pragma unroll
        for (unsigned j = 0; j < 16; ++j) { const unsigned c = xb_ld(&bar[XB_XCNT(j)]); sum += c; cnt += (c > 0u) ? 1u : 0u; mine = (j == x) ? c : mine; }
        if (sum == G) break;
        __builtin_amdgcn_s_sleep(1);
        if ((++sp & 255u) == 0u) { if (xb_ld(&bar[XB_TMO])) break; if (sp > XB_SPIN_CAP) { atomicAdd(&bar[XB_TMO], 1u); break; } }
    }
    nloc = mine > 0u ? mine : 1u; nx = cnt > 0u ? cnt : 1u;
}
__device__ __forceinline__ void xcd_barrier(const XcdBarrier& b) {
    asm volatile("s_waitcnt vmcnt(0)" ::: "memory");
    __syncthreads();
    if (threadIdx.x == 0) {
        unsigned* bar = b.bar;
        __builtin_amdgcn_s_waitcnt(0);
        unsigned nloc = b.st[0], nx = b.st[1];
        if (nloc == 0u) { xcd_barrier_complete(bar, b.x, nloc, nx); b.st[0] = nloc; b.st[1] = nx; }
        const unsigned old = xb_add(&bar[XB_XSUB(b.x)], 1u);
        const unsigned gen = old / nloc;
        if (old + 1u == (gen + 1u) * nloc) {
            __builtin_amdgcn_fence(__ATOMIC_RELEASE, "agent");
            asm volatile("s_waitcnt vmcnt(0)" ::: "memory");
            const unsigned og = xb_add(&bar[XB_TOP], 1u);
            const unsigned tg = og / nx;
            if (og + 1u == (tg + 1u) * nx) xb_add(&bar[XB_TOPGEN], 1u);
            else XB_SPIN(xb_ld(&bar[XB_TOPGEN]) == tg, bar);
            __builtin_amdgcn_fence(__ATOMIC_ACQUIRE, "agent");
            xb_add(&bar[XB_XGEN(b.x)], 1u);
            asm volatile("s_waitcnt vmcnt(0)" ::: "memory");
        } else {
            XB_SPIN(xb_ld(&bar[XB_XGEN(b.x)]) == gen, bar);
            __builtin_amdgcn_fence(__ATOMIC_ACQUIRE, "agent");
            asm volatile("s_waitcnt vmcnt(0)" ::: "memory");
        }
    }
    __syncthreads();
}

__global__ void __launch_bounds__(NTHREADS) fwd_megakernel(Params p) {
    extern __shared__ __attribute__((aligned(16))) unsigned char lds_raw[];
    cg::grid_group grid = cg::this_grid();
    unsigned short* hb = (unsigned short*)(p.ws + WS_HB);
    const float* mod = (const float*)(p.ws + WS_MOD);
    typedef const unsigned short* cbf;

    volatile LAS unsigned* bst = (volatile LAS unsigned*)((LAS unsigned char*)lds_raw + LDS_MISC_OFF);
    if (threadIdx.x < 2) bst[threadIdx.x] = 0u;
    __syncthreads();
    const XcdBarrier xbar = xcd_barrier_post((unsigned*)(p.ws + WS_BAR), bst);
    stage_prologue(p, (float*)lds_raw);
    if (p.ws == nullptr) grid.sync();
    xcd_barrier(xbar);
    stage_norm_mod<true>(p, p.x, hb, 0 * D, 1 * D);
    stage_gemv8(mod + 3 * D, NMOD, false, p.w_pq, 2048, nullptr, (float*)(p.ws + WS_BPQ), (float*)lds_raw);
    xcd_barrier(xbar);
    gemm_dma<2, 1>((cbf)(p.ws + WS_WIN), D, hb, D, 1280, T, D, 1, 0, 0, lds_raw, EpiProj{p.ws});
    xcd_barrier(xbar);
    gemm_xyT<2, true>((cbf)(p.ws + WS_WQUP), 256, (cbf)(p.ws + WS_QL), 256, 768, T, 256, 1, 0, 0, lds_raw, EpiQup{p.ws});
    gemm_xyT<2, true>((cbf)(p.ws + WS_WKVUP), 128, (cbf)(p.ws + WS_KVL), 128, 1024, T, 128, 1, 0, 0, lds_raw, EpiKVup{p.ws});
    xcd_barrier(xbar);
    stage_attn_flash<64, true>(p, lds_raw);
    stage_attn_flash<96, false>(p, lds_raw);
    xcd_barrier(xbar);
    gemm_dma<2, 1>((cbf)(p.ws + WS_WOUT), D, (cbf)(p.ws + WS_OAB), D, D, T, D, 1, 0, 0, lds_raw,
                   EpiOutProj{p.x, mod, p.out, hb, (const float*)(p.ws + WS_SSQO), (float*)(p.ws + WS_SSQ1), {}, {}, {}});
    xcd_barrier(xbar);
    gemm_pq_fused(p, lds_raw);
    xcd_barrier(xbar);
    stage_peer_u(p);
    xcd_barrier(xbar);
    stage_peer_v(p, p.out);
}

extern "C" void kernel_launch(void* const* d_in, const int* in_sizes, int n_in, void* d_out, int out_size, void* d_ws, size_t ws_size, hipStream_t stream) {
    static int grid_blocks = 0;
    if (grid_blocks == 0) {
        if (n_in != 18 || in_sizes[0] != T * D || out_size != T * D || ws_size < WS_END) {
            fprintf(stderr, "kernel_launch: unexpected shapes (n_in %d, in0 %d, out %d, ws %zu); nothing launched\n", n_in, n_in > 0 ? in_sizes[0] : -1, out_size, ws_size);
            grid_blocks = -1; return;
        }
        int dev = 0, cus = 0, per_cu = 0;
        (void)hipGetDevice(&dev);
        (void)hipDeviceGetAttribute(&cus, hipDeviceAttributeMultiprocessorCount, dev);
        if (hipFuncSetAttribute((const void*)fwd_megakernel, hipFuncAttributeMaxDynamicSharedMemorySize, LDS_BYTES) != hipSuccess) { fprintf(stderr, "kernel_launch: hipFuncSetAttribute failed\n"); grid_blocks = -1; return; }
        (void)hipOccupancyMaxActiveBlocksPerMultiprocessor(&per_cu, fwd_megakernel, NTHREADS, LDS_BYTES);
        if (per_cu < 1) { fprintf(stderr, "kernel_launch: occupancy query says %d blocks/CU\n", per_cu); grid_blocks = -1; return; }
        grid_blocks = cus < 256 ? cus : 256;
    }
    if (grid_blocks < 0) return;
    Params p{};
    p.x = (const float*)d_in[0]; p.c = (const float*)d_in[1]; p.w_ada = (const float*)d_in[2]; p.b_ada = (const float*)d_in[3];
    p.w_in = (const float*)d_in[4]; p.sink = (const float*)d_in[5]; p.qnorm = (const float*)d_in[6]; p.w_qup = (const float*)d_in[7];
    p.kvnorm = (const float*)d_in[8]; p.w_kvup = (const float*)d_in[9]; p.onorm_a = (const float*)d_in[10]; p.onorm_b = (const float*)d_in[11];
    p.w_out = (const float*)d_in[12]; p.w_pq = (const float*)d_in[13]; p.subk = (const float*)d_in[14]; p.eu = (const float*)d_in[15];
    p.ev = (const float*)d_in[16]; p.fnorm = (const float*)d_in[17];
    p.out = (float*)d_out; p.ws = (unsigned char*)d_ws;
    if (hipMemsetAsync((char*)d_ws + WS_BAR, 0, BAR_BYTES, stream) != hipSuccess) { fprintf(stderr, "kernel_launch: hipMemsetAsync failed\n"); return; }
    void* args[] = {&p};
    hipError_t e = hipLaunchCooperativeKernel((void*)fwd_megakernel, dim3(grid_blocks), dim3(NTHREADS), args, LDS_BYTES, stream);
    if (e != hipSuccess) fprintf(stderr, "cooperative launch failed: %s (grid %d)\n", hipGetErrorString(e), grid_blocks);
}
```

```cpp
#include <hip/hip_runtime.h>
#include <hip/hip_cooperative_groups.h>
#include <cstdio>
#include <cstdint>
namespace cg = cooperative_groups;

constexpr int Bsz = 8, S = 4096, D = 1024, T = Bsz * S;
constexpr int INW = 1184;
constexpr int C_QA = 0, C_KA = 512, C_VA = 640, C_QL = 768, C_KVL = 1024, C_KR = 1152;
constexpr int NMOD = 6 * D;
constexpr float EPS = 1e-6f;
constexpr float LOG2E = 1.4426950408889634f;
constexpr float QA_SCALE = 0.125f * LOG2E;
constexpr float QM_SCALE = 0.10206207261596575f * LOG2E;
constexpr int NTHREADS = 512, NWAVES = 8;

constexpr size_t MiB = 1u << 20;
constexpr size_t WS_MOD = 0;
constexpr size_t WS_COSA = 1 * MiB;
constexpr size_t WS_SINA = WS_COSA + 512 * 1024;
constexpr size_t WS_COSB = 2 * MiB;
constexpr size_t WS_SINB = WS_COSB + 256 * 1024;
constexpr size_t WS_WIN = 4 * MiB;
constexpr size_t WS_WQUP = 7 * MiB;
constexpr size_t WS_WKVUP = 7 * MiB + 512 * 1024;
constexpr size_t WS_WOUT = 8 * MiB;
constexpr size_t WS_WPQ = 10 * MiB;
constexpr size_t WS_SUBK = 14 * MiB;
constexpr size_t WS_EU8 = 16 * MiB;
constexpr size_t WS_EV8 = 32 * MiB;
constexpr size_t WS_US = 48 * MiB;
constexpr size_t WS_VS = WS_US + 64 * 1024;
constexpr size_t WS_HB = 52 * MiB;
constexpr size_t WS_QA = 116 * MiB;
constexpr size_t WS_KA = 148 * MiB;
constexpr size_t WS_VAT = 156 * MiB;
constexpr size_t WS_QL = 164 * MiB;
constexpr size_t WS_KVL = 180 * MiB;
constexpr size_t WS_QMB = 192 * MiB;
constexpr size_t WS_K96 = 240 * MiB;
constexpr size_t WS_VT = 288 * MiB;
constexpr size_t WS_OAB = 320 * MiB;
constexpr size_t WS_PQ = 116 * MiB;
constexpr size_t WS_TOPS = 244 * MiB;
constexpr size_t WS_TOPI = 276 * MiB;
constexpr size_t WS_IDX = 284 * MiB;
constexpr size_t WS_G = 292 * MiB;
constexpr size_t WS_SSQO = 49 * MiB;
constexpr size_t WS_SSQ1 = 384 * MiB;
constexpr size_t WS_BPQ = 3 * MiB + 64 * 1024;
constexpr size_t WS_KEEP = 386 * MiB;
constexpr size_t WS_W = 390 * MiB;
constexpr size_t WS_END = 408 * MiB;
constexpr int LDS_BYTES = 148480;
constexpr int NEXP = 16384;

struct Params {
    const float *x, *c, *w_ada, *b_ada, *w_in, *sink, *qnorm, *w_qup, *kvnorm, *w_kvup, *onorm_a, *onorm_b, *w_out, *w_pq, *subk, *eu, *ev, *fnorm;
    float* out;
    unsigned char* ws;
};

typedef short bf16x8 __attribute__((ext_vector_type(8)));
typedef float f32x4 __attribute__((ext_vector_type(4)));
typedef unsigned u32x4 __attribute__((ext_vector_type(4)));
typedef float f32x2 __attribute__((ext_vector_type(2)));
typedef int i32x8 __attribute__((ext_vector_type(8)));

__device__ __forceinline__ int tid_opaque() { int t = threadIdx.x; asm volatile("" : "+v"(t)); return t; }
__device__ __forceinline__ unsigned f2bf(float f) { unsigned u = __builtin_bit_cast(unsigned, f); return (u + 0x7fffu + ((u >> 16) & 1u)) >> 16; }
__device__ __forceinline__ unsigned pk2(float lo, float hi) { return f2bf(lo) | (f2bf(hi) << 16); }
__device__ __forceinline__ float bf2f(unsigned short h) { return __builtin_bit_cast(float, (unsigned)h << 16); }
__device__ __forceinline__ float bflo(unsigned w) { return __builtin_bit_cast(float, w << 16); }
__device__ __forceinline__ float bfhi(unsigned w) { return __builtin_bit_cast(float, w & 0xffff0000u); }
__device__ __forceinline__ float wave_sum(float v) {
#pragma unroll
    for (int o = 1; o < 64; o <<= 1) v += __shfl_xor(v, o);
    return v;
}

__device__ __forceinline__ float wave_max(float v) {
#pragma unroll
    for (int o = 1; o < 64; o <<= 1) v = fmaxf(v, __shfl_xor(v, o));
    return v;
}
template <int CTRL> __device__ __forceinline__ float dpp_add(float s) {
    return s + __builtin_bit_cast(float, __builtin_amdgcn_update_dpp(0, __builtin_bit_cast(int, s), CTRL, 0xF, 0xF, true));
}
__device__ __forceinline__ float group16_sum(float s) { s = dpp_add<0xB1>(s); s = dpp_add<0x4E>(s); s = dpp_add<0x141>(s); s = dpp_add<0x140>(s); return s; }

__device__ void stage_gemv8(const float* vec, int vstride, bool silu, const float* W, int N, const float* bias, float* dst, float* lds) {
    const int tid = threadIdx.x;
    __syncthreads();
    for (int i = tid; i < Bsz * D; i += NTHREADS) { const int b = i >> 10, k = i & 1023; float v = vec[b * vstride + k]; lds[i] = silu ? v / (1.f + __expf(-v)) : v; }
    __syncthreads();
    float* red = lds + Bsz * D;
    const int col_l = tid & 15, slice = tid >> 4;
    for (int item = blockIdx.x; item < N / 16; item += gridDim.x) {
        const int n = item * 16 + col_l;
        float acc[Bsz];
#pragma unroll
        for (int b = 0; b < Bsz; ++b) acc[b] = 0.f;
#pragma unroll 8
        for (int kk = 0; kk < 32; ++kk) {
            const int k = slice * 32 + kk;
            const float w = W[(size_t)k * N + n];
#pragma unroll
            for (int b = 0; b < Bsz; ++b) acc[b] += lds[b * D + k] * w;
        }
#pragma unroll
        for (int b = 0; b < Bsz; ++b) red[(slice * 16 + col_l) * Bsz + b] = acc[b];
        __syncthreads();
        if (tid < 128) {
            const int cc = tid >> 3, b = tid & 7;
            float sacc = 0.f;
#pragma unroll
            for (int sl = 0; sl < 32; ++sl) sacc += red[(sl * 16 + cc) * Bsz + b];
            dst[b * N + item * 16 + cc] = sacc + (bias ? bias[item * 16 + cc] : 0.f);
        }
        __syncthreads();
    }
}

template <int MAP> __device__ __forceinline__ int map_row(int n) {
    if (MAP == 1) { const int h = n / 96, j = n % 96; return j < 64 ? h * 64 + j : 512 + h * 32 + (j - 64); }
    return n;
}
template <int MAP>
__device__ __forceinline__ void transpose_item(const float* W, int K, int N, unsigned short* WT, const float* kgain, float* scr, int item, int lane, const float* kgain2 = nullptr) {
    const int nblk = N / 32, kb = item / nblk, nb = item % nblk, k0 = 64 * kb, n0 = 32 * nb;
#pragma unroll 8
    for (int i = 0; i < 32; ++i) {
        const int kk = 2 * i + (lane >> 5);
        float w = W[(size_t)(k0 + kk) * N + n0 + (lane & 31)];
        if (kgain) w *= (kgain2 && k0 + kk >= 512) ? kgain2[k0 + kk - 512] : kgain[k0 + kk];
        scr[kk * 33 + (lane & 31)] = w;
    }
    asm volatile("s_waitcnt lgkmcnt(0)" ::: "memory");
    const int c = lane & 7;
#pragma unroll
    for (int j = 0; j < 4; ++j) {
        const int n = (lane >> 3) + 8 * j; const float* q = scr + (8 * c) * 33 + n;
        u32x4 o; o.x = pk2(q[0 * 33], q[1 * 33]); o.y = pk2(q[2 * 33], q[3 * 33]); o.z = pk2(q[4 * 33], q[5 * 33]); o.w = pk2(q[6 * 33], q[7 * 33]);
        *(u32x4*)(WT + (size_t)map_row<MAP>(n0 + n) * K + k0 + 8 * c) = o;
    }
    asm volatile("s_waitcnt lgkmcnt(0)" ::: "memory");
}

__device__ void stage_prologue(const Params& p, float* lds) {
    const int tid = threadIdx.x;
    stage_gemv8(p.c, D, true, p.w_ada, NMOD, p.b_ada, (float*)(p.ws + WS_MOD), lds);
    float* cosA = (float*)(p.ws + WS_COSA); float* sinA = (float*)(p.ws + WS_SINA);
    float* cosB = (float*)(p.ws + WS_COSB); float* sinB = (float*)(p.ws + WS_SINB);
    const int gtid = blockIdx.x * NTHREADS + tid, gn = gridDim.x * NTHREADS;
    for (int e = gtid; e < S * 32; e += gn) {
        const int pos = e >> 5, i = e & 31;
        const double inv = exp2(-(double)(2 * i) / 64.0 * 13.287712379549449);
        const double a = (double)pos * inv;
        const float r = (float)(a - 6.283185307179586476925 * rint(a * 0.15915494309189533577));
        cosA[e] = cosf(r); sinA[e] = sinf(r);
    }
    for (int e = gtid; e < S * 16; e += gn) {
        const int pos = e >> 4, i = e & 15;
        const double inv = exp2(-(double)(2 * i) / 32.0 * 13.287712379549449);
        const double a = (double)pos * inv;
        const float r = (float)(a - 6.283185307179586476925 * rint(a * 0.15915494309189533577));
        cosB[e] = cosf(r); sinB[e] = sinf(r);
    }
    {
        const int lane = tid & 63, wave = tid >> 6;
        float* scr = lds + wave * (64 * 33);
        const int gw = blockIdx.x * NWAVES + wave, NGW = gridDim.x * NWAVES;
        constexpr int I_IN = (D / 64) * (INW / 32), I_QU = (256 / 64) * (768 / 32), I_KV = (128 / 64) * (1024 / 32), I_OUT = (D / 64) * (D / 32), I_PQ = (D / 64) * (2048 / 32);
        constexpr int NITEMS = I_IN + I_QU + I_KV + I_OUT + I_PQ;
        __syncthreads();
        for (int it = gw; it < NITEMS; it += NGW) {
            int r = it;
            if (r < I_IN) { transpose_item<0>(p.w_in, D, INW, (unsigned short*)(p.ws + WS_WIN), nullptr, scr, r, lane); continue; } r -= I_IN;
            if (r < I_QU) { transpose_item<1>(p.w_qup, 256, 768, (unsigned short*)(p.ws + WS_WQUP), p.qnorm, scr, r, lane); continue; } r -= I_QU;
            if (r < I_KV) { transpose_item<0>(p.w_kvup, 128, 1024, (unsigned short*)(p.ws + WS_WKVUP), p.kvnorm, scr, r, lane); continue; } r -= I_KV;
            if (r < I_OUT) { transpose_item<0>(p.w_out, D, D, (unsigned short*)(p.ws + WS_WOUT), p.onorm_a, scr, r, lane, p.onorm_b); continue; } r -= I_OUT;
            transpose_item<0>(p.w_pq, D, 2048, (unsigned short*)(p.ws + WS_WPQ), nullptr, scr, r, lane);
        }
        {
            u32x4* z = (u32x4*)(p.ws + WS_WIN + (size_t)INW * D * 2);
            const int nz = (1280 - INW) * D * 2 / 16;
            for (int e = blockIdx.x * NTHREADS + tid; e < nz; e += gridDim.x * NTHREADS) z[e] = (u32x4){0u, 0u, 0u, 0u};
        }
        {
            const f32x4* src = (const f32x4*)p.subk; unsigned long long* dst = (unsigned long long*)(p.ws + WS_SUBK);
            for (int e = blockIdx.x * NTHREADS + tid; e < 16 * 128 * 128 / 4; e += gridDim.x * NTHREADS) {
                const f32x4 v = src[e]; dst[e] = (unsigned long long)pk2(v.x, v.y) | ((unsigned long long)pk2(v.z, v.w) << 32);
            }
        }
    }
    {
        const int lane = tid & 63, wave = tid >> 6;
        for (int r = blockIdx.x * NWAVES + wave; r < 2 * NEXP; r += gridDim.x * NWAVES) {
            const int tab = r >= NEXP, row = r - tab * NEXP;
            const f32x4* src = (const f32x4*)((tab ? p.ev : p.eu) + (size_t)row * D) + lane;
            f32x4 v[4]; float am = 0.f;
#pragma unroll
            for (int j = 0; j < 4; ++j) { v[j] = src[64 * j]; am = fmaxf(am, fmaxf(fmaxf(fabsf(v[j].x), fabsf(v[j].y)), fmaxf(fabsf(v[j].z), fabsf(v[j].w)))); }
            am = wave_max(am);
            int ex = 0; (void)frexpf(am, &ex);
            const float sc = ldexpf(1.f, 8 - ex), isc = ldexpf(1.f, ex - 8);
            unsigned* dst = (unsigned*)(p.ws + (tab ? WS_EV8 : WS_EU8) + (size_t)row * D) + lane;
#pragma unroll
            for (int j = 0; j < 4; ++j) {
                int w = 0;
                w = __builtin_amdgcn_cvt_pk_fp8_f32(v[j].x * sc, v[j].y * sc, w, false);
                w = __builtin_amdgcn_cvt_pk_fp8_f32(v[j].z * sc, v[j].w * sc, w, true);
                dst[64 * j] = (unsigned)w;
            }
            if (lane == 0) ((float*)(p.ws + (tab ? WS_VS : WS_US)))[row] = isc;
        }
    }
}

template <bool BF>
__device__ void stage_norm_mod(const Params& p, const float* src, void* dstv, int sh_off, int sc_off) {
    const float* mod = (const float*)(p.ws + WS_MOD);
    const int lane = threadIdx.x & 63, wave = threadIdx.x >> 6;
    const int tstride = gridDim.x * NWAVES;
    int t = blockIdx.x * NWAVES + wave;
    if (t >= T) return;
    f32x4 v[4], vn[4];
#pragma unroll
    for (int j = 0; j < 4; ++j) v[j] = ((const f32x4*)(src + (size_t)t * D) + lane)[64 * j];
    for (; t < T; t += tstride) {
        const int tn = (t + tstride < T) ? t + tstride : t;
#pragma unroll
        for (int j = 0; j < 4; ++j) vn[j] = ((const f32x4*)(src + (size_t)tn * D) + lane)[64 * j];
        const int b = t >> 12;
        f32x4 shv[4], scv[4];
#pragma unroll
        for (int j = 0; j < 4; ++j) { shv[j] = *((const f32x4*)(mod + b * NMOD + sh_off) + lane + 64 * j); scv[j] = *((const f32x4*)(mod + b * NMOD + sc_off) + lane + 64 * j); }
        float s = 0.f;
#pragma unroll
        for (int j = 0; j < 4; ++j) s += v[j].x * v[j].x + v[j].y * v[j].y + v[j].z * v[j].z + v[j].w * v[j].w;
        const float rstd = rsqrtf(wave_sum(s) * (1.f / D) + EPS);
#pragma unroll
        for (int j = 0; j < 4; ++j) {
            const f32x4 sh = shv[j], sc = scv[j];
            f32x4 r;
            r.x = v[j].x * rstd * (1.f + sc.x) + sh.x; r.y = v[j].y * rstd * (1.f + sc.y) + sh.y;
            r.z = v[j].z * rstd * (1.f + sc.z) + sh.z; r.w = v[j].w * rstd * (1.f + sc.w) + sh.w;
            if (BF) ((unsigned long long*)((unsigned short*)dstv + (size_t)t * D))[lane + 64 * j] = (unsigned long long)pk2(r.x, r.y) | ((unsigned long long)pk2(r.z, r.w) << 32);
            else ((f32x4*)((float*)dstv + (size_t)t * D))[lane + 64 * j] = r;
        }
#pragma unroll
        for (int j = 0; j < 4; ++j) v[j] = vn[j];
    }
}

constexpr int TP = 128, TQ = 256, TBK = 64;
constexpr int XS_BYTES = TP * 128, YS_BYTES = TQ * 128, STG_BYTES = XS_BYTES + YS_BYTES;
__device__ __forceinline__ int swz(int r, int c) { return r * 128 + ((c ^ ((r >> 1) & 7)) << 4); }
constexpr int SSQ_OFF = 2 * (TP * 128 + TQ * 128);
__device__ __forceinline__ float ssq8(u32x4 w) {
    const float a0 = bflo(w.x), a1 = bfhi(w.x), a2 = bflo(w.y), a3 = bfhi(w.y), a4 = bflo(w.z), a5 = bfhi(w.z), a6 = bflo(w.w), a7 = bfhi(w.w);
    return (a0 * a0 + a1 * a1) + (a2 * a2 + a3 * a3) + (a4 * a4 + a5 * a5) + (a6 * a6 + a7 * a7);
}
template <int WPN, bool YSSQ, class Epi>
__device__ void gemm_xyT(const unsigned short* X, int ldx, const unsigned short* Y, int ldy, int P, int Q, int K, int nb, size_t xbs, size_t ybs, unsigned char* lds, const Epi& epi) {
    constexpr int WQN = 8 / WPN, FI = TP / (WPN * 16), FJ = TQ / (WQN * 16);
    const int tid = threadIdx.x, lane = tid & 63, wave = tid >> 6;
    const int wp = wave / WQN, wq = wave % WQN, fr = lane & 15, fq = lane >> 4;
    const int nPt = P / TP, nQt = Q / TQ, npb = nPt * nb, nunits = npb * nQt;
    const int G = gridDim.x, bx = blockIdx.x;
    const int vcu = (G % 8 == 0) ? (bx % 8) * (G / 8) + bx / 8 : bx;
    const int srow = tid >> 3, sc = tid & 7;
    const int nk = K / TBK;
    for (int u = vcu; u < nunits; u += G) {
        const int qt = u / npb, rem = u % npb, bi = rem / nPt, pt = rem % nPt, p0 = pt * TP, q0 = qt * TQ;
        f32x4 acc[FI][FJ];
#pragma unroll
        for (int i = 0; i < FI; ++i)
#pragma unroll
            for (int j = 0; j < FJ; ++j) acc[i][j] = (f32x4){0.f, 0.f, 0.f, 0.f};
        const unsigned short* xg = X + (size_t)bi * xbs + (size_t)(p0 + srow) * ldx + sc * 8;
        const unsigned short* yg = Y + (size_t)bi * ybs + (size_t)(q0 + srow) * ldy + sc * 8;
        u32x4 rx[2], ry[4];
        float sq[4] = {0.f, 0.f, 0.f, 0.f};
#pragma unroll
        for (int i = 0; i < 2; ++i) rx[i] = *(const u32x4*)(xg + (size_t)(64 * i) * ldx);
#pragma unroll
        for (int i = 0; i < 4; ++i) ry[i] = *(const u32x4*)(yg + (size_t)(64 * i) * ldy);
        if (YSSQ) {
#pragma unroll
            for (int i = 0; i < 4; ++i) sq[i] += ssq8(ry[i]);
        }
        __syncthreads();
#pragma unroll
        for (int i = 0; i < 2; ++i) *(u32x4*)(lds + swz(srow + 64 * i, sc)) = rx[i];
#pragma unroll
        for (int i = 0; i < 4; ++i) *(u32x4*)(lds + XS_BYTES + swz(srow + 64 * i, sc)) = ry[i];
        __syncthreads();
        for (int kt = 0; kt < nk; ++kt) {
            unsigned char* st = lds + (kt & 1) * STG_BYTES;
            unsigned char* sn = lds + ((kt & 1) ^ 1) * STG_BYTES;
            const bool more = (kt + 1 < nk);
            if (more) {
                const int k1 = (kt + 1) * TBK;
#pragma unroll
                for (int i = 0; i < 2; ++i) rx[i] = *(const u32x4*)(xg + (size_t)(64 * i) * ldx + k1);
#pragma unroll
                for (int i = 0; i < 4; ++i) ry[i] = *(const u32x4*)(yg + (size_t)(64 * i) * ldy + k1);
            }
            if (YSSQ && more) {
#pragma unroll
                for (int i = 0; i < 4; ++i) sq[i] += ssq8(ry[i]);
            }
#pragma unroll
            for (int kk = 0; kk < 2; ++kk) {
                bf16x8 af[FI], bfr[FJ];
#pragma unroll
                for (int i = 0; i < FI; ++i) af[i] = *(const bf16x8*)(st + swz(wp * (FI * 16) + i * 16 + fr, kk * 4 + fq));
#pragma unroll
                for (int j = 0; j < FJ; ++j) bfr[j] = *(const bf16x8*)(st + XS_BYTES + swz(wq * (FJ * 16) + j * 16 + fr, kk * 4 + fq));
#pragma unroll
                for (int i = 0; i < FI; ++i)
#pragma unroll
                    for (int j = 0; j < FJ; ++j) acc[i][j] = __builtin_amdgcn_mfma_f32_16x16x32_bf16(af[i], bfr[j], acc[i][j], 0, 0, 0);
            }
            if (more) {
#pragma unroll
                for (int i = 0; i < 2; ++i) *(u32x4*)(sn + swz(srow + 64 * i, sc)) = rx[i];
#pragma unroll
                for (int i = 0; i < 4; ++i) *(u32x4*)(sn + XS_BYTES + swz(srow + 64 * i, sc)) = ry[i];
            }
            __syncthreads();
        }
        if (YSSQ) {
            float* ssq = (float*)(lds + SSQ_OFF);
#pragma unroll
            for (int i = 0; i < 4; ++i) {
                float v = sq[i];
                v += __shfl_xor(v, 1); v += __shfl_xor(v, 2); v += __shfl_xor(v, 4);
                if (sc == 0) ssq[srow + 64 * i] = v;
            }
            __syncthreads();
        }
        epi(acc, p0 + wp * (FI * 16), q0 + wq * (FJ * 16), lane, (const float*)(lds + SSQ_OFF) + wq * (FJ * 16), bi);
        if (YSSQ) __syncthreads();
    }
}
constexpr int DMA_STAGES = 3;
#define RAW_BARRIER() do { asm volatile("s_waitcnt lgkmcnt(0)" ::: "memory"); __builtin_amdgcn_s_barrier(); } while (0)
template <int WPN, int SUB, class Epi>
__device__ void gemm_dma(const unsigned short* X, int ldx, const unsigned short* Y, int ldy, int P, int Q, int K, int nb, size_t xbs, size_t ybs, unsigned char* lds, Epi epi) {
    constexpr int WQN = 8 / WPN, FI = TP / (WPN * 16), FJ = TQ / (WQN * 16);
    const int tid = threadIdx.x, lane = tid & 63, wave = __builtin_amdgcn_readfirstlane(tid >> 6);
    const int wp = wave / WQN, wq = wave % WQN, fr = lane & 15, fq = lane >> 4;
    const int nPt = P / TP, nQt = Q / TQ, npb = nPt * nb / SUB, nunits = npb * nQt;
    const int G = gridDim.x, bx = blockIdx.x;
    const int vcu = (G % 8 == 0) ? (bx % 8) * (G / 8) + bx / 8 : bx;
    const int srow = wave * 8 + (lane >> 3), pc = lane & 7;
    const int nk = K / TBK;
    const int lc = pc ^ ((srow >> 1) & 7);
    for (int u = vcu; u < nunits; u += G)
#pragma unroll
    for (int sub = 0; sub < SUB; ++sub) {
        const int qt = u / npb, rem = (u % npb) * SUB + sub, bi = rem / nPt, pt = rem % nPt, p0 = pt * TP, q0 = qt * TQ;
        f32x4 acc[FI][FJ];
#pragma unroll
        for (int i = 0; i < FI; ++i)
#pragma unroll
            for (int j = 0; j < FJ; ++j) acc[i][j] = (f32x4){0.f, 0.f, 0.f, 0.f};
        const unsigned short* xg = X + (size_t)bi * xbs + (size_t)(p0 + srow) * ldx + lc * 8;
        const unsigned short* yg = Y + (size_t)bi * ybs + (size_t)(q0 + srow) * ldy + lc * 8;
        epi.pre(q0 + wq * (FJ * 16), lane);
        asm volatile("s_waitcnt vmcnt(0)" ::: "memory");
        RAW_BARRIER();
#define GEMM_DMA_TILE(kt_, stg_) do { \
            unsigned char* _b = lds + (stg_) * STG_BYTES + wave * 1024; const int _k = (kt_) * TBK; \
            _Pragma("unroll") for (int _i = 0; _i < 2; ++_i) __builtin_amdgcn_global_load_lds((const unsigned*)(xg + (size_t)(64 * _i) * ldx + _k), (unsigned*)(_b + _i * 8192), 16, 0, 0); \
            _Pragma("unroll") for (int _i = 0; _i < 4; ++_i) __builtin_amdgcn_global_load_lds((const unsigned*)(yg + (size_t)(64 * _i) * ldy + _k), (unsigned*)(_b + XS_BYTES + _i * 8192), 16, 0, 0); \
        } while (0)
        GEMM_DMA_TILE(0, 0);
        GEMM_DMA_TILE(1, 1);
        int cur = 0;
        for (int kt = 0; kt < nk; ++kt) {
            if (kt + 1 < nk) asm volatile("s_waitcnt vmcnt(6)" ::: "memory");
            else if (Epi::HAS_LATE) asm volatile("s_waitcnt vmcnt(16)" ::: "memory");
            else asm volatile("s_waitcnt vmcnt(0)" ::: "memory");
            RAW_BARRIER();
            if (kt + 2 < nk) { const int nxt = (cur == 0) ? 2 : cur - 1; GEMM_DMA_TILE(kt + 2, nxt); }
            if (Epi::HAS_LATE && kt + 2 == nk) epi.late(p0 + wp * (FI * 16), q0 + wq * (FJ * 16), lane);
            const unsigned char* st = lds + cur * STG_BYTES;
#pragma unroll
            for (int kk = 0; kk < 2; ++kk) {
                bf16x8 af[FI], bfr[FJ];
#pragma unroll
                for (int i = 0; i < FI; ++i) af[i] = *(const bf16x8*)(st + swz(wp * (FI * 16) + i * 16 + fr, kk * 4 + fq));
#pragma unroll
                for (int j = 0; j < FJ; ++j) bfr[j] = *(const bf16x8*)(st + XS_BYTES + swz(wq * (FJ * 16) + j * 16 + fr, kk * 4 + fq));
#pragma unroll
                for (int i = 0; i < FI; ++i)
#pragma unroll
                    for (int j = 0; j < FJ; ++j) acc[i][j] = __builtin_amdgcn_mfma_f32_16x16x32_bf16(af[i], bfr[j], acc[i][j], 0, 0, 0);
            }
            cur = (cur == 2) ? 0 : cur + 1;
            if (Epi::HAS_MID && kt + 1 == (nk >> 1)) epi.mid(acc);
        }
#undef GEMM_DMA_TILE
        epi(acc, p0 + wp * (FI * 16), q0 + wq * (FJ * 16), lane, (const float*)nullptr, bi, sub);
    }
}
__device__ __forceinline__ unsigned long long pk4(float a, float b, float c, float d) { return (unsigned long long)pk2(a, b) | ((unsigned long long)pk2(c, d) << 32); }
struct EpiOutProj {
    static constexpr bool HAS_MID = true;
    static constexpr bool HAS_LATE = true;
    const float* x; const float* mod; float* out; unsigned short* y1; const float* ssqo; float* ssq1;
    float ratio[4], rb[4];
    f32x4 xv[4][4];
    __device__ __forceinline__ void late(int pb, int qb, int lane) {
        const int fr = lane & 15, fq = lane >> 4;
#pragma unroll
        for (int j = 0; j < 4; ++j)
#pragma unroll
            for (int i = 0; i < 4; ++i) xv[j][i] = *(const f32x4*)(x + (size_t)(qb + j * 16 + fr) * D + pb + i * 16 + fq * 4);
    }
    __device__ __forceinline__ void pre(int qb, int lane) {
#pragma unroll
        for (int j = 0; j < 4; ++j) {
            const f32x4* s4 = (const f32x4*)(ssqo + (size_t)(qb + j * 16 + (lane & 15)) * 16);
            const f32x4 a0 = s4[0], a1 = s4[1], b0 = s4[2], b1 = s4[3];
            const float sa = (a0.x + a0.y + a0.z + a0.w) + (a1.x + a1.y + a1.z + a1.w), sb = (b0.x + b0.y + b0.z + b0.w) + (b1.x + b1.y + b1.z + b1.w);
            const float ra = rsqrtf(sa * (1.f / 512.f) + EPS); rb[j] = rsqrtf(sb * (1.f / 512.f) + EPS); ratio[j] = ra / rb[j];
        }
    }
    __device__ __forceinline__ void mid(f32x4 (&acc)[4][4]) {
#pragma unroll
        for (int i = 0; i < 4; ++i)
#pragma unroll
            for (int j = 0; j < 4; ++j) { acc[i][j].x *= ratio[j]; acc[i][j].y *= ratio[j]; acc[i][j].z *= ratio[j]; acc[i][j].w *= ratio[j]; }
    }
    __device__ __forceinline__ void operator()(const f32x4 (&acc)[4][4], int pb, int qb, int lane, const float*, int, int = 0) {
        const int fr = lane & 15, fq = lane >> 4;
        const float* __restrict__ xr = x; float* __restrict__ outr = out; unsigned short* __restrict__ yr = y1; float* __restrict__ sr = ssq1;
        const float* mt = mod + (qb >> 12) * NMOD + pb + fq * 4;
        f32x4 gv[4], scv[4];
#pragma unroll
        for (int i = 0; i < 4; ++i) { gv[i] = *(const f32x4*)(mt + 2 * D + i * 16); scv[i] = *(const f32x4*)(mt + 4 * D + i * 16); }
#pragma unroll
        for (int j = 0; j < 4; ++j) {
            const int t = qb + j * 16 + fr;
            float ss = 0.f;
#pragma unroll
            for (int i = 0; i < 4; ++i) {
                const int n = pb + i * 16 + fq * 4;
                const f32x4 xx = xv[j][i];
                f32x4 r; r.x = xx.x + gv[i].x * (acc[i][j].x * rb[j]); r.y = xx.y + gv[i].y * (acc[i][j].y * rb[j]); r.z = xx.z + gv[i].z * (acc[i][j].z * rb[j]); r.w = xx.w + gv[i].w * (acc[i][j].w * rb[j]);
                *(f32x4*)(outr + (size_t)t * D + n) = r;
                ss += (r.x * r.x + r.y * r.y) + (r.z * r.z + r.w * r.w);
                *(unsigned long long*)(yr + (size_t)t * D + n) = pk4(r.x * (1.f + scv[i].x), r.y * (1.f + scv[i].y), r.z * (1.f + scv[i].z), r.w * (1.f + scv[i].w));
            }
            ss += __shfl_xor(ss, 16); ss += __shfl_xor(ss, 32);
            if (fq == 0) sr[(size_t)t * 16 + (pb >> 6)] = ss;
        }
    }
};
struct EpiPQ {
    static constexpr bool HAS_MID = false, HAS_LATE = false;
    __device__ __forceinline__ void late(int, int, int) {}
    unsigned short* C; const float* ssq1; const float* bias;
    float r1[4];
    __device__ __forceinline__ void pre(int qb, int lane) {
#pragma unroll
        for (int j = 0; j < 4; ++j) {
            const f32x4* s4 = (const f32x4*)(ssq1 + (size_t)(qb + j * 16 + (lane & 15)) * 16);
            const f32x4 a0 = s4[0], a1 = s4[1], a2 = s4[2], a3 = s4[3];
            const float sa = ((a0.x + a0.y + a0.z + a0.w) + (a1.x + a1.y + a1.z + a1.w)) + ((a2.x + a2.y + a2.z + a2.w) + (a3.x + a3.y + a3.z + a3.w));
            r1[j] = rsqrtf(sa * (1.f / D) + EPS);
        }
    }
    template <class A> __device__ __forceinline__ void mid(A&) {}
    __device__ __forceinline__ void operator()(const f32x4 (&acc)[4][4], int pb, int qb, int lane, const float*, int, int = 0) {
        const int fr = lane & 15, fq = lane >> 4;
        unsigned short* __restrict__ Cr = C;
        const float* bt = bias + (qb >> 12) * 2048 + pb + fq * 4;
        f32x4 bv[4];
#pragma unroll
        for (int i = 0; i < 4; ++i) bv[i] = *(const f32x4*)(bt + i * 16);
#pragma unroll
        for (int j = 0; j < 4; ++j) {
            const int t = qb + j * 16 + fr;
#pragma unroll
            for (int i = 0; i < 4; ++i) {
                const int n = pb + i * 16 + fq * 4;
                *(unsigned long long*)(Cr + (size_t)t * 2048 + n) = pk4(acc[i][j].x * r1[j] + bv[i].x, acc[i][j].y * r1[j] + bv[i].y, acc[i][j].z * r1[j] + bv[i].z, acc[i][j].w * r1[j] + bv[i].w);
            }
        }
    }
};

struct EpiProj {
    static constexpr bool HAS_MID = false, HAS_LATE = false;
    __device__ __forceinline__ void late(int, int, int) {}
    __device__ __forceinline__ void pre(int, int) {}
    template <class A> __device__ __forceinline__ void mid(A&) {}
    unsigned char* ws;
    __device__ __forceinline__ void operator()(const f32x4 (&acc)[4][4], int pb, int qb, int lane, const float*, int, int = 0) const {
        const int fr = lane & 15, fq = lane >> 4;
        if (pb >= 1216) return;
        const int t0 = qb + fr, b = t0 >> 12, pos0 = t0 & (S - 1);
        if (pb < C_VA) {
            const float* __restrict__ cosA = (const float*)(ws + WS_COSA); const float* __restrict__ sinA = (const float*)(ws + WS_SINA);
            const bool isq = pb < C_KA;
            const int head = isq ? (pb >> 6) : ((pb - C_KA) >> 6);
            unsigned short* __restrict__ dst0 = isq ? (unsigned short*)(ws + WS_QA) + ((size_t)(b * 8 + head) * S + pos0) * 64 : (unsigned short*)(ws + WS_KA) + ((size_t)(b * 2 + head) * S + pos0) * 64;
            const float sc = isq ? QA_SCALE : 1.f;
#pragma unroll
            for (int jh = 0; jh < 4; jh += 2) {
                f32x4 c[2][2], sn[2][2];
#pragma unroll
                for (int jj = 0; jj < 2; ++jj)
#pragma unroll
                    for (int i = 0; i < 2; ++i) { c[jj][i] = *(const f32x4*)(cosA + (pos0 + 16 * (jh + jj)) * 32 + i * 16 + fq * 4); sn[jj][i] = *(const f32x4*)(sinA + (pos0 + 16 * (jh + jj)) * 32 + i * 16 + fq * 4); }
#pragma unroll
                for (int jj = 0; jj < 2; ++jj)
#pragma unroll
                    for (int i = 0; i < 2; ++i) {
                        const int j = jh + jj, d = i * 16 + fq * 4;
                        const f32x4 x1 = acc[i][j], x2 = acc[i + 2][j], cc = c[jj][i], ss = sn[jj][i];
                        unsigned short* dst = dst0 + (size_t)(16 * j) * 64;
                        *(unsigned long long*)(dst + d) = pk4((x1.x * cc.x - x2.x * ss.x) * sc, (x1.y * cc.y - x2.y * ss.y) * sc, (x1.z * cc.z - x2.z * ss.z) * sc, (x1.w * cc.w - x2.w * ss.w) * sc);
                        *(unsigned long long*)(dst + 32 + d) = pk4((x2.x * cc.x + x1.x * ss.x) * sc, (x2.y * cc.y + x1.y * ss.y) * sc, (x2.z * cc.z + x1.z * ss.z) * sc, (x2.w * cc.w + x1.w * ss.w) * sc);
                    }
            }
        } else if (pb < C_QL) {
            const int kvh = (pb - C_VA) >> 6;
            unsigned short* __restrict__ dst0 = (unsigned short*)(ws + WS_VAT) + (size_t)(b * 2 + kvh) * 64 * S + pos0;
#pragma unroll
            for (int j = 0; j < 4; ++j)
#pragma unroll
                for (int i = 0; i < 4; ++i) {
                    const int dv = i * 16 + fq * 4; unsigned short* dst = dst0 + 16 * j;
                    dst[(size_t)(dv + 0) * S] = (unsigned short)f2bf(acc[i][j].x); dst[(size_t)(dv + 1) * S] = (unsigned short)f2bf(acc[i][j].y);
                    dst[(size_t)(dv + 2) * S] = (unsigned short)f2bf(acc[i][j].z); dst[(size_t)(dv + 3) * S] = (unsigned short)f2bf(acc[i][j].w);
                }
        } else if (pb < C_KR) {
            const bool isq = pb < C_KVL;
            unsigned short* __restrict__ dst0 = isq ? (unsigned short*)(ws + WS_QL) + (size_t)t0 * 256 + (pb - C_QL) : (unsigned short*)(ws + WS_KVL) + (size_t)t0 * 128 + (pb - C_KVL);
            const int ld = isq ? 256 : 128;
#pragma unroll
            for (int j = 0; j < 4; ++j)
#pragma unroll
                for (int i = 0; i < 4; ++i) *(unsigned long long*)(dst0 + (size_t)(16 * j) * ld + i * 16 + fq * 4) = pk4(acc[i][j].x, acc[i][j].y, acc[i][j].z, acc[i][j].w);
        } else {
            const float* __restrict__ cosB = (const float*)(ws + WS_COSB); const float* __restrict__ sinB = (const float*)(ws + WS_SINB);
            unsigned short* __restrict__ K96 = (unsigned short*)(ws + WS_K96);
            const int d = fq * 4;
            f32x4 c[4], sn[4];
#pragma unroll
            for (int j = 0; j < 4; ++j) { c[j] = *(const f32x4*)(cosB + (pos0 + 16 * j) * 16 + d); sn[j] = *(const f32x4*)(sinB + (pos0 + 16 * j) * 16 + d); }
#pragma unroll
            for (int j = 0; j < 4; ++j) {
                const f32x4 x1 = acc[0][j], x2 = acc[1][j], cc = c[j], ss = sn[j];
                const unsigned long long lo = pk4(x1.x * cc.x - x2.x * ss.x, x1.y * cc.y - x2.y * ss.y, x1.z * cc.z - x2.z * ss.z, x1.w * cc.w - x2.w * ss.w);
                const unsigned long long hi = pk4(x2.x * cc.x + x1.x * ss.x, x2.y * cc.y + x1.y * ss.y, x2.z * cc.z + x1.z * ss.z, x2.w * cc.w + x1.w * ss.w);
#pragma unroll
                for (int h = 0; h < 8; ++h) {
                    unsigned short* dst = K96 + ((size_t)(b * 8 + h) * S + pos0 + 16 * j) * 64 + 32 + d;
                    *(unsigned long long*)dst = lo; *(unsigned long long*)(dst + 16) = hi;
                }
            }
        }
    }
};
struct EpiQup {
    unsigned char* ws;
    __device__ __forceinline__ void operator()(const f32x4 (&acc)[4][4], int pb, int qb, int lane, const float* ssq, int, int = 0) const {
        const int fr = lane & 15, fq = lane >> 4;
        unsigned short* __restrict__ QMB = (unsigned short*)(ws + WS_QMB);
        const float* __restrict__ cosB = (const float*)(ws + WS_COSB); const float* __restrict__ sinB = (const float*)(ws + WS_SINB);
        const int t0 = qb + fr, b = t0 >> 12, pos0 = t0 & (S - 1);
        float sc[4];
#pragma unroll
        for (int j = 0; j < 4; ++j) sc[j] = rsqrtf(ssq[j * 16 + fr] * (1.f / 256.f) + EPS) * QM_SCALE;
        if (pb < 512) {
            unsigned char* dst0 = (unsigned char*)(QMB + ((size_t)(b * 8 + (pb >> 6)) * S + pos0) * 64);
#pragma unroll
            for (int j = 0; j < 4; ++j)
#pragma unroll
                for (int i = 0; i < 4; ++i) {
                    const float s8 = sc[j] * 8.f; int w = 0;
                    w = __builtin_amdgcn_cvt_pk_fp8_f32(acc[i][j].x * s8, acc[i][j].y * s8, w, false); w = __builtin_amdgcn_cvt_pk_fp8_f32(acc[i][j].z * s8, acc[i][j].w * s8, w, true);
                    *(unsigned*)(dst0 + (size_t)(16 * j) * 128 + i * 16 + fq * 4) = (unsigned)w;
                }
        } else {
            const int d = fq * 4;
            f32x4 c[4], sn[4];
#pragma unroll
            for (int j = 0; j < 4; ++j) { c[j] = *(const f32x4*)(cosB + (pos0 + 16 * j) * 16 + d); sn[j] = *(const f32x4*)(sinB + (pos0 + 16 * j) * 16 + d); }
#pragma unroll
            for (int j = 0; j < 4; ++j)
#pragma unroll
                for (int hh = 0; hh < 2; ++hh) {
                    const int h = ((pb - 512) >> 5) + hh;
                    unsigned short* dst = QMB + ((size_t)(b * 8 + h) * S + pos0 + 16 * j) * 64 + 32 + d;
                    const f32x4 x1 = acc[2 * hh][j], x2 = acc[2 * hh + 1][j], cc = c[j], ss = sn[j]; const float s_ = sc[j];
                    *(unsigned long long*)dst = pk4((x1.x * cc.x - x2.x * ss.x) * s_, (x1.y * cc.y - x2.y * ss.y) * s_, (x1.z * cc.z - x2.z * ss.z) * s_, (x1.w * cc.w - x2.w * ss.w) * s_);
                    *(unsigned long long*)(dst + 16) = pk4((x2.x * cc.x + x1.x * ss.x) * s_, (x2.y * cc.y + x1.y * ss.y) * s_, (x2.z * cc.z + x1.z * ss.z) * s_, (x2.w * cc.w + x1.w * ss.w) * s_);
                }
        }
    }
};
struct EpiKVup {
    unsigned char* ws;
    __device__ __forceinline__ void operator()(const f32x4 (&acc)[4][4], int pb, int qb, int lane, const float* ssq, int, int = 0) const {
        const int fr = lane & 15, fq = lane >> 4;
        unsigned short* K96 = (unsigned short*)(ws + WS_K96); unsigned short* VT = (unsigned short*)(ws + WS_VT);
        const int h = pb >> 7;
#pragma unroll
        for (int j = 0; j < 4; ++j) {
            const int t = qb + j * 16 + fr, b = t >> 12, pos = t & (S - 1);
            const float sc = rsqrtf(ssq[j * 16 + fr] * (1.f / 128.f) + EPS);
            if ((pb & 64) == 0) {
                unsigned char* dst = (unsigned char*)(K96 + ((size_t)(b * 8 + h) * S + pos) * 64);
#pragma unroll
                for (int i = 0; i < 4; ++i) {
                    int w = 0;
                    w = __builtin_amdgcn_cvt_pk_fp8_f32(acc[i][j].x * sc, acc[i][j].y * sc, w, false); w = __builtin_amdgcn_cvt_pk_fp8_f32(acc[i][j].z * sc, acc[i][j].w * sc, w, true);
                    *(unsigned*)(dst + i * 16 + fq * 4) = (unsigned)w;
                }
            } else {
                unsigned char* dst = (unsigned char*)VT + (size_t)(b * 8 + h) * 64 * S + pos;
#pragma unroll
                for (int i = 0; i < 4; ++i) {
                    const int dv = i * 16 + fq * 4;
                    const int w0 = __builtin_amdgcn_cvt_pk_fp8_f32(acc[i][j].x * sc, acc[i][j].y * sc, 0, false), w1 = __builtin_amdgcn_cvt_pk_fp8_f32(acc[i][j].z * sc, acc[i][j].w * sc, 0, false);
                    dst[(size_t)(dv + 0) * S] = (unsigned char)(w0 & 0xff); dst[(size_t)(dv + 1) * S] = (unsigned char)((w0 >> 8) & 0xff);
                    dst[(size_t)(dv + 2) * S] = (unsigned char)(w1 & 0xff); dst[(size_t)(dv + 3) * S] = (unsigned char)((w1 >> 8) & 0xff);
                }
            }
        }
    }
};

typedef float f32x16 __attribute__((ext_vector_type(16)));
typedef __bf16 bf16x2_t __attribute__((ext_vector_type(2)));
__device__ __forceinline__ unsigned cvtpk(float lo, float hi) { f32x2 v = {lo, hi}; bf16x2_t b = __builtin_convertvector(v, bf16x2_t); return __builtin_bit_cast(unsigned, b); }
__device__ __forceinline__ int crow(int r, int hi) { return (r & 3) + 8 * (r >> 2) + 4 * hi; }
__device__ __forceinline__ int kperm(int rho) { return (rho & 0x13) | ((rho & 4) << 1) | ((rho & 8) >> 1); }

template <int DQK, bool SWA>
__device__ void stage_attn_flash(const Params& p, unsigned char* lds) {
    constexpr bool V8 = !SWA;
    constexpr bool Q8 = !SWA;
    constexpr int NK = DQK / 16, KCH = DQK / 8, KSTR = Q8 ? 80 : (KCH + 1) * 16, VSTR = V8 ? 80 : 144;
    constexpr int KT_BYTES = Q8 ? 2 * 64 * 80 : 64 * KSTR, VT_BYTES = 64 * VSTR, STG = KT_BYTES + VT_BYTES, NKC = 64 * KCH;
    const unsigned short* Qg = (const unsigned short*)(p.ws + (SWA ? WS_QA : WS_QMB));
    const unsigned short* Kg = (const unsigned short*)(p.ws + (SWA ? WS_KA : WS_K96));
    const unsigned short* Vg = (const unsigned short*)(p.ws + (SWA ? WS_VAT : WS_VT));
    unsigned short* O = (unsigned short*)(p.ws + WS_OAB);
    const int tid = threadIdx.x, lane = tid & 63, wave = tid >> 6, r32 = lane & 31, hi = lane >> 5;
    const int G = gridDim.x, bx = blockIdx.x;
    const int vcu = (G % 8 == 0) ? (bx % 8) * (G / 8) + bx / 8 : bx;
    const int nunits = SWA ? Bsz * 2 * 64 : Bsz * 8 * 16;
    const int kro = kperm(r32) * KSTR + hi * (Q8 ? 32 : 16);
    const int krr = 64 * 80 + kperm(r32) * 80 + hi * 16;
    const int k8lds = ((tid & 7) < 4) ? ((tid >> 3) * 80 + (tid & 7) * 16) : (64 * 80 + (tid >> 3) * 80 + ((tid & 7) - 4) * 16);
    const int vro = r32 * VSTR + hi * (V8 ? 32 : 16);
    const int kid0 = tid, kid1 = tid + 512;
    const int k0row = kid0 / KCH, k0c = kid0 % KCH, k1row = kid1 / KCH, k1c = kid1 % KCH;
    const int vrow = V8 ? (tid >> 2) : (tid >> 3), vc = V8 ? (tid & 3) : (tid & 7);
#define FA_DECODE(U_, b_, qb_, tlo_, thi_, sq_, ocol_, Qp_, Kb_, Vb_, m_, l_) do { \
        if (SWA) { \
            qb_ = (U_) & 63; const int kvh_ = ((U_) >> 6) & 1; b_ = (U_) >> 7; \
            const int head_ = kvh_ * 4 + (wave >> 1); \
            sq_ = qb_ * 64 + (wave & 1) * 32 + r32; \
            Qp_ = Qg + ((size_t)(b_ * 8 + head_) * S + sq_) * 64; \
            Kb_ = Kg + (size_t)(b_ * 2 + kvh_) * S * 64; Vb_ = Vg + (size_t)(b_ * 2 + kvh_) * 64 * S; \
            tlo_ = qb_ - 2 < 0 ? 0 : qb_ - 2; thi_ = qb_ + 2 > 63 ? 63 : qb_ + 2; \
            m_ = p.sink[head_] * LOG2E; l_ = 0.5f; ocol_ = head_ * 64; \
        } else { \
            qb_ = (U_) & 15; const int h_ = ((U_) >> 4) & 7; b_ = (U_) >> 7; \
            sq_ = qb_ * 256 + wave * 32 + r32; \
            Qp_ = Qg + ((size_t)(b_ * 8 + h_) * S + sq_) * 64; \
            Kb_ = Kg + (size_t)(b_ * 8 + h_) * S * 64; Vb_ = (const unsigned short*)((const unsigned char*)Vg + (size_t)(b_ * 8 + h_) * 64 * S); \
            tlo_ = 0; thi_ = 63; m_ = 0.f; l_ = 0.f; ocol_ = 512 + h_ * 64; \
        } } while (0)
#define FA_LOADQ(Qp_, qfd_, qnd_) do { \
        if (Q8) { \
            const u32x4 q0_ = *(const u32x4*)((const unsigned char*)(Qp_) + hi * 32), q1_ = *(const u32x4*)((const unsigned char*)(Qp_) + hi * 32 + 16); \
            qnd_ = (i32x8){(int)q0_.x, (int)q0_.y, (int)q0_.z, (int)q0_.w, (int)q1_.x, (int)q1_.y, (int)q1_.z, (int)q1_.w}; \
            qfd_[0] = *(const bf16x8*)((Qp_) + 32 + hi * 8); qfd_[1] = *(const bf16x8*)((Qp_) + 48 + hi * 8); \
        } else { \
            _Pragma("unroll") for (int ks = 0; ks < NK; ++ks) qfd_[ks] = *(const bf16x8*)((Qp_) + ks * 16 + hi * 8); \
        } } while (0)
#define FA_LOADT(Kb_, Vb_, T_) do { \
        const unsigned short* kt_ = (Kb_) + (size_t)(T_) * 64 * (Q8 ? 64 : DQK); \
        rk0 = *(const u32x4*)(kt_ + kid0 * 8); \
        if (!Q8 && kid1 < NKC) rk1 = *(const u32x4*)(kt_ + kid1 * 8); \
        if (!V8 || tid < 256) rv = *(const u32x4*)((const unsigned char*)(Vb_) + (V8 ? 1 : 2) * ((size_t)vrow * S + (T_) * 64) + vc * 16); } while (0)
#define FA_STORET(ST_) do { unsigned char* st_ = (ST_); \
        if (Q8) *(u32x4*)(st_ + k8lds) = rk0; \
        else { *(u32x4*)(st_ + k0row * KSTR + k0c * 16) = rk0; if (kid1 < NKC) *(u32x4*)(st_ + k1row * KSTR + k1c * 16) = rk1; } \
        if (V8) { if (tid < 256) { unsigned long long* vd = (unsigned long long*)(st_ + KT_BYTES + vrow * VSTR + vc * 8); vd[0] = (unsigned long long)rv.x | ((unsigned long long)rv.y << 32); vd[4] = (unsigned long long)rv.z | ((unsigned long long)rv.w << 32); } } \
        else *(u32x4*)(st_ + KT_BYTES + vrow * VSTR + vc * 16) = rv; } while (0)
    u32x4 rk0, rk1, rv;
    bf16x8 qfn[NK]; i32x8 qnn = {0, 0, 0, 0, 0, 0, 0, 0};
    if (vcu < nunits) {
        int b, qb, tlo, thi, sq, ocol; const unsigned short *Qp, *Kb, *Vb; float m, l;
        FA_DECODE(vcu, b, qb, tlo, thi, sq, ocol, Qp, Kb, Vb, m, l);
        (void)b; (void)qb; (void)thi; (void)sq; (void)ocol; (void)m; (void)l;
        FA_LOADQ(Qp, qfn, qnn);
        FA_LOADT(Kb, Vb, tlo);
    }
    for (int u = vcu; u < nunits; u += G) {
        int b, qb, tlo, thi, sq, ocol; const unsigned short *Qp, *Kb, *Vb; float m, l;
        FA_DECODE(u, b, qb, tlo, thi, sq, ocol, Qp, Kb, Vb, m, l);
        (void)Qp;
        bf16x8 qf[NK];
        i32x8 qn = qnn;
#pragma unroll
        for (int ks = 0; ks < NK; ++ks) qf[ks] = qfn[ks];
        f32x16 o0, o1, negm;
        i32x8 pb = {0, 0, 0, 0, 0, 0, 0, 0};
#pragma unroll
        for (int r = 0; r < 16; ++r) { o0[r] = 0.f; o1[r] = 0.f; negm[r] = -m; }
        FA_STORET(lds);
        const int un = u + G;
        int nb = 0, nqb = 0, ntlo = 0, nthi = 0, nsq = 0, nocol = 0; const unsigned short *nQp = Qg, *nKb = Kg, *nVb = Vg; float nm = 0.f, nl = 0.f;
        if (un < nunits) FA_DECODE(un, nb, nqb, ntlo, nthi, nsq, nocol, nQp, nKb, nVb, nm, nl);
        (void)nb; (void)nqb; (void)nthi; (void)nsq; (void)nocol; (void)nm; (void)nl;
        __syncthreads();
        for (int tt = tlo; tt <= thi; ++tt) {
            const unsigned char* Kl = lds + ((tt - tlo) & 1) * STG;
            const unsigned char* Vl = Kl + KT_BYTES;
            unsigned char* Kn = lds + (((tt - tlo) & 1) ^ 1) * STG;
            const bool more = tt < thi;
            if (more) FA_LOADT(Kb, Vb, tt + 1);
            else if (un < nunits) { FA_LOADQ(nQp, qfn, qnn); FA_LOADT(nKb, nVb, ntlo); }
            f32x16 s0, s1;
            if (!Q8) {
                const float nm = -m;
#pragma unroll
                for (int r = 0; r < 16; ++r) { s0[r] = nm; s1[r] = nm; }
            }
            if (Q8) {
                const u32x4 k00 = *(const u32x4*)(Kl + kro), k01 = *(const u32x4*)(Kl + kro + 16), k10 = *(const u32x4*)(Kl + 32 * 80 + kro), k11 = *(const u32x4*)(Kl + 32 * 80 + kro + 16);
                const i32x8 ka0 = {(int)k00.x, (int)k00.y, (int)k00.z, (int)k00.w, (int)k01.x, (int)k01.y, (int)k01.z, (int)k01.w};
                const i32x8 ka1 = {(int)k10.x, (int)k10.y, (int)k10.z, (int)k10.w, (int)k11.x, (int)k11.y, (int)k11.z, (int)k11.w};
                s0 = __builtin_amdgcn_mfma_scale_f32_32x32x64_f8f6f4(ka0, qn, negm, 0, 0, 0, 0x7f7f7f7f, 0, 0x7c7c7c7c);
                s1 = __builtin_amdgcn_mfma_scale_f32_32x32x64_f8f6f4(ka1, qn, negm, 0, 0, 0, 0x7f7f7f7f, 0, 0x7c7c7c7c);
#pragma unroll
                for (int ks = 0; ks < 2; ++ks) {
                    const bf16x8 kf0 = *(const bf16x8*)(Kl + krr + ks * 32);
                    const bf16x8 kf1 = *(const bf16x8*)(Kl + 32 * 80 + krr + ks * 32);
                    s0 = __builtin_amdgcn_mfma_f32_32x32x16_bf16(kf0, qf[ks], s0, 0, 0, 0);
                    s1 = __builtin_amdgcn_mfma_f32_32x32x16_bf16(kf1, qf[ks], s1, 0, 0, 0);
                }
            } else {
#pragma unroll
            for (int ks = 0; ks < NK; ++ks) {
                const bf16x8 kf0 = *(const bf16x8*)(Kl + kro + ks * 32);
                const bf16x8 kf1 = *(const bf16x8*)(Kl + 32 * KSTR + kro + ks * 32);
                s0 = __builtin_amdgcn_mfma_f32_32x32x16_bf16(kf0, qf[ks], s0, 0, 0, 0);
                s1 = __builtin_amdgcn_mfma_f32_32x32x16_bf16(kf1, qf[ks], s1, 0, 0, 0);
            }
            }
            if (SWA) {
                const int rel = tt - qb;
                if (rel == -2 || rel == 2) {
                    const int qi = (wave & 1) * 32 + r32;
#pragma unroll
                    for (int r = 0; r < 16; ++r) {
                        const int kk = kperm(crow(r, hi));
                        const bool v0 = (rel == -2) ? (kk >= qi) : (kk <= qi);
                        const bool v1 = (rel == -2) ? (kk + 32 >= qi) : (kk + 32 <= qi);
                        s0[r] = v0 ? s0[r] : -1e30f; s1[r] = v1 ? s1[r] : -1e30f;
                    }
                }
            }
            if ((!SWA) && (tt == tlo)) {
                float mx = fmaxf(s0[0], s1[0]);
#pragma unroll
                for (int r = 1; r < 16; ++r) mx = fmaxf(mx, fmaxf(s0[r], s1[r]));
                mx = fmaxf(mx, __shfl_xor(mx, 32));
                m = mx;
#pragma unroll
                for (int r = 0; r < 16; ++r) { s0[r] -= mx; s1[r] -= mx; negm[r] = -mx; }
            }
            float rs = 0.f;
#pragma unroll
            for (int r = 0; r < 16; ++r) { s0[r] = __builtin_amdgcn_exp2f(s0[r]); s1[r] = __builtin_amdgcn_exp2f(s1[r]); rs += s0[r] + s1[r]; }
            if (!__all(rs <= 1024.f)) {
                float mp = fmaxf(s0[0], s1[0]);
#pragma unroll
                for (int r = 1; r < 16; ++r) mp = fmaxf(mp, fmaxf(s0[r], s1[r]));
                mp = fmaxf(fmaxf(mp, __shfl_xor(mp, 32)), 1.f);
                const float alpha = 1.f / mp;
                m += __builtin_amdgcn_logf(mp);
                l *= alpha; rs *= alpha;
#pragma unroll
                for (int r = 0; r < 16; ++r) { o0[r] *= alpha; o1[r] *= alpha; s0[r] *= alpha; s1[r] *= alpha; negm[r] = -m; }
            }
            l += rs;
            if (V8) {
#pragma unroll
                for (int q = 0; q < 4; ++q) {
                    pb[q] = __builtin_amdgcn_cvt_pk_bf8_f32(s0[4 * q + 0], s0[4 * q + 1], pb[q], false); pb[q] = __builtin_amdgcn_cvt_pk_bf8_f32(s0[4 * q + 2], s0[4 * q + 3], pb[q], true);
                    pb[4 + q] = __builtin_amdgcn_cvt_pk_bf8_f32(s1[4 * q + 0], s1[4 * q + 1], pb[4 + q], false); pb[4 + q] = __builtin_amdgcn_cvt_pk_bf8_f32(s1[4 * q + 2], s1[4 * q + 3], pb[4 + q], true);
                }
                const u32x4 a00 = *(const u32x4*)(Vl + vro), a01 = *(const u32x4*)(Vl + vro + 16), a10 = *(const u32x4*)(Vl + 32 * VSTR + vro), a11 = *(const u32x4*)(Vl + 32 * VSTR + vro + 16);
                const i32x8 va0 = {(int)a00.x, (int)a00.y, (int)a00.z, (int)a00.w, (int)a01.x, (int)a01.y, (int)a01.z, (int)a01.w};
                const i32x8 va1 = {(int)a10.x, (int)a10.y, (int)a10.z, (int)a10.w, (int)a11.x, (int)a11.y, (int)a11.z, (int)a11.w};
                o0 = __builtin_amdgcn_mfma_scale_f32_32x32x64_f8f6f4(va0, pb, o0, 0, 1, 0, 0x7f7f7f7f, 0, 0x7f7f7f7f);
                o1 = __builtin_amdgcn_mfma_scale_f32_32x32x64_f8f6f4(va1, pb, o1, 0, 1, 0, 0x7f7f7f7f, 0, 0x7f7f7f7f);
            } else {
#pragma unroll
            for (int st = 0; st < 2; ++st) {
                u32x4 pw;
                pw.x = cvtpk(s0[8 * st + 0], s0[8 * st + 1]); pw.y = cvtpk(s0[8 * st + 2], s0[8 * st + 3]);
                pw.z = cvtpk(s0[8 * st + 4], s0[8 * st + 5]); pw.w = cvtpk(s0[8 * st + 6], s0[8 * st + 7]);
                const bf16x8 pf = __builtin_bit_cast(bf16x8, pw);
                const bf16x8 vf0 = *(const bf16x8*)(Vl + vro + st * 32);
                const bf16x8 vf1 = *(const bf16x8*)(Vl + 32 * VSTR + vro + st * 32);
                o0 = __builtin_amdgcn_mfma_f32_32x32x16_bf16(vf0, pf, o0, 0, 0, 0);
                o1 = __builtin_amdgcn_mfma_f32_32x32x16_bf16(vf1, pf, o1, 0, 0, 0);
            }
#pragma unroll
            for (int st = 0; st < 2; ++st) {
                u32x4 pw;
                pw.x = cvtpk(s1[8 * st + 0], s1[8 * st + 1]); pw.y = cvtpk(s1[8 * st + 2], s1[8 * st + 3]);
                pw.z = cvtpk(s1[8 * st + 4], s1[8 * st + 5]); pw.w = cvtpk(s1[8 * st + 6], s1[8 * st + 7]);
                const bf16x8 pf = __builtin_bit_cast(bf16x8, pw);
                const bf16x8 vf0 = *(const bf16x8*)(Vl + vro + 64 + st * 32);
                const bf16x8 vf1 = *(const bf16x8*)(Vl + 32 * VSTR + vro + 64 + st * 32);
                o0 = __builtin_amdgcn_mfma_f32_32x32x16_bf16(vf0, pf, o0, 0, 0, 0);
                o1 = __builtin_amdgcn_mfma_f32_32x32x16_bf16(vf1, pf, o1, 0, 0, 0);
            }
            }
            if (more) FA_STORET(Kn);
            __syncthreads();
        }
        const float il = 1.f / (l + __shfl_xor(l, 32));
        {
            float ss = 0.f;
#pragma unroll
            for (int r = 0; r < 16; ++r) { const float a0 = o0[r] * il, a1 = o1[r] * il; ss += a0 * a0 + a1 * a1; }
            ss += __shfl_xor(ss, 32);
            if (hi == 0) ((float*)(p.ws + WS_SSQO))[(size_t)(b * S + sq) * 16 + (ocol >> 6)] = ss;
        }
        unsigned short* orow = O + (size_t)(b * S + sq) * D + ocol + 4 * hi;
#pragma unroll
        for (int g = 0; g < 4; ++g) {
            *(unsigned long long*)(orow + 8 * g) = (unsigned long long)cvtpk(o0[4 * g] * il, o0[4 * g + 1] * il) | ((unsigned long long)cvtpk(o0[4 * g + 2] * il, o0[4 * g + 3] * il) << 32);
            *(unsigned long long*)(orow + 32 + 8 * g) = (unsigned long long)cvtpk(o1[4 * g] * il, o1[4 * g + 1] * il) | ((unsigned long long)cvtpk(o1[4 * g + 2] * il, o1[4 * g + 3] * il) << 32);
        }
    }
#undef FA_DECODE
#undef FA_LOADQ
#undef FA_LOADT
#undef FA_STORET
}

__device__ __forceinline__ int kmax(int a, int b) { return __builtin_bit_cast(int, __builtin_fmaxf(__builtin_bit_cast(float, a), __builtin_bit_cast(float, b))); }
__device__ __forceinline__ int kmin(int a, int b) { return __builtin_bit_cast(int, __builtin_fminf(__builtin_bit_cast(float, a), __builtin_bit_cast(float, b))); }
__device__ __forceinline__ void ce_desc(int& a, int& b) { const int hi = kmax(a, b), lo = kmin(a, b); a = hi; b = lo; }
__device__ __forceinline__ void ce_asc(int& a, int& b) { const int hi = kmax(a, b), lo = kmin(a, b); a = lo; b = hi; }
template <int OFF> __device__ __forceinline__ void sort16_desc(int (&a)[32]) {
#define CE_(i_, j_) ce_desc(a[OFF + (i_)], a[OFF + (j_)]);
    CE_(0,13) CE_(1,12) CE_(2,15) CE_(3,14) CE_(4,8) CE_(5,6) CE_(7,11) CE_(9,10)
    CE_(0,5) CE_(1,7) CE_(2,9) CE_(3,4) CE_(6,13) CE_(8,14) CE_(10,15) CE_(11,12)
    CE_(0,1) CE_(2,3) CE_(4,5) CE_(6,8) CE_(7,9) CE_(10,11) CE_(12,13) CE_(14,15)
    CE_(0,2) CE_(1,3) CE_(4,10) CE_(5,11) CE_(6,7) CE_(8,9) CE_(12,14) CE_(13,15)
    CE_(1,2) CE_(3,12) CE_(4,6) CE_(5,7) CE_(8,10) CE_(9,11) CE_(13,14)
    CE_(1,4) CE_(2,6) CE_(5,8) CE_(7,10) CE_(9,13) CE_(11,14)
    CE_(2,4) CE_(3,6) CE_(9,12) CE_(11,13)
    CE_(3,5) CE_(6,8) CE_(7,9) CE_(10,12)
    CE_(3,4) CE_(5,6) CE_(7,8) CE_(9,10) CE_(11,12)
    CE_(6,7) CE_(8,9)
#undef CE_
}
template <int N, int OFF> __device__ __forceinline__ void bitonic_sort_desc(int (&a)[32]) {
#pragma unroll
    for (int k = 2; k <= N; k <<= 1)
#pragma unroll
        for (int j = k >> 1; j > 0; j >>= 1)
#pragma unroll
            for (int i = 0; i < N; ++i) {
                const int l = i ^ j;
                if (l > i) { if ((i & k) == 0) ce_desc(a[OFF + i], a[OFF + l]); else ce_asc(a[OFF + i], a[OFF + l]); }
            }
}
__device__ __forceinline__ void bitonic_clean16_desc(int (&a)[32]) {
#pragma unroll
    for (int j = 8; j > 0; j >>= 1)
#pragma unroll
        for (int i = 0; i < 16; ++i) { const int l = i ^ j; if (l > i) ce_desc(a[i], a[l]); }
}
__device__ __forceinline__ int f2sortable(float f) { return __builtin_bit_cast(int, f); }
__device__ __forceinline__ float sortable2f(int s) { return __builtin_bit_cast(float, s); }
constexpr int KEY_LOWEST = (int)0xff800000;
struct CandTab { int i[52], j[52]; };
constexpr CandTab make_cands() { CandTab t{}; int n = 0; for (int i = 0; i < 16; ++i) for (int j = 0; j < 16; ++j) if ((i + 1) * (j + 1) <= 16) { t.i[n] = i; t.j[n] = j; ++n; } for (; n < 52; ++n) { t.i[n] = -1; t.j[n] = -1; } return t; }
constexpr CandTab CANDS = make_cands();
struct EpiTopkSel {
    static constexpr bool HAS_MID = false, HAS_LATE = false;
    __device__ __forceinline__ void late(int, int, int) {}
    __device__ __forceinline__ void pre(int, int) {}
    template <class A> __device__ __forceinline__ void mid(A&) {}
    unsigned short* idx; float* g;
    int* keepg;
    __device__ __forceinline__ void operator()(const f32x4 (&acc)[8][2], int pb, int qb, int lane, const float*, int hp, int half) {
        const int fr = lane & 15, fq = lane >> 4;
#pragma unroll
        for (int j = 0; j < 2; ++j) {
            int v[32];
#pragma unroll
            for (int i = 0; i < 8; ++i)
#pragma unroll
                for (int r = 0; r < 4; ++r) v[i * 4 + r] = (f2sortable(acc[i][j][r]) & ~127) | (i * 16 + fq * 4 + r);
            sort16_desc<0>(v); sort16_desc<16>(v);
#pragma unroll
            for (int i = 0; i < 16; ++i) v[i] = kmax(v[i], v[31 - i]);
            bitonic_clean16_desc(v);
#pragma unroll
            for (int x = 16; x <= 32; x <<= 1) {
#pragma unroll
                for (int i = 0; i < 16; ++i) v[16 + i] = __shfl_xor(v[i], x);
#pragma unroll
                for (int i = 0; i < 16; ++i) v[i] = kmax(v[i], v[31 - i]);
                bitonic_clean16_desc(v);
            }
            u32x4* kp = (u32x4*)(keepg + ((qb & 255) + j * 16 + fr) * 16);
            if (half == 0) {
                if (fq == 0) {
#pragma unroll
                    for (int i = 0; i < 4; ++i) kp[i] = (u32x4){(unsigned)v[4 * i], (unsigned)v[4 * i + 1], (unsigned)v[4 * i + 2], (unsigned)v[4 * i + 3]};
                }
            } else {
                float as[16], bs[16]; int ai[16], bi[16];
#pragma unroll
                for (int i = 0; i < 4; ++i) {
                    const u32x4 kv = kp[i];
#pragma unroll
                    for (int c = 0; c < 4; ++c) { as[4 * i + c] = sortable2f((int)kv[c] & ~127); ai[4 * i + c] = ((int)kv[c] & 127) << 7; }
                }
#pragma unroll
                for (int i = 0; i < 16; ++i) { bs[i] = sortable2f(v[i] & ~127); bi[i] = v[i] & 127; }
                int w[32];
#pragma unroll
                for (int sl = 0; sl < 13; ++sl) {
                    int c4[4];
#pragma unroll
                    for (int f = 0; f < 4; ++f) {
                        constexpr int dummy = 0; (void)dummy;
                        const int ci = CANDS.i[sl * 4 + f], cj = CANDS.j[sl * 4 + f];
                        c4[f] = (ci >= 0) ? ((f2sortable(as[ci >= 0 ? ci : 0] + bs[cj >= 0 ? cj : 0]) & ~0x3fff) | (ai[ci >= 0 ? ci : 0] | bi[cj >= 0 ? cj : 0])) : KEY_LOWEST;
                    }
                    w[sl] = (fq == 0) ? c4[0] : (fq == 1) ? c4[1] : (fq == 2) ? c4[2] : c4[3];
                }
                w[13] = w[14] = w[15] = KEY_LOWEST;
                sort16_desc<0>(w);
#pragma unroll
                for (int x = 16; x <= 32; x <<= 1) {
#pragma unroll
                    for (int i = 0; i < 16; ++i) w[16 + i] = __shfl_xor(w[i], x);
#pragma unroll
                    for (int i = 0; i < 16; ++i) w[i] = kmax(w[i], w[31 - i]);
                    bitonic_clean16_desc(w);
                }
                int my[4];
#pragma unroll
                for (int c = 0; c < 4; ++c) my[c] = (fq == 0) ? w[c] : (fq == 1) ? w[4 + c] : (fq == 2) ? w[8 + c] : w[12 + c];
                const float top = sortable2f(w[0] & ~0x3fff);
                float e[4], part = 0.f;
#pragma unroll
                for (int c = 0; c < 4; ++c) { e[c] = __expf(sortable2f(my[c] & ~0x3fff) - top); part += e[c]; }
                part += __shfl_xor(part, 16); part += __shfl_xor(part, 32);
                const float inv = 1.f / part;
                const int t = qb + j * 16 + fr;
                const size_t o = (size_t)t * 128 + (hp >> 1) * 16 + fq * 4;
                *(unsigned long long*)(idx + o) = (unsigned long long)(unsigned)((my[0] & 0x3fff) | ((my[1] & 0x3fff) << 16)) | ((unsigned long long)(unsigned)((my[2] & 0x3fff) | ((my[3] & 0x3fff) << 16)) << 32);
                *(f32x4*)(g + o) = (f32x4){e[0] * inv, e[1] * inv, e[2] * inv, e[3] * inv};
            }
        }
    }
};
__device__ void gemm_pq_fused(const Params& p, unsigned char* lds) {
    const unsigned short* X = (const unsigned short*)(p.ws + WS_WPQ);
    const unsigned short* Y = (const unsigned short*)(p.ws + WS_HB);
    const unsigned short* SK = (const unsigned short*)(p.ws + WS_SUBK);
    const float* ssq1 = (const float*)(p.ws + WS_SSQ1); const float* bias = (const float*)(p.ws + WS_BPQ);
    EpiTopkSel tsel{(unsigned short*)(p.ws + WS_IDX), (float*)(p.ws + WS_G), (int*)(p.ws + WS_KEEP) + (size_t)blockIdx.x * 4096};
    const int tid = threadIdx.x, lane = tid & 63, wave = __builtin_amdgcn_readfirstlane(tid >> 6);
    const int wp = wave >> 2, wq = wave & 3, fr = lane & 15, fq = lane >> 4;
    const int G = gridDim.x, bx = blockIdx.x;
    const int vcu = (G % 8 == 0) ? (bx % 8) * (G / 8) + bx / 8 : bx;
    const int srow = wave * 8 + (lane >> 3), pc = lane & 7, lc = pc ^ ((srow >> 1) & 7);
    constexpr int nk = D / TBK, nunits = 8 * (T / TQ);
    for (int u = vcu; u < nunits; u += G) {
        const int qt = u >> 3, h = u & 7, q0 = qt * TQ;
#pragma unroll
        for (int sub = 0; sub < 2; ++sub) {
            const int hp = h * 2 + sub, p0 = hp * TP;
            f32x4 acc[4][4];
#pragma unroll
            for (int i = 0; i < 4; ++i)
#pragma unroll
                for (int j = 0; j < 4; ++j) acc[i][j] = (f32x4){0.f, 0.f, 0.f, 0.f};
            const unsigned short* xg = X + (size_t)(p0 + srow) * D + lc * 8;
            const unsigned short* yg = Y + (size_t)(q0 + srow) * D + lc * 8;
            asm volatile("s_waitcnt vmcnt(0)" ::: "memory");
            RAW_BARRIER();
#define PQ_DMA_TILE(kt_, stg_) do { \
                unsigned char* _b = lds + (stg_) * STG_BYTES + wave * 1024; const int _k = (kt_) * TBK; \
                _Pragma("unroll") for (int _i = 0; _i < 2; ++_i) __builtin_amdgcn_global_load_lds((const unsigned*)(xg + (size_t)(64 * _i) * D + _k), (unsigned*)(_b + _i * 8192), 16, 0, 0); \
                _Pragma("unroll") for (int _i = 0; _i < 4; ++_i) __builtin_amdgcn_global_load_lds((const unsigned*)(yg + (size_t)(64 * _i) * D + _k), (unsigned*)(_b + XS_BYTES + _i * 8192), 16, 0, 0); \
            } while (0)
            PQ_DMA_TILE(0, 0);
            PQ_DMA_TILE(1, 1);
            int cur = 0;
            for (int kt = 0; kt < nk; ++kt) {
                if (kt + 1 < nk) asm volatile("s_waitcnt vmcnt(6)" ::: "memory"); else asm volatile("s_waitcnt vmcnt(0)" ::: "memory");
                RAW_BARRIER();
                if (kt + 2 < nk) { const int nxt = (cur == 0) ? 2 : cur - 1; PQ_DMA_TILE(kt + 2, nxt); }
                const unsigned char* st = lds + cur * STG_BYTES;
#pragma unroll
                for (int kk = 0; kk < 2; ++kk) {
                    bf16x8 af[4], bfr[4];
#pragma unroll
                    for (int i = 0; i < 4; ++i) af[i] = *(const bf16x8*)(st + swz(wp * 64 + i * 16 + fr, kk * 4 + fq));
#pragma unroll
                    for (int j = 0; j < 4; ++j) bfr[j] = *(const bf16x8*)(st + XS_BYTES + swz(wq * 64 + j * 16 + fr, kk * 4 + fq));
#pragma unroll
                    for (int i = 0; i < 4; ++i)
#pragma unroll
                        for (int j = 0; j < 4; ++j) acc[i][j] = __builtin_amdgcn_mfma_f32_16x16x32_bf16(af[i], bfr[j], acc[i][j], 0, 0, 0);
                }
                cur = (cur == 2) ? 0 : cur + 1;
            }
#undef PQ_DMA_TILE
            RAW_BARRIER();
            {
                float r1[4]; f32x4 bv[4];
#pragma unroll
                for (int j = 0; j < 4; ++j) {
                    const f32x4* s4 = (const f32x4*)(ssq1 + (size_t)(q0 + wq * 64 + j * 16 + fr) * 16);
                    const f32x4 a0 = s4[0], a1 = s4[1], a2 = s4[2], a3 = s4[3];
                    r1[j] = rsqrtf((((a0.x + a0.y + a0.z + a0.w) + (a1.x + a1.y + a1.z + a1.w)) + ((a2.x + a2.y + a2.z + a2.w) + (a3.x + a3.y + a3.z + a3.w))) * (1.f / D) + EPS);
                }
                {
                    const float* bt = bias + (q0 >> 12) * 2048 + p0 + wp * 64 + fq * 4;
#pragma unroll
                    for (int i = 0; i < 4; ++i) bv[i] = *(const f32x4*)(bt + i * 16);
                }
                const unsigned short* kg = SK + (size_t)hp * 128 * 128 + (size_t)srow * 128 + lc * 8;
#pragma unroll
                for (int s2 = 0; s2 < 2; ++s2)
#pragma unroll
                    for (int i = 0; i < 2; ++i) __builtin_amdgcn_global_load_lds((const unsigned*)(kg + (size_t)(64 * i) * 128 + s2 * 64), (unsigned*)(lds + s2 * STG_BYTES + wave * 1024 + i * 8192), 16, 0, 0);
                unsigned char* yb = lds + wp * STG_BYTES + XS_BYTES + (fq & 1) * 8;
#pragma unroll
                for (int j = 0; j < 4; ++j)
#pragma unroll
                    for (int i = 0; i < 4; ++i)
                        *(unsigned long long*)(yb + swz(wq * 64 + j * 16 + fr, 2 * i + (fq >> 1))) =
                            pk4(acc[i][j].x * r1[j] + bv[i].x, acc[i][j].y * r1[j] + bv[i].y, acc[i][j].z * r1[j] + bv[i].z, acc[i][j].w * r1[j] + bv[i].w);
            }
            asm volatile("s_waitcnt vmcnt(0)" ::: "memory");
            RAW_BARRIER();
            f32x4 sc2[8][2];
#pragma unroll
            for (int i = 0; i < 8; ++i)
#pragma unroll
                for (int j = 0; j < 2; ++j) sc2[i][j] = (f32x4){0.f, 0.f, 0.f, 0.f};
#pragma unroll
            for (int s2 = 0; s2 < 2; ++s2) {
                const unsigned char* st = lds + s2 * STG_BYTES;
#pragma unroll
                for (int kk = 0; kk < 2; ++kk) {
                    bf16x8 af[8], bfr[2];
#pragma unroll
                    for (int i = 0; i < 8; ++i) af[i] = *(const bf16x8*)(st + swz(i * 16 + fr, kk * 4 + fq));
#pragma unroll
                    for (int j = 0; j < 2; ++j) bfr[j] = *(const bf16x8*)(st + XS_BYTES + swz(wave * 32 + j * 16 + fr, kk * 4 + fq));
#pragma unroll
                    for (int i = 0; i < 8; ++i)
#pragma unroll
                        for (int j = 0; j < 2; ++j) sc2[i][j] = __builtin_amdgcn_mfma_f32_16x16x32_bf16(af[i], bfr[j], sc2[i][j], 0, 0, 0);
                }
            }
            tsel(sc2, 0, q0 + wave * 32, lane, (const float*)nullptr, hp, sub);
        }
    }
}

__device__ __forceinline__ int rd_lane_i(int v, int l) { return __builtin_amdgcn_readlane(v, l); }
__device__ __forceinline__ float rd_lane_f(float v, int l) { return __builtin_bit_cast(float, __builtin_amdgcn_readlane(__builtin_bit_cast(int, v), l)); }
__device__ void stage_peer_u(const Params& p) {
    const unsigned short* h2 = (const unsigned short*)(p.ws + WS_HB);
    const float* mod = (const float*)(p.ws + WS_MOD);
    const unsigned short* idx = (const unsigned short*)(p.ws + WS_IDX); float* g = (float*)(p.ws + WS_G);
    const unsigned char* eu8 = p.ws + WS_EU8;
    const float* us = (const float*)(p.ws + WS_US);
    const int tid_ = tid_opaque(); const int lane = tid_ & 63, wave = tid_ >> 6;
    for (int t = blockIdx.x * NWAVES + wave; t < T; t += gridDim.x * NWAVES) {
        const int b = t >> 12;
        f32x2 hq[8];
        {
            const float rstd1 = rsqrtf(group16_sum(((const float*)(p.ws + WS_SSQ1))[(size_t)t * 16 + (lane & 15)]) * (1.f / D) + EPS);
            const float* shf = mod + b * NMOD + 3 * D + lane * 16;
            const u32x4 w0 = *(const u32x4*)(h2 + (size_t)t * D + lane * 16), w1 = *(const u32x4*)(h2 + (size_t)t * D + lane * 16 + 8);
            const f32x4 s0 = *(const f32x4*)(shf), s1 = *(const f32x4*)(shf + 4), s2 = *(const f32x4*)(shf + 8), s3 = *(const f32x4*)(shf + 12);
            hq[0] = (f32x2){bflo(w0.x) * rstd1 + s0.x, bfhi(w0.x) * rstd1 + s0.y}; hq[1] = (f32x2){bflo(w0.y) * rstd1 + s0.z, bfhi(w0.y) * rstd1 + s0.w};
            hq[2] = (f32x2){bflo(w0.z) * rstd1 + s1.x, bfhi(w0.z) * rstd1 + s1.y}; hq[3] = (f32x2){bflo(w0.w) * rstd1 + s1.z, bfhi(w0.w) * rstd1 + s1.w};
            hq[4] = (f32x2){bflo(w1.x) * rstd1 + s2.x, bfhi(w1.x) * rstd1 + s2.y}; hq[5] = (f32x2){bflo(w1.y) * rstd1 + s2.z, bfhi(w1.y) * rstd1 + s2.w};
            hq[6] = (f32x2){bflo(w1.z) * rstd1 + s3.x, bfhi(w1.z) * rstd1 + s3.y}; hq[7] = (f32x2){bflo(w1.w) * rstd1 + s3.z, bfhi(w1.w) * rstd1 + s3.w};
        }
        const int idv0 = idx[(size_t)t * 128 + lane], idv1 = idx[(size_t)t * 128 + 64 + lane];
        float wv0 = 0.f, wv1 = 0.f;
        u32x4 cur[8], nxt[8];
#pragma unroll
        for (int i = 0; i < 8; ++i) cur[i] = *(const u32x4*)(eu8 + (size_t)rd_lane_i(idv0, i) * D + lane * 16);
#pragma unroll 2
        for (int b8 = 0; b8 < 16; ++b8) {
            const int bn = (b8 + 1 < 16) ? b8 + 1 : b8;
#pragma unroll
            for (int i = 0; i < 8; ++i) { const int r = bn * 8 + i; nxt[i] = *(const u32x4*)(eu8 + (size_t)rd_lane_i((bn < 8) ? idv0 : idv1, r & 63) * D + lane * 16); }
            float pr[8];
#pragma unroll
            for (int i = 0; i < 8; ++i) {
                f32x2 a = {0.f, 0.f}, c2 = {0.f, 0.f};
#pragma unroll
                for (int c = 0; c < 4; ++c) {
                    const f32x2 lo = __builtin_amdgcn_cvt_pk_f32_fp8((int)cur[i][c], false), hi = __builtin_amdgcn_cvt_pk_f32_fp8((int)cur[i][c], true);
                    a += lo * hq[2 * c]; c2 += hi * hq[2 * c + 1];
                }
                a += c2; pr[i] = a.x + a.y;
            }
            float x4[4], x2[2], x1;
            const bool b5 = (lane & 32) != 0, b4 = (lane & 16) != 0, b3 = (lane & 8) != 0;
#pragma unroll
            for (int i = 0; i < 4; ++i) { const float keep = b5 ? pr[i + 4] : pr[i], give = b5 ? pr[i] : pr[i + 4]; x4[i] = keep + __shfl_xor(give, 32); }
#pragma unroll
            for (int i = 0; i < 2; ++i) { const float keep = b4 ? x4[i + 2] : x4[i], give = b4 ? x4[i] : x4[i + 2]; x2[i] = keep + __shfl_xor(give, 16); }
            { const float keep = b3 ? x2[1] : x2[0], give = b3 ? x2[0] : x2[1]; x1 = keep + __shfl_xor(give, 8); }
            x1 += __shfl_xor(x1, 4); x1 += __shfl_xor(x1, 2); x1 += __shfl_xor(x1, 1);
            const float st = __shfl(x1, (lane & 7) * 8);
            const bool mine = (lane >> 3) == (b8 & 7);
            if (b8 < 8) wv0 = mine ? st : wv0; else wv1 = mine ? st : wv1;
#pragma unroll
            for (int i = 0; i < 8; ++i) cur[i] = nxt[i];
        }
        {
            const float s0 = wv0 * us[idv0], s1 = wv1 * us[idv1];
            const float gv0 = g[(size_t)t * 128 + lane], gv1 = g[(size_t)t * 128 + 64 + lane];
            wv0 = gv0 * (0.5f * s0 * (1.f + erff(s0 * 0.70710678118654752f)));
            wv1 = gv1 * (0.5f * s1 * (1.f + erff(s1 * 0.70710678118654752f)));
        }
        { float* wdst = (float*)(p.ws + WS_W); wdst[(size_t)t * 128 + lane] = wv0; wdst[(size_t)t * 128 + 64 + lane] = wv1; }
    }
}
__device__ void stage_peer_v(const Params& p, float* outp) {
    const float* mod = (const float*)(p.ws + WS_MOD);
    const unsigned short* idx = (const unsigned short*)(p.ws + WS_IDX); const float* g = (const float*)(p.ws + WS_W);
    const unsigned char* ev8 = p.ws + WS_EV8;
    const float* vs = (const float*)(p.ws + WS_VS);
    const int tid_ = tid_opaque(); const int lane = tid_ & 63, wave = tid_ >> 6;
    for (int t = blockIdx.x * NWAVES + wave; t < T; t += gridDim.x * NWAVES) {
        const int b = t >> 12;
        const int idv0 = idx[(size_t)t * 128 + lane], idv1 = idx[(size_t)t * 128 + 64 + lane];
        const float wv0 = g[(size_t)t * 128 + lane] * vs[idv0], wv1 = g[(size_t)t * 128 + 64 + lane] * vs[idv1];
        f32x2 acc[8];
#pragma unroll
        for (int i = 0; i < 8; ++i) acc[i] = (f32x2){0.f, 0.f};
        u32x4 cur[8], nxt[8];
#pragma unroll
        for (int i = 0; i < 8; ++i) cur[i] = *(const u32x4*)(ev8 + (size_t)rd_lane_i(idv0, i) * D + lane * 16);
#pragma unroll 2
        for (int b8 = 0; b8 < 16; ++b8) {
            const int bn = (b8 + 1 < 16) ? b8 + 1 : b8;
#pragma unroll
            for (int i = 0; i < 8; ++i) { const int r = bn * 8 + i; nxt[i] = *(const u32x4*)(ev8 + (size_t)rd_lane_i((bn < 8) ? idv0 : idv1, r & 63) * D + lane * 16); }
#pragma unroll
            for (int i = 0; i < 8; ++i) {
                const int r = b8 * 8 + i;
                const float wr = rd_lane_f((b8 < 8) ? wv0 : wv1, r & 63);
                const f32x2 w2 = {wr, wr};
#pragma unroll
                for (int c = 0; c < 4; ++c) {
                    const f32x2 lo = __builtin_amdgcn_cvt_pk_f32_fp8((int)cur[i][c], false), hi = __builtin_amdgcn_cvt_pk_f32_fp8((int)cur[i][c], true);
                    acc[2 * c] += w2 * lo; acc[2 * c + 1] += w2 * hi;
                }
            }
#pragma unroll
            for (int i = 0; i < 8; ++i) cur[i] = nxt[i];
        }
        const int eoff = lane * 16;
        const float* xin = p.out + (size_t)t * D + eoff;
        float* xr = outp + (size_t)t * D + eoff;
        const float* gf = mod + b * NMOD + 5 * D + eoff;
        float sel[16];
        float ss = 0.f;
#pragma unroll
        for (int c = 0; c < 4; ++c) {
            const f32x4 x1 = *(const f32x4*)(xin + c * 4); const f32x4 gg = *(const f32x4*)(gf + c * 4);
            sel[c * 4 + 0] = x1.x + gg.x * acc[2 * c].x; sel[c * 4 + 1] = x1.y + gg.y * acc[2 * c].y;
            sel[c * 4 + 2] = x1.z + gg.z * acc[2 * c + 1].x; sel[c * 4 + 3] = x1.w + gg.w * acc[2 * c + 1].y;
            ss += sel[c * 4 + 0] * sel[c * 4 + 0] + sel[c * 4 + 1] * sel[c * 4 + 1] + sel[c * 4 + 2] * sel[c * 4 + 2] + sel[c * 4 + 3] * sel[c * 4 + 3];
        }
        const float rstd = rsqrtf(wave_sum(ss) * (1.f / D) + EPS);
#pragma unroll
        for (int c = 0; c < 4; ++c) {
            const f32x4 fn = *(const f32x4*)(p.fnorm + eoff + c * 4);
            f32x4 r; r.x = sel[c * 4 + 0] * rstd * fn.x; r.y = sel[c * 4 + 1] * rstd * fn.y; r.z = sel[c * 4 + 2] * rstd * fn.z; r.w = sel[c * 4 + 3] * rstd * fn.w;
            *(f32x4*)(xr + c * 4) = r;
        }
    }
}

#define LAS __attribute__((address_space(3)))
constexpr size_t WS_BAR = 3 * MiB;
constexpr int BAR_BYTES = 16384;
constexpr int LDS_MISC_OFF = 147456;
#define XB_TMO      128
#define XB_XCNT(j)  (256  + 64 * (j))
#define XB_XSUB(j)  (1280 + 64 * (j))
#define XB_XGEN(j)  (2304 + 64 * (j))
#define XB_TOP      3328
#define XB_TOPGEN   3392
#define XB_SPIN_CAP (1u << 18)
__device__ __forceinline__ unsigned xb_ld(unsigned* p)              { return __hip_atomic_load(p, __ATOMIC_RELAXED, __HIP_MEMORY_SCOPE_AGENT); }
__device__ __forceinline__ unsigned xb_add(unsigned* p, unsigned v) { return __hip_atomic_fetch_add(p, v, __ATOMIC_RELAXED, __HIP_MEMORY_SCOPE_AGENT); }
__device__ __forceinline__ unsigned xb_xcc_id() { return (unsigned)__builtin_amdgcn_s_getreg((3 << 11) | 20) & 0xFu; }
#define XB_SPIN(cond, bar) do { unsigned _sp = 0; while (cond) { __builtin_amdgcn_s_sleep(1); \
    if ((++_sp & 255u) == 0u) { if (xb_ld(&(bar)[XB_TMO])) break; if (_sp > XB_SPIN_CAP) { atomicAdd(&(bar)[XB_TMO], 1u); break; } } } } while (0)
struct XcdBarrier { unsigned* bar; unsigned x; volatile LAS unsigned* st; };
__device__ __forceinline__ XcdBarrier xcd_barrier_post(unsigned* bar, volatile LAS unsigned* st) {
    XcdBarrier b; b.bar = bar; b.x = xb_xcc_id(); b.st = st;
    if (threadIdx.x == 0) (void)xb_add(&bar[XB_XCNT(b.x)], 1u);
    return b;
}
__device__ __forceinline__ void xcd_barrier_complete(unsigned* bar, unsigned x, unsigned& nloc, unsigned& nx) {
    const unsigned G = gridDim.x * gridDim.y * gridDim.z;
    unsigned sum, cnt, mine, sp = 0u;
    for (;;) {
        sum = 0u; cnt = 0u; mine = 0u;
#pragma unroll
        for (unsigned j = 0; j < 16; ++j) { const unsigned c = xb_ld(&bar[XB_XCNT(j)]); sum += c; cnt += (c > 0u) ? 1u : 0u; mine = (j == x) ? c : mine; }
        if (sum == G) break;
        __builtin_amdgcn_s_sleep(1);
        if ((++sp & 255u) == 0u) { if (xb_ld(&bar[XB_TMO])) break; if (sp > XB_SPIN_CAP) { atomicAdd(&bar[XB_TMO], 1u); break; } }
    }
    nloc = mine > 0u ? mine : 1u; nx = cnt > 0u ? cnt : 1u;
}
__device__ __forceinline__ void xcd_barrier(const XcdBarrier& b) {
    asm volatile("s_waitcnt vmcnt(0)" ::: "memory");
    __syncthreads();
    if (threadIdx.x == 0) {
        unsigned* bar = b.bar;
        __builtin_amdgcn_s_waitcnt(0);
        unsigned nloc = b.st[0], nx = b.st[1];
        if (nloc == 0u) { xcd_barrier_complete(bar, b.x, nloc, nx); b.st[0] = nloc; b.st[1] = nx; }
        const unsigned old = xb_add(&bar[XB_XSUB(b.x)], 1u);
        const unsigned gen = old / nloc;
        if (old + 1u == (gen + 1u) * nloc) {
            __builtin_amdgcn_fence(__ATOMIC_RELEASE, "agent");
            asm volatile("s_waitcnt vmcnt(0)" ::: "memory");
            const unsigned og = xb_add(&bar[XB_TOP], 1u);
            const unsigned tg = og / nx;
            if (og + 1u == (tg + 1u) * nx) xb_add(&bar[XB_TOPGEN], 1u);
            else XB_SPIN(xb_ld(&bar[XB_TOPGEN]) == tg, bar);
            __builtin_amdgcn_fence(__ATOMIC_ACQUIRE, "agent");
            xb_add(&bar[XB_XGEN(b.x)], 1u);
            asm volatile("s_waitcnt vmcnt(0)" ::: "memory");
        } else {
            XB_SPIN(xb_ld(&bar[XB_XGEN(b.x)]) == gen, bar);
            __builtin_amdgcn_fence(__ATOMIC_ACQUIRE, "agent");
            asm volatile("s_waitcnt vmcnt(0)" ::: "memory");
        }
    }
    __syncthreads();
}

__global__ void __launch_bounds__(NTHREADS) fwd_megakernel(Params p) {
    extern __shared__ __attribute__((aligned(16))) unsigned char lds_raw[];
    cg::grid_group grid = cg::this_grid();
    unsigned short* hb = (unsigned short*)(p.ws + WS_HB);
    const float* mod = (const float*)(p.ws + WS_MOD);
    typedef const unsigned short* cbf;

    volatile LAS unsigned* bst = (volatile LAS unsigned*)((LAS unsigned char*)lds_raw + LDS_MISC_OFF);
    if (threadIdx.x < 2) bst[threadIdx.x] = 0u;
    __syncthreads();
    const XcdBarrier xbar = xcd_barrier_post((unsigned*)(p.ws + WS_BAR), bst);
    stage_prologue(p, (float*)lds_raw);
    if (p.ws == nullptr) grid.sync();
    xcd_barrier(xbar);
    stage_norm_mod<true>(p, p.x, hb, 0 * D, 1 * D);
    stage_gemv8(mod + 3 * D, NMOD, false, p.w_pq, 2048, nullptr, (float*)(p.ws + WS_BPQ), (float*)lds_raw);
    xcd_barrier(xbar);
    gemm_dma<2, 1>((cbf)(p.ws + WS_WIN), D, hb, D, 1280, T, D, 1, 0, 0, lds_raw, EpiProj{p.ws});
    xcd_barrier(xbar);
    gemm_xyT<2, true>((cbf)(p.ws + WS_WQUP), 256, (cbf)(p.ws + WS_QL), 256, 768, T, 256, 1, 0, 0, lds_raw, EpiQup{p.ws});
    gemm_xyT<2, true>((cbf)(p.ws + WS_WKVUP), 128, (cbf)(p.ws + WS_KVL), 128, 1024, T, 128, 1, 0, 0, lds_raw, EpiKVup{p.ws});
    xcd_barrier(xbar);
    stage_attn_flash<64, true>(p, lds_raw);
    stage_attn_flash<96, false>(p, lds_raw);
    xcd_barrier(xbar);
    gemm_dma<2, 1>((cbf)(p.ws + WS_WOUT), D, (cbf)(p.ws + WS_OAB), D, D, T, D, 1, 0, 0, lds_raw,
                   EpiOutProj{p.x, mod, p.out, hb, (const float*)(p.ws + WS_SSQO), (float*)(p.ws + WS_SSQ1), {}, {}, {}});
    xcd_barrier(xbar);
    gemm_pq_fused(p, lds_raw);
    xcd_barrier(xbar);
    stage_peer_u(p);
    xcd_barrier(xbar);
    stage_peer_v(p, p.out);
}

extern "C" void kernel_launch(void* const* d_in, const int* in_sizes, int n_in, void* d_out, int out_size, void* d_ws, size_t ws_size, hipStream_t stream) {
    static int grid_blocks = 0;
    if (grid_blocks == 0) {
        if (n_in != 18 || in_sizes[0] != T * D || out_size != T * D || ws_size < WS_END) {
            fprintf(stderr, "kernel_launch: unexpected shapes (n_in %d, in0 %d, out %d, ws %zu); nothing launched\n", n_in, n_in > 0 ? in_sizes[0] : -1, out_size, ws_size);
            grid_blocks = -1; return;
        }
        int dev = 0, cus = 0, per_cu = 0;
        (void)hipGetDevice(&dev);
        (void)hipDeviceGetAttribute(&cus, hipDeviceAttributeMultiprocessorCount, dev);
        if (hipFuncSetAttribute((const void*)fwd_megakernel, hipFuncAttributeMaxDynamicSharedMemorySize, LDS_BYTES) != hipSuccess) { fprintf(stderr, "kernel_launch: hipFuncSetAttribute failed\n"); grid_blocks = -1; return; }
        (void)hipOccupancyMaxActiveBlocksPerMultiprocessor(&per_cu, fwd_megakernel, NTHREADS, LDS_BYTES);
        if (per_cu < 1) { fprintf(stderr, "kernel_launch: occupancy query says %d blocks/CU\n", per_cu); grid_blocks = -1; return; }
        grid_blocks = cus < 256 ? cus : 256;
    }
    if (grid_blocks < 0) return;
    Params p{};
    p.x = (const float*)d_in[0]; p.c = (const float*)d_in[1]; p.w_ada = (const float*)d_in[2]; p.b_ada = (const float*)d_in[3];
    p.w_in = (const float*)d_in[4]; p.sink = (const float*)d_in[5]; p.qnorm = (const float*)d_in[6]; p.w_qup = (const float*)d_in[7];
    p.kvnorm = (const float*)d_in[8]; p.w_kvup = (const float*)d_in[9]; p.onorm_a = (const float*)d_in[10]; p.onorm_b = (const float*)d_in[11];
    p.w_out = (const float*)d_in[12]; p.w_pq = (const float*)d_in[13]; p.subk = (const float*)d_in[14]; p.eu = (const float*)d_in[15];
    p.ev = (const float*)d_in[16]; p.fnorm = (const float*)d_in[17];
    p.out = (float*)d_out; p.ws = (unsigned char*)d_ws;
    if (hipMemsetAsync((char*)d_ws + WS_BAR, 0, BAR_BYTES, stream) != hipSuccess) { fprintf(stderr, "kernel_launch: hipMemsetAsync failed\n"); return; }
    void* args[] = {&p};
    hipError_t e = hipLaunchCooperativeKernel((void*)fwd_megakernel, dim3(grid_blocks), dim3(NTHREADS), args, LDS_BYTES, stream);
    if (e != hipSuccess) fprintf(stderr, "cooperative launch failed: %s (grid %d)\n", hipGetErrorString(e), grid_blocks);
}
```
